# Optimizing an MI355X kernel written in HIP

```python
import math
import jax
import jax.numpy as jnp
from jax import lax
import numpy as np

D_MODEL = 1024
BATCH = 16
SEQ = 4096
DEPTH = 1
DEC_BATCH = 16
DEC_SEQ = 64
PAST_LEN = 1024

CHUNK = 64
RMS_EPS = 1e-6
RW_HEADS = 8
RW_HEAD_DIM = 64
RW_WIDTH = RW_HEADS * RW_HEAD_DIM
LORA_W = 64
LORA_A = 64
LORA_G = 128
RW_COLS = 3 * RW_WIDTH + LORA_W + LORA_A + LORA_G
GN_EPS = 64e-5
ATT_Q_HEADS = 8
ATT_KV_HEADS = 2
ATT_HEAD_DIM = 64
ATT_GROUP = ATT_Q_HEADS // ATT_KV_HEADS
ATT_Q_WIDTH = ATT_Q_HEADS * ATT_HEAD_DIM
ATT_KV_WIDTH = ATT_KV_HEADS * ATT_HEAD_DIM
ATT_COLS = ATT_Q_WIDTH + 2 * ATT_KV_WIDTH
WINDOW = 128
N_PREV_CHUNKS = WINDOW // CHUNK
N_BRANCH = 2
BRANCH_WIDTH = 512
GATE_COLS = N_BRANCH * D_MODEL
IN_COLS = RW_COLS + ATT_COLS + GATE_COLS
O_R = 0
O_K = O_R + RW_WIDTH
O_V = O_K + RW_WIDTH
O_W = O_V + RW_WIDTH
O_A = O_W + LORA_W
O_G = O_A + LORA_A
O_GATE = RW_COLS + ATT_COLS
PEER_HEADS = 8
PEER_NKEYS = 128
PEER_EXPERTS = PEER_NKEYS * PEER_NKEYS
PEER_KEY_DIM = 128
PEER_HALF = PEER_KEY_DIM // 2
PEER_TOPK = 16
PEER_BLOCK = 256

kernel_name = "rwkv7_swa_peer_streaming_step"


def rms_norm(x, g):
    xf = x.astype(jnp.float32)
    y = xf * lax.rsqrt(jnp.mean(xf * xf, axis=-1, keepdims=True) + RMS_EPS)
    return (y * g.astype(jnp.float32)).astype(x.dtype)


def project_inputs(h, h_prev, w_in, mu_shift):
    p = jnp.einsum('btd,dc->btc', h, w_in)
    p_rw = p[..., :RW_COLS]
    prev_row = jnp.einsum('bd,dc->bc', h_prev.astype(h.dtype), w_in[:, :RW_COLS])
    p_shift = jnp.concatenate([prev_row[:, None], p_rw[:, :-1]], axis=1)
    p_rw = p_rw + (p_shift - p_rw) * mu_shift
    return p_rw, p[..., RW_COLS:O_GATE], p[..., O_GATE:]


def rwkv7_branch(p_rw, wkv0, w0, w2, a0, a2, g2, k_k, k_a, r_k, lnx_w, lnx_b):
    B, T, _ = p_rw.shape
    f = p_rw.astype(jnp.float32)
    r = f[..., O_R:O_K]
    k = f[..., O_K:O_V]
    v = f[..., O_V:O_W]
    xw = f[..., O_W:O_A]
    xa = f[..., O_A:O_G]
    xg = f[..., O_G:RW_COLS]
    w = -jax.nn.softplus(-(w0 + jnp.tanh(xw) @ w2)) - 0.5
    decay = jnp.exp(-jnp.exp(w))
    a = jax.nn.sigmoid(a0 + xa @ a2)
    g = jax.nn.sigmoid(xg) @ g2
    heads = lambda t: t.reshape(B, T, RW_HEADS, RW_HEAD_DIM)
    kk = heads(k * k_k)
    kk = kk / jnp.maximum(jnp.sqrt(jnp.sum(kk * kk, axis=-1, keepdims=True)), 1e-12)
    k = k * (1.0 + (a - 1.0) * k_a)
    r_h, k_h, v_h, d_h, a_h = heads(r), heads(k), heads(v), heads(decay), heads(a)
    b_h = kk * a_h

    def step(S, inp):
        r_t, d_t, k_t, v_t, kk_t, b_t = inp
        sa = jnp.einsum('bhij,bhj->bhi', S, -kk_t)
        S = S * d_t[:, :, None, :] + sa[..., None] * b_t[:, :, None, :] + v_t[..., None] * k_t[:, :, None, :]
        y_t = jnp.einsum('bhij,bhj->bhi', S, r_t)
        return S, y_t

    xs = tuple(jnp.moveaxis(t, 1, 0) for t in (r_h, d_h, k_h, v_h, kk, b_h))
    S_fin, ys = lax.scan(step, wkv0.astype(jnp.float32), xs)
    y = jnp.moveaxis(ys, 0, 1)
    mean = jnp.mean(y, axis=-1, keepdims=True)
    var = jnp.mean(jnp.square(y - mean), axis=-1, keepdims=True)
    y = (y - mean) * lax.rsqrt(var + GN_EPS)
    y = y * lnx_w.astype(jnp.float32).reshape(RW_HEADS, RW_HEAD_DIM) + lnx_b.astype(jnp.float32).reshape(RW_HEADS, RW_HEAD_DIM)
    y = y + jnp.sum(r_h * k_h * r_k.astype(jnp.float32), axis=-1, keepdims=True) * v_h
    out = y.reshape(B, T, RW_WIDTH) * g
    return out.astype(p_rw.dtype), S_fin


def attn_core(q, k, v, q_pos, k_pos, k_valid, sinks):
    scale = ATT_HEAD_DIM ** -0.5
    s = jnp.einsum('bnqhgd,bnkhd->bnhgqk', q.astype(jnp.float32), k.astype(jnp.float32)) * scale
    slopes = jnp.exp2(-8.0 * jnp.arange(1, ATT_Q_HEADS + 1, dtype=jnp.float32) / ATT_Q_HEADS)
    slopes = slopes.reshape(ATT_KV_HEADS, ATT_GROUP)[None, None, :, :, None, None]
    dist = jnp.abs(q_pos[:, :, None] - k_pos[:, None, :]).astype(jnp.float32)
    s = s - slopes * dist[None, :, None, None, :, :]
    s = jnp.where(k_valid[None, :, None, None, None, :], s, -1e30)
    sink = sinks.astype(jnp.float32).reshape(ATT_KV_HEADS, ATT_GROUP)[None, None, :, :, None, None]
    m = jnp.maximum(jnp.max(s, axis=-1, keepdims=True), sink)
    p = jnp.exp(s - m)
    denom = jnp.sum(p, axis=-1, keepdims=True) + jnp.exp(sink - m)
    return jnp.einsum('bnhgqk,bnkhd->bnqhgd', p / denom, v.astype(jnp.float32))


def split_attn_cols(p_att):
    B, T, _ = p_att.shape
    q = p_att[..., :ATT_Q_WIDTH].reshape(B, T, ATT_KV_HEADS, ATT_GROUP, ATT_HEAD_DIM)
    k = p_att[..., ATT_Q_WIDTH:ATT_Q_WIDTH + ATT_KV_WIDTH].reshape(B, T, ATT_KV_HEADS, ATT_HEAD_DIM)
    v = p_att[..., ATT_Q_WIDTH + ATT_KV_WIDTH:].reshape(B, T, ATT_KV_HEADS, ATT_HEAD_DIM)
    return q, k, v


def attn_prompt(p_att, sinks):
    B, T, _ = p_att.shape
    nC = T // CHUNK
    q, k, v = split_attn_cols(p_att)
    qb = q.reshape(B, nC, CHUNK, ATT_KV_HEADS, ATT_GROUP, ATT_HEAD_DIM)
    pad = ((0, 0), (N_PREV_CHUNKS, 0), (0, 0), (0, 0), (0, 0))
    kp = jnp.pad(k.reshape(B, nC, CHUNK, ATT_KV_HEADS, ATT_HEAD_DIM), pad)
    vp = jnp.pad(v.reshape(B, nC, CHUNK, ATT_KV_HEADS, ATT_HEAD_DIM), pad)
    kband = jnp.concatenate([kp[:, j:j + nC] for j in range(N_PREV_CHUNKS + 1)], axis=2)
    vband = jnp.concatenate([vp[:, j:j + nC] for j in range(N_PREV_CHUNKS + 1)], axis=2)
    c = jnp.arange(nC)
    q_pos = c[:, None] * CHUNK + jnp.arange(CHUNK)[None, :]
    k_pos = (c[:, None] - N_PREV_CHUNKS) * CHUNK + jnp.arange((N_PREV_CHUNKS + 1) * CHUNK)[None, :]
    o = attn_core(qb, kband, vband, q_pos, k_pos, k_pos >= 0, sinks)
    keep = min(WINDOW, T)
    return o.reshape(B, T, ATT_Q_WIDTH).astype(p_att.dtype), k[:, T - keep:], v[:, T - keep:]


def attn_sample(p_att, cache_k, cache_v, sinks):
    B, S, _ = p_att.shape
    L = cache_k.shape[1]
    q, k, v = split_attn_cols(p_att)
    k_all = jnp.concatenate([cache_k.astype(k.dtype), k], axis=1)[:, None]
    v_all = jnp.concatenate([cache_v.astype(v.dtype), v], axis=1)[:, None]
    q_pos = (PAST_LEN + jnp.arange(S))[None, :]
    k_pos = (PAST_LEN - L + jnp.arange(L + S))[None, :]
    valid = jnp.ones((1, L + S), dtype=bool)
    o = attn_core(q[:, None], k_all, v_all, q_pos, k_pos, valid, sinks)
    return o.reshape(B, S, ATT_Q_WIDTH).astype(p_att.dtype), k, v


def merge_branches(o_rw, o_att, p_gate, w_branch, w_out):
    B, T, _ = p_gate.shape
    gates = jax.nn.sigmoid(p_gate.astype(jnp.float32)).astype(o_rw.dtype).reshape(B, T, N_BRANCH, D_MODEL)
    merged = gates[:, :, 0] * (o_rw @ w_branch[0]) + gates[:, :, 1] * (o_att @ w_branch[1])
    return merged @ w_out


def peer(h, w_q, sub_keys, u, v):
    B, T, D = h.shape
    n = B * T
    n_pad = (-n) % PEER_BLOCK
    blocks = jnp.pad(h.reshape(n, D), ((0, n_pad), (0, 0))).reshape(-1, PEER_BLOCK, D)

    def one_block(hb):
        q = (hb @ w_q).reshape(PEER_BLOCK, PEER_HEADS, 2, PEER_HALF).astype(jnp.float32)
        s = jnp.einsum('bhpk,pnk->bhpn', q, sub_keys.astype(jnp.float32))
        s1, i1 = lax.top_k(s[:, :, 0], PEER_TOPK)
        s2, i2 = lax.top_k(s[:, :, 1], PEER_TOPK)
        cand = (s1[..., :, None] + s2[..., None, :]).reshape(PEER_BLOCK, PEER_HEADS, PEER_TOPK * PEER_TOPK)
        cidx = (i1[..., :, None] * PEER_NKEYS + i2[..., None, :]).reshape(PEER_BLOCK, PEER_HEADS, PEER_TOPK * PEER_TOPK)
        best, pos = lax.top_k(cand, PEER_TOPK)
        idx = jnp.take_along_axis(cidx, pos, axis=-1)
        gate = jax.nn.softmax(best, axis=-1)
        ue = u[idx]
        ve = v[idx]
        act = jax.nn.gelu(jnp.einsum('bhkd,bd->bhk', ue, hb).astype(jnp.float32), approximate=False) * gate
        return jnp.einsum('bhk,bhkd->bd', act.astype(hb.dtype), ve)

    out = lax.map(one_block, blocks).reshape(-1, D)[:n]
    return out.reshape(B, T, D)


def trunk_layer(x, h_prev, wkv0, cache_k, cache_v, norm1_g, w_in, mu_shift, w_decay0, w_decay_lora,
                a_icl0, a_icl_lora, g_lora, k_k, k_a, r_k, lnx_w, lnx_b, attn_sinks, w_branch, w_out,
                norm2_g, peer_wq, peer_sub_keys, peer_u, peer_v):
    h = rms_norm(x, norm1_g)
    p_rw, p_att, p_gate = project_inputs(h, h_prev, w_in, mu_shift)
    o_rw, wkv_new = rwkv7_branch(p_rw, wkv0, w_decay0, w_decay_lora, a_icl0, a_icl_lora, g_lora,
                                 k_k, k_a, r_k, lnx_w, lnx_b)
    if cache_k is None:
        o_att, k_new, v_new = attn_prompt(p_att, attn_sinks)
    else:
        o_att, k_new, v_new = attn_sample(p_att, cache_k, cache_v, attn_sinks)
    x = x + merge_branches(o_rw, o_att, p_gate, w_branch, w_out)
    x = x + peer(rms_norm(x, norm2_g), peer_wq, peer_sub_keys, peer_u, peer_v)
    return x, h[:, -1], wkv_new.astype(x.dtype), k_new, v_new


def setup_inputs(seed: int = 0) -> dict:
    key = jax.random.key(seed)
    ks = iter(jax.random.split(key, 40))
    nrm = lambda shape, scale: jax.random.normal(next(ks), shape, jnp.float32) * scale
    att_cache = min(WINDOW, PAST_LEN)
    D = D_MODEL
    return {
        "x_prompt": nrm((BATCH, SEQ, D), 1.0),
        "x_sample": nrm((DEC_BATCH, DEC_SEQ, D), 1.0),
        "state_shift": nrm((DEPTH, DEC_BATCH, D), 1.0),
        "state_wkv": nrm((DEPTH, DEC_BATCH, RW_HEADS, RW_HEAD_DIM, RW_HEAD_DIM), 0.5),
        "cache_k": nrm((DEPTH, DEC_BATCH, att_cache, ATT_KV_HEADS, ATT_HEAD_DIM), 1.0),
        "cache_v": nrm((DEPTH, DEC_BATCH, att_cache, ATT_KV_HEADS, ATT_HEAD_DIM), 1.0),
        "norm1_g": 1.0 + nrm((DEPTH, D), 0.02),
        "w_in": nrm((DEPTH, D, IN_COLS), D ** -0.5),
        "mu_shift": jax.random.uniform(next(ks), (DEPTH, RW_COLS), jnp.float32),
        "w_decay0": jax.random.uniform(next(ks), (DEPTH, RW_WIDTH), jnp.float32, minval=-6.0, maxval=1.0),
        "w_decay_lora": nrm((DEPTH, LORA_W, RW_WIDTH), 0.1),
        "a_icl0": nrm((DEPTH, RW_WIDTH), 0.1),
        "a_icl_lora": nrm((DEPTH, LORA_A, RW_WIDTH), 0.1),
        "g_lora": nrm((DEPTH, LORA_G, RW_WIDTH), LORA_G ** -0.5),
        "k_k": 0.85 + nrm((DEPTH, RW_WIDTH), 0.02),
        "k_a": 1.0 + nrm((DEPTH, RW_WIDTH), 0.02),
        "r_k": nrm((DEPTH, RW_HEADS, RW_HEAD_DIM), 0.1),
        "lnx_w": 1.0 + nrm((DEPTH, RW_WIDTH), 0.02),
        "lnx_b": nrm((DEPTH, RW_WIDTH), 0.02),
        "attn_sinks": nrm((DEPTH, ATT_Q_HEADS), 0.5),
        "w_branch": nrm((DEPTH, N_BRANCH, BRANCH_WIDTH, D), BRANCH_WIDTH ** -0.5),
        "w_out": nrm((DEPTH, D, D), D ** -0.5),
        "norm2_g": 1.0 + nrm((DEPTH, D), 0.02),
        "peer_wq": nrm((DEPTH, D, PEER_HEADS * PEER_KEY_DIM), D ** -0.5),
        "peer_sub_keys": nrm((DEPTH, 2, PEER_NKEYS, PEER_HALF), PEER_HALF ** -0.5),
        "peer_u": nrm((DEPTH, PEER_EXPERTS, D), D ** -0.5),
        "peer_v": nrm((DEPTH, PEER_EXPERTS, D), (PEER_HEADS * PEER_TOPK) ** -0.5),
        "final_g": 1.0 + nrm((D,), 0.02),
    }


def reference(x_prompt, x_sample, state_shift, state_wkv, cache_k, cache_v, norm1_g, w_in, mu_shift,
              w_decay0, w_decay_lora, a_icl0, a_icl_lora, g_lora, k_k, k_a, r_k, lnx_w, lnx_b,
              attn_sinks, w_branch, w_out, norm2_g, peer_wq, peer_sub_keys, peer_u, peer_v, final_g):
    yp = x_prompt
    ys = x_sample
    shift_p, wkv_p, k_p, v_p = [], [], [], []
    shift_s, wkv_s, k_s, v_s = [], [], [], []
    for l in range(DEPTH):
        lp = (norm1_g[l], w_in[l], mu_shift[l], w_decay0[l], w_decay_lora[l], a_icl0[l], a_icl_lora[l],
              g_lora[l], k_k[l], k_a[l], r_k[l], lnx_w[l], lnx_b[l], attn_sinks[l], w_branch[l], w_out[l],
              norm2_g[l], peer_wq[l], peer_sub_keys[l], peer_u[l], peer_v[l])
        h0 = jnp.zeros((yp.shape[0], D_MODEL), yp.dtype)
        s0 = jnp.zeros((yp.shape[0], RW_HEADS, RW_HEAD_DIM, RW_HEAD_DIM), jnp.float32)
        yp, a1, a2, a3, a4 = trunk_layer(yp, h0, s0, None, None, *lp)
        shift_p.append(a1)
        wkv_p.append(a2)
        k_p.append(a3)
        v_p.append(a4)
        ys, b1, b2, b3, b4 = trunk_layer(ys, state_shift[l], state_wkv[l], cache_k[l], cache_v[l], *lp)
        shift_s.append(b1)
        wkv_s.append(b2)
        k_s.append(b3)
        v_s.append(b4)
    y_prompt = rms_norm(yp, final_g)
    y_sample = rms_norm(ys, final_g)
    return (y_prompt, y_sample, jnp.stack(shift_p), jnp.stack(wkv_p), jnp.stack(k_p), jnp.stack(v_p),
            jnp.stack(shift_s), jnp.stack(wkv_s), jnp.stack(k_s), jnp.stack(v_s))
```

```cpp
#include <hip/hip_runtime.h>
#include <hip/hip_cooperative_groups.h>
#include <cstdio>
namespace cg = cooperative_groups;

#ifndef MEGA
#define MEGA 0
#endif

typedef unsigned short u16;
typedef unsigned int u32;
using bf16x8 = __attribute__((ext_vector_type(8))) short;
using f32x4 = __attribute__((ext_vector_type(4))) float;
using f32x16 = __attribute__((ext_vector_type(16))) float;
using u32x4 = __attribute__((ext_vector_type(4))) u32;
#define DI __device__ __forceinline__

constexpr int TP = 65536, TS = 1024, T = 66560, MP = 66688;
constexpr int INC = 4608;
constexpr size_t OFF_Y = 0, OFF_SHIFT_P = 68157440, OFF_WKV_P = 68173824, OFF_KP = 68698112, OFF_VP = 68960256,
                 OFF_SHIFT_S = 69222400, OFF_WKV_S = 69238784, OFF_KS = 69763072, OFF_VS = 69894144;
constexpr int SMEM_BYTES = 52736;

struct Params {
  const float *x_prompt, *x_sample, *state_shift, *state_wkv, *cache_k, *cache_v, *norm1_g, *w_in, *mu, *w0, *w2, *a0,
      *a2, *g2, *k_k, *k_a, *r_k, *lnx_w, *lnx_b, *sinks, *w_branch, *w_out, *norm2_g, *peer_wq, *sub_keys, *peer_u,
      *peer_v, *final_g;
  float* out;
  u16 *H, *P, *Ubf, *Vbf, *WinT, *WbT, *WoutT, *WqT, *W2T, *A2T, *G2T, *SK, *Y, *G, *OATT;
};

DI u16 f2bf(float x) {
  u32 u = __float_as_uint(x);
  u += 0x7fffu + ((u >> 16) & 1u);
  return (u16)(u >> 16);
}
DI float bf2f(u16 b) { return __uint_as_float(((u32)b) << 16); }
DI u32 pack2(float a, float b) { return (u32)f2bf(a) | ((u32)f2bf(b) << 16); }
DI float bflo(u32 w) { return __uint_as_float(w << 16); }
DI float bfhi(u32 w) { return __uint_as_float(w & 0xffff0000u); }
DI float wave_sum(float v) {
#pragma unroll
  for (int o = 32; o; o >>= 1) v += __shfl_xor(v, o);
  return v;
}
DI float sigmoidf_(float x) { return 1.f / (1.f + __expf(-x)); }
DI const float* xrow(const Params& p, int g) {
  return g < TP ? p.x_prompt + (size_t)g * 1024 : p.x_sample + (size_t)(g - TP) * 1024;
}
#define MFMA32(a, b, c) __builtin_amdgcn_mfma_f32_32x32x16_bf16((a), (b), (c), 0, 0, 0)
#define MFMA16(a, b, c) __builtin_amdgcn_mfma_f32_16x16x32_bf16((a), (b), (c), 0, 0, 0)

DI void tcvt(const float* __restrict__ W, u16* __restrict__ Wt, int K, int N, int gt, int nt) {
  const int total = N * (K / 8);
  for (int i = gt; i < total; i += nt) {
    const int n = i % N, kg = i / N;
    u32 o[4];
#pragma unroll
    for (int j = 0; j < 4; j++)
      o[j] = pack2(W[(size_t)(kg * 8 + 2 * j) * N + n], W[(size_t)(kg * 8 + 2 * j + 1) * N + n]);
    *(uint4*)(Wt + (size_t)n * K + kg * 8) = make_uint4(o[0], o[1], o[2], o[3]);
  }
}
DI void scvt(const float* __restrict__ W, u16* __restrict__ O, int n8, int gt, int nt) {
  for (int i = gt; i < n8; i += nt) {
    const float4 a = ((const float4*)W)[2 * i], b = ((const float4*)W)[2 * i + 1];
    ((uint4*)O)[i] = make_uint4(pack2(a.x, a.y), pack2(a.z, a.w), pack2(b.x, b.y), pack2(b.z, b.w));
  }
}

__device__ void ph_prep(const Params& p, int bid, int nb) {
  const int tid = threadIdx.x, lane = tid & 63, wv = tid >> 6;
  for (int row = bid * 4 + wv; row < MP; row += nb * 4) {
    u16* hr = p.H + (size_t)row * 1024;
    if (row < T) {
      const float4* x = (const float4*)xrow(p, row);
      float4 v[4];
      float ss = 0.f;
#pragma unroll
      for (int i = 0; i < 4; i++) {
        v[i] = x[lane + i * 64];
        ss += v[i].x * v[i].x + v[i].y * v[i].y + v[i].z * v[i].z + v[i].w * v[i].w;
      }
      ss = wave_sum(ss);
      const float rs = rsqrtf(ss * (1.f / 1024.f) + 1e-6f);
      float* so = nullptr;
      if (row < TP) {
        if ((row & 4095) == 4095) so = p.out + OFF_SHIFT_P + (size_t)(row >> 12) * 1024;
      } else {
        const int r2 = row - TP;
        if ((r2 & 63) == 63) so = p.out + OFF_SHIFT_S + (size_t)(r2 >> 6) * 1024;
      }
#pragma unroll
      for (int i = 0; i < 4; i++) {
        const float4 g = ((const float4*)p.norm1_g)[lane + i * 64];
        float4 y;
        y.x = v[i].x * rs * g.x; y.y = v[i].y * rs * g.y; y.z = v[i].z * rs * g.z; y.w = v[i].w * rs * g.w;
        ((uint2*)hr)[lane + i * 64] = make_uint2(pack2(y.x, y.y), pack2(y.z, y.w));
        if (so) ((float4*)so)[lane + i * 64] = y;
      }
    } else if (row < T + 16) {
      const float4* x = (const float4*)(p.state_shift + (size_t)(row - T) * 1024);
#pragma unroll
      for (int i = 0; i < 4; i++) {
        const float4 y = x[lane + i * 64];
        ((uint2*)hr)[lane + i * 64] = make_uint2(pack2(y.x, y.y), pack2(y.z, y.w));
      }
    } else {
#pragma unroll
      for (int i = 0; i < 4; i++) ((uint2*)hr)[lane + i * 64] = make_uint2(0u, 0u);
    }
  }
  const int gt = bid * 256 + tid, nt = nb * 256;
  tcvt(p.w_in, p.WinT, 1024, 4608, gt, nt);
  tcvt(p.w_branch, p.WbT, 512, 1024, gt, nt);
  tcvt(p.w_branch + 512 * 1024, p.WbT + 1024 * 512, 512, 1024, gt, nt);
  tcvt(p.w_out, p.WoutT, 1024, 1024, gt, nt);
  tcvt(p.peer_wq, p.WqT, 1024, 1024, gt, nt);
  tcvt(p.w2, p.W2T, 64, 512, gt, nt);
  tcvt(p.a2, p.A2T, 64, 512, gt, nt);
  tcvt(p.g2, p.G2T, 128, 512, gt, nt);
  scvt(p.sub_keys, p.SK, 2 * 128 * 64 / 8, gt, nt);
  scvt(p.peer_u, p.Ubf, 16384 * 1024 / 8, gt, nt);
  scvt(p.peer_v, p.Vbf, 16384 * 1024 / 8, gt, nt);
}

DI void gemm_mainloop(const u16* __restrict__ A, int lda, const u16* __restrict__ B, int ldb, int K, u16* As, u16* Bs,
                      f32x16 (&acc)[2][2]) {
  const int tid = threadIdx.x, lane = tid & 63, wv = tid >> 6;
  const int wm = wv >> 1, wn = wv & 1, l31 = lane & 31, kh = lane >> 5;
  const int lr = tid >> 3, lc = (tid & 7) * 8;
  u32x4 ra[4], rb[4];
#pragma unroll
  for (int i = 0; i < 4; i++) {
    ra[i] = *(const u32x4*)(A + (size_t)(lr + i * 32) * lda + lc);
    rb[i] = *(const u32x4*)(B + (size_t)(lr + i * 32) * ldb + lc);
  }
#pragma unroll
  for (int mi = 0; mi < 2; mi++)
#pragma unroll
    for (int ni = 0; ni < 2; ni++)
#pragma unroll
      for (int i = 0; i < 16; i++) acc[mi][ni][i] = 0.f;
  for (int k0 = 0; k0 < K; k0 += 64) {
    __syncthreads();
#pragma unroll
    for (int i = 0; i < 4; i++) {
      *(u32x4*)(As + (lr + i * 32) * 72 + lc) = ra[i];
      *(u32x4*)(Bs + (lr + i * 32) * 72 + lc) = rb[i];
    }
    __syncthreads();
    if (k0 + 64 < K) {
#pragma unroll
      for (int i = 0; i < 4; i++) {
        ra[i] = *(const u32x4*)(A + (size_t)(lr + i * 32) * lda + k0 + 64 + lc);
        rb[i] = *(const u32x4*)(B + (size_t)(lr + i * 32) * ldb + k0 + 64 + lc);
      }
    }
#pragma unroll
    for (int kk = 0; kk < 4; kk++) {
      bf16x8 a[2], b[2];
#pragma unroll
      for (int mi = 0; mi < 2; mi++) a[mi] = *(const bf16x8*)(As + (wm * 64 + mi * 32 + l31) * 72 + kk * 16 + kh * 8);
#pragma unroll
      for (int ni = 0; ni < 2; ni++) b[ni] = *(const bf16x8*)(Bs + (wn * 64 + ni * 32 + l31) * 72 + kk * 16 + kh * 8);
#pragma unroll
      for (int mi = 0; mi < 2; mi++)
#pragma unroll
        for (int ni = 0; ni < 2; ni++) acc[mi][ni] = MFMA32(a[mi], b[ni], acc[mi][ni]);
    }
  }
}
#define TILE_ROW(mi, i) (wm * 64 + (mi) * 32 + ((i) >> 2) * 8 + kh * 4 + ((i) & 3))
#define TILE_COL(ni) (wn * 64 + (ni) * 32 + l31)
#define TILE_VARS                                             \
  const int tid = threadIdx.x, lane = tid & 63, wv = tid >> 6; \
  const int wm = wv >> 1, wn = wv & 1, l31 = lane & 31, kh = lane >> 5;

__device__ void ph_gemm1(const Params& p, int bid, int nb, char* smem) {
  TILE_VARS
  u16* As = (u16*)smem;
  u16* Bs = As + 128 * 72;
  const int vb = (bid & 7) * (nb >> 3) + (bid >> 3);
  const int NT = 66 * 4 * 72;
  for (int ti = vb; ti < NT; ti += nb) {
    const int st = ti / 72, w = ti % 72;
    const int mt = (st >> 2) * 8 + (w & 7), nt = (st & 3) * 9 + (w >> 3);
    if (mt >= 521) continue;
    f32x16 acc[2][2];
    gemm_mainloop(p.H + (size_t)mt * 128 * 1024, 1024, p.WinT + (size_t)nt * 128 * 1024, 1024, 1024, As, Bs, acc);
    const bool kvt = (nt == 18 || nt == 19);
#pragma unroll
    for (int mi = 0; mi < 2; mi++)
#pragma unroll
      for (int ni = 0; ni < 2; ni++)
#pragma unroll
        for (int i = 0; i < 16; i++) {
          const int row = mt * 128 + TILE_ROW(mi, i), col = nt * 128 + TILE_COL(ni);
          const float v = acc[mi][ni][i];
          p.P[(size_t)row * INC + col] = f2bf(v);
          if (kvt) {
            const int c = TILE_COL(ni);
            if (row < TP) {
              const int tt = row & 4095;
              if (tt >= 3968)
                p.out[(nt == 18 ? OFF_KP : OFF_VP) + ((size_t)(row >> 12) * 128 + (tt - 3968)) * 128 + c] = v;
            } else if (row < T) {
              p.out[(nt == 18 ? OFF_KS : OFF_VS) + (size_t)(row - TP) * 128 + c] = v;
            }
          }
        }
  }
}

DI int prev_row(int g) {
  if (g < TP) return (g & 4095) ? g - 1 : -1;
  const int r2 = g - TP;
  return (r2 & 63) ? g - 1 : T + (r2 >> 6);
}

__device__ void ph_rwprep(const Params& p, int bid, int nb, char* smem) {
  const int tid = threadIdx.x, lane = tid & 63, wv = tid >> 6, l31 = lane & 31, kh = lane >> 5;
  u16* A1 = (u16*)smem;
  u16* A2 = A1 + 64 * 72;
  u16* A3 = A2 + 64 * 72;
  u16* SA = (u16*)(p.out);
  u16* SB = p.H;
  for (int tile = bid; tile < T / 64; tile += nb) {
    const int g0 = tile * 64;
    __syncthreads();
    {
      const int row = tid >> 2, part = tid & 3;
      const int g = g0 + row, pr = prev_row(g);
      const int cb = 1536 + part * 64;
      const u16* cur = p.P + (size_t)g * INC + cb;
      const u16* prv = p.P + (size_t)(pr < 0 ? 0 : pr) * INC + cb;
#pragma unroll
      for (int q = 0; q < 8; q++) {
        const uint4 c4 = *(const uint4*)(cur + q * 8);
        uint4 p4 = make_uint4(0, 0, 0, 0);
        if (pr >= 0) p4 = *(const uint4*)(prv + q * 8);
        const u32 cw[4] = {c4.x, c4.y, c4.z, c4.w}, pw[4] = {p4.x, p4.y, p4.z, p4.w};
        u32 ow[4];
#pragma unroll
        for (int e = 0; e < 4; e++) {
          const float c0 = bflo(cw[e]), c1 = bfhi(cw[e]), q0 = bflo(pw[e]), q1 = bfhi(pw[e]);
          float f0 = c0 + (q0 - c0) * p.mu[cb + q * 8 + 2 * e];
          float f1 = c1 + (q1 - c1) * p.mu[cb + q * 8 + 2 * e + 1];
          if (part == 0) { f0 = tanhf(f0); f1 = tanhf(f1); }
          else if (part >= 2) { f0 = sigmoidf_(f0); f1 = sigmoidf_(f1); }
          ow[e] = pack2(f0, f1);
        }
        u16* dst = part == 0 ? A1 + row * 72 + q * 8
                 : part == 1 ? A2 + row * 72 + q * 8
                             : A3 + row * 136 + (part - 2) * 64 + q * 8;
        *(uint4*)dst = make_uint4(ow[0], ow[1], ow[2], ow[3]);
      }
    }
    __syncthreads();
#pragma unroll 1
    for (int hh = 0; hh < 2; hh++) {
      const int hd = wv * 2 + hh;
#pragma unroll 1
      for (int mi = 0; mi < 2; mi++) {
        f32x16 aw[2], aa[2];
#pragma unroll
        for (int ni = 0; ni < 2; ni++)
#pragma unroll
          for (int i = 0; i < 16; i++) { aw[ni][i] = 0.f; aa[ni][i] = 0.f; }
#pragma unroll
        for (int kk = 0; kk < 4; kk++) {
          const bf16x8 f1 = *(const bf16x8*)(A1 + (mi * 32 + l31) * 72 + kk * 16 + kh * 8);
          const bf16x8 f2 = *(const bf16x8*)(A2 + (mi * 32 + l31) * 72 + kk * 16 + kh * 8);
#pragma unroll
          for (int ni = 0; ni < 2; ni++) {
            const bf16x8 bw = *(const bf16x8*)(p.W2T + (size_t)(hd * 64 + ni * 32 + l31) * 64 + kk * 16 + kh * 8);
            const bf16x8 ba = *(const bf16x8*)(p.A2T + (size_t)(hd * 64 + ni * 32 + l31) * 64 + kk * 16 + kh * 8);
            aw[ni] = MFMA32(f1, bw, aw[ni]);
            aa[ni] = MFMA32(f2, ba, aa[ni]);
          }
        }
        float ss[16];
#pragma unroll
        for (int i = 0; i < 16; i++) ss[i] = 0.f;
#pragma unroll
        for (int ni = 0; ni < 2; ni++) {
          const int c = ni * 32 + l31, col = hd * 64 + c;
          const float mu_r = p.mu[col], mu_k = p.mu[512 + col], mu_v = p.mu[1024 + col];
          const float w0c = p.w0[col], a0c = p.a0[col], kkc = p.k_k[col], kac = p.k_a[col];
#pragma unroll
          for (int ig = 0; ig < 4; ig++) {
            const int rowb = mi * 32 + ig * 8 + kh * 4;
            const int g = g0 + rowb;
            const int pr = (rowb == 0) ? prev_row(g) : g - 1;
            float qr = 0.f, qk = 0.f, qv = 0.f;
            if (pr >= 0) {
              const u16* pp = p.P + (size_t)pr * INC + col;
              qr = bf2f(pp[0]); qk = bf2f(pp[512]); qv = bf2f(pp[1024]);
            }
#pragma unroll
            for (int ii = 0; ii < 4; ii++) {
              const int i = ig * 4 + ii;
              const int gg = g + ii;
              const u16* pc = p.P + (size_t)gg * INC + col;
              const float cr = bf2f(pc[0]), ck = bf2f(pc[512]), cv = bf2f(pc[1024]);
              const float r = cr + (qr - cr) * mu_r, k = ck + (qk - ck) * mu_k, v = cv + (qv - cv) * mu_v;
              qr = cr; qk = ck; qv = cv;
              const float wpre = w0c + aw[ni][i];
              const float z = -wpre;
              const float sp = fmaxf(z, 0.f) + log1pf(__expf(-fabsf(z)));
              const float ed = __expf(-sp - 0.5f);
              const float dm = -expm1f(-ed);
              const float a = sigmoidf_(a0c + aa[ni][i]);
              const float kkv = k * kkc;
              ss[i] += kkv * kkv;
              const float k2 = k * (1.f + (a - 1.f) * kac);
              const size_t ba_ = ((size_t)gg * 8 + hd) * 256 + c;
              SA[ba_] = f2bf(r);
              SA[ba_ + 64] = f2bf(dm);
              SA[ba_ + 128] = f2bf(k2);
              SB[((size_t)gg * 8 + hd) * 128 + c] = f2bf(v);
              aw[ni][i] = kkv;
              aa[ni][i] = a;
            }
          }
        }
#pragma unroll
        for (int i = 0; i < 16; i++) {
          float s = ss[i];
#pragma unroll
          for (int o = 16; o; o >>= 1) s += __shfl_xor(s, o);
          ss[i] = 1.f / fmaxf(sqrtf(s), 1e-12f);
        }
#pragma unroll
        for (int ni = 0; ni < 2; ni++) {
          const int c = ni * 32 + l31;
#pragma unroll
          for (int i = 0; i < 16; i++) {
            const int gg = g0 + mi * 32 + (i >> 2) * 8 + kh * 4 + (i & 3);
            const float kkn = aw[ni][i] * ss[i];
            SA[((size_t)gg * 8 + hd) * 256 + 192 + c] = f2bf(kkn);
            SB[((size_t)gg * 8 + hd) * 128 + 64 + c] = f2bf(kkn * aa[ni][i]);
          }
        }
        f32x16 ag[2];
#pragma unroll
        for (int ni = 0; ni < 2; ni++)
#pragma unroll
          for (int i = 0; i < 16; i++) ag[ni][i] = 0.f;
#pragma unroll
        for (int kk = 0; kk < 8; kk++) {
          const bf16x8 f3 = *(const bf16x8*)(A3 + (mi * 32 + l31) * 136 + kk * 16 + kh * 8);
#pragma unroll
          for (int ni = 0; ni < 2; ni++) {
            const bf16x8 bg = *(const bf16x8*)(p.G2T + (size_t)(hd * 64 + ni * 32 + l31) * 128 + kk * 16 + kh * 8);
            ag[ni] = MFMA32(f3, bg, ag[ni]);
          }
        }
#pragma unroll
        for (int ni = 0; ni < 2; ni++)
#pragma unroll
          for (int i = 0; i < 16; i++) {
            const int gg = g0 + mi * 32 + (i >> 2) * 8 + kh * 4 + (i & 3);
            p.G[(size_t)gg * 512 + hd * 64 + ni * 32 + l31] = f2bf(ag[ni][i]);
          }
      }
    }
  }
}

template <int CTRL>
DI float dppmov(float v) {
  return __int_as_float(__builtin_amdgcn_update_dpp(0, __float_as_int(v), CTRL, 0xF, 0xF, false));
}
DI float red8(float v) {
  v += dppmov<0xB1>(v);
  v += dppmov<0x4E>(v);
  v += dppmov<0x141>(v);
  return v;
}

__device__ void ph_scan(const Params& p, int bid, int nb, char* smem) {
  const int tid = threadIdx.x, lane = tid & 63, wv = tid >> 6;
  float* buf = (float*)smem;
  const u16* SA = (const u16*)(p.out);
  const u16* SB = p.H;
  for (int item = bid; item < 512; item += nb) {
    const int type = item >> 8, r_ = item & 255, half = r_ & 1, hb = r_ >> 1, h = hb & 7, b = hb >> 3;
    const int nch = type ? 4 : 256;
    const int gbase = type ? TP + b * 64 : b * 4096;
    const int row = half * 32 + wv * 8 + (lane >> 3), j0 = (lane & 7) * 8;
    float S[8];
#pragma unroll
    for (int j = 0; j < 8; j++) S[j] = 0.f;
    if (type) {
      const float* s0 = p.state_wkv + ((size_t)(b * 8 + h) * 64 + row) * 64 + j0;
#pragma unroll
      for (int j = 0; j < 8; j++) S[j] = s0[j];
    }
    uint4 la[2], lb;
    auto gload = [&](int c) {
#pragma unroll
      for (int q = 0; q < 2; q++) {
        const int idx = tid + q * 256, step = idx >> 5, u = idx & 31;
        la[q] = *(const uint4*)(SA + ((size_t)(gbase + c * 16 + step) * 8 + h) * 256 + u * 8);
      }
      {
        const int step = tid >> 4, u = tid & 15;
        lb = *(const uint4*)(SB + ((size_t)(gbase + c * 16 + step) * 8 + h) * 128 + u * 8);
      }
    };
    gload(0);
    for (int c = 0; c < nch; c++) {
      __syncthreads();
#pragma unroll
      for (int q = 0; q < 2; q++) {
        const int idx = tid + q * 256, step = idx >> 5, u = idx & 31, arr = u >> 3, c0 = (u & 7) * 8;
        float* d = buf + step * 384 + arr * 64 + c0;
        const u32 w[4] = {la[q].x, la[q].y, la[q].z, la[q].w};
        float f[8];
#pragma unroll
        for (int e = 0; e < 4; e++) { f[2 * e] = bflo(w[e]); f[2 * e + 1] = bfhi(w[e]); }
        if (arr == 1) {
#pragma unroll
          for (int e = 0; e < 8; e++) f[e] = 1.f - f[e];
        }
        *(float4*)d = make_float4(f[0], f[1], f[2], f[3]);
        *(float4*)(d + 4) = make_float4(f[4], f[5], f[6], f[7]);
      }
      {
        const int step = tid >> 4, u = tid & 15, arr = u >> 3, c0 = (u & 7) * 8;
        float* d = buf + step * 384 + (4 + arr) * 64 + c0;
        const u32 w[4] = {lb.x, lb.y, lb.z, lb.w};
        *(float4*)d = make_float4(bflo(w[0]), bfhi(w[0]), bflo(w[1]), bfhi(w[1]));
        *(float4*)(d + 4) = make_float4(bflo(w[2]), bfhi(w[2]), bflo(w[3]), bfhi(w[3]));
      }
      __syncthreads();
      if (c + 1 < nch) gload(c + 1);
#pragma unroll 4
      for (int s = 0; s < 16; s++) {
        const float* sb = buf + s * 384;
        float rr[8], dd[8], kk_[8], kn[8], bb[8];
        *(float4*)&rr[0] = *(const float4*)(sb + j0);        *(float4*)&rr[4] = *(const float4*)(sb + j0 + 4);
        *(float4*)&dd[0] = *(const float4*)(sb + 64 + j0);   *(float4*)&dd[4] = *(const float4*)(sb + 64 + j0 + 4);
        *(float4*)&kk_[0] = *(const float4*)(sb + 128 + j0); *(float4*)&kk_[4] = *(const float4*)(sb + 128 + j0 + 4);
        *(float4*)&kn[0] = *(const float4*)(sb + 192 + j0);  *(float4*)&kn[4] = *(const float4*)(sb + 192 + j0 + 4);
        *(float4*)&bb[0] = *(const float4*)(sb + 320 + j0);  *(float4*)&bb[4] = *(const float4*)(sb + 320 + j0 + 4);
        const float vi = sb[256 + row];
        float sa = 0.f;
#pragma unroll
        for (int j = 0; j < 8; j++) sa += S[j] * kn[j];
        sa = -red8(sa);
        float yp = 0.f;
#pragma unroll
        for (int j = 0; j < 8; j++) {
          S[j] = S[j] * dd[j] + vi * kk_[j] + sa * bb[j];
          yp += S[j] * rr[j];
        }
        yp = red8(yp);
        if ((lane & 7) == 0) p.Y[(size_t)(gbase + c * 16 + s) * 512 + h * 64 + row] = f2bf(yp);
      }
    }
    float* so = p.out + (type ? OFF_WKV_S : OFF_WKV_P) + ((size_t)(b * 8 + h) * 64 + row) * 64 + j0;
    *(float4*)so = make_float4(S[0], S[1], S[2], S[3]);
    *(float4*)(so + 4) = make_float4(S[4], S[5], S[6], S[7]);
  }
}

__device__ void ph_attn(const Params& p, int bid, int nb, char* smem) {
  const int tid = threadIdx.x, lane = tid & 63, wv = tid >> 6, l31 = lane & 31, kh = lane >> 5;
  u16* Ks = (u16*)smem;
  u16* Vt = Ks + 192 * 72;
  for (int item = bid; item < 2080; item += nb) {
    const int kvh = item & 1, r = item >> 1;
    const bool samp = r >= 1024;
    const int b = samp ? r - 1024 : r >> 6, c = samp ? 0 : (r & 63);
    const int gq0 = samp ? TP + b * 64 : b * 4096 + c * 64;
    __syncthreads();
#pragma unroll 2
    for (int q = 0; q < 6; q++) {
      const int idx = tid + q * 256, j = idx >> 3, d0 = (idx & 7) * 8;
      uint4 kq = make_uint4(0, 0, 0, 0), vq = make_uint4(0, 0, 0, 0);
      if (!samp) {
        const int tok = (c - 2) * 64 + j;
        if (tok >= 0) {
          const u16* src = p.P + (size_t)(b * 4096 + tok) * INC + 2304 + kvh * 64 + d0;
          kq = *(const uint4*)src;
          vq = *(const uint4*)(src + 128);
        }
      } else if (j < 128) {
        const float4* ck = (const float4*)(p.cache_k + ((size_t)(b * 128 + j) * 2 + kvh) * 64 + d0);
        const float4* cv = (const float4*)(p.cache_v + ((size_t)(b * 128 + j) * 2 + kvh) * 64 + d0);
        const float4 k0 = ck[0], k1 = ck[1], v0 = cv[0], v1 = cv[1];
        kq = make_uint4(pack2(k0.x, k0.y), pack2(k0.z, k0.w), pack2(k1.x, k1.y), pack2(k1.z, k1.w));
        vq = make_uint4(pack2(v0.x, v0.y), pack2(v0.z, v0.w), pack2(v1.x, v1.y), pack2(v1.z, v1.w));
      } else {
        const u16* src = p.P + (size_t)(TP + b * 64 + (j - 128)) * INC + 2304 + kvh * 64 + d0;
        kq = *(const uint4*)src;
        vq = *(const uint4*)(src + 128);
      }
      *(uint4*)(Ks + j * 72 + d0) = kq;
      const u32 vw[4] = {vq.x, vq.y, vq.z, vq.w};
#pragma unroll
      for (int e = 0; e < 4; e++) {
        Vt[(d0 + 2 * e) * 196 + j] = (u16)(vw[e] & 0xffffu);
        Vt[(d0 + 2 * e + 1) * 196 + j] = (u16)(vw[e] >> 16);
      }
    }
    __syncthreads();
    const int qh = kvh * 4 + wv;
    const float slope = exp2f(-(float)(qh + 1)), sink = p.sinks[qh];
#pragma unroll 1
    for (int nq = 0; nq < 2; nq++) {
      const int tq = nq * 32 + l31;
      const u16* qp = p.P + (size_t)(gq0 + tq) * INC + 1792 + qh * 64 + kh * 8;
      bf16x8 qf[4];
#pragma unroll
      for (int kk = 0; kk < 4; kk++) qf[kk] = *(const bf16x8*)(qp + kk * 16);
      f32x16 sc[6];
#pragma unroll
      for (int mt = 0; mt < 6; mt++) {
#pragma unroll
        for (int i = 0; i < 16; i++) sc[mt][i] = 0.f;
#pragma unroll
        for (int kk = 0; kk < 4; kk++) {
          const bf16x8 a = *(const bf16x8*)(Ks + (mt * 32 + l31) * 72 + kk * 16 + kh * 8);
          sc[mt] = MFMA32(a, qf[kk], sc[mt]);
        }
      }
      float mx = -3e38f;
#pragma unroll
      for (int mt = 0; mt < 6; mt++)
#pragma unroll
        for (int i = 0; i < 16; i++) {
          const int j = mt * 32 + (i >> 2) * 8 + kh * 4 + (i & 3);
          float s = sc[mt][i] * 0.125f - slope * fabsf((float)(128 + tq - j));
          if (!samp && (c - 2) * 64 + j < 0) s = -1e30f;
          sc[mt][i] = s;
          mx = fmaxf(mx, s);
        }
      mx = fmaxf(mx, __shfl_xor(mx, 32));
      mx = fmaxf(mx, sink);
      float sum = 0.f;
#pragma unroll
      for (int mt = 0; mt < 6; mt++)
#pragma unroll
        for (int i = 0; i < 16; i++) {
          const float e = __expf(sc[mt][i] - mx);
          sc[mt][i] = e;
          sum += e;
        }
      sum += __shfl_xor(sum, 32);
      sum += __expf(sink - mx);
      const float inv = 1.f / sum;
      f32x16 o[2];
#pragma unroll
      for (int dt = 0; dt < 2; dt++)
#pragma unroll
        for (int i = 0; i < 16; i++) o[dt][i] = 0.f;
#pragma unroll
      for (int mt = 0; mt < 6; mt++)
#pragma unroll
        for (int s2 = 0; s2 < 2; s2++) {
          u32 pw[4];
#pragma unroll
          for (int e = 0; e < 4; e++) pw[e] = pack2(sc[mt][8 * s2 + 2 * e] * inv, sc[mt][8 * s2 + 2 * e + 1] * inv);
          const bf16x8 pa = __builtin_bit_cast(bf16x8, make_uint4(pw[0], pw[1], pw[2], pw[3]));
#pragma unroll
          for (int dt = 0; dt < 2; dt++) {
            const u16* vp = Vt + (dt * 32 + l31) * 196 + mt * 32 + 16 * s2 + 4 * kh;
            const uint2 v0 = *(const uint2*)vp, v1 = *(const uint2*)(vp + 8);
            const bf16x8 vb = __builtin_bit_cast(bf16x8, make_uint4(v0.x, v0.y, v1.x, v1.y));
            o[dt] = MFMA32(pa, vb, o[dt]);
          }
        }
#pragma unroll
      for (int dt = 0; dt < 2; dt++)
#pragma unroll
        for (int i = 0; i < 16; i++) {
          const int qrow = nq * 32 + (i >> 2) * 8 + kh * 4 + (i & 3);
          p.OATT[(size_t)(gq0 + qrow) * 512 + qh * 64 + dt * 32 + l31] = f2bf(o[dt][i]);
        }
    }
  }
  const u16* SA = (const u16*)(p.out);
  const u16* SB = p.H;
  for (int it = bid * 4 + wv; it < T * 8; it += nb * 4) {
    const int g = it >> 3, h = it & 7, col = h * 64 + lane;
    const float y = bf2f(p.Y[(size_t)g * 512 + col]);
    const float mean = wave_sum(y) * (1.f / 64.f);
    const float dy = y - mean;
    const float var = wave_sum(dy * dy) * (1.f / 64.f);
    float yn = dy * rsqrtf(var + 64e-5f) * p.lnx_w[col] + p.lnx_b[col];
    const size_t ba_ = (size_t)it * 256 + lane;
    const float r = bf2f(SA[ba_]), k2 = bf2f(SA[ba_ + 128]);
    const float v = bf2f(SB[(size_t)it * 128 + lane]);
    const float bonus = wave_sum(r * k2 * p.r_k[col]);
    yn += bonus * v;
    p.Y[(size_t)g * 512 + col] = f2bf(yn * bf2f(p.G[(size_t)g * 512 + col]));
  }
}

__device__ void ph_gemm2(const Params& p, int bid, int nb, char* smem) {
  TILE_VARS
  u16* As = (u16*)smem;
  u16* Bs = As + 128 * 72;
  u16* MG = p.H;
  const int vb = (bid & 7) * (nb >> 3) + (bid >> 3);
  for (int ti = vb; ti < 520 * 8; ti += nb) {
    const int mt = ti >> 3, nt = ti & 7;
    f32x16 acc[2][2], res[2][2];
    gemm_mainloop(p.Y + (size_t)mt * 128 * 512, 512, p.WbT + (size_t)nt * 128 * 512, 512, 512, As, Bs, acc);
#pragma unroll
    for (int mi = 0; mi < 2; mi++)
#pragma unroll
      for (int ni = 0; ni < 2; ni++)
#pragma unroll
        for (int i = 0; i < 16; i++) {
          const int row = mt * 128 + TILE_ROW(mi, i), col = nt * 128 + TILE_COL(ni);
          res[mi][ni][i] = sigmoidf_(bf2f(p.P[(size_t)row * INC + 2560 + col])) * acc[mi][ni][i];
        }
    gemm_mainloop(p.OATT + (size_t)mt * 128 * 512, 512, p.WbT + (size_t)(1024 + nt * 128) * 512, 512, 512, As, Bs, acc);
#pragma unroll
    for (int mi = 0; mi < 2; mi++)
#pragma unroll
      for (int ni = 0; ni < 2; ni++)
#pragma unroll
        for (int i = 0; i < 16; i++) {
          const int row = mt * 128 + TILE_ROW(mi, i), col = nt * 128 + TILE_COL(ni);
          const float v = res[mi][ni][i] + sigmoidf_(bf2f(p.P[(size_t)row * INC + 3584 + col])) * acc[mi][ni][i];
          MG[(size_t)row * 1024 + col] = f2bf(v);
        }
  }
}

__device__ void ph_gemm3(const Params& p, int bid, int nb, char* smem) {
  TILE_VARS
  u16* As = (u16*)smem;
  u16* Bs = As + 128 * 72;
  const u16* MG = p.H;
  const int vb = (bid & 7) * (nb >> 3) + (bid >> 3);
  for (int ti = vb; ti < 520 * 8; ti += nb) {
    const int mt = ti >> 3, nt = ti & 7;
    f32x16 acc[2][2];
    gemm_mainloop(MG + (size_t)mt * 128 * 1024, 1024, p.WoutT + (size_t)nt * 128 * 1024, 1024, 1024, As, Bs, acc);
#pragma unroll
    for (int mi = 0; mi < 2; mi++)
#pragma unroll
      for (int ni = 0; ni < 2; ni++)
#pragma unroll
        for (int i = 0; i < 16; i++) {
          const int row = mt * 128 + TILE_ROW(mi, i), col = nt * 128 + TILE_COL(ni);
          p.out[(size_t)row * 1024 + col] = xrow(p, row)[col] + acc[mi][ni][i];
        }
  }
}

__device__ void ph_norm2(const Params& p, int bid, int nb) {
  const int tid = threadIdx.x, lane = tid & 63, wv = tid >> 6;
  for (int row = bid * 4 + wv; row < T; row += nb * 4) {
    const float4* x = (const float4*)(p.out + (size_t)row * 1024);
    float4 v[4];
    float ss = 0.f;
#pragma unroll
    for (int i = 0; i < 4; i++) {
      v[i] = x[lane + i * 64];
      ss += v[i].x * v[i].x + v[i].y * v[i].y + v[i].z * v[i].z + v[i].w * v[i].w;
    }
    ss = wave_sum(ss);
    const float rs = rsqrtf(ss * (1.f / 1024.f) + 1e-6f);
    u16* hr = p.H + (size_t)row * 1024;
#pragma unroll
    for (int i = 0; i < 4; i++) {
      const float4 g = ((const float4*)p.norm2_g)[lane + i * 64];
      ((uint2*)hr)[lane + i * 64] = make_uint2(pack2(v[i].x * rs * g.x, v[i].y * rs * g.y), pack2(v[i].z * rs * g.z, v[i].w * rs * g.w));
    }
  }
}

DI void ins16(float (&l)[16], float x) {
#pragma unroll
  for (int i = 0; i < 16; i++) {
    const float hi = fmaxf(l[i], x);
    x = fminf(l[i], x);
    l[i] = hi;
  }
}

__device__ void ph_peerq(const Params& p, int bid, int nb, char* smem) {
  TILE_VARS
  u16* As = (u16*)smem;
  u16* Bs = As + 128 * 72;
  u16* Qs = (u16*)smem;
  unsigned char* lt = (unsigned char*)(smem + 36864 + wv * 1024);
  int* IDX = (int*)p.G;
  float* GATE = (float*)p.OATT;
  const int vb = (bid & 7) * (nb >> 3) + (bid >> 3);
  for (int ti = vb; ti < 520 * 8; ti += nb) {
    const int mt = ti >> 3, hp = ti & 7;
    {
      f32x16 acc[2][2];
      gemm_mainloop(p.H + (size_t)mt * 128 * 1024, 1024, p.WqT + (size_t)hp * 128 * 1024, 1024, 1024, As, Bs, acc);
      __syncthreads();
#pragma unroll
      for (int mi = 0; mi < 2; mi++)
#pragma unroll
        for (int ni = 0; ni < 2; ni++)
#pragma unroll
          for (int i = 0; i < 16; i++) Qs[TILE_ROW(mi, i) * 136 + TILE_COL(ni)] = f2bf(acc[mi][ni][i]);
      __syncthreads();
    }
    float l1[16], l2[16];
#pragma unroll
    for (int pp = 0; pp < 2; pp++) {
      f32x16 sc[4];
#pragma unroll
      for (int m4 = 0; m4 < 4; m4++) {
#pragma unroll
        for (int i = 0; i < 16; i++) sc[m4][i] = 0.f;
#pragma unroll
        for (int kk = 0; kk < 4; kk++) {
          const bf16x8 a = *(const bf16x8*)(p.SK + (size_t)(pp * 128 + m4 * 32 + l31) * 64 + kk * 16 + kh * 8);
          const bf16x8 bq = *(const bf16x8*)(Qs + (wv * 32 + l31) * 136 + pp * 64 + kk * 16 + kh * 8);
          sc[m4] = MFMA32(a, bq, sc[m4]);
        }
      }
      float l[16];
#pragma unroll
      for (int i = 0; i < 16; i++) l[i] = -3e38f;
#pragma unroll
      for (int m4 = 0; m4 < 4; m4++)
#pragma unroll
        for (int i = 0; i < 16; i++) {
          const u32 n = m4 * 32 + (i >> 2) * 8 + kh * 4 + (i & 3);
          ins16(l, __uint_as_float((__float_as_uint(sc[m4][i]) & ~0x7Fu) | n));
        }
      float o[16];
#pragma unroll
      for (int i = 0; i < 16; i++) o[i] = __shfl_xor(l[i], 32);
#pragma unroll
      for (int i = 0; i < 16; i++) ins16(l, o[i]);
#pragma unroll
      for (int i = 0; i < 16; i++) {
        if (pp == 0) l1[i] = l[i]; else l2[i] = l[i];
      }
    }
    if (kh == 0) {
      u32 w[8];
#pragma unroll
      for (int q = 0; q < 4; q++) {
        w[q] = (__float_as_uint(l1[4 * q]) & 0x7F) | ((__float_as_uint(l1[4 * q + 1]) & 0x7F) << 8) |
               ((__float_as_uint(l1[4 * q + 2]) & 0x7F) << 16) | ((__float_as_uint(l1[4 * q + 3]) & 0x7F) << 24);
        w[4 + q] = (__float_as_uint(l2[4 * q]) & 0x7F) | ((__float_as_uint(l2[4 * q + 1]) & 0x7F) << 8) |
                   ((__float_as_uint(l2[4 * q + 2]) & 0x7F) << 16) | ((__float_as_uint(l2[4 * q + 3]) & 0x7F) << 24);
      }
      *(uint4*)(lt + l31 * 32) = make_uint4(w[0], w[1], w[2], w[3]);
      *(uint4*)(lt + l31 * 32 + 16) = make_uint4(w[4], w[5], w[6], w[7]);
    }
    float l3[16];
#pragma unroll
    for (int i = 0; i < 16; i++) l3[i] = -3e38f;
#pragma unroll
    for (int a = 0; a < 16; a++)
#pragma unroll
      for (int b = 0; b < 16; b++)
        if ((a + 1) * (b + 1) <= 16) {
          const float s = __uint_as_float(__float_as_uint(l1[a]) & ~0x7Fu) + __uint_as_float(__float_as_uint(l2[b]) & ~0x7Fu);
          ins16(l3, __uint_as_float((__float_as_uint(s) & ~0xFFu) | (u32)(a * 16 + b)));
        }
    __builtin_amdgcn_fence(__ATOMIC_RELEASE, "workgroup");
    __builtin_amdgcn_wave_barrier();
    if (kh == 0) {
      const int g = mt * 128 + wv * 32 + l31;
      float ev[16];
      int ei[16];
      float sum = 0.f;
      const float m = __uint_as_float(__float_as_uint(l3[0]) & ~0xFFu);
#pragma unroll
      for (int k = 0; k < 16; k++) {
        const u32 bits = __float_as_uint(l3[k]);
        const u32 pos = bits & 0xFF;
        ev[k] = __expf(__uint_as_float(bits & ~0xFFu) - m);
        sum += ev[k];
        ei[k] = (int)lt[l31 * 32 + (pos >> 4)] * 128 + (int)lt[l31 * 32 + 16 + (pos & 15)];
      }
      const float inv = 1.f / sum;
      int4* ip = (int4*)(IDX + (size_t)g * 128 + hp * 16);
      float4* gp = (float4*)(GATE + (size_t)g * 128 + hp * 16);
#pragma unroll
      for (int q = 0; q < 4; q++) {
        ip[q] = make_int4(ei[4 * q], ei[4 * q + 1], ei[4 * q + 2], ei[4 * q + 3]);
        gp[q] = make_float4(ev[4 * q] * inv, ev[4 * q + 1] * inv, ev[4 * q + 2] * inv, ev[4 * q + 3] * inv);
      }
    }
  }
}

__device__ void ph_peer(const Params& p, int bid, int nb, char* smem) {
  const int tid = threadIdx.x, lane = tid & 63, wv = tid >> 6;
  char* wb = smem + wv * 3072;
  u16* hs = (u16*)wb;
  float* acts = (float*)(wb + 2048);
  int* idxs = (int*)(wb + 2560);
  const int* IDX = (const int*)p.G;
  const float* GATE = (const float*)p.OATT;
  const int n = lane & 15, quad = lane >> 4;
  for (int g = bid * 4 + wv; g < T; g += nb * 4) {
    const u16* h2 = p.H + (size_t)g * 1024;
    *(uint4*)(hs + lane * 8) = *(const uint4*)(h2 + lane * 8);
    *(uint4*)(hs + 512 + lane * 8) = *(const uint4*)(h2 + 512 + lane * 8);
    idxs[lane] = IDX[(size_t)g * 128 + lane];
    idxs[lane + 64] = IDX[(size_t)g * 128 + 64 + lane];
    __builtin_amdgcn_fence(__ATOMIC_RELEASE, "workgroup");
    __builtin_amdgcn_wave_barrier();
#pragma unroll 1
    for (int grp = 0; grp < 8; grp++) {
      const int e = idxs[grp * 16 + n];
      const u16* ur = p.Ubf + (size_t)e * 1024 + quad * 8;
      f32x4 acc = {0.f, 0.f, 0.f, 0.f};
#pragma unroll 8
      for (int kk = 0; kk < 32; kk++) {
        const bf16x8 a = *(const bf16x8*)(ur + kk * 32);
        const bf16x8 bb = *(const bf16x8*)(hs + kk * 32 + quad * 8);
        acc = MFMA16(a, bb, acc);
      }
      const float4 gt = *(const float4*)(GATE + (size_t)g * 128 + grp * 16 + quad * 4);
      float4 av;
      av.x = 0.5f * acc[0] * (1.f + erff(acc[0] * 0.70710678118f)) * gt.x;
      av.y = 0.5f * acc[1] * (1.f + erff(acc[1] * 0.70710678118f)) * gt.y;
      av.z = 0.5f * acc[2] * (1.f + erff(acc[2] * 0.70710678118f)) * gt.z;
      av.w = 0.5f * acc[3] * (1.f + erff(acc[3] * 0.70710678118f)) * gt.w;
      if (n == 0) *(float4*)(acts + grp * 16 + quad * 4) = av;
    }
    __builtin_amdgcn_fence(__ATOMIC_RELEASE, "workgroup");
    __builtin_amdgcn_wave_barrier();
    float o[16];
#pragma unroll
    for (int j = 0; j < 16; j++) o[j] = 0.f;
#pragma unroll 4
    for (int k = 0; k < 128; k++) {
      const float a = acts[k];
      const int e = idxs[k];
      const u16* vr = p.Vbf + (size_t)e * 1024 + lane * 8;
      const uint4 v0 = *(const uint4*)vr, v1 = *(const uint4*)(vr + 512);
      o[0] += a * bflo(v0.x); o[1] += a * bfhi(v0.x); o[2] += a * bflo(v0.y); o[3] += a * bfhi(v0.y);
      o[4] += a * bflo(v0.z); o[5] += a * bfhi(v0.z); o[6] += a * bflo(v0.w); o[7] += a * bfhi(v0.w);
      o[8] += a * bflo(v1.x); o[9] += a * bfhi(v1.x); o[10] += a * bflo(v1.y); o[11] += a * bfhi(v1.y);
      o[12] += a * bflo(v1.z); o[13] += a * bfhi(v1.z); o[14] += a * bflo(v1.w); o[15] += a * bfhi(v1.w);
    }
    float* xr = p.out + (size_t)g * 1024;
    float4 x[4];
    x[0] = *(const float4*)(xr + lane * 8);
    x[1] = *(const float4*)(xr + lane * 8 + 4);
    x[2] = *(const float4*)(xr + 512 + lane * 8);
    x[3] = *(const float4*)(xr + 512 + lane * 8 + 4);
    float ss = 0.f;
#pragma unroll
    for (int q = 0; q < 4; q++) {
      x[q].x += o[4 * q]; x[q].y += o[4 * q + 1]; x[q].z += o[4 * q + 2]; x[q].w += o[4 * q + 3];
      ss += x[q].x * x[q].x + x[q].y * x[q].y + x[q].z * x[q].z + x[q].w * x[q].w;
    }
    ss = wave_sum(ss);
    const float rs = rsqrtf(ss * (1.f / 1024.f) + 1e-6f);
    const float4 g0 = *(const float4*)(p.final_g + lane * 8), g1 = *(const float4*)(p.final_g + lane * 8 + 4);
    const float4 g2 = *(const float4*)(p.final_g + 512 + lane * 8), g3 = *(const float4*)(p.final_g + 512 + lane * 8 + 4);
    *(float4*)(xr + lane * 8) = make_float4(x[0].x * rs * g0.x, x[0].y * rs * g0.y, x[0].z * rs * g0.z, x[0].w * rs * g0.w);
    *(float4*)(xr + lane * 8 + 4) = make_float4(x[1].x * rs * g1.x, x[1].y * rs * g1.y, x[1].z * rs * g1.z, x[1].w * rs * g1.w);
    *(float4*)(xr + 512 + lane * 8) = make_float4(x[2].x * rs * g2.x, x[2].y * rs * g2.y, x[2].z * rs * g2.z, x[2].w * rs * g2.w);
    *(float4*)(xr + 512 + lane * 8 + 4) = make_float4(x[3].x * rs * g3.x, x[3].y * rs * g3.y, x[3].z * rs * g3.z, x[3].w * rs * g3.w);
  }
}

DI void run_phase(const Params& p, int ph, int bid, int nb, char* smem) {
  switch (ph) {
    case 0: ph_prep(p, bid, nb); break;
    case 1: ph_gemm1(p, bid, nb, smem); break;
    case 2: ph_rwprep(p, bid, nb, smem); break;
    case 3: ph_scan(p, bid, nb, smem); break;
    case 4: ph_attn(p, bid, nb, smem); break;
    case 5: ph_gemm2(p, bid, nb, smem); break;
    case 6: ph_gemm3(p, bid, nb, smem); break;
    case 7: ph_norm2(p, bid, nb); break;
    case 8: ph_peerq(p, bid, nb, smem); break;
    case 9: ph_peer(p, bid, nb, smem); break;
  }
}

#if MEGA
__global__ void __launch_bounds__(256) mega_kernel(Params p) {
  __shared__ __attribute__((aligned(16))) char smem[SMEM_BYTES];
  cg::grid_group grid = cg::this_grid();
  const int bid = blockIdx.x, nb = gridDim.x;
#pragma unroll 1
  for (int ph = 0; ph < 10; ph++) {
    run_phase(p, ph, bid, nb, smem);
    if (ph < 9) grid.sync();
  }
}
#else
template <int PH>
__global__ void __launch_bounds__(256) phase_kernel(Params p) {
  __shared__ __attribute__((aligned(16))) char smem[SMEM_BYTES];
  run_phase(p, PH, blockIdx.x, gridDim.x, smem);
}
#endif

extern "C" void kernel_launch(void* const* d_in, const int* in_sizes, int n_in, void* d_out, int out_size, void* d_ws,
                              size_t ws_size, hipStream_t stream) {
  Params p{};
  const float** f = (const float**)&p;
  for (int i = 0; i < 28; i++) f[i] = (const float*)d_in[i];
  p.out = (float*)d_out;
  char* w = (char*)d_ws;
  size_t off = 0;
  auto take = [&](size_t bytes) { char* r = w + off; off += (bytes + 255) & ~(size_t)255; return (u16*)r; };
  p.H = take((size_t)MP * 1024 * 2);
  p.P = take((size_t)MP * INC * 2);
  p.Ubf = take((size_t)16384 * 1024 * 2);
  p.Vbf = take((size_t)16384 * 1024 * 2);
  p.WinT = take((size_t)4608 * 1024 * 2);
  p.WbT = take((size_t)2 * 1024 * 512 * 2);
  p.WoutT = take((size_t)1024 * 1024 * 2);
  p.WqT = take((size_t)1024 * 1024 * 2);
  p.W2T = take((size_t)512 * 64 * 2);
  p.A2T = take((size_t)512 * 64 * 2);
  p.G2T = take((size_t)512 * 128 * 2);
  p.SK = take((size_t)2 * 128 * 64 * 2);
  p.Y = take((size_t)T * 512 * 2);
  p.G = take((size_t)T * 512 * 2);
  p.OATT = take((size_t)T * 512 * 2);
#if MEGA
  static int grid_blocks = 0;
  if (!grid_blocks) {
    int dev = 0, cus = 0, per_cu = 0;
    hipGetDevice(&dev);
    hipDeviceGetAttribute(&cus, hipDeviceAttributeMultiprocessorCount, dev);
    hipOccupancyMaxActiveBlocksPerMultiprocessor(&per_cu, mega_kernel, 256, 0);
    if (per_cu > 4) per_cu = 4;
    grid_blocks = cus * per_cu;
  }
  void* args[] = {&p};
  hipError_t e = hipLaunchCooperativeKernel((void*)mega_kernel, dim3(grid_blocks), dim3(256), args, 0, stream);
  if (e != hipSuccess) fprintf(stderr, "cooperative launch failed: %s (grid %d)\n", hipGetErrorString(e), grid_blocks);
#else
  const int G = 1024;
  phase_kernel<0><<<G, 256, 0, stream>>>(p);
  phase_kernel<1><<<G, 256, 0, stream>>>(p);
  phase_kernel<2><<<G, 256, 0, stream>>>(p);
  phase_kernel<3><<<G, 256, 0, stream>>>(p);
  phase_kernel<4><<<G, 256, 0, stream>>>(p);
  phase_kernel<5><<<G, 256, 0, stream>>>(p);
  phase_kernel<6><<<G, 256, 0, stream>>>(p);
  phase_kernel<7><<<G, 256, 0, stream>>>(p);
  phase_kernel<8><<<G, 256, 0, stream>>>(p);
  phase_kernel<9><<<G, 256, 0, stream>>>(p);
#endif
}
```

```cpp
#include <hip/hip_runtime.h>
#include <hip/hip_cooperative_groups.h>
#include <cstdio>
namespace cg = cooperative_groups;

#ifndef REP
#define REP -1
#endif
#ifndef ONLY
#define ONLY -1
#endif
#define ON(k) (ONLY < 0 || ONLY == (k))

typedef unsigned short u16;
typedef unsigned int u32;
using bf16x8 = __attribute__((ext_vector_type(8))) short;
using f32x4 = __attribute__((ext_vector_type(4))) float;
using f32x16 = __attribute__((ext_vector_type(16))) float;
using u32x4 = __attribute__((ext_vector_type(4))) u32;
#define DI __device__ __forceinline__

constexpr int TP = 65536, TS = 1024, T = 66560, MP = 66816;
constexpr int INC = 4608;
constexpr int NW = 8;
constexpr int NTH = 512;
constexpr size_t OFF_Y = 0, OFF_SHIFT_P = 68157440, OFF_WKV_P = 68173824, OFF_KP = 68698112, OFF_VP = 68960256,
                 OFF_SHIFT_S = 69222400, OFF_WKV_S = 69238784, OFF_KS = 69763072, OFF_VS = 69894144;
constexpr int DYN_LDS = 147456;

extern __shared__ __attribute__((aligned(16))) char dsm[];

struct Params {
  const float *x_prompt, *x_sample, *state_shift, *state_wkv, *cache_k, *cache_v, *norm1_g, *w_in, *mu, *w0, *w2, *a0,
      *a2, *g2, *k_k, *k_a, *r_k, *lnx_w, *lnx_b, *sinks, *w_branch, *w_out, *norm2_g, *peer_wq, *sub_keys, *peer_u,
      *peer_v, *final_g;
  float* out;
  u16 *H, *P, *Ubf, *Vbf, *WinT, *WbT, *WoutT, *WqT, *W2T, *A2T, *G2T, *SK, *Y, *G, *OATT;
};

DI u16 f2bf(float x) {
  u32 u = __float_as_uint(x);
  u += 0x7fffu + ((u >> 16) & 1u);
  return (u16)(u >> 16);
}
DI float bf2f(u16 b) { return __uint_as_float(((u32)b) << 16); }
DI u32 pack2(float a, float b) { return (u32)f2bf(a) | ((u32)f2bf(b) << 16); }
DI float bflo(u32 w) { return __uint_as_float(w << 16); }
DI float bfhi(u32 w) { return __uint_as_float(w & 0xffff0000u); }
DI float wave_sum(float v) {
#pragma unroll
  for (int o = 32; o; o >>= 1) v += __shfl_xor(v, o);
  return v;
}
DI float sigmoidf_(float x) { return 1.f / (1.f + __expf(-x)); }
DI const float* xrow(const Params& p, int g) {
  return g < TP ? p.x_prompt + (size_t)g * 1024 : p.x_sample + (size_t)(g - TP) * 1024;
}
DI int otid() { int t = threadIdx.x; asm volatile("" : "+v"(t)); return t; }
#define MFMA32(a, b, c) __builtin_amdgcn_mfma_f32_32x32x16_bf16((a), (b), (c), 0, 0, 0)
#define MFMA16(a, b, c) __builtin_amdgcn_mfma_f32_16x16x32_bf16((a), (b), (c), 0, 0, 0)

template <int CTRL>
DI float dppmov(float v) {
  return __int_as_float(__builtin_amdgcn_update_dpp(0, __float_as_int(v), CTRL, 0xF, 0xF, false));
}
DI float red16(float v) {
  v += dppmov<0x128>(v);
  v += dppmov<0x124>(v);
  v += dppmov<0x122>(v);
  v += dppmov<0x121>(v);
  return v;
}

DI void tcvt(const float* __restrict__ W, u16* __restrict__ Wt, int K, int N, int gt, int nt) {
  const int total = N * (K / 8);
  for (int i = gt; i < total; i += nt) {
    const int n = i % N, kg = i / N;
    u32 o[4];
#pragma unroll
    for (int j = 0; j < 4; j++)
      o[j] = pack2(W[(size_t)(kg * 8 + 2 * j) * N + n], W[(size_t)(kg * 8 + 2 * j + 1) * N + n]);
    *(uint4*)(Wt + (size_t)n * K + kg * 8) = make_uint4(o[0], o[1], o[2], o[3]);
  }
}
DI void scvt(const float* __restrict__ W, u16* __restrict__ O, int n8, int gt, int nt) {
  for (int i = gt; i < n8; i += nt) {
    const float4 a = ((const float4*)W)[2 * i], b = ((const float4*)W)[2 * i + 1];
    ((uint4*)O)[i] = make_uint4(pack2(a.x, a.y), pack2(a.z, a.w), pack2(b.x, b.y), pack2(b.z, b.w));
  }
}

__device__ void ph_prep(const Params& p, int bid, int nb) {
  const int tid = otid(), lane = tid & 63, wv = tid >> 6;
  for (int row = bid * NW + wv; row < MP; row += nb * NW) {
    u16* hr = p.H + (size_t)row * 1024;
    if (row < T) {
      const float4* x = (const float4*)xrow(p, row);
      float4 v[4];
      float ss = 0.f;
#pragma unroll
      for (int i = 0; i < 4; i++) {
        v[i] = x[lane + i * 64];
        ss += v[i].x * v[i].x + v[i].y * v[i].y + v[i].z * v[i].z + v[i].w * v[i].w;
      }
      ss = wave_sum(ss);
      const float rs = rsqrtf(ss * (1.f / 1024.f) + 1e-6f);
      float* so = nullptr;
      if (row < TP) {
        if ((row & 4095) == 4095) so = p.out + OFF_SHIFT_P + (size_t)(row >> 12) * 1024;
      } else {
        const int r2 = row - TP;
        if ((r2 & 63) == 63) so = p.out + OFF_SHIFT_S + (size_t)(r2 >> 6) * 1024;
      }
#pragma unroll
      for (int i = 0; i < 4; i++) {
        const float4 g = ((const float4*)p.norm1_g)[lane + i * 64];
        float4 y;
        y.x = v[i].x * rs * g.x; y.y = v[i].y * rs * g.y; y.z = v[i].z * rs * g.z; y.w = v[i].w * rs * g.w;
        ((uint2*)hr)[lane + i * 64] = make_uint2(pack2(y.x, y.y), pack2(y.z, y.w));
        if (so) ((float4*)so)[lane + i * 64] = y;
      }
    } else if (row < T + 16) {
      const float4* x = (const float4*)(p.state_shift + (size_t)(row - T) * 1024);
#pragma unroll
      for (int i = 0; i < 4; i++) {
        const float4 y = x[lane + i * 64];
        ((uint2*)hr)[lane + i * 64] = make_uint2(pack2(y.x, y.y), pack2(y.z, y.w));
      }
    } else {
#pragma unroll
      for (int i = 0; i < 4; i++) ((uint2*)hr)[lane + i * 64] = make_uint2(0u, 0u);
    }
  }
  const int gt = bid * NTH + tid, nt = nb * NTH;
  tcvt(p.w_in, p.WinT, 1024, 4608, gt, nt);
  tcvt(p.w_branch, p.WbT, 512, 1024, gt, nt);
  tcvt(p.w_branch + 512 * 1024, p.WbT + 1024 * 512, 512, 1024, gt, nt);
  tcvt(p.w_out, p.WoutT, 1024, 1024, gt, nt);
  tcvt(p.peer_wq, p.WqT, 1024, 1024, gt, nt);
  tcvt(p.w2, p.W2T, 64, 512, gt, nt);
  tcvt(p.a2, p.A2T, 64, 512, gt, nt);
  tcvt(p.g2, p.G2T, 128, 512, gt, nt);
  scvt(p.sub_keys, p.SK, 2 * 128 * 64 / 8, gt, nt);
  scvt(p.peer_u, p.Ubf, 16384 * 1024 / 8, gt, nt);
  scvt(p.peer_v, p.Vbf, 16384 * 1024 / 8, gt, nt);
}

constexpr int GBK = 64, GHALF = 128, GHT = GHALF * GBK;
DI int lds_byte(int r, int c) {
  const int st = (r >> 4) * 2 + (c >> 5), rr = r & 15, cc = c & 31, ob = rr * 64 + cc * 2;
  return st * 1024 + (ob ^ (((ob >> 9) & 1) << 5));
}
DI void stage_rc(int b, int& R, int& C) {
  const int st = b / 1024, sb = b % 1024, swz = sb ^ (((sb >> 9) & 1) << 5);
  R = (st >> 1) * 16 + swz / 64;
  C = (st & 1) * 32 + (swz % 64) / 2;
}
typedef __attribute__((address_space(3))) unsigned lds_u32;
#define G_SA(b, h) (shm + ((b) * 2 + (h)) * GHT)
#define G_SB(b, h) (shm + (4 + (b) * 2 + (h)) * GHT)
#define G_STAGE(P_, RS, br, kt)                                                                                   \
  do {                                                                                                            \
    const int _so = ((br) * K + (kt) * GBK) * 2;                                                                  \
    __builtin_amdgcn_raw_ptr_buffer_load_lds(RS, (lds_u32*)((char*)(P_) + tb0), 16, ob0, _so, 0, 0);              \
    __builtin_amdgcn_raw_ptr_buffer_load_lds(RS, (lds_u32*)((char*)(P_) + tb0 + 8192), 16, ob1, _so, 0, 0);       \
  } while (0)
#define G_LDA(dst, b, h)                                  \
  _Pragma("unroll") for (int m = 0; m < 4; ++m)           \
  _Pragma("unroll") for (int k = 0; k < 2; ++k)           \
    dst[m][k] = *reinterpret_cast<const bf16x8*>((const char*)G_SA(b, h) + lds_byte(wr * 64 + m * 16 + fr, k * 32 + fq * 8))
#define G_LDB(dst, b, h)                                  \
  _Pragma("unroll") for (int n = 0; n < 2; ++n)           \
  _Pragma("unroll") for (int k = 0; k < 2; ++k)           \
    dst[n][k] = *reinterpret_cast<const bf16x8*>((const char*)G_SB(b, h) + lds_byte(wc * 32 + n * 16 + fr, k * 32 + fq * 8))
#define G_MMA(ai, bj, At_, Bt_)                                                                         \
  do {                                                                                                  \
    __builtin_amdgcn_s_setprio(1);                                                                      \
    _Pragma("unroll") for (int m = 0; m < 4; ++m)                                                       \
    _Pragma("unroll") for (int n = 0; n < 2; ++n)                                                       \
    _Pragma("unroll") for (int k = 0; k < 2; ++k)                                                       \
      acc[ai][bj][m][n] = MFMA16(At_[m][k], Bt_[n][k], acc[ai][bj][m][n]);                              \
    __builtin_amdgcn_s_setprio(0);                                                                      \
  } while (0)
#define WAIT_V(n) asm volatile("s_waitcnt vmcnt(" #n ")" ::: "memory")
#define WAIT_L(n) asm volatile("s_waitcnt lgkmcnt(" #n ")" ::: "memory")
#define BAR __builtin_amdgcn_s_barrier()
#define SCHED __builtin_amdgcn_sched_barrier(0)

template <int K>
DI void gemm256(const u16* __restrict__ A, const u16* __restrict__ Bt, const int brow, const int bcol,
                f32x4 (&acc)[2][2][4][2]) {
  u16* shm = (u16*)dsm;
  const int tid_ = otid();
  const int wid = tid_ >> 6, lane = tid_ & 63, wr = wid >> 2, wc = wid & 3, fr = lane & 15, fq = lane >> 4;
#pragma unroll
  for (int a = 0; a < 2; a++)
#pragma unroll
    for (int b = 0; b < 2; b++)
#pragma unroll
      for (int m = 0; m < 4; m++)
#pragma unroll
        for (int n = 0; n < 2; n++) acc[a][b][m][n] = f32x4{0.f, 0.f, 0.f, 0.f};
  bf16x8 At[4][2], B0[2][2], B1[2][2];
  constexpr int nt = K / GBK;
  const __amdgpu_buffer_rsrc_t rsA = __builtin_amdgcn_make_buffer_rsrc((void*)A, 0, 0x7fffffff, 0x00020000);
  const __amdgpu_buffer_rsrc_t rsB = __builtin_amdgcn_make_buffer_rsrc((void*)Bt, 0, 0x7fffffff, 0x00020000);
  const unsigned tb0 = tid_ * 16;
  int ob0, ob1;
  {
    int r_, c_;
    stage_rc((int)tb0, r_, c_);
    ob0 = (r_ * K + c_) * 2;
    stage_rc((int)tb0 + 8192, r_, c_);
    ob1 = (r_ * K + c_) * 2;
  }
  WAIT_V(0);
  __syncthreads();
  G_STAGE(G_SB(0, 0), rsB, bcol, 0); G_STAGE(G_SA(0, 0), rsA, brow, 0);
  G_STAGE(G_SB(0, 1), rsB, bcol + GHALF, 0); G_STAGE(G_SA(0, 1), rsA, brow + GHALF, 0);
  if (wr == 1) BAR;
  WAIT_V(4); BAR;
  G_STAGE(G_SB(1, 0), rsB, bcol, 1); G_STAGE(G_SA(1, 0), rsA, brow, 1); G_STAGE(G_SB(1, 1), rsB, bcol + GHALF, 1);
  WAIT_V(6); BAR;
  for (int t = 0; t < nt - 2; t += 2) {
    G_LDB(B0, 0, 0); SCHED; G_LDA(At, 0, 0); G_STAGE(G_SA(1, 1), rsA, brow + GHALF, t + 1);
    WAIT_L(8); BAR; WAIT_L(0); G_MMA(0, 0, At, B0); BAR; SCHED;
    G_LDB(B1, 0, 1); G_STAGE(G_SB(0, 0), rsB, bcol, t + 2);
    BAR; WAIT_L(0); G_MMA(0, 1, At, B1); BAR;
    G_LDA(At, 0, 1); G_STAGE(G_SA(0, 0), rsA, brow, t + 2);
    BAR; WAIT_L(0); G_MMA(1, 0, At, B0); BAR; SCHED;
    G_STAGE(G_SB(0, 1), rsB, bcol + GHALF, t + 2);
    WAIT_V(6); BAR; G_MMA(1, 1, At, B1); BAR;
    G_LDB(B0, 1, 0); SCHED; G_LDA(At, 1, 0); G_STAGE(G_SA(0, 1), rsA, brow + GHALF, t + 2);
    WAIT_L(8); BAR; WAIT_L(0); G_MMA(0, 0, At, B0); BAR; SCHED;
    G_LDB(B1, 1, 1); G_STAGE(G_SB(1, 0), rsB, bcol, t + 3);
    BAR; WAIT_L(0); G_MMA(0, 1, At, B1); BAR;
    G_LDA(At, 1, 1); G_STAGE(G_SA(1, 0), rsA, brow, t + 3);
    BAR; WAIT_L(0); G_MMA(1, 0, At, B0); BAR; SCHED;
    G_STAGE(G_SB(1, 1), rsB, bcol + GHALF, t + 3);
    WAIT_V(6); BAR; G_MMA(1, 1, At, B1); BAR;
  }
  {
    G_LDB(B0, 0, 0); G_LDA(At, 0, 0); G_STAGE(G_SA(1, 1), rsA, brow + GHALF, nt - 1);
    BAR; WAIT_L(0); G_MMA(0, 0, At, B0); BAR;
    G_LDB(B1, 0, 1); BAR; WAIT_L(0); G_MMA(0, 1, At, B1); BAR;
    G_LDA(At, 0, 1); WAIT_V(4); BAR; WAIT_L(0); G_MMA(1, 0, At, B0); G_MMA(1, 1, At, B1); BAR;
  }
  {
    G_LDB(B0, 1, 0); G_LDA(At, 1, 0); WAIT_V(2); BAR; WAIT_L(0); G_MMA(0, 0, At, B0); BAR;
    G_LDB(B1, 1, 1); WAIT_V(0); BAR; WAIT_L(0); G_MMA(0, 1, At, B1); BAR;
    G_LDA(At, 1, 1); BAR; WAIT_L(0); G_MMA(1, 0, At, B0); G_MMA(1, 1, At, B1); BAR;
  }
  if (wr == 0) BAR;
}
#define GT_VARS \
  const int tid_ = otid(); const int wid = tid_ >> 6, lane = tid_ & 63, wr = wid >> 2, wc = wid & 3, fr = lane & 15, fq = lane >> 4;
#define GT_ROW(ai, m, j) ((ai) * 128 + wr * 64 + (m) * 16 + fq * 4 + (j))
#define GT_COL(bj, n) ((bj) * 128 + wc * 32 + (n) * 16 + fr)
#define GT_FOR                                       \
  _Pragma("unroll") for (int ai = 0; ai < 2; ++ai)   \
  _Pragma("unroll") for (int bj = 0; bj < 2; ++bj)   \
  _Pragma("unroll") for (int m = 0; m < 4; ++m)      \
  _Pragma("unroll") for (int n = 0; n < 2; ++n)      \
  _Pragma("unroll") for (int j = 0; j < 4; ++j)

DI bool tile_of(int round, int bid, int nb, int nM, int nN, int& pm, int& pn) {
  const int vt = round * nb + (bid & 7) * (nb >> 3) + (bid >> 3);
  if (vt >= nM * nN) return false;
  const int nig = 8 * nN, gid = vt / nig, fm = gid * 8, gsz = min(nM - fm, 8);
  pm = fm + (vt % nig) % gsz;
  pn = (vt % nig) / gsz;
  return true;
}


constexpr int CS_LD = 264;
DI void acc_to_lds(const f32x4 (&acc)[2][2][4][2]) {
  GT_VARS
  u16* Cs = (u16*)dsm;
  __syncthreads();
  GT_FOR { Cs[GT_ROW(ai, m, j) * CS_LD + GT_COL(bj, n)] = f2bf(acc[ai][bj][m][n][j]); }
  __syncthreads();
}

__device__ void ph_gemm1(const Params& p, int bid, int nb) {
  const int tid_ = otid();
  const int nM = 261, nN = 18;
  for (int round = 0; round * nb < nM * nN; ++round) {
    int pm, pn;
    if (!tile_of(round, bid, nb, nM, nN, pm, pn)) break;
    f32x4 acc[2][2][4][2];
    gemm256<1024>(p.H, p.WinT, pm * 256, pn * 256, acc);
    acc_to_lds(acc);
    const u16* Cs = (const u16*)dsm;
#pragma unroll 4
    for (int it = 0; it < 16; it++) {
      const int id = it * NTH + tid_, rl = id >> 5, c8 = (id & 31) * 8;
      const int row = pm * 256 + rl;
      const u32x4 v = *(const u32x4*)(Cs + rl * CS_LD + c8);
      *(u32x4*)(p.P + (size_t)row * INC + pn * 256 + c8) = v;
      if (pn == 9) {
        float* dst = nullptr;
        const int c2 = c8 & 127;
        if (row < TP) {
          const int tt = row & 4095;
          if (tt >= 3968) dst = p.out + (c8 < 128 ? OFF_KP : OFF_VP) + ((size_t)(row >> 12) * 128 + (tt - 3968)) * 128 + c2;
        } else if (row < T) {
          dst = p.out + (c8 < 128 ? OFF_KS : OFF_VS) + (size_t)(row - TP) * 128 + c2;
        }
        if (dst) {
          *(float4*)dst = make_float4(bflo(v[0]), bfhi(v[0]), bflo(v[1]), bfhi(v[1]));
          *(float4*)(dst + 4) = make_float4(bflo(v[2]), bfhi(v[2]), bflo(v[3]), bfhi(v[3]));
        }
      }
    }
  }
}

DI int prev_row(int g) {
  if (g < TP) return (g & 4095) ? g - 1 : -1;
  const int r2 = g - TP;
  return (r2 & 63) ? g - 1 : T + (r2 >> 6);
}

__device__ void ph_rwprep(const Params& p, int bid, int nb) {
  const int tid = otid(), lane = tid & 63, wv = tid >> 6, fr = lane & 15, fq = lane >> 4;
  u16* A1 = (u16*)dsm;
  u16* A2 = A1 + 64 * 80;
  u16* A3 = A2 + 64 * 80;
  u16* SA = (u16*)(p.out);
  u16* SB = p.H;
  const int hd = wv;
  for (int tile = bid; tile < T / 64; tile += nb) {
    const int g0 = tile * 64;
    __syncthreads();
    {
      const int row = tid >> 3, part8 = tid & 7, part = part8 >> 1, sub = part8 & 1;
      const int g = g0 + row, pr = prev_row(g);
      const int cb = 1536 + part * 64 + sub * 32;
      const u16* cur = p.P + (size_t)g * INC + cb;
      const u16* prv = p.P + (size_t)(pr < 0 ? 0 : pr) * INC + cb;
#pragma unroll
      for (int q = 0; q < 4; q++) {
        const u32x4 c4 = *(const u32x4*)(cur + q * 8);
        u32x4 p4 = {0u, 0u, 0u, 0u};
        if (pr >= 0) p4 = *(const u32x4*)(prv + q * 8);
        u32x4 ow;
#pragma unroll
        for (int e = 0; e < 4; e++) {
          const float c0 = bflo(c4[e]), c1 = bfhi(c4[e]), q0 = bflo(p4[e]), q1 = bfhi(p4[e]);
          float f0 = c0 + (q0 - c0) * p.mu[cb + q * 8 + 2 * e];
          float f1 = c1 + (q1 - c1) * p.mu[cb + q * 8 + 2 * e + 1];
          if (part == 0) { f0 = tanhf(f0); f1 = tanhf(f1); }
          else if (part >= 2) { f0 = sigmoidf_(f0); f1 = sigmoidf_(f1); }
          ow[e] = pack2(f0, f1);
        }
        u16* dst = part == 0 ? A1 + row * 80 + sub * 32 + q * 8
                 : part == 1 ? A2 + row * 80 + sub * 32 + q * 8
                             : A3 + row * 144 + (part - 2) * 64 + sub * 32 + q * 8;
        *(u32x4*)dst = ow;
      }
    }
    __syncthreads();
#pragma unroll 1
    for (int rg = 0; rg < 4; rg++) {
      f32x4 aw[4], aa[4];
#pragma unroll
      for (int nt = 0; nt < 4; nt++) { aw[nt] = f32x4{0.f, 0.f, 0.f, 0.f}; aa[nt] = f32x4{0.f, 0.f, 0.f, 0.f}; }
#pragma unroll
      for (int ks = 0; ks < 2; ks++) {
        const bf16x8 f1 = *(const bf16x8*)(A1 + (rg * 16 + fr) * 80 + ks * 32 + fq * 8);
        const bf16x8 f2 = *(const bf16x8*)(A2 + (rg * 16 + fr) * 80 + ks * 32 + fq * 8);
#pragma unroll
        for (int nt = 0; nt < 4; nt++) {
          const bf16x8 bw = *(const bf16x8*)(p.W2T + (size_t)(hd * 64 + nt * 16 + fr) * 64 + ks * 32 + fq * 8);
          const bf16x8 ba = *(const bf16x8*)(p.A2T + (size_t)(hd * 64 + nt * 16 + fr) * 64 + ks * 32 + fq * 8);
          aw[nt] = MFMA16(f1, bw, aw[nt]);
          aa[nt] = MFMA16(f2, ba, aa[nt]);
        }
      }
      float ss[4] = {0.f, 0.f, 0.f, 0.f};
      const int rowb = rg * 16 + fq * 4;
      const int gb = g0 + rowb;
      const int pr = (rowb == 0) ? prev_row(gb) : gb - 1;
#pragma unroll
      for (int nt = 0; nt < 4; nt++) {
        const int c = nt * 16 + fr, col = hd * 64 + c;
        const float mu_r = p.mu[col], mu_k = p.mu[512 + col], mu_v = p.mu[1024 + col];
        const float w0c = p.w0[col], a0c = p.a0[col], kkc = p.k_k[col], kac = p.k_a[col];
        float qr = 0.f, qk = 0.f, qv = 0.f;
        if (pr >= 0) {
          const u16* pp = p.P + (size_t)pr * INC + col;
          qr = bf2f(pp[0]); qk = bf2f(pp[512]); qv = bf2f(pp[1024]);
        }
#pragma unroll
        for (int j = 0; j < 4; j++) {
          const int gg = gb + j;
          const u16* pc = p.P + (size_t)gg * INC + col;
          const float cr = bf2f(pc[0]), ck = bf2f(pc[512]), cv = bf2f(pc[1024]);
          const float r = cr + (qr - cr) * mu_r, k = ck + (qk - ck) * mu_k, v = cv + (qv - cv) * mu_v;
          qr = cr; qk = ck; qv = cv;
          const float z = -(w0c + aw[nt][j]);
          const float sp = fmaxf(z, 0.f) + log1pf(__expf(-fabsf(z)));
          const float ed = __expf(-sp - 0.5f);
          const float dm = -expm1f(-ed);
          const float a = sigmoidf_(a0c + aa[nt][j]);
          const float kkv = k * kkc;
          ss[j] += kkv * kkv;
          const float k2 = k * (1.f + (a - 1.f) * kac);
          const size_t ba_ = ((size_t)gg * 8 + hd) * 256 + c;
          SA[ba_] = f2bf(r);
          SA[ba_ + 64] = f2bf(dm);
          SA[ba_ + 128] = f2bf(k2);
          SB[((size_t)gg * 8 + hd) * 128 + c] = f2bf(v);
          aw[nt][j] = kkv;
          aa[nt][j] = a;
        }
      }
#pragma unroll
      for (int j = 0; j < 4; j++) ss[j] = 1.f / fmaxf(sqrtf(red16(ss[j])), 1e-12f);
#pragma unroll
      for (int nt = 0; nt < 4; nt++) {
        const int c = nt * 16 + fr;
#pragma unroll
        for (int j = 0; j < 4; j++) {
          const int gg = gb + j;
          const float kkn = aw[nt][j] * ss[j];
          SA[((size_t)gg * 8 + hd) * 256 + 192 + c] = f2bf(kkn);
          SB[((size_t)gg * 8 + hd) * 128 + 64 + c] = f2bf(kkn * aa[nt][j]);
        }
      }
      f32x4 ag[4];
#pragma unroll
      for (int nt = 0; nt < 4; nt++) ag[nt] = f32x4{0.f, 0.f, 0.f, 0.f};
#pragma unroll
      for (int ks = 0; ks < 4; ks++) {
        const bf16x8 f3 = *(const bf16x8*)(A3 + (rg * 16 + fr) * 144 + ks * 32 + fq * 8);
#pragma unroll
        for (int nt = 0; nt < 4; nt++) {
          const bf16x8 bg = *(const bf16x8*)(p.G2T + (size_t)(hd * 64 + nt * 16 + fr) * 128 + ks * 32 + fq * 8);
          ag[nt] = MFMA16(f3, bg, ag[nt]);
        }
      }
#pragma unroll
      for (int nt = 0; nt < 4; nt++)
#pragma unroll
        for (int j = 0; j < 4; j++) p.G[(size_t)(gb + j) * 512 + hd * 64 + nt * 16 + fr] = f2bf(ag[nt][j]);
    }
  }
}

__device__ void ph_scan(const Params& p, int bid, int nb) {
  const int tid = otid(), lane = tid & 63, wv = tid >> 6;
  float* buf = (float*)dsm;
  const u16* SA = (const u16*)(p.out);
  const u16* SB = p.H;
  constexpr int CH = 32;
  for (int item = bid; item < 512; item += nb) {
    const int type = item >> 8, r_ = item & 255, half = r_ & 1, hb = r_ >> 1, h = hb & 7, b = hb >> 3;
    const int nch = type ? 64 / CH : 4096 / CH;
    const int gbase = type ? TP + b * 64 : b * 4096;
    const int row = half * 32 + wv * 4 + (lane >> 4), j0 = (lane & 15) * 4;
    float S[4] = {0.f, 0.f, 0.f, 0.f};
    if (type) {
      const float4 s0 = *(const float4*)(p.state_wkv + ((size_t)(b * 8 + h) * 64 + row) * 64 + j0);
      S[0] = s0.x; S[1] = s0.y; S[2] = s0.z; S[3] = s0.w;
    }
    u32x4 la[2], lb;
    auto gload = [&](int c) {
#pragma unroll
      for (int q = 0; q < 2; q++) {
        const int idx = tid + q * NTH, step = idx >> 5, u = idx & 31;
        la[q] = *(const u32x4*)(SA + ((size_t)(gbase + c * CH + step) * 8 + h) * 256 + u * 8);
      }
      {
        const int step = tid >> 4, u = tid & 15;
        lb = *(const u32x4*)(SB + ((size_t)(gbase + c * CH + step) * 8 + h) * 128 + u * 8);
      }
    };
    gload(0);
    for (int c = 0; c < nch; c++) {
      __syncthreads();
#pragma unroll
      for (int q = 0; q < 2; q++) {
        const int idx = tid + q * NTH, step = idx >> 5, u = idx & 31, arr = u >> 3, c0 = (u & 7) * 8;
        float* d = buf + step * 384 + arr * 64 + c0;
        float f[8];
#pragma unroll
        for (int e = 0; e < 4; e++) { f[2 * e] = bflo(la[q][e]); f[2 * e + 1] = bfhi(la[q][e]); }
        if (arr == 1) {
#pragma unroll
          for (int e = 0; e < 8; e++) f[e] = 1.f - f[e];
        }
        *(float4*)d = make_float4(f[0], f[1], f[2], f[3]);
        *(float4*)(d + 4) = make_float4(f[4], f[5], f[6], f[7]);
      }
      {
        const int step = tid >> 4, u = tid & 15, arr = u >> 3, c0 = (u & 7) * 8;
        float* d = buf + step * 384 + (4 + arr) * 64 + c0;
        *(float4*)d = make_float4(bflo(lb[0]), bfhi(lb[0]), bflo(lb[1]), bfhi(lb[1]));
        *(float4*)(d + 4) = make_float4(bflo(lb[2]), bfhi(lb[2]), bflo(lb[3]), bfhi(lb[3]));
      }
      __syncthreads();
      if (c + 1 < nch) gload(c + 1);
#pragma unroll 4
      for (int s = 0; s < CH; s++) {
        const float* sb = buf + s * 384;
        const float4 rr = *(const float4*)(sb + j0), dd = *(const float4*)(sb + 64 + j0), kk_ = *(const float4*)(sb + 128 + j0);
        const float4 kn = *(const float4*)(sb + 192 + j0), bb = *(const float4*)(sb + 320 + j0);
        const float vi = sb[256 + row];
        float sa = S[0] * kn.x + S[1] * kn.y + S[2] * kn.z + S[3] * kn.w;
        sa = -red16(sa);
        S[0] = S[0] * dd.x + vi * kk_.x + sa * bb.x;
        S[1] = S[1] * dd.y + vi * kk_.y + sa * bb.y;
        S[2] = S[2] * dd.z + vi * kk_.z + sa * bb.z;
        S[3] = S[3] * dd.w + vi * kk_.w + sa * bb.w;
        float yp = S[0] * rr.x + S[1] * rr.y + S[2] * rr.z + S[3] * rr.w;
        yp = red16(yp);
        if ((lane & 15) == 0) p.Y[(size_t)(gbase + c * CH + s) * 512 + h * 64 + row] = f2bf(yp);
      }
    }
    float* so = p.out + (type ? OFF_WKV_S : OFF_WKV_P) + ((size_t)(b * 8 + h) * 64 + row) * 64 + j0;
    *(float4*)so = make_float4(S[0], S[1], S[2], S[3]);
  }
}

__device__ void ph_attn(const Params& p, int bid, int nb, bool dry = false) {
  const int tid = otid(), lane = tid & 63, wv = tid >> 6, fr = lane & 15, fq = lane >> 4;
  u16* Ks = (u16*)dsm;
  u16* Vt = Ks + 192 * 72;
  for (int item = bid; item < 2080; item += nb) {
    const int kvh = item & 1, r = item >> 1;
    const bool samp = r >= 1024;
    const int b = samp ? r - 1024 : r >> 6, c = samp ? 0 : (r & 63);
    const int gq0 = samp ? TP + b * 64 : b * 4096 + c * 64;
    __syncthreads();
#pragma unroll
    for (int q = 0; q < 3; q++) {
      const int idx = tid + q * NTH, j = idx >> 3, d0 = (idx & 7) * 8;
      u32x4 kq = {0u, 0u, 0u, 0u}, vq = {0u, 0u, 0u, 0u};
      if (!samp) {
        const int tok = (c - 2) * 64 + j;
        if (tok >= 0) {
          const u16* src = p.P + (size_t)(b * 4096 + tok) * INC + 2304 + kvh * 64 + d0;
          kq = *(const u32x4*)src;
          vq = *(const u32x4*)(src + 128);
        }
      } else if (j < 128) {
        const float4* ck = (const float4*)(p.cache_k + ((size_t)(b * 128 + j) * 2 + kvh) * 64 + d0);
        const float4* cv = (const float4*)(p.cache_v + ((size_t)(b * 128 + j) * 2 + kvh) * 64 + d0);
        const float4 k0 = ck[0], k1 = ck[1], v0 = cv[0], v1 = cv[1];
        kq = u32x4{pack2(k0.x, k0.y), pack2(k0.z, k0.w), pack2(k1.x, k1.y), pack2(k1.z, k1.w)};
        vq = u32x4{pack2(v0.x, v0.y), pack2(v0.z, v0.w), pack2(v1.x, v1.y), pack2(v1.z, v1.w)};
      } else {
        const u16* src = p.P + (size_t)(TP + b * 64 + (j - 128)) * INC + 2304 + kvh * 64 + d0;
        kq = *(const u32x4*)src;
        vq = *(const u32x4*)(src + 128);
      }
      *(u32x4*)(Ks + j * 72 + d0) = kq;
#pragma unroll
      for (int e = 0; e < 4; e++) {
        Vt[(d0 + 2 * e) * 196 + j] = (u16)(vq[e] & 0xffffu);
        Vt[(d0 + 2 * e + 1) * 196 + j] = (u16)(vq[e] >> 16);
      }
    }
    __syncthreads();
    const int qh = kvh * 4 + (wv & 3);
    const float slope = exp2f(-(float)(qh + 1)), sink = p.sinks[qh];
#pragma unroll 1
    for (int ps = 0; ps < 2; ps++) {
      const int q0 = (wv >> 2) * 32 + ps * 16;
      const int tq = q0 + fr;
      const u16* qp = p.P + (size_t)(gq0 + tq) * INC + 1792 + qh * 64 + fq * 8;
      const bf16x8 qf0 = *(const bf16x8*)(qp), qf1 = *(const bf16x8*)(qp + 32);
      f32x4 sc[12];
#pragma unroll
      for (int kt = 0; kt < 12; kt++) {
        sc[kt] = f32x4{0.f, 0.f, 0.f, 0.f};
        const bf16x8 a0 = *(const bf16x8*)(Ks + (kt * 16 + fr) * 72 + fq * 8);
        const bf16x8 a1 = *(const bf16x8*)(Ks + (kt * 16 + fr) * 72 + 32 + fq * 8);
        sc[kt] = MFMA16(a0, qf0, sc[kt]);
        sc[kt] = MFMA16(a1, qf1, sc[kt]);
        if ((kt & 3) == 3) SCHED;
      }
      float mx = -3e38f;
#pragma unroll
      for (int kt = 0; kt < 12; kt++)
#pragma unroll
        for (int j = 0; j < 4; j++) {
          const int key = kt * 16 + fq * 4 + j;
          float s = sc[kt][j] * 0.125f - slope * fabsf((float)(128 + tq - key));
          if (!samp && (c - 2) * 64 + key < 0) s = -1e30f;
          sc[kt][j] = s;
          mx = fmaxf(mx, s);
        }
      mx = fmaxf(mx, __shfl_xor(mx, 16));
      mx = fmaxf(mx, __shfl_xor(mx, 32));
      mx = fmaxf(mx, sink);
      float sum = 0.f;
#pragma unroll
      for (int kt = 0; kt < 12; kt++)
#pragma unroll
        for (int j = 0; j < 4; j++) {
          const float e = __expf(sc[kt][j] - mx);
          sc[kt][j] = e;
          sum += e;
        }
      sum += __shfl_xor(sum, 16);
      sum += __shfl_xor(sum, 32);
      sum += __expf(sink - mx);
      const float inv = 1.f / sum;
      f32x4 o[4];
#pragma unroll
      for (int dt = 0; dt < 4; dt++) o[dt] = f32x4{0.f, 0.f, 0.f, 0.f};
#pragma unroll
      for (int t2 = 0; t2 < 6; t2++) {
        const u32x4 pw = {pack2(sc[2 * t2][0] * inv, sc[2 * t2][1] * inv), pack2(sc[2 * t2][2] * inv, sc[2 * t2][3] * inv),
                          pack2(sc[2 * t2 + 1][0] * inv, sc[2 * t2 + 1][1] * inv),
                          pack2(sc[2 * t2 + 1][2] * inv, sc[2 * t2 + 1][3] * inv)};
        const bf16x8 pa = __builtin_bit_cast(bf16x8, pw);
#pragma unroll
        for (int dt = 0; dt < 4; dt++) {
          const u16* vp = Vt + (dt * 16 + fr) * 196 + t2 * 32 + fq * 4;
          const uint2 v0 = *(const uint2*)vp, v1 = *(const uint2*)(vp + 16);
          const bf16x8 vb = __builtin_bit_cast(bf16x8, u32x4{v0.x, v0.y, v1.x, v1.y});
          o[dt] = MFMA16(pa, vb, o[dt]);
        }
        SCHED;
      }
#pragma unroll
      for (int dt = 0; dt < 4; dt++)
#pragma unroll
        for (int j = 0; j < 4; j++)
          p.OATT[(size_t)(gq0 + q0 + fq * 4 + j) * 512 + qh * 64 + dt * 16 + fr] = f2bf(o[dt][j]);
    }
  }
  const u16* SA = (const u16*)(p.out);
  const u16* SB = p.H;
  for (int it = bid * NW + wv; it < T * 8; it += nb * NW) {
    const int g = it >> 3, h = it & 7, col = h * 64 + lane;
    const float y = bf2f(p.Y[(size_t)g * 512 + col]);
    const float mean = wave_sum(y) * (1.f / 64.f);
    const float dy = y - mean;
    const float var = wave_sum(dy * dy) * (1.f / 64.f);
    float yn = dy * rsqrtf(var + 64e-5f) * p.lnx_w[col] + p.lnx_b[col];
    const size_t ba_ = (size_t)it * 256 + lane;
    const float r = bf2f(SA[ba_]), k2 = bf2f(SA[ba_ + 128]);
    const float v = bf2f(SB[(size_t)it * 128 + lane]);
    const float bonus = wave_sum(r * k2 * p.r_k[col]);
    yn += bonus * v;
    if (!dry || yn == 123.456f) p.Y[(size_t)g * 512 + col] = f2bf(yn * bf2f(p.G[(size_t)g * 512 + col]));
  }
}

__device__ void ph_gemm2(const Params& p, int bid, int nb) {
  const int tid_ = otid();
  u16* MG = p.H;
  const u16* Cs = (const u16*)dsm;
  const int nM = 260, nN = 4;
  for (int round = 0; round * nb < nM * nN; ++round) {
    int pm, pn;
    if (!tile_of(round, bid, nb, nM, nN, pm, pn)) break;
    f32x4 acc[2][2][4][2];
#pragma unroll 1
    for (int br = 0; br < 2; br++) {
      gemm256<512>(br ? p.OATT : p.Y, p.WbT + (size_t)br * 1024 * 512, pm * 256, pn * 256, acc);
      acc_to_lds(acc);
#pragma unroll 2
      for (int it = 0; it < 16; it++) {
        const int id = it * NTH + tid_, rl = id >> 5, c8 = (id & 31) * 8;
        const int row = pm * 256 + rl, col = pn * 256 + c8;
        const u32x4 v = *(const u32x4*)(Cs + rl * CS_LD + c8);
        const u32x4 gw = *(const u32x4*)(p.P + (size_t)row * INC + 2560 + br * 1024 + col);
        u32x4 prev = {0u, 0u, 0u, 0u};
        if (br) prev = *(const u32x4*)(MG + (size_t)row * 1024 + col);
        u32x4 o;
#pragma unroll
        for (int e = 0; e < 4; e++) {
          const float r0 = bflo(prev[e]) + sigmoidf_(bflo(gw[e])) * bflo(v[e]);
          const float r1 = bfhi(prev[e]) + sigmoidf_(bfhi(gw[e])) * bfhi(v[e]);
          o[e] = pack2(r0, r1);
        }
        *(u32x4*)(MG + (size_t)row * 1024 + col) = o;
      }
    }
  }
}

__device__ void ph_gemm3(const Params& p, int bid, int nb) {
  const int tid_ = otid();
  const u16* MG = p.H;
  const u16* Cs = (const u16*)dsm;
  const int nM = 260, nN = 4;
  for (int round = 0; round * nb < nM * nN; ++round) {
    int pm, pn;
    if (!tile_of(round, bid, nb, nM, nN, pm, pn)) break;
    f32x4 acc[2][2][4][2];
    gemm256<1024>(MG, p.WoutT, pm * 256, pn * 256, acc);
    acc_to_lds(acc);
#pragma unroll 2
    for (int it = 0; it < 16; it++) {
      const int id = it * NTH + tid_, rl = id >> 5, c8 = (id & 31) * 8;
      const int row = pm * 256 + rl, col = pn * 256 + c8;
      const u32x4 v = *(const u32x4*)(Cs + rl * CS_LD + c8);
      const float* xr = xrow(p, row) + col;
      const float4 x0 = *(const float4*)xr, x1 = *(const float4*)(xr + 4);
      float* dst = p.out + (size_t)row * 1024 + col;
      *(float4*)dst = make_float4(x0.x + bflo(v[0]), x0.y + bfhi(v[0]), x0.z + bflo(v[1]), x0.w + bfhi(v[1]));
      *(float4*)(dst + 4) = make_float4(x1.x + bflo(v[2]), x1.y + bfhi(v[2]), x1.z + bflo(v[3]), x1.w + bfhi(v[3]));
    }
  }
}

__device__ void ph_norm2(const Params& p, int bid, int nb) {
  const int tid = otid(), lane = tid & 63, wv = tid >> 6;
  for (int row = bid * NW + wv; row < T; row += nb * NW) {
    const float4* x = (const float4*)(p.out + (size_t)row * 1024);
    float4 v[4];
    float ss = 0.f;
#pragma unroll
    for (int i = 0; i < 4; i++) {
      v[i] = x[lane + i * 64];
      ss += v[i].x * v[i].x + v[i].y * v[i].y + v[i].z * v[i].z + v[i].w * v[i].w;
    }
    ss = wave_sum(ss);
    const float rs = rsqrtf(ss * (1.f / 1024.f) + 1e-6f);
    u16* hr = p.H + (size_t)row * 1024;
#pragma unroll
    for (int i = 0; i < 4; i++) {
      const float4 g = ((const float4*)p.norm2_g)[lane + i * 64];
      ((uint2*)hr)[lane + i * 64] = make_uint2(pack2(v[i].x * rs * g.x, v[i].y * rs * g.y), pack2(v[i].z * rs * g.z, v[i].w * rs * g.w));
    }
  }
}

DI void ins16(float (&l)[16], float x) {
#pragma unroll
  for (int i = 0; i < 16; i++) {
    const float hi = fmaxf(l[i], x);
    x = fminf(l[i], x);
    l[i] = hi;
  }
}

__device__ void ph_peerq(const Params& p, int bid, int nb) {
  GT_VARS
  const int l31 = lane & 31, kh = lane >> 5;
  u16* Qs = (u16*)dsm;
  unsigned char* lt = (unsigned char*)(dsm + 135168 + wid * 1024);
  int* IDX = (int*)p.G;
  float* GATE = (float*)p.OATT;
  const int nM = 260, nN = 4;
  for (int round = 0; round * nb < nM * nN; ++round) {
    int pm, pn;
    if (!tile_of(round, bid, nb, nM, nN, pm, pn)) break;
    {
      f32x4 acc[2][2][4][2];
      gemm256<1024>(p.H, p.WqT, pm * 256, pn * 256, acc);
      acc_to_lds(acc);
    }
#pragma unroll 1
    for (int hh = 0; hh < 2; hh++) {
      const int hp = pn * 2 + hh;
      float l1[16], l2[16];
#pragma unroll
      for (int i = 0; i < 16; i++) { l1[i] = 0.f; l2[i] = 0.f; }
#pragma unroll 1
      for (int pp = 0; pp < 2; pp++) {
        f32x16 sc[4];
#pragma unroll
        for (int m4 = 0; m4 < 4; m4++) {
#pragma unroll
          for (int i = 0; i < 16; i++) sc[m4][i] = 0.f;
#pragma unroll
          for (int kk = 0; kk < 4; kk++) {
            const bf16x8 a = *(const bf16x8*)(p.SK + (size_t)(pp * 128 + m4 * 32 + l31) * 64 + kk * 16 + kh * 8);
            const bf16x8 bq = *(const bf16x8*)(Qs + (wid * 32 + l31) * 264 + hh * 128 + pp * 64 + kk * 16 + kh * 8);
            sc[m4] = MFMA32(a, bq, sc[m4]);
          }
        }
        float l[16];
#pragma unroll
        for (int i = 0; i < 16; i++) l[i] = -3e38f;
#pragma unroll
        for (int m4 = 0; m4 < 4; m4++)
#pragma unroll
          for (int i = 0; i < 16; i++) {
            const u32 nn = m4 * 32 + (i >> 2) * 8 + kh * 4 + (i & 3);
            ins16(l, __uint_as_float((__float_as_uint(sc[m4][i]) & ~0x7Fu) | nn));
          }
        float o[16];
#pragma unroll
        for (int i = 0; i < 16; i++) o[i] = __shfl_xor(l[i], 32);
#pragma unroll
        for (int i = 0; i < 16; i++) ins16(l, o[i]);
#pragma unroll
        for (int i = 0; i < 16; i++) {
          l1[i] = pp == 0 ? l[i] : l1[i];
          l2[i] = pp == 0 ? l2[i] : l[i];
        }
      }
      if (kh == 0) {
        u32 w[8];
#pragma unroll
        for (int q = 0; q < 4; q++) {
          w[q] = (__float_as_uint(l1[4 * q]) & 0x7F) | ((__float_as_uint(l1[4 * q + 1]) & 0x7F) << 8) |
                 ((__float_as_uint(l1[4 * q + 2]) & 0x7F) << 16) | ((__float_as_uint(l1[4 * q + 3]) & 0x7F) << 24);
          w[4 + q] = (__float_as_uint(l2[4 * q]) & 0x7F) | ((__float_as_uint(l2[4 * q + 1]) & 0x7F) << 8) |
                     ((__float_as_uint(l2[4 * q + 2]) & 0x7F) << 16) | ((__float_as_uint(l2[4 * q + 3]) & 0x7F) << 24);
        }
        *(uint4*)(lt + l31 * 32) = make_uint4(w[0], w[1], w[2], w[3]);
        *(uint4*)(lt + l31 * 32 + 16) = make_uint4(w[4], w[5], w[6], w[7]);
      }
      float l3[16];
#pragma unroll
      for (int i = 0; i < 16; i++) l3[i] = -3e38f;
#pragma unroll
      for (int a = 0; a < 16; a++)
#pragma unroll
        for (int b = 0; b < 16; b++)
          if ((a + 1) * (b + 1) <= 16) {
            const float s = __uint_as_float(__float_as_uint(l1[a]) & ~0x7Fu) + __uint_as_float(__float_as_uint(l2[b]) & ~0x7Fu);
            ins16(l3, __uint_as_float((__float_as_uint(s) & ~0xFFu) | (u32)(a * 16 + b)));
          }
      __builtin_amdgcn_fence(__ATOMIC_RELEASE, "workgroup");
      __builtin_amdgcn_wave_barrier();
      if (kh == 0) {
        const int g = pm * 256 + wid * 32 + l31;
        float ev[16];
        int ei[16];
        float sum = 0.f;
        const float mxv = __uint_as_float(__float_as_uint(l3[0]) & ~0xFFu);
#pragma unroll
        for (int k = 0; k < 16; k++) {
          const u32 bits = __float_as_uint(l3[k]);
          const u32 pos = bits & 0xFF;
          ev[k] = __expf(__uint_as_float(bits & ~0xFFu) - mxv);
          sum += ev[k];
          ei[k] = (int)lt[l31 * 32 + (pos >> 4)] * 128 + (int)lt[l31 * 32 + 16 + (pos & 15)];
        }
        const float inv = 1.f / sum;
        int4* ip = (int4*)(IDX + (size_t)g * 128 + hp * 16);
        float4* gp = (float4*)(GATE + (size_t)g * 128 + hp * 16);
#pragma unroll
        for (int q = 0; q < 4; q++) {
          ip[q] = make_int4(ei[4 * q], ei[4 * q + 1], ei[4 * q + 2], ei[4 * q + 3]);
          gp[q] = make_float4(ev[4 * q] * inv, ev[4 * q + 1] * inv, ev[4 * q + 2] * inv, ev[4 * q + 3] * inv);
        }
      }
      __builtin_amdgcn_wave_barrier();
    }
  }
}

__device__ void ph_peer(const Params& p, int bid, int nb, bool dry = false) {
  const int tid = otid(), lane = tid & 63, wv = tid >> 6;
  char* wb = dsm + wv * 3072;
  u16* hs = (u16*)wb;
  float* acts = (float*)(wb + 2048);
  int* idxs = (int*)(wb + 2560);
  const int* IDX = (const int*)p.G;
  const float* GATE = (const float*)p.OATT;
  const int n = lane & 15, quad = lane >> 4;
  for (int g = bid * NW + wv; g < T; g += nb * NW) {
    const u16* h2 = p.H + (size_t)g * 1024;
    *(uint4*)(hs + lane * 8) = *(const uint4*)(h2 + lane * 8);
    *(uint4*)(hs + 512 + lane * 8) = *(const uint4*)(h2 + 512 + lane * 8);
    idxs[lane] = IDX[(size_t)g * 128 + lane];
    idxs[lane + 64] = IDX[(size_t)g * 128 + 64 + lane];
    __builtin_amdgcn_fence(__ATOMIC_RELEASE, "workgroup");
    __builtin_amdgcn_wave_barrier();
#pragma unroll 1
    for (int grp = 0; grp < 8; grp++) {
      const int e = idxs[grp * 16 + n];
      const u16* ur = p.Ubf + (size_t)e * 1024 + quad * 8;
      f32x4 acc = {0.f, 0.f, 0.f, 0.f};
#pragma unroll 16
      for (int kk = 0; kk < 32; kk++) {
        const bf16x8 a = *(const bf16x8*)(ur + kk * 32);
        const bf16x8 bb = *(const bf16x8*)(hs + kk * 32 + quad * 8);
        acc = MFMA16(a, bb, acc);
      }
      const float4 gt = *(const float4*)(GATE + (size_t)g * 128 + grp * 16 + quad * 4);
      float4 av;
      av.x = 0.5f * acc[0] * (1.f + erff(acc[0] * 0.70710678118f)) * gt.x;
      av.y = 0.5f * acc[1] * (1.f + erff(acc[1] * 0.70710678118f)) * gt.y;
      av.z = 0.5f * acc[2] * (1.f + erff(acc[2] * 0.70710678118f)) * gt.z;
      av.w = 0.5f * acc[3] * (1.f + erff(acc[3] * 0.70710678118f)) * gt.w;
      if (n == 0) *(float4*)(acts + grp * 16 + quad * 4) = av;
    }
    __builtin_amdgcn_fence(__ATOMIC_RELEASE, "workgroup");
    __builtin_amdgcn_wave_barrier();
    float o[16];
#pragma unroll
    for (int j = 0; j < 16; j++) o[j] = 0.f;
#pragma unroll 8
    for (int k = 0; k < 128; k++) {
      const float a = acts[k];
      const int e = idxs[k];
      const u16* vr = p.Vbf + (size_t)e * 1024 + lane * 8;
      const uint4 v0 = *(const uint4*)vr, v1 = *(const uint4*)(vr + 512);
      o[0] += a * bflo(v0.x); o[1] += a * bfhi(v0.x); o[2] += a * bflo(v0.y); o[3] += a * bfhi(v0.y);
      o[4] += a * bflo(v0.z); o[5] += a * bfhi(v0.z); o[6] += a * bflo(v0.w); o[7] += a * bfhi(v0.w);
      o[8] += a * bflo(v1.x); o[9] += a * bfhi(v1.x); o[10] += a * bflo(v1.y); o[11] += a * bfhi(v1.y);
      o[12] += a * bflo(v1.z); o[13] += a * bfhi(v1.z); o[14] += a * bflo(v1.w); o[15] += a * bfhi(v1.w);
    }
    float* xr = p.out + (size_t)g * 1024;
    float4 x[4];
    x[0] = *(const float4*)(xr + lane * 8);
    x[1] = *(const float4*)(xr + lane * 8 + 4);
    x[2] = *(const float4*)(xr + 512 + lane * 8);
    x[3] = *(const float4*)(xr + 512 + lane * 8 + 4);
    float ss = 0.f;
#pragma unroll
    for (int q = 0; q < 4; q++) {
      x[q].x += o[4 * q]; x[q].y += o[4 * q + 1]; x[q].z += o[4 * q + 2]; x[q].w += o[4 * q + 3];
      ss += x[q].x * x[q].x + x[q].y * x[q].y + x[q].z * x[q].z + x[q].w * x[q].w;
    }
    ss = wave_sum(ss);
    if (dry && ss != 123.456f) continue;
    const float rs = rsqrtf(ss * (1.f / 1024.f) + 1e-6f);
    const float4 g0 = *(const float4*)(p.final_g + lane * 8), g1 = *(const float4*)(p.final_g + lane * 8 + 4);
    const float4 g2 = *(const float4*)(p.final_g + 512 + lane * 8), g3 = *(const float4*)(p.final_g + 512 + lane * 8 + 4);
    *(float4*)(xr + lane * 8) = make_float4(x[0].x * rs * g0.x, x[0].y * rs * g0.y, x[0].z * rs * g0.z, x[0].w * rs * g0.w);
    *(float4*)(xr + lane * 8 + 4) = make_float4(x[1].x * rs * g1.x, x[1].y * rs * g1.y, x[1].z * rs * g1.z, x[1].w * rs * g1.w);
    *(float4*)(xr + 512 + lane * 8) = make_float4(x[2].x * rs * g2.x, x[2].y * rs * g2.y, x[2].z * rs * g2.z, x[2].w * rs * g2.w);
    *(float4*)(xr + 512 + lane * 8 + 4) = make_float4(x[3].x * rs * g3.x, x[3].y * rs * g3.y, x[3].z * rs * g3.z, x[3].w * rs * g3.w);
  }
}

__global__ void __launch_bounds__(512) mega_kernel(Params p) {
  cg::grid_group grid = cg::this_grid();
  const int bid = blockIdx.x, nb = gridDim.x;
  if (ON(0)) ph_prep(p, bid, nb);
  grid.sync();
  if (ON(1)) ph_gemm1(p, bid, nb);
  grid.sync();
  if (REP == 1) { ph_gemm1(p, bid, nb); grid.sync(); }
  if (ON(2)) ph_rwprep(p, bid, nb);
  grid.sync();
  if (REP == 2) { ph_rwprep(p, bid, nb); grid.sync(); }
  if (ON(3)) ph_scan(p, bid, nb);
  grid.sync();
  if (REP == 3) { ph_scan(p, bid, nb); grid.sync(); }
  if (REP == 4) { ph_attn(p, bid, nb, true); grid.sync(); }
  if (ON(4)) ph_attn(p, bid, nb);
  grid.sync();
  if (ON(5)) ph_gemm2(p, bid, nb);
  grid.sync();
  if (REP == 5) { ph_gemm2(p, bid, nb); grid.sync(); }
  if (ON(6)) ph_gemm3(p, bid, nb);
  grid.sync();
  if (REP == 6) { ph_gemm3(p, bid, nb); grid.sync(); }
  if (ON(7)) ph_norm2(p, bid, nb);
  grid.sync();
  if (ON(8)) ph_peerq(p, bid, nb);
  grid.sync();
  if (REP == 8) { ph_peerq(p, bid, nb); grid.sync(); }
  if (REP == 9) { ph_peer(p, bid, nb, true); grid.sync(); }
  if (ON(9)) ph_peer(p, bid, nb);
}

extern "C" void kernel_launch(void* const* d_in, const int* in_sizes, int n_in, void* d_out, int out_size, void* d_ws,
                              size_t ws_size, hipStream_t stream) {
  Params p{};
  const float** f = (const float**)&p;
  for (int i = 0; i < 28; i++) f[i] = (const float*)d_in[i];
  p.out = (float*)d_out;
  char* w = (char*)d_ws;
  size_t off = 0;
  auto take = [&](size_t bytes) { char* r = w + off; off += (bytes + 255) & ~(size_t)255; return (u16*)r; };
  p.H = take((size_t)MP * 1024 * 2);
  p.P = take((size_t)MP * INC * 2);
  p.Ubf = take((size_t)16384 * 1024 * 2);
  p.Vbf = take((size_t)16384 * 1024 * 2);
  p.WinT = take((size_t)4608 * 1024 * 2);
  p.WbT = take((size_t)2 * 1024 * 512 * 2);
  p.WoutT = take((size_t)1024 * 1024 * 2);
  p.WqT = take((size_t)1024 * 1024 * 2);
  p.W2T = take((size_t)512 * 64 * 2);
  p.A2T = take((size_t)512 * 64 * 2);
  p.G2T = take((size_t)512 * 128 * 2);
  p.SK = take((size_t)2 * 128 * 64 * 2);
  p.Y = take((size_t)T * 512 * 2);
  p.G = take((size_t)T * 512 * 2);
  p.OATT = take((size_t)T * 512 * 2);
  static int grid_blocks = 0;
  if (!grid_blocks) {
    int dev = 0, cus = 0, per_cu = 0;
    (void)hipGetDevice(&dev);
    (void)hipDeviceGetAttribute(&cus, hipDeviceAttributeMultiprocessorCount, dev);
    (void)hipFuncSetAttribute((const void*)mega_kernel, hipFuncAttributeMaxDynamicSharedMemorySize, DYN_LDS);
    (void)hipOccupancyMaxActiveBlocksPerMultiprocessor(&per_cu, mega_kernel, NTH, DYN_LDS);
    if (per_cu > 1) per_cu = 1;
    grid_blocks = cus * per_cu;
  }
  void* args[] = {&p};
  hipError_t e = hipLaunchCooperativeKernel((void*)mega_kernel, dim3(grid_blocks), dim3(NTH), args, DYN_LDS, stream);
  if (e != hipSuccess) fprintf(stderr, "cooperative launch failed: %s (grid %d)\n", hipGetErrorString(e), grid_blocks);
}
```

```cpp
#include <hip/hip_runtime.h>
#include <hip/hip_cooperative_groups.h>
#include <cstdio>
namespace cg = cooperative_groups;

#ifndef REP
#define REP -1
#endif
#ifndef ONLY
#define ONLY -1
#endif
#define ON(k) (ONLY < 0 || ONLY == (k))

typedef unsigned short u16;
typedef unsigned int u32;
using bf16x8 = __attribute__((ext_vector_type(8))) short;
using f32x4 = __attribute__((ext_vector_type(4))) float;
using f32x16 = __attribute__((ext_vector_type(16))) float;
using u32x4 = __attribute__((ext_vector_type(4))) u32;
#define DI __device__ __forceinline__

constexpr int TP = 65536, TS = 1024, T = 66560, MP = 66816;
constexpr int INC = 4608;
constexpr int NW = 8;
constexpr int NTH = 512;
constexpr size_t OFF_Y = 0, OFF_SHIFT_P = 68157440, OFF_WKV_P = 68173824, OFF_KP = 68698112, OFF_VP = 68960256,
                 OFF_SHIFT_S = 69222400, OFF_WKV_S = 69238784, OFF_KS = 69763072, OFF_VS = 69894144;
constexpr int DYN_LDS = 147456;

extern __shared__ __attribute__((aligned(16))) char dsm[];

struct Params {
  const float *x_prompt, *x_sample, *state_shift, *state_wkv, *cache_k, *cache_v, *norm1_g, *w_in, *mu, *w0, *w2, *a0,
      *a2, *g2, *k_k, *k_a, *r_k, *lnx_w, *lnx_b, *sinks, *w_branch, *w_out, *norm2_g, *peer_wq, *sub_keys, *peer_u,
      *peer_v, *final_g;
  float* out;
  u16 *H, *P, *WinT, *WbT, *WoutT, *WqT, *W2T, *A2T, *G2T, *SK, *Y, *G, *OATT;
  unsigned char *U8, *V8;
  float *SU, *SV, *SH;
};

DI u16 f2bf(float x) {
  u32 u = __float_as_uint(x);
  u += 0x7fffu + ((u >> 16) & 1u);
  return (u16)(u >> 16);
}
DI float bf2f(u16 b) { return __uint_as_float(((u32)b) << 16); }
DI u32 pack2(float a, float b) { return (u32)f2bf(a) | ((u32)f2bf(b) << 16); }
DI float bflo(u32 w) { return __uint_as_float(w << 16); }
DI float bfhi(u32 w) { return __uint_as_float(w & 0xffff0000u); }
DI float wave_sum(float v) {
#pragma unroll
  for (int o = 32; o; o >>= 1) v += __shfl_xor(v, o);
  return v;
}
DI float sigmoidf_(float x) { return 1.f / (1.f + __expf(-x)); }
DI const float* xrow(const Params& p, int g) {
  return g < TP ? p.x_prompt + (size_t)g * 1024 : p.x_sample + (size_t)(g - TP) * 1024;
}
DI int otid() { int t = threadIdx.x; asm volatile("" : "+v"(t)); return t; }
#define MFMA32(a, b, c) __builtin_amdgcn_mfma_f32_32x32x16_bf16((a), (b), (c), 0, 0, 0)
#define MFMA16(a, b, c) __builtin_amdgcn_mfma_f32_16x16x32_bf16((a), (b), (c), 0, 0, 0)

template <int CTRL>
DI float dppmov(float v) {
  return __int_as_float(__builtin_amdgcn_update_dpp(0, __float_as_int(v), CTRL, 0xF, 0xF, false));
}
DI float red16(float v) {
  v += dppmov<0x128>(v);
  v += dppmov<0x124>(v);
  v += dppmov<0x122>(v);
  v += dppmov<0x121>(v);
  return v;
}


using f32x2 = __attribute__((ext_vector_type(2))) float;
DI float wave_max(float v) {
#pragma unroll
  for (int o = 32; o; o >>= 1) v = fmaxf(v, __shfl_xor(v, o));
  return v;
}
DI u32 q4(float a, float b, float c, float d, float sc) {
  int w = 0;
  w = __builtin_amdgcn_cvt_pk_fp8_f32(a * sc, b * sc, w, false);
  w = __builtin_amdgcn_cvt_pk_fp8_f32(c * sc, d * sc, w, true);
  return (u32)w;
}

DI void tcvt(const float* __restrict__ W, u16* __restrict__ Wt, int K, int N, int gt, int nt) {
  const int total = N * (K / 8);
  for (int i = gt; i < total; i += nt) {
    const int n = i % N, kg = i / N;
    u32 o[4];
#pragma unroll
    for (int j = 0; j < 4; j++)
      o[j] = pack2(W[(size_t)(kg * 8 + 2 * j) * N + n], W[(size_t)(kg * 8 + 2 * j + 1) * N + n]);
    *(uint4*)(Wt + (size_t)n * K + kg * 8) = make_uint4(o[0], o[1], o[2], o[3]);
  }
}
DI void scvt(const float* __restrict__ W, u16* __restrict__ O, int n8, int gt, int nt) {
  for (int i = gt; i < n8; i += nt) {
    const float4 a = ((const float4*)W)[2 * i], b = ((const float4*)W)[2 * i + 1];
    ((uint4*)O)[i] = make_uint4(pack2(a.x, a.y), pack2(a.z, a.w), pack2(b.x, b.y), pack2(b.z, b.w));
  }
}

__device__ void ph_prep(const Params& p, int bid, int nb) {
  const int tid = otid(), lane = tid & 63, wv = tid >> 6;
  for (int row = bid * NW + wv; row < MP; row += nb * NW) {
    u16* hr = p.H + (size_t)row * 1024;
    if (row < T) {
      const float4* x = (const float4*)xrow(p, row);
      float4 v[4];
      float ss = 0.f;
#pragma unroll
      for (int i = 0; i < 4; i++) {
        v[i] = x[lane + i * 64];
        ss += v[i].x * v[i].x + v[i].y * v[i].y + v[i].z * v[i].z + v[i].w * v[i].w;
      }
      ss = wave_sum(ss);
      const float rs = rsqrtf(ss * (1.f / 1024.f) + 1e-6f);
      float* so = nullptr;
      if (row < TP) {
        if ((row & 4095) == 4095) so = p.out + OFF_SHIFT_P + (size_t)(row >> 12) * 1024;
      } else {
        const int r2 = row - TP;
        if ((r2 & 63) == 63) so = p.out + OFF_SHIFT_S + (size_t)(r2 >> 6) * 1024;
      }
#pragma unroll
      for (int i = 0; i < 4; i++) {
        const float4 g = ((const float4*)p.norm1_g)[lane + i * 64];
        float4 y;
        y.x = v[i].x * rs * g.x; y.y = v[i].y * rs * g.y; y.z = v[i].z * rs * g.z; y.w = v[i].w * rs * g.w;
        ((uint2*)hr)[lane + i * 64] = make_uint2(pack2(y.x, y.y), pack2(y.z, y.w));
        if (so) ((float4*)so)[lane + i * 64] = y;
      }
    } else if (row < T + 16) {
      const float4* x = (const float4*)(p.state_shift + (size_t)(row - T) * 1024);
#pragma unroll
      for (int i = 0; i < 4; i++) {
        const float4 y = x[lane + i * 64];
        ((uint2*)hr)[lane + i * 64] = make_uint2(pack2(y.x, y.y), pack2(y.z, y.w));
      }
    } else {
#pragma unroll
      for (int i = 0; i < 4; i++) ((uint2*)hr)[lane + i * 64] = make_uint2(0u, 0u);
    }
  }
  const int gt = bid * NTH + tid, nt = nb * NTH;
  tcvt(p.w_in, p.WinT, 1024, 4608, gt, nt);
  tcvt(p.w_branch, p.WbT, 512, 1024, gt, nt);
  tcvt(p.w_branch + 512 * 1024, p.WbT + 1024 * 512, 512, 1024, gt, nt);
  tcvt(p.w_out, p.WoutT, 1024, 1024, gt, nt);
  tcvt(p.peer_wq, p.WqT, 1024, 1024, gt, nt);
  tcvt(p.w2, p.W2T, 64, 512, gt, nt);
  tcvt(p.a2, p.A2T, 64, 512, gt, nt);
  tcvt(p.g2, p.G2T, 128, 512, gt, nt);
  scvt(p.sub_keys, p.SK, 2 * 128 * 64 / 8, gt, nt);
  for (int r = bid * NW + wv; r < 32768; r += nb * NW) {
    const bool isv = r >= 16384;
    const int e = r & 16383;
    const float4* src = (const float4*)((isv ? p.peer_v : p.peer_u) + (size_t)e * 1024) + lane * 4;
    const float4 a = src[0], b = src[1], c = src[2], d = src[3];
    float am = fmaxf(fmaxf(fmaxf(fabsf(a.x), fabsf(a.y)), fmaxf(fabsf(a.z), fabsf(a.w))),
                     fmaxf(fmaxf(fabsf(b.x), fabsf(b.y)), fmaxf(fabsf(b.z), fabsf(b.w))));
    am = fmaxf(am, fmaxf(fmaxf(fmaxf(fabsf(c.x), fabsf(c.y)), fmaxf(fabsf(c.z), fabsf(c.w))),
                         fmaxf(fmaxf(fabsf(d.x), fabsf(d.y)), fmaxf(fabsf(d.z), fabsf(d.w)))));
    am = fmaxf(wave_max(am), 1e-30f);
    const float sc = 240.f / am;
    if (lane == 0) (isv ? p.SV : p.SU)[e] = am * (1.f / 240.f);
    *(u32x4*)((isv ? p.V8 : p.U8) + (size_t)e * 1024 + lane * 16) =
        u32x4{q4(a.x, a.y, a.z, a.w, sc), q4(b.x, b.y, b.z, b.w, sc), q4(c.x, c.y, c.z, c.w, sc), q4(d.x, d.y, d.z, d.w, sc)};
  }
}

constexpr int GBK = 64, GHALF = 128, GHT = GHALF * GBK;
DI int lds_byte(int r, int c) {
  const int st = (r >> 4) * 2 + (c >> 5), rr = r & 15, cc = c & 31, ob = rr * 64 + cc * 2;
  return st * 1024 + (ob ^ (((ob >> 9) & 1) << 5));
}
DI void stage_rc(int b, int& R, int& C) {
  const int st = b / 1024, sb = b % 1024, swz = sb ^ (((sb >> 9) & 1) << 5);
  R = (st >> 1) * 16 + swz / 64;
  C = (st & 1) * 32 + (swz % 64) / 2;
}
typedef __attribute__((address_space(3))) unsigned lds_u32;
#define G_SA(b, h) (shm + ((b) * 2 + (h)) * GHT)
#define G_SB(b, h) (shm + (4 + (b) * 2 + (h)) * GHT)
#define G_STAGE(P_, RS, br, kt)                                                                                   \
  do {                                                                                                            \
    const int _so = ((br) * K + (kt) * GBK) * 2;                                                                  \
    __builtin_amdgcn_raw_ptr_buffer_load_lds(RS, (lds_u32*)((char*)(P_) + tb0), 16, ob0, _so, 0, 0);              \
    __builtin_amdgcn_raw_ptr_buffer_load_lds(RS, (lds_u32*)((char*)(P_) + tb0 + 8192), 16, ob1, _so, 0, 0);       \
  } while (0)
#define G_LDA(dst, b, h)                                  \
  _Pragma("unroll") for (int m = 0; m < 4; ++m)           \
  _Pragma("unroll") for (int k = 0; k < 2; ++k)           \
    dst[m][k] = *reinterpret_cast<const bf16x8*>((const char*)G_SA(b, h) + lds_byte(wr * 64 + m * 16 + fr, k * 32 + fq * 8))
#define G_LDB(dst, b, h)                                  \
  _Pragma("unroll") for (int n = 0; n < 2; ++n)           \
  _Pragma("unroll") for (int k = 0; k < 2; ++k)           \
    dst[n][k] = *reinterpret_cast<const bf16x8*>((const char*)G_SB(b, h) + lds_byte(wc * 32 + n * 16 + fr, k * 32 + fq * 8))
#define G_MMA(ai, bj, At_, Bt_)                                                                         \
  do {                                                                                                  \
    __builtin_amdgcn_s_setprio(1);                                                                      \
    _Pragma("unroll") for (int m = 0; m < 4; ++m)                                                       \
    _Pragma("unroll") for (int n = 0; n < 2; ++n)                                                       \
    _Pragma("unroll") for (int k = 0; k < 2; ++k)                                                       \
      acc[ai][bj][m][n] = MFMA16(At_[m][k], Bt_[n][k], acc[ai][bj][m][n]);                              \
    __builtin_amdgcn_s_setprio(0);                                                                      \
  } while (0)
#define WAIT_V(n) asm volatile("s_waitcnt vmcnt(" #n ")" ::: "memory")
#define WAIT_L(n) asm volatile("s_waitcnt lgkmcnt(" #n ")" ::: "memory")
#define BAR __builtin_amdgcn_s_barrier()
#define SCHED __builtin_amdgcn_sched_barrier(0)

template <int K>
DI void gemm256(const u16* __restrict__ A, const u16* __restrict__ Bt, const int brow, const int bcol,
                f32x4 (&acc)[2][2][4][2]) {
  u16* shm = (u16*)dsm;
  const int tid_ = otid();
  const int wid = tid_ >> 6, lane = tid_ & 63, wr = wid >> 2, wc = wid & 3, fr = lane & 15, fq = lane >> 4;
#pragma unroll
  for (int a = 0; a < 2; a++)
#pragma unroll
    for (int b = 0; b < 2; b++)
#pragma unroll
      for (int m = 0; m < 4; m++)
#pragma unroll
        for (int n = 0; n < 2; n++) acc[a][b][m][n] = f32x4{0.f, 0.f, 0.f, 0.f};
  bf16x8 At[4][2], B0[2][2], B1[2][2];
  constexpr int nt = K / GBK;
  const __amdgpu_buffer_rsrc_t rsA = __builtin_amdgcn_make_buffer_rsrc((void*)A, 0, 0x7fffffff, 0x00020000);
  const __amdgpu_buffer_rsrc_t rsB = __builtin_amdgcn_make_buffer_rsrc((void*)Bt, 0, 0x7fffffff, 0x00020000);
  const unsigned tb0 = tid_ * 16;
  int ob0, ob1;
  {
    int r_, c_;
    stage_rc((int)tb0, r_, c_);
    ob0 = (r_ * K + c_) * 2;
    stage_rc((int)tb0 + 8192, r_, c_);
    ob1 = (r_ * K + c_) * 2;
  }
  WAIT_V(0);
  __syncthreads();
  G_STAGE(G_SB(0, 0), rsB, bcol, 0); G_STAGE(G_SA(0, 0), rsA, brow, 0);
  G_STAGE(G_SB(0, 1), rsB, bcol + GHALF, 0); G_STAGE(G_SA(0, 1), rsA, brow + GHALF, 0);
  if (wr == 1) BAR;
  WAIT_V(4); BAR;
  G_STAGE(G_SB(1, 0), rsB, bcol, 1); G_STAGE(G_SA(1, 0), rsA, brow, 1); G_STAGE(G_SB(1, 1), rsB, bcol + GHALF, 1);
  WAIT_V(6); BAR;
  for (int t = 0; t < nt - 2; t += 2) {
    G_LDB(B0, 0, 0); SCHED; G_LDA(At, 0, 0); G_STAGE(G_SA(1, 1), rsA, brow + GHALF, t + 1);
    WAIT_L(8); BAR; WAIT_L(0); G_MMA(0, 0, At, B0); BAR; SCHED;
    G_LDB(B1, 0, 1); G_STAGE(G_SB(0, 0), rsB, bcol, t + 2);
    BAR; WAIT_L(0); G_MMA(0, 1, At, B1); BAR;
    G_LDA(At, 0, 1); G_STAGE(G_SA(0, 0), rsA, brow, t + 2);
    BAR; WAIT_L(0); G_MMA(1, 0, At, B0); BAR; SCHED;
    G_STAGE(G_SB(0, 1), rsB, bcol + GHALF, t + 2);
    WAIT_V(6); BAR; G_MMA(1, 1, At, B1); BAR;
    G_LDB(B0, 1, 0); SCHED; G_LDA(At, 1, 0); G_STAGE(G_SA(0, 1), rsA, brow + GHALF, t + 2);
    WAIT_L(8); BAR; WAIT_L(0); G_MMA(0, 0, At, B0); BAR; SCHED;
    G_LDB(B1, 1, 1); G_STAGE(G_SB(1, 0), rsB, bcol, t + 3);
    BAR; WAIT_L(0); G_MMA(0, 1, At, B1); BAR;
    G_LDA(At, 1, 1); G_STAGE(G_SA(1, 0), rsA, brow, t + 3);
    BAR; WAIT_L(0); G_MMA(1, 0, At, B0); BAR; SCHED;
    G_STAGE(G_SB(1, 1), rsB, bcol + GHALF, t + 3);
    WAIT_V(6); BAR; G_MMA(1, 1, At, B1); BAR;
  }
  {
    G_LDB(B0, 0, 0); G_LDA(At, 0, 0); G_STAGE(G_SA(1, 1), rsA, brow + GHALF, nt - 1);
    BAR; WAIT_L(0); G_MMA(0, 0, At, B0); BAR;
    G_LDB(B1, 0, 1); BAR; WAIT_L(0); G_MMA(0, 1, At, B1); BAR;
    G_LDA(At, 0, 1); WAIT_V(4); BAR; WAIT_L(0); G_MMA(1, 0, At, B0); G_MMA(1, 1, At, B1); BAR;
  }
  {
    G_LDB(B0, 1, 0); G_LDA(At, 1, 0); WAIT_V(2); BAR; WAIT_L(0); G_MMA(0, 0, At, B0); BAR;
    G_LDB(B1, 1, 1); WAIT_V(0); BAR; WAIT_L(0); G_MMA(0, 1, At, B1); BAR;
    G_LDA(At, 1, 1); BAR; WAIT_L(0); G_MMA(1, 0, At, B0); G_MMA(1, 1, At, B1); BAR;
  }
  if (wr == 0) BAR;
}
#define GT_VARS \
  const int tid_ = otid(); const int wid = tid_ >> 6, lane = tid_ & 63, wr = wid >> 2, wc = wid & 3, fr = lane & 15, fq = lane >> 4;
#define GT_ROW(ai, m, j) ((ai) * 128 + wr * 64 + (m) * 16 + fq * 4 + (j))
#define GT_COL(bj, n) ((bj) * 128 + wc * 32 + (n) * 16 + fr)
#define GT_FOR                                       \
  _Pragma("unroll") for (int ai = 0; ai < 2; ++ai)   \
  _Pragma("unroll") for (int bj = 0; bj < 2; ++bj)   \
  _Pragma("unroll") for (int m = 0; m < 4; ++m)      \
  _Pragma("unroll") for (int n = 0; n < 2; ++n)      \
  _Pragma("unroll") for (int j = 0; j < 4; ++j)

DI bool tile_of(int round, int bid, int nb, int nM, int nN, int& pm, int& pn) {
  const int vt = round * nb + (bid & 7) * (nb >> 3) + (bid >> 3);
  if (vt >= nM * nN) return false;
  const int nig = 8 * nN, gid = vt / nig, fm = gid * 8, gsz = min(nM - fm, 8);
  pm = fm + (vt % nig) % gsz;
  pn = (vt % nig) / gsz;
  return true;
}


constexpr int CS_LD = 264;
DI void acc_to_lds(const f32x4 (&acc)[2][2][4][2]) {
  GT_VARS
  u16* Cs = (u16*)dsm;
  __syncthreads();
  GT_FOR { Cs[GT_ROW(ai, m, j) * CS_LD + GT_COL(bj, n)] = f2bf(acc[ai][bj][m][n][j]); }
  __syncthreads();
}

__device__ void ph_gemm1(const Params& p, int bid, int nb) {
  const int tid_ = otid();
  const int nM = 261, nN = 18;
  for (int round = 0; round * nb < nM * nN; ++round) {
    int pm, pn;
    if (!tile_of(round, bid, nb, nM, nN, pm, pn)) break;
    f32x4 acc[2][2][4][2];
    gemm256<1024>(p.H, p.WinT, pm * 256, pn * 256, acc);
    acc_to_lds(acc);
    const u16* Cs = (const u16*)dsm;
#pragma unroll 4
    for (int it = 0; it < 16; it++) {
      const int id = it * NTH + tid_, rl = id >> 5, c8 = (id & 31) * 8;
      const int row = pm * 256 + rl;
      const u32x4 v = *(const u32x4*)(Cs + rl * CS_LD + c8);
      *(u32x4*)(p.P + (size_t)row * INC + pn * 256 + c8) = v;
      if (pn == 9) {
        float* dst = nullptr;
        const int c2 = c8 & 127;
        if (row < TP) {
          const int tt = row & 4095;
          if (tt >= 3968) dst = p.out + (c8 < 128 ? OFF_KP : OFF_VP) + ((size_t)(row >> 12) * 128 + (tt - 3968)) * 128 + c2;
        } else if (row < T) {
          dst = p.out + (c8 < 128 ? OFF_KS : OFF_VS) + (size_t)(row - TP) * 128 + c2;
        }
        if (dst) {
          *(float4*)dst = make_float4(bflo(v[0]), bfhi(v[0]), bflo(v[1]), bfhi(v[1]));
          *(float4*)(dst + 4) = make_float4(bflo(v[2]), bfhi(v[2]), bflo(v[3]), bfhi(v[3]));
        }
      }
    }
  }
}

DI int prev_row(int g) {
  if (g < TP) return (g & 4095) ? g - 1 : -1;
  const int r2 = g - TP;
  return (r2 & 63) ? g - 1 : T + (r2 >> 6);
}

__device__ void ph_rwprep(const Params& p, int bid, int nb) {
  const int tid = otid(), lane = tid & 63, wv = tid >> 6, fr = lane & 15, fq = lane >> 4;
  u16* A1 = (u16*)dsm;
  u16* A2 = A1 + 64 * 80;
  u16* A3 = A2 + 64 * 80;
  u16* SA = (u16*)(p.out);
  u16* SB = p.H;
  const int hd = wv;
  for (int tile = bid; tile < T / 64; tile += nb) {
    const int g0 = tile * 64;
    __syncthreads();
    {
      const int row = tid >> 3, part8 = tid & 7, part = part8 >> 1, sub = part8 & 1;
      const int g = g0 + row, pr = prev_row(g);
      const int cb = 1536 + part * 64 + sub * 32;
      const u16* cur = p.P + (size_t)g * INC + cb;
      const u16* prv = p.P + (size_t)(pr < 0 ? 0 : pr) * INC + cb;
#pragma unroll
      for (int q = 0; q < 4; q++) {
        const u32x4 c4 = *(const u32x4*)(cur + q * 8);
        u32x4 p4 = {0u, 0u, 0u, 0u};
        if (pr >= 0) p4 = *(const u32x4*)(prv + q * 8);
        u32x4 ow;
#pragma unroll
        for (int e = 0; e < 4; e++) {
          const float c0 = bflo(c4[e]), c1 = bfhi(c4[e]), q0 = bflo(p4[e]), q1 = bfhi(p4[e]);
          float f0 = c0 + (q0 - c0) * p.mu[cb + q * 8 + 2 * e];
          float f1 = c1 + (q1 - c1) * p.mu[cb + q * 8 + 2 * e + 1];
          if (part == 0) { f0 = tanhf(f0); f1 = tanhf(f1); }
          else if (part >= 2) { f0 = sigmoidf_(f0); f1 = sigmoidf_(f1); }
          ow[e] = pack2(f0, f1);
        }
        u16* dst = part == 0 ? A1 + row * 80 + sub * 32 + q * 8
                 : part == 1 ? A2 + row * 80 + sub * 32 + q * 8
                             : A3 + row * 144 + (part - 2) * 64 + sub * 32 + q * 8;
        *(u32x4*)dst = ow;
      }
    }
    __syncthreads();
#pragma unroll 1
    for (int rg = 0; rg < 4; rg++) {
      f32x4 aw[4], aa[4];
#pragma unroll
      for (int nt = 0; nt < 4; nt++) { aw[nt] = f32x4{0.f, 0.f, 0.f, 0.f}; aa[nt] = f32x4{0.f, 0.f, 0.f, 0.f}; }
#pragma unroll
      for (int ks = 0; ks < 2; ks++) {
        const bf16x8 f1 = *(const bf16x8*)(A1 + (rg * 16 + fr) * 80 + ks * 32 + fq * 8);
        const bf16x8 f2 = *(const bf16x8*)(A2 + (rg * 16 + fr) * 80 + ks * 32 + fq * 8);
#pragma unroll
        for (int nt = 0; nt < 4; nt++) {
          const bf16x8 bw = *(const bf16x8*)(p.W2T + (size_t)(hd * 64 + nt * 16 + fr) * 64 + ks * 32 + fq * 8);
          const bf16x8 ba = *(const bf16x8*)(p.A2T + (size_t)(hd * 64 + nt * 16 + fr) * 64 + ks * 32 + fq * 8);
          aw[nt] = MFMA16(f1, bw, aw[nt]);
          aa[nt] = MFMA16(f2, ba, aa[nt]);
        }
      }
      float ss[4] = {0.f, 0.f, 0.f, 0.f};
      const int rowb = rg * 16 + fq * 4;
      const int gb = g0 + rowb;
      const int pr = (rowb == 0) ? prev_row(gb) : gb - 1;
#pragma unroll
      for (int nt = 0; nt < 4; nt++) {
        const int c = nt * 16 + fr, col = hd * 64 + c;
        const float mu_r = p.mu[col], mu_k = p.mu[512 + col], mu_v = p.mu[1024 + col];
        const float w0c = p.w0[col], a0c = p.a0[col], kkc = p.k_k[col], kac = p.k_a[col];
        float qr = 0.f, qk = 0.f, qv = 0.f;
        if (pr >= 0) {
          const u16* pp = p.P + (size_t)pr * INC + col;
          qr = bf2f(pp[0]); qk = bf2f(pp[512]); qv = bf2f(pp[1024]);
        }
#pragma unroll
        for (int j = 0; j < 4; j++) {
          const int gg = gb + j;
          const u16* pc = p.P + (size_t)gg * INC + col;
          const float cr = bf2f(pc[0]), ck = bf2f(pc[512]), cv = bf2f(pc[1024]);
          const float r = cr + (qr - cr) * mu_r, k = ck + (qk - ck) * mu_k, v = cv + (qv - cv) * mu_v;
          qr = cr; qk = ck; qv = cv;
          const float z = -(w0c + aw[nt][j]);
          const float sp = fmaxf(z, 0.f) + log1pf(__expf(-fabsf(z)));
          const float ed = __expf(-sp - 0.5f);
          const float dm = -expm1f(-ed);
          const float a = sigmoidf_(a0c + aa[nt][j]);
          const float kkv = k * kkc;
          ss[j] += kkv * kkv;
          const float k2 = k * (1.f + (a - 1.f) * kac);
          const size_t ba_ = ((size_t)gg * 8 + hd) * 256 + c;
          SA[ba_] = f2bf(r);
          SA[ba_ + 64] = f2bf(dm);
          SA[ba_ + 128] = f2bf(k2);
          SB[((size_t)gg * 8 + hd) * 128 + c] = f2bf(v);
          aw[nt][j] = kkv;
          aa[nt][j] = a;
        }
      }
#pragma unroll
      for (int j = 0; j < 4; j++) ss[j] = 1.f / fmaxf(sqrtf(red16(ss[j])), 1e-12f);
#pragma unroll
      for (int nt = 0; nt < 4; nt++) {
        const int c = nt * 16 + fr;
#pragma unroll
        for (int j = 0; j < 4; j++) {
          const int gg = gb + j;
          const float kkn = aw[nt][j] * ss[j];
          SA[((size_t)gg * 8 + hd) * 256 + 192 + c] = f2bf(kkn);
          SB[((size_t)gg * 8 + hd) * 128 + 64 + c] = f2bf(kkn * aa[nt][j]);
        }
      }
      f32x4 ag[4];
#pragma unroll
      for (int nt = 0; nt < 4; nt++) ag[nt] = f32x4{0.f, 0.f, 0.f, 0.f};
#pragma unroll
      for (int ks = 0; ks < 4; ks++) {
        const bf16x8 f3 = *(const bf16x8*)(A3 + (rg * 16 + fr) * 144 + ks * 32 + fq * 8);
#pragma unroll
        for (int nt = 0; nt < 4; nt++) {
          const bf16x8 bg = *(const bf16x8*)(p.G2T + (size_t)(hd * 64 + nt * 16 + fr) * 128 + ks * 32 + fq * 8);
          ag[nt] = MFMA16(f3, bg, ag[nt]);
        }
      }
#pragma unroll
      for (int nt = 0; nt < 4; nt++)
#pragma unroll
        for (int j = 0; j < 4; j++) p.G[(size_t)(gb + j) * 512 + hd * 64 + nt * 16 + fr] = f2bf(ag[nt][j]);
    }
  }
}

__device__ void ph_scan(const Params& p, int bid, int nb) {
  const int tid = otid(), lane = tid & 63, wv = tid >> 6;
  float* buf = (float*)dsm;
  const u16* SA = (const u16*)(p.out);
  const u16* SB = p.H;
  constexpr int CH = 32;
  for (int item = bid; item < 512; item += nb) {
    const int type = item >> 8, r_ = item & 255, half = r_ & 1, hb = r_ >> 1, h = hb & 7, b = hb >> 3;
    const int nch = type ? 64 / CH : 4096 / CH;
    const int gbase = type ? TP + b * 64 : b * 4096;
    const int row = half * 32 + wv * 4 + (lane >> 4), j0 = (lane & 15) * 4;
    float S[4] = {0.f, 0.f, 0.f, 0.f};
    if (type) {
      const float4 s0 = *(const float4*)(p.state_wkv + ((size_t)(b * 8 + h) * 64 + row) * 64 + j0);
      S[0] = s0.x; S[1] = s0.y; S[2] = s0.z; S[3] = s0.w;
    }
    u32x4 la[2], lb;
    auto gload = [&](int c) {
#pragma unroll
      for (int q = 0; q < 2; q++) {
        const int idx = tid + q * NTH, step = idx >> 5, u = idx & 31;
        la[q] = *(const u32x4*)(SA + ((size_t)(gbase + c * CH + step) * 8 + h) * 256 + u * 8);
      }
      {
        const int step = tid >> 4, u = tid & 15;
        lb = *(const u32x4*)(SB + ((size_t)(gbase + c * CH + step) * 8 + h) * 128 + u * 8);
      }
    };
    gload(0);
    for (int c = 0; c < nch; c++) {
      __syncthreads();
#pragma unroll
      for (int q = 0; q < 2; q++) {
        const int idx = tid + q * NTH, step = idx >> 5, u = idx & 31, arr = u >> 3, c0 = (u & 7) * 8;
        float* d = buf + step * 384 + arr * 64 + c0;
        float f[8];
#pragma unroll
        for (int e = 0; e < 4; e++) { f[2 * e] = bflo(la[q][e]); f[2 * e + 1] = bfhi(la[q][e]); }
        if (arr == 1) {
#pragma unroll
          for (int e = 0; e < 8; e++) f[e] = 1.f - f[e];
        }
        *(float4*)d = make_float4(f[0], f[1], f[2], f[3]);
        *(float4*)(d + 4) = make_float4(f[4], f[5], f[6], f[7]);
      }
      {
        const int step = tid >> 4, u = tid & 15, arr = u >> 3, c0 = (u & 7) * 8;
        float* d = buf + step * 384 + (4 + arr) * 64 + c0;
        *(float4*)d = make_float4(bflo(lb[0]), bfhi(lb[0]), bflo(lb[1]), bfhi(lb[1]));
        *(float4*)(d + 4) = make_float4(bflo(lb[2]), bfhi(lb[2]), bflo(lb[3]), bfhi(lb[3]));
      }
      __syncthreads();
      if (c + 1 < nch) gload(c + 1);
#pragma unroll 4
      for (int s = 0; s < CH; s++) {
        const float* sb = buf + s * 384;
        const float4 rr = *(const float4*)(sb + j0), dd = *(const float4*)(sb + 64 + j0), kk_ = *(const float4*)(sb + 128 + j0);
        const float4 kn = *(const float4*)(sb + 192 + j0), bb = *(const float4*)(sb + 320 + j0);
        const float vi = sb[256 + row];
        float sa = S[0] * kn.x + S[1] * kn.y + S[2] * kn.z + S[3] * kn.w;
        sa = -red16(sa);
        S[0] = S[0] * dd.x + vi * kk_.x + sa * bb.x;
        S[1] = S[1] * dd.y + vi * kk_.y + sa * bb.y;
        S[2] = S[2] * dd.z + vi * kk_.z + sa * bb.z;
        S[3] = S[3] * dd.w + vi * kk_.w + sa * bb.w;
        float yp = S[0] * rr.x + S[1] * rr.y + S[2] * rr.z + S[3] * rr.w;
        yp = red16(yp);
        if ((lane & 15) == 0) p.Y[(size_t)(gbase + c * CH + s) * 512 + h * 64 + row] = f2bf(yp);
      }
    }
    float* so = p.out + (type ? OFF_WKV_S : OFF_WKV_P) + ((size_t)(b * 8 + h) * 64 + row) * 64 + j0;
    *(float4*)so = make_float4(S[0], S[1], S[2], S[3]);
  }
}

__device__ void ph_attn(const Params& p, int bid, int nb, bool dry = false) {
  const int tid = otid(), lane = tid & 63, wv = tid >> 6, fr = lane & 15, fq = lane >> 4;
  u16* Ks = (u16*)dsm;
  u16* Vt = Ks + 192 * 72;
  for (int item = bid; item < 2080; item += nb) {
    const int kvh = item & 1, r = item >> 1;
    const bool samp = r >= 1024;
    const int b = samp ? r - 1024 : r >> 6, c = samp ? 0 : (r & 63);
    const int gq0 = samp ? TP + b * 64 : b * 4096 + c * 64;
    __syncthreads();
#pragma unroll
    for (int q = 0; q < 3; q++) {
      const int idx = tid + q * NTH, j = idx >> 3, d0 = (idx & 7) * 8;
      u32x4 kq = {0u, 0u, 0u, 0u}, vq = {0u, 0u, 0u, 0u};
      if (!samp) {
        const int tok = (c - 2) * 64 + j;
        if (tok >= 0) {
          const u16* src = p.P + (size_t)(b * 4096 + tok) * INC + 2304 + kvh * 64 + d0;
          kq = *(const u32x4*)src;
          vq = *(const u32x4*)(src + 128);
        }
      } else if (j < 128) {
        const float4* ck = (const float4*)(p.cache_k + ((size_t)(b * 128 + j) * 2 + kvh) * 64 + d0);
        const float4* cv = (const float4*)(p.cache_v + ((size_t)(b * 128 + j) * 2 + kvh) * 64 + d0);
        const float4 k0 = ck[0], k1 = ck[1], v0 = cv[0], v1 = cv[1];
        kq = u32x4{pack2(k0.x, k0.y), pack2(k0.z, k0.w), pack2(k1.x, k1.y), pack2(k1.z, k1.w)};
        vq = u32x4{pack2(v0.x, v0.y), pack2(v0.z, v0.w), pack2(v1.x, v1.y), pack2(v1.z, v1.w)};
      } else {
        const u16* src = p.P + (size_t)(TP + b * 64 + (j - 128)) * INC + 2304 + kvh * 64 + d0;
        kq = *(const u32x4*)src;
        vq = *(const u32x4*)(src + 128);
      }
      *(u32x4*)(Ks + j * 72 + d0) = kq;
#pragma unroll
      for (int e = 0; e < 4; e++) {
        Vt[(d0 + 2 * e) * 196 + j] = (u16)(vq[e] & 0xffffu);
        Vt[(d0 + 2 * e + 1) * 196 + j] = (u16)(vq[e] >> 16);
      }
    }
    __syncthreads();
    const int qh = kvh * 4 + (wv & 3);
    const float slope = exp2f(-(float)(qh + 1)), sink = p.sinks[qh];
#pragma unroll 1
    for (int ps = 0; ps < 2; ps++) {
      const int q0 = (wv >> 2) * 32 + ps * 16;
      const int tq = q0 + fr;
      const u16* qp = p.P + (size_t)(gq0 + tq) * INC + 1792 + qh * 64 + fq * 8;
      const bf16x8 qf0 = *(const bf16x8*)(qp), qf1 = *(const bf16x8*)(qp + 32);
      f32x4 sc[12];
#pragma unroll
      for (int kt = 0; kt < 12; kt++) {
        sc[kt] = f32x4{0.f, 0.f, 0.f, 0.f};
        const bf16x8 a0 = *(const bf16x8*)(Ks + (kt * 16 + fr) * 72 + fq * 8);
        const bf16x8 a1 = *(const bf16x8*)(Ks + (kt * 16 + fr) * 72 + 32 + fq * 8);
        sc[kt] = MFMA16(a0, qf0, sc[kt]);
        sc[kt] = MFMA16(a1, qf1, sc[kt]);
        if ((kt & 3) == 3) SCHED;
      }
      float mx = -3e38f;
#pragma unroll
      for (int kt = 0; kt < 12; kt++)
#pragma unroll
        for (int j = 0; j < 4; j++) {
          const int key = kt * 16 + fq * 4 + j;
          float s = sc[kt][j] * 0.125f - slope * fabsf((float)(128 + tq - key));
          if (!samp && (c - 2) * 64 + key < 0) s = -1e30f;
          sc[kt][j] = s;
          mx = fmaxf(mx, s);
        }
      mx = fmaxf(mx, __shfl_xor(mx, 16));
      mx = fmaxf(mx, __shfl_xor(mx, 32));
      mx = fmaxf(mx, sink);
      float sum = 0.f;
#pragma unroll
      for (int kt = 0; kt < 12; kt++)
#pragma unroll
        for (int j = 0; j < 4; j++) {
          const float e = __expf(sc[kt][j] - mx);
          sc[kt][j] = e;
          sum += e;
        }
      sum += __shfl_xor(sum, 16);
      sum += __shfl_xor(sum, 32);
      sum += __expf(sink - mx);
      const float inv = 1.f / sum;
      f32x4 o[4];
#pragma unroll
      for (int dt = 0; dt < 4; dt++) o[dt] = f32x4{0.f, 0.f, 0.f, 0.f};
#pragma unroll
      for (int t2 = 0; t2 < 6; t2++) {
        const u32x4 pw = {pack2(sc[2 * t2][0] * inv, sc[2 * t2][1] * inv), pack2(sc[2 * t2][2] * inv, sc[2 * t2][3] * inv),
                          pack2(sc[2 * t2 + 1][0] * inv, sc[2 * t2 + 1][1] * inv),
                          pack2(sc[2 * t2 + 1][2] * inv, sc[2 * t2 + 1][3] * inv)};
        const bf16x8 pa = __builtin_bit_cast(bf16x8, pw);
#pragma unroll
        for (int dt = 0; dt < 4; dt++) {
          const u16* vp = Vt + (dt * 16 + fr) * 196 + t2 * 32 + fq * 4;
          const uint2 v0 = *(const uint2*)vp, v1 = *(const uint2*)(vp + 16);
          const bf16x8 vb = __builtin_bit_cast(bf16x8, u32x4{v0.x, v0.y, v1.x, v1.y});
          o[dt] = MFMA16(pa, vb, o[dt]);
        }
        SCHED;
      }
#pragma unroll
      for (int dt = 0; dt < 4; dt++)
#pragma unroll
        for (int j = 0; j < 4; j++)
          p.OATT[(size_t)(gq0 + q0 + fq * 4 + j) * 512 + qh * 64 + dt * 16 + fr] = f2bf(o[dt][j]);
    }
  }
  const u16* SA = (const u16*)(p.out);
  const u16* SB = p.H;
  for (int it = bid * NW + wv; it < T * 8; it += nb * NW) {
    const int g = it >> 3, h = it & 7, col = h * 64 + lane;
    const float y = bf2f(p.Y[(size_t)g * 512 + col]);
    const float mean = wave_sum(y) * (1.f / 64.f);
    const float dy = y - mean;
    const float var = wave_sum(dy * dy) * (1.f / 64.f);
    float yn = dy * rsqrtf(var + 64e-5f) * p.lnx_w[col] + p.lnx_b[col];
    const size_t ba_ = (size_t)it * 256 + lane;
    const float r = bf2f(SA[ba_]), k2 = bf2f(SA[ba_ + 128]);
    const float v = bf2f(SB[(size_t)it * 128 + lane]);
    const float bonus = wave_sum(r * k2 * p.r_k[col]);
    yn += bonus * v;
    if (!dry || yn == 123.456f) p.Y[(size_t)g * 512 + col] = f2bf(yn * bf2f(p.G[(size_t)g * 512 + col]));
  }
}

__device__ void ph_gemm2(const Params& p, int bid, int nb) {
  const int tid_ = otid();
  u16* MG = p.H;
  const u16* Cs = (const u16*)dsm;
  const int nM = 260, nN = 4;
  for (int round = 0; round * nb < nM * nN; ++round) {
    int pm, pn;
    if (!tile_of(round, bid, nb, nM, nN, pm, pn)) break;
    f32x4 acc[2][2][4][2];
#pragma unroll 1
    for (int br = 0; br < 2; br++) {
      gemm256<512>(br ? p.OATT : p.Y, p.WbT + (size_t)br * 1024 * 512, pm * 256, pn * 256, acc);
      acc_to_lds(acc);
#pragma unroll 2
      for (int it = 0; it < 16; it++) {
        const int id = it * NTH + tid_, rl = id >> 5, c8 = (id & 31) * 8;
        const int row = pm * 256 + rl, col = pn * 256 + c8;
        const u32x4 v = *(const u32x4*)(Cs + rl * CS_LD + c8);
        const u32x4 gw = *(const u32x4*)(p.P + (size_t)row * INC + 2560 + br * 1024 + col);
        u32x4 prev = {0u, 0u, 0u, 0u};
        if (br) prev = *(const u32x4*)(MG + (size_t)row * 1024 + col);
        u32x4 o;
#pragma unroll
        for (int e = 0; e < 4; e++) {
          const float r0 = bflo(prev[e]) + sigmoidf_(bflo(gw[e])) * bflo(v[e]);
          const float r1 = bfhi(prev[e]) + sigmoidf_(bfhi(gw[e])) * bfhi(v[e]);
          o[e] = pack2(r0, r1);
        }
        *(u32x4*)(MG + (size_t)row * 1024 + col) = o;
      }
    }
  }
}

__device__ void ph_gemm3(const Params& p, int bid, int nb) {
  const int tid_ = otid();
  const u16* MG = p.H;
  const u16* Cs = (const u16*)dsm;
  const int nM = 260, nN = 4;
  for (int round = 0; round * nb < nM * nN; ++round) {
    int pm, pn;
    if (!tile_of(round, bid, nb, nM, nN, pm, pn)) break;
    f32x4 acc[2][2][4][2];
    gemm256<1024>(MG, p.WoutT, pm * 256, pn * 256, acc);
    acc_to_lds(acc);
#pragma unroll 2
    for (int it = 0; it < 16; it++) {
      const int id = it * NTH + tid_, rl = id >> 5, c8 = (id & 31) * 8;
      const int row = pm * 256 + rl, col = pn * 256 + c8;
      const u32x4 v = *(const u32x4*)(Cs + rl * CS_LD + c8);
      const float* xr = xrow(p, row) + col;
      const float4 x0 = *(const float4*)xr, x1 = *(const float4*)(xr + 4);
      float* dst = p.out + (size_t)row * 1024 + col;
      *(float4*)dst = make_float4(x0.x + bflo(v[0]), x0.y + bfhi(v[0]), x0.z + bflo(v[1]), x0.w + bfhi(v[1]));
      *(float4*)(dst + 4) = make_float4(x1.x + bflo(v[2]), x1.y + bfhi(v[2]), x1.z + bflo(v[3]), x1.w + bfhi(v[3]));
    }
  }
}

__device__ void ph_norm2(const Params& p, int bid, int nb) {
  const int tid = otid(), lane = tid & 63, wv = tid >> 6;
  for (int row = bid * NW + wv; row < T; row += nb * NW) {
    const float4* x = (const float4*)(p.out + (size_t)row * 1024);
    float4 v[4];
    float ss = 0.f;
#pragma unroll
    for (int i = 0; i < 4; i++) {
      v[i] = x[lane + i * 64];
      ss += v[i].x * v[i].x + v[i].y * v[i].y + v[i].z * v[i].z + v[i].w * v[i].w;
    }
    ss = wave_sum(ss);
    const float rs = rsqrtf(ss * (1.f / 1024.f) + 1e-6f);
    u16* hr = p.H + (size_t)row * 1024;
    float4 y[4];
    float am = 0.f;
#pragma unroll
    for (int i = 0; i < 4; i++) {
      const float4 g = ((const float4*)p.norm2_g)[lane + i * 64];
      y[i] = make_float4(v[i].x * rs * g.x, v[i].y * rs * g.y, v[i].z * rs * g.z, v[i].w * rs * g.w);
      ((uint2*)hr)[lane + i * 64] = make_uint2(pack2(y[i].x, y[i].y), pack2(y[i].z, y[i].w));
      am = fmaxf(am, fmaxf(fmaxf(fabsf(y[i].x), fabsf(y[i].y)), fmaxf(fabsf(y[i].z), fabsf(y[i].w))));
    }
    am = fmaxf(wave_max(am), 1e-30f);
    const float sc = 240.f / am;
    if (lane == 0) p.SH[row] = am * (1.f / 240.f);
    u32* h8 = (u32*)((unsigned char*)p.Y + (size_t)row * 1024);
#pragma unroll
    for (int i = 0; i < 4; i++) h8[lane + i * 64] = q4(y[i].x, y[i].y, y[i].z, y[i].w, sc);
  }
}

DI void ins16(float (&l)[16], float x) {
#pragma unroll
  for (int i = 0; i < 16; i++) {
    const float hi = fmaxf(l[i], x);
    x = fminf(l[i], x);
    l[i] = hi;
  }
}

__device__ void ph_peerq(const Params& p, int bid, int nb) {
  GT_VARS
  const int l31 = lane & 31, kh = lane >> 5;
  u16* Qs = (u16*)dsm;
  unsigned char* lt = (unsigned char*)(dsm + 135168 + wid * 1024);
  int* IDX = (int*)p.G;
  float* GATE = (float*)p.OATT;
  const int nM = 260, nN = 4;
  for (int round = 0; round * nb < nM * nN; ++round) {
    int pm, pn;
    if (!tile_of(round, bid, nb, nM, nN, pm, pn)) break;
    {
      f32x4 acc[2][2][4][2];
      gemm256<1024>(p.H, p.WqT, pm * 256, pn * 256, acc);
      acc_to_lds(acc);
    }
#pragma unroll 1
    for (int hh = 0; hh < 2; hh++) {
      const int hp = pn * 2 + hh;
      float l1[16], l2[16];
#pragma unroll
      for (int i = 0; i < 16; i++) { l1[i] = 0.f; l2[i] = 0.f; }
#pragma unroll 1
      for (int pp = 0; pp < 2; pp++) {
        f32x16 sc[4];
#pragma unroll
        for (int m4 = 0; m4 < 4; m4++) {
#pragma unroll
          for (int i = 0; i < 16; i++) sc[m4][i] = 0.f;
#pragma unroll
          for (int kk = 0; kk < 4; kk++) {
            const bf16x8 a = *(const bf16x8*)(p.SK + (size_t)(pp * 128 + m4 * 32 + l31) * 64 + kk * 16 + kh * 8);
            const bf16x8 bq = *(const bf16x8*)(Qs + (wid * 32 + l31) * 264 + hh * 128 + pp * 64 + kk * 16 + kh * 8);
            sc[m4] = MFMA32(a, bq, sc[m4]);
          }
        }
        float l[16];
#pragma unroll
        for (int i = 0; i < 16; i++) l[i] = -3e38f;
#pragma unroll
        for (int m4 = 0; m4 < 4; m4++)
#pragma unroll
          for (int i = 0; i < 16; i++) {
            const u32 nn = m4 * 32 + (i >> 2) * 8 + kh * 4 + (i & 3);
            ins16(l, __uint_as_float((__float_as_uint(sc[m4][i]) & ~0x7Fu) | nn));
          }
        float o[16];
#pragma unroll
        for (int i = 0; i < 16; i++) o[i] = __shfl_xor(l[i], 32);
#pragma unroll
        for (int i = 0; i < 16; i++) ins16(l, o[i]);
#pragma unroll
        for (int i = 0; i < 16; i++) {
          l1[i] = pp == 0 ? l[i] : l1[i];
          l2[i] = pp == 0 ? l2[i] : l[i];
        }
      }
      if (kh == 0) {
        u32 w[8];
#pragma unroll
        for (int q = 0; q < 4; q++) {
          w[q] = (__float_as_uint(l1[4 * q]) & 0x7F) | ((__float_as_uint(l1[4 * q + 1]) & 0x7F) << 8) |
                 ((__float_as_uint(l1[4 * q + 2]) & 0x7F) << 16) | ((__float_as_uint(l1[4 * q + 3]) & 0x7F) << 24);
          w[4 + q] = (__float_as_uint(l2[4 * q]) & 0x7F) | ((__float_as_uint(l2[4 * q + 1]) & 0x7F) << 8) |
                     ((__float_as_uint(l2[4 * q + 2]) & 0x7F) << 16) | ((__float_as_uint(l2[4 * q + 3]) & 0x7F) << 24);
        }
        *(uint4*)(lt + l31 * 32) = make_uint4(w[0], w[1], w[2], w[3]);
        *(uint4*)(lt + l31 * 32 + 16) = make_uint4(w[4], w[5], w[6], w[7]);
      }
      float l3[16];
#pragma unroll
      for (int i = 0; i < 16; i++) l3[i] = -3e38f;
#pragma unroll
      for (int a = 0; a < 16; a++)
#pragma unroll
        for (int b = 0; b < 16; b++)
          if ((a + 1) * (b + 1) <= 16) {
            const float s = __uint_as_float(__float_as_uint(l1[a]) & ~0x7Fu) + __uint_as_float(__float_as_uint(l2[b]) & ~0x7Fu);
            ins16(l3, __uint_as_float((__float_as_uint(s) & ~0xFFu) | (u32)(a * 16 + b)));
          }
      __builtin_amdgcn_fence(__ATOMIC_RELEASE, "workgroup");
      __builtin_amdgcn_wave_barrier();
      if (kh == 0) {
        const int g = pm * 256 + wid * 32 + l31;
        float ev[16];
        int ei[16];
        float sum = 0.f;
        const float mxv = __uint_as_float(__float_as_uint(l3[0]) & ~0xFFu);
#pragma unroll
        for (int k = 0; k < 16; k++) {
          const u32 bits = __float_as_uint(l3[k]);
          const u32 pos = bits & 0xFF;
          ev[k] = __expf(__uint_as_float(bits & ~0xFFu) - mxv);
          sum += ev[k];
          ei[k] = (int)lt[l31 * 32 + (pos >> 4)] * 128 + (int)lt[l31 * 32 + 16 + (pos & 15)];
        }
        const float inv = 1.f / sum;
        int4* ip = (int4*)(IDX + (size_t)g * 128 + hp * 16);
        float4* gp = (float4*)(GATE + (size_t)g * 128 + hp * 16);
#pragma unroll
        for (int q = 0; q < 4; q++) {
          ip[q] = make_int4(ei[4 * q], ei[4 * q + 1], ei[4 * q + 2], ei[4 * q + 3]);
          gp[q] = make_float4(ev[4 * q] * inv, ev[4 * q + 1] * inv, ev[4 * q + 2] * inv, ev[4 * q + 3] * inv);
        }
      }
      __builtin_amdgcn_wave_barrier();
    }
  }
}

__device__ void ph_peer(const Params& p, int bid, int nb, bool dry = false) {
  const int tid = otid(), lane = tid & 63, wv = tid >> 6;
  char* wb = dsm + wv * 2048;
  unsigned char* hs = (unsigned char*)wb;
  float* acts = (float*)(wb + 1024);
  int* idxs = (int*)(wb + 1536);
  const int* IDX = (const int*)p.G;
  const float* GATE = (const float*)p.OATT;
  const unsigned char* H8 = (const unsigned char*)p.Y;
  const int n = lane & 15, quad = lane >> 4;
  for (int g = bid * NW + wv; g < T; g += nb * NW) {
    *(u32x4*)(hs + lane * 16) = *(const u32x4*)(H8 + (size_t)g * 1024 + lane * 16);
    idxs[lane] = IDX[(size_t)g * 128 + lane];
    idxs[lane + 64] = IDX[(size_t)g * 128 + 64 + lane];
    const float shv = p.SH[g];
    __builtin_amdgcn_fence(__ATOMIC_RELEASE, "workgroup");
    __builtin_amdgcn_wave_barrier();
#pragma unroll 1
    for (int grp = 0; grp < 8; grp++) {
      const int e = idxs[grp * 16 + n];
      const unsigned char* ur = p.U8 + (size_t)e * 1024 + quad * 16;
      f32x4 acc = {0.f, 0.f, 0.f, 0.f};
      u32x4 ua[16];
#pragma unroll
      for (int st = 0; st < 16; st++) ua[st] = *(const u32x4*)(ur + st * 64);
#pragma unroll
      for (int st = 0; st < 16; st++) {
        const u32x4 hb = *(const u32x4*)(hs + st * 64 + quad * 16);
        const long a0 = (long)(((unsigned long)ua[st][1] << 32) | ua[st][0]);
        const long a1 = (long)(((unsigned long)ua[st][3] << 32) | ua[st][2]);
        const long b0 = (long)(((unsigned long)hb[1] << 32) | hb[0]);
        const long b1 = (long)(((unsigned long)hb[3] << 32) | hb[2]);
        acc = __builtin_amdgcn_mfma_f32_16x16x32_fp8_fp8(a0, b0, acc, 0, 0, 0);
        acc = __builtin_amdgcn_mfma_f32_16x16x32_fp8_fp8(a1, b1, acc, 0, 0, 0);
      }
      const float4 gt = *(const float4*)(GATE + (size_t)g * 128 + grp * 16 + quad * 4);
      const int4 ee = *(const int4*)(idxs + grp * 16 + quad * 4);
      const float d0 = acc[0] * shv * p.SU[ee.x], d1 = acc[1] * shv * p.SU[ee.y];
      const float d2 = acc[2] * shv * p.SU[ee.z], d3 = acc[3] * shv * p.SU[ee.w];
      float4 av;
      av.x = 0.5f * d0 * (1.f + erff(d0 * 0.70710678118f)) * gt.x * p.SV[ee.x];
      av.y = 0.5f * d1 * (1.f + erff(d1 * 0.70710678118f)) * gt.y * p.SV[ee.y];
      av.z = 0.5f * d2 * (1.f + erff(d2 * 0.70710678118f)) * gt.z * p.SV[ee.z];
      av.w = 0.5f * d3 * (1.f + erff(d3 * 0.70710678118f)) * gt.w * p.SV[ee.w];
      if (n == 0) *(float4*)(acts + grp * 16 + quad * 4) = av;
    }
    __builtin_amdgcn_fence(__ATOMIC_RELEASE, "workgroup");
    __builtin_amdgcn_wave_barrier();
    float o[16];
#pragma unroll
    for (int j = 0; j < 16; j++) o[j] = 0.f;
#pragma unroll 16
    for (int k = 0; k < 128; k++) {
      const float a = acts[k];
      const int e = idxs[k];
      const u32x4 vq = *(const u32x4*)(p.V8 + (size_t)e * 1024 + lane * 16);
#pragma unroll
      for (int q = 0; q < 4; q++) {
        const f32x2 lo = __builtin_amdgcn_cvt_pk_f32_fp8((int)vq[q], false);
        const f32x2 hi = __builtin_amdgcn_cvt_pk_f32_fp8((int)vq[q], true);
        o[4 * q] += a * lo[0]; o[4 * q + 1] += a * lo[1]; o[4 * q + 2] += a * hi[0]; o[4 * q + 3] += a * hi[1];
      }
    }
    float* xr = p.out + (size_t)g * 1024 + lane * 16;
    float4 x[4];
#pragma unroll
    for (int q = 0; q < 4; q++) x[q] = *(const float4*)(xr + q * 4);
    float ss = 0.f;
#pragma unroll
    for (int q = 0; q < 4; q++) {
      x[q].x += o[4 * q]; x[q].y += o[4 * q + 1]; x[q].z += o[4 * q + 2]; x[q].w += o[4 * q + 3];
      ss += x[q].x * x[q].x + x[q].y * x[q].y + x[q].z * x[q].z + x[q].w * x[q].w;
    }
    ss = wave_sum(ss);
    if (dry && ss != 123.456f) continue;
    const float rs = rsqrtf(ss * (1.f / 1024.f) + 1e-6f);
#pragma unroll
    for (int q = 0; q < 4; q++) {
      const float4 gq = *(const float4*)(p.final_g + lane * 16 + q * 4);
      *(float4*)(xr + q * 4) = make_float4(x[q].x * rs * gq.x, x[q].y * rs * gq.y, x[q].z * rs * gq.z, x[q].w * rs * gq.w);
    }
  }
}

__global__ void __launch_bounds__(512) mega_kernel(Params p) {
  cg::grid_group grid = cg::this_grid();
  const int bid = blockIdx.x, nb = gridDim.x;
  if (ON(0)) ph_prep(p, bid, nb);
  grid.sync();
  if (ON(1)) ph_gemm1(p, bid, nb);
  grid.sync();
  if (REP == 1) { ph_gemm1(p, bid, nb); grid.sync(); }
  if (ON(2)) ph_rwprep(p, bid, nb);
  grid.sync();
  if (REP == 2) { ph_rwprep(p, bid, nb); grid.sync(); }
  if (ON(3)) ph_scan(p, bid, nb);
  grid.sync();
  if (REP == 3) { ph_scan(p, bid, nb); grid.sync(); }
  if (REP == 4) { ph_attn(p, bid, nb, true); grid.sync(); }
  if (ON(4)) ph_attn(p, bid, nb);
  grid.sync();
  if (ON(5)) ph_gemm2(p, bid, nb);
  grid.sync();
  if (REP == 5) { ph_gemm2(p, bid, nb); grid.sync(); }
  if (ON(6)) ph_gemm3(p, bid, nb);
  grid.sync();
  if (REP == 6) { ph_gemm3(p, bid, nb); grid.sync(); }
  if (ON(7)) ph_norm2(p, bid, nb);
  grid.sync();
  if (ON(8)) ph_peerq(p, bid, nb);
  grid.sync();
  if (REP == 8) { ph_peerq(p, bid, nb); grid.sync(); }
  if (REP == 9) { ph_peer(p, bid, nb, true); grid.sync(); }
  if (ON(9)) ph_peer(p, bid, nb);
}

extern "C" void kernel_launch(void* const* d_in, const int* in_sizes, int n_in, void* d_out, int out_size, void* d_ws,
                              size_t ws_size, hipStream_t stream) {
  Params p{};
  const float** f = (const float**)&p;
  for (int i = 0; i < 28; i++) f[i] = (const float*)d_in[i];
  p.out = (float*)d_out;
  char* w = (char*)d_ws;
  size_t off = 0;
  auto take = [&](size_t bytes) { char* r = w + off; off += (bytes + 255) & ~(size_t)255; return (u16*)r; };
  p.H = take((size_t)MP * 1024 * 2);
  p.P = take((size_t)MP * INC * 2);
  p.U8 = (unsigned char*)take((size_t)16384 * 1024);
  p.V8 = (unsigned char*)take((size_t)16384 * 1024);
  p.SU = (float*)take(16384 * 4);
  p.SV = (float*)take(16384 * 4);
  p.SH = (float*)take((size_t)T * 4);
  p.WinT = take((size_t)4608 * 1024 * 2);
  p.WbT = take((size_t)2 * 1024 * 512 * 2);
  p.WoutT = take((size_t)1024 * 1024 * 2);
  p.WqT = take((size_t)1024 * 1024 * 2);
  p.W2T = take((size_t)512 * 64 * 2);
  p.A2T = take((size_t)512 * 64 * 2);
  p.G2T = take((size_t)512 * 128 * 2);
  p.SK = take((size_t)2 * 128 * 64 * 2);
  p.Y = take((size_t)T * 512 * 2);
  p.G = take((size_t)T * 512 * 2);
  p.OATT = take((size_t)T * 512 * 2);
  static int grid_blocks = 0;
  if (!grid_blocks) {
    int dev = 0, cus = 0, per_cu = 0;
    (void)hipGetDevice(&dev);
    (void)hipDeviceGetAttribute(&cus, hipDeviceAttributeMultiprocessorCount, dev);
    (void)hipFuncSetAttribute((const void*)mega_kernel, hipFuncAttributeMaxDynamicSharedMemorySize, DYN_LDS);
    (void)hipOccupancyMaxActiveBlocksPerMultiprocessor(&per_cu, mega_kernel, NTH, DYN_LDS);
    if (per_cu > 1) per_cu = 1;
    grid_blocks = cus * per_cu;
  }
  void* args[] = {&p};
  hipError_t e = hipLaunchCooperativeKernel((void*)mega_kernel, dim3(grid_blocks), dim3(NTH), args, DYN_LDS, stream);
  if (e != hipSuccess) fprintf(stderr, "cooperative launch failed: %s (grid %d)\n", hipGetErrorString(e), grid_blocks);
}
```

```cpp
#include <hip/hip_runtime.h>
#include <hip/hip_cooperative_groups.h>
#include <cstdio>
namespace cg = cooperative_groups;

#ifndef REP
#define REP -1
#endif
#ifndef ONLY
#define ONLY -1
#endif
#define ON(k) (ONLY < 0 || ONLY == (k))

typedef unsigned short u16;
typedef unsigned int u32;
using bf16x8 = __attribute__((ext_vector_type(8))) short;
using f32x4 = __attribute__((ext_vector_type(4))) float;
using f32x16 = __attribute__((ext_vector_type(16))) float;
using u32x4 = __attribute__((ext_vector_type(4))) u32;
#define DI __device__ __forceinline__

constexpr int TP = 65536, TS = 1024, T = 66560, MP = 66816;
constexpr int INC = 4608;
constexpr int NW = 8;
constexpr int NTH = 512;
constexpr size_t OFF_Y = 0, OFF_SHIFT_P = 68157440, OFF_WKV_P = 68173824, OFF_KP = 68698112, OFF_VP = 68960256,
                 OFF_SHIFT_S = 69222400, OFF_WKV_S = 69238784, OFF_KS = 69763072, OFF_VS = 69894144;
constexpr int DYN_LDS = 147456;

extern __shared__ __attribute__((aligned(16))) char dsm[];

struct Params {
  const float *x_prompt, *x_sample, *state_shift, *state_wkv, *cache_k, *cache_v, *norm1_g, *w_in, *mu, *w0, *w2, *a0,
      *a2, *g2, *k_k, *k_a, *r_k, *lnx_w, *lnx_b, *sinks, *w_branch, *w_out, *norm2_g, *peer_wq, *sub_keys, *peer_u,
      *peer_v, *final_g;
  float* out;
  u16 *H, *P, *WinT, *WbT, *WoutT, *WqT, *W2T, *A2T, *G2T, *SK, *Y, *G, *OATT;
  unsigned char *U8, *V8;
  float *SU, *SV, *SH;
};

DI u16 f2bf(float x) {
  u32 u = __float_as_uint(x);
  u += 0x7fffu + ((u >> 16) & 1u);
  return (u16)(u >> 16);
}
DI float bf2f(u16 b) { return __uint_as_float(((u32)b) << 16); }
DI u32 pack2(float a, float b) { return (u32)f2bf(a) | ((u32)f2bf(b) << 16); }
DI float bflo(u32 w) { return __uint_as_float(w << 16); }
DI float bfhi(u32 w) { return __uint_as_float(w & 0xffff0000u); }
DI float wave_sum(float v) {
#pragma unroll
  for (int o = 32; o; o >>= 1) v += __shfl_xor(v, o);
  return v;
}
DI float sigmoidf_(float x) { return 1.f / (1.f + __expf(-x)); }
DI const float* xrow(const Params& p, int g) {
  return g < TP ? p.x_prompt + (size_t)g * 1024 : p.x_sample + (size_t)(g - TP) * 1024;
}
DI int otid() { int t = threadIdx.x; asm volatile("" : "+v"(t)); return t; }
#define MFMA32(a, b, c) __builtin_amdgcn_mfma_f32_32x32x16_bf16((a), (b), (c), 0, 0, 0)
#define MFMA16(a, b, c) __builtin_amdgcn_mfma_f32_16x16x32_bf16((a), (b), (c), 0, 0, 0)

template <int CTRL>
DI float dppmov(float v) {
  return __int_as_float(__builtin_amdgcn_update_dpp(0, __float_as_int(v), CTRL, 0xF, 0xF, false));
}
DI float red16(float v) {
  v += dppmov<0x128>(v);
  v += dppmov<0x124>(v);
  v += dppmov<0x122>(v);
  v += dppmov<0x121>(v);
  return v;
}


using f32x2 = __attribute__((ext_vector_type(2))) float;
DI float wave_max(float v) {
#pragma unroll
  for (int o = 32; o; o >>= 1) v = fmaxf(v, __shfl_xor(v, o));
  return v;
}
DI u32 q4(float a, float b, float c, float d, float sc) {
  int w = 0;
  w = __builtin_amdgcn_cvt_pk_fp8_f32(a * sc, b * sc, w, false);
  w = __builtin_amdgcn_cvt_pk_fp8_f32(c * sc, d * sc, w, true);
  return (u32)w;
}

DI void tcvt(const float* __restrict__ W, u16* __restrict__ Wt, int K, int N, int gt, int nt) {
  const int total = N * (K / 8);
  for (int i = gt; i < total; i += nt) {
    const int n = i % N, kg = i / N;
    u32 o[4];
#pragma unroll
    for (int j = 0; j < 4; j++)
      o[j] = pack2(W[(size_t)(kg * 8 + 2 * j) * N + n], W[(size_t)(kg * 8 + 2 * j + 1) * N + n]);
    *(uint4*)(Wt + (size_t)n * K + kg * 8) = make_uint4(o[0], o[1], o[2], o[3]);
  }
}
DI void scvt(const float* __restrict__ W, u16* __restrict__ O, int n8, int gt, int nt) {
  for (int i = gt; i < n8; i += nt) {
    const float4 a = ((const float4*)W)[2 * i], b = ((const float4*)W)[2 * i + 1];
    ((uint4*)O)[i] = make_uint4(pack2(a.x, a.y), pack2(a.z, a.w), pack2(b.x, b.y), pack2(b.z, b.w));
  }
}

__device__ void ph_prep(const Params& p, int bid, int nb) {
  const int tid = otid(), lane = tid & 63, wv = tid >> 6;
  for (int row = bid * NW + wv; row < MP; row += nb * NW) {
    u16* hr = p.H + (size_t)row * 1024;
    if (row < T) {
      const float4* x = (const float4*)xrow(p, row);
      float4 v[4];
      float ss = 0.f;
#pragma unroll
      for (int i = 0; i < 4; i++) {
        v[i] = x[lane + i * 64];
        ss += v[i].x * v[i].x + v[i].y * v[i].y + v[i].z * v[i].z + v[i].w * v[i].w;
      }
      ss = wave_sum(ss);
      const float rs = rsqrtf(ss * (1.f / 1024.f) + 1e-6f);
      float* so = nullptr;
      if (row < TP) {
        if ((row & 4095) == 4095) so = p.out + OFF_SHIFT_P + (size_t)(row >> 12) * 1024;
      } else {
        const int r2 = row - TP;
        if ((r2 & 63) == 63) so = p.out + OFF_SHIFT_S + (size_t)(r2 >> 6) * 1024;
      }
#pragma unroll
      for (int i = 0; i < 4; i++) {
        const float4 g = ((const float4*)p.norm1_g)[lane + i * 64];
        float4 y;
        y.x = v[i].x * rs * g.x; y.y = v[i].y * rs * g.y; y.z = v[i].z * rs * g.z; y.w = v[i].w * rs * g.w;
        ((uint2*)hr)[lane + i * 64] = make_uint2(pack2(y.x, y.y), pack2(y.z, y.w));
        if (so) ((float4*)so)[lane + i * 64] = y;
      }
    } else if (row < T + 16) {
      const float4* x = (const float4*)(p.state_shift + (size_t)(row - T) * 1024);
#pragma unroll
      for (int i = 0; i < 4; i++) {
        const float4 y = x[lane + i * 64];
        ((uint2*)hr)[lane + i * 64] = make_uint2(pack2(y.x, y.y), pack2(y.z, y.w));
      }
    } else {
#pragma unroll
      for (int i = 0; i < 4; i++) ((uint2*)hr)[lane + i * 64] = make_uint2(0u, 0u);
    }
  }
  const int gt = bid * NTH + tid, nt = nb * NTH;
  tcvt(p.w_in, p.WinT, 1024, 4608, gt, nt);
  tcvt(p.w_branch, p.WbT, 512, 1024, gt, nt);
  tcvt(p.w_branch + 512 * 1024, p.WbT + 1024 * 512, 512, 1024, gt, nt);
  tcvt(p.w_out, p.WoutT, 1024, 1024, gt, nt);
  tcvt(p.peer_wq, p.WqT, 1024, 1024, gt, nt);
  tcvt(p.w2, p.W2T, 64, 512, gt, nt);
  tcvt(p.a2, p.A2T, 64, 512, gt, nt);
  tcvt(p.g2, p.G2T, 128, 512, gt, nt);
  scvt(p.sub_keys, p.SK, 2 * 128 * 64 / 8, gt, nt);
  for (int r = bid * NW + wv; r < 32768; r += nb * NW) {
    const bool isv = r >= 16384;
    const int e = r & 16383;
    const float4* src = (const float4*)((isv ? p.peer_v : p.peer_u) + (size_t)e * 1024) + lane * 4;
    const float4 a = src[0], b = src[1], c = src[2], d = src[3];
    float am = fmaxf(fmaxf(fmaxf(fabsf(a.x), fabsf(a.y)), fmaxf(fabsf(a.z), fabsf(a.w))),
                     fmaxf(fmaxf(fabsf(b.x), fabsf(b.y)), fmaxf(fabsf(b.z), fabsf(b.w))));
    am = fmaxf(am, fmaxf(fmaxf(fmaxf(fabsf(c.x), fabsf(c.y)), fmaxf(fabsf(c.z), fabsf(c.w))),
                         fmaxf(fmaxf(fabsf(d.x), fabsf(d.y)), fmaxf(fabsf(d.z), fabsf(d.w)))));
    am = fmaxf(wave_max(am), 1e-30f);
    const float sc = 240.f / am;
    if (lane == 0) (isv ? p.SV : p.SU)[e] = am * (1.f / 240.f);
    *(u32x4*)((isv ? p.V8 : p.U8) + (size_t)e * 1024 + lane * 16) =
        u32x4{q4(a.x, a.y, a.z, a.w, sc), q4(b.x, b.y, b.z, b.w, sc), q4(c.x, c.y, c.z, c.w, sc), q4(d.x, d.y, d.z, d.w, sc)};
  }
}

constexpr int GBK = 64, GHALF = 128, GHT = GHALF * GBK;
DI int lds_byte(int r, int c) {
  const int st = (r >> 4) * 2 + (c >> 5), rr = r & 15, cc = c & 31, ob = rr * 64 + cc * 2;
  return st * 1024 + (ob ^ (((ob >> 9) & 1) << 5));
}
DI void stage_rc(int b, int& R, int& C) {
  const int st = b / 1024, sb = b % 1024, swz = sb ^ (((sb >> 9) & 1) << 5);
  R = (st >> 1) * 16 + swz / 64;
  C = (st & 1) * 32 + (swz % 64) / 2;
}
typedef __attribute__((address_space(3))) unsigned lds_u32;
#define G_SA(b, h) (shm + ((b) * 2 + (h)) * GHT)
#define G_SB(b, h) (shm + (4 + (b) * 2 + (h)) * GHT)
#define G_STAGE(P_, RS, br, kt)                                                                                   \
  do {                                                                                                            \
    const int _so = ((br) * K + (kt) * GBK) * 2;                                                                  \
    __builtin_amdgcn_raw_ptr_buffer_load_lds(RS, (lds_u32*)((char*)(P_) + tb0), 16, ob0, _so, 0, 0);              \
    __builtin_amdgcn_raw_ptr_buffer_load_lds(RS, (lds_u32*)((char*)(P_) + tb0 + 8192), 16, ob1, _so, 0, 0);       \
  } while (0)
#define G_LDA(dst, b, h)                                  \
  _Pragma("unroll") for (int m = 0; m < 4; ++m)           \
  _Pragma("unroll") for (int k = 0; k < 2; ++k)           \
    dst[m][k] = *reinterpret_cast<const bf16x8*>((const char*)G_SA(b, h) + lds_byte(wr * 64 + m * 16 + fr, k * 32 + fq * 8))
#define G_LDB(dst, b, h)                                  \
  _Pragma("unroll") for (int n = 0; n < 2; ++n)           \
  _Pragma("unroll") for (int k = 0; k < 2; ++k)           \
    dst[n][k] = *reinterpret_cast<const bf16x8*>((const char*)G_SB(b, h) + lds_byte(wc * 32 + n * 16 + fr, k * 32 + fq * 8))
#define G_MMA(ai, bj, At_, Bt_)                                                                         \
  do {                                                                                                  \
    __builtin_amdgcn_s_setprio(1);                                                                      \
    _Pragma("unroll") for (int m = 0; m < 4; ++m)                                                       \
    _Pragma("unroll") for (int n = 0; n < 2; ++n)                                                       \
    _Pragma("unroll") for (int k = 0; k < 2; ++k)                                                       \
      acc[ai][bj][m][n] = MFMA16(At_[m][k], Bt_[n][k], acc[ai][bj][m][n]);                              \
    __builtin_amdgcn_s_setprio(0);                                                                      \
  } while (0)
#define WAIT_V(n) asm volatile("s_waitcnt vmcnt(" #n ")" ::: "memory")
#define WAIT_L(n) asm volatile("s_waitcnt lgkmcnt(" #n ")" ::: "memory")
#define BAR __builtin_amdgcn_s_barrier()
#define SCHED __builtin_amdgcn_sched_barrier(0)

template <int K>
DI void gemm256(const u16* __restrict__ A, const u16* __restrict__ Bt, const int brow, const int bcol,
                f32x4 (&acc)[2][2][4][2]) {
  u16* shm = (u16*)dsm;
  const int tid_ = otid();
  const int wid = tid_ >> 6, lane = tid_ & 63, wr = wid >> 2, wc = wid & 3, fr = lane & 15, fq = lane >> 4;
#pragma unroll
  for (int a = 0; a < 2; a++)
#pragma unroll
    for (int b = 0; b < 2; b++)
#pragma unroll
      for (int m = 0; m < 4; m++)
#pragma unroll
        for (int n = 0; n < 2; n++) acc[a][b][m][n] = f32x4{0.f, 0.f, 0.f, 0.f};
  bf16x8 At[4][2], B0[2][2], B1[2][2];
  constexpr int nt = K / GBK;
  const __amdgpu_buffer_rsrc_t rsA = __builtin_amdgcn_make_buffer_rsrc((void*)A, 0, 0x7fffffff, 0x00020000);
  const __amdgpu_buffer_rsrc_t rsB = __builtin_amdgcn_make_buffer_rsrc((void*)Bt, 0, 0x7fffffff, 0x00020000);
  const unsigned tb0 = tid_ * 16;
  int ob0, ob1;
  {
    int r_, c_;
    stage_rc((int)tb0, r_, c_);
    ob0 = (r_ * K + c_) * 2;
    stage_rc((int)tb0 + 8192, r_, c_);
    ob1 = (r_ * K + c_) * 2;
  }
  WAIT_V(0);
  __syncthreads();
  G_STAGE(G_SB(0, 0), rsB, bcol, 0); G_STAGE(G_SA(0, 0), rsA, brow, 0);
  G_STAGE(G_SB(0, 1), rsB, bcol + GHALF, 0); G_STAGE(G_SA(0, 1), rsA, brow + GHALF, 0);
  if (wr == 1) BAR;
  WAIT_V(4); BAR;
  G_STAGE(G_SB(1, 0), rsB, bcol, 1); G_STAGE(G_SA(1, 0), rsA, brow, 1); G_STAGE(G_SB(1, 1), rsB, bcol + GHALF, 1);
  WAIT_V(6); BAR;
  for (int t = 0; t < nt - 2; t += 2) {
    G_LDB(B0, 0, 0); SCHED; G_LDA(At, 0, 0); G_STAGE(G_SA(1, 1), rsA, brow + GHALF, t + 1);
    WAIT_L(8); BAR; WAIT_L(0); G_MMA(0, 0, At, B0); BAR; SCHED;
    G_LDB(B1, 0, 1); G_STAGE(G_SB(0, 0), rsB, bcol, t + 2);
    BAR; WAIT_L(0); G_MMA(0, 1, At, B1); BAR;
    G_LDA(At, 0, 1); G_STAGE(G_SA(0, 0), rsA, brow, t + 2);
    BAR; WAIT_L(0); G_MMA(1, 0, At, B0); BAR; SCHED;
    G_STAGE(G_SB(0, 1), rsB, bcol + GHALF, t + 2);
    WAIT_V(6); BAR; G_MMA(1, 1, At, B1); BAR;
    G_LDB(B0, 1, 0); SCHED; G_LDA(At, 1, 0); G_STAGE(G_SA(0, 1), rsA, brow + GHALF, t + 2);
    WAIT_L(8); BAR; WAIT_L(0); G_MMA(0, 0, At, B0); BAR; SCHED;
    G_LDB(B1, 1, 1); G_STAGE(G_SB(1, 0), rsB, bcol, t + 3);
    BAR; WAIT_L(0); G_MMA(0, 1, At, B1); BAR;
    G_LDA(At, 1, 1); G_STAGE(G_SA(1, 0), rsA, brow, t + 3);
    BAR; WAIT_L(0); G_MMA(1, 0, At, B0); BAR; SCHED;
    G_STAGE(G_SB(1, 1), rsB, bcol + GHALF, t + 3);
    WAIT_V(6); BAR; G_MMA(1, 1, At, B1); BAR;
  }
  {
    G_LDB(B0, 0, 0); G_LDA(At, 0, 0); G_STAGE(G_SA(1, 1), rsA, brow + GHALF, nt - 1);
    BAR; WAIT_L(0); G_MMA(0, 0, At, B0); BAR;
    G_LDB(B1, 0, 1); BAR; WAIT_L(0); G_MMA(0, 1, At, B1); BAR;
    G_LDA(At, 0, 1); WAIT_V(4); BAR; WAIT_L(0); G_MMA(1, 0, At, B0); G_MMA(1, 1, At, B1); BAR;
  }
  {
    G_LDB(B0, 1, 0); G_LDA(At, 1, 0); WAIT_V(2); BAR; WAIT_L(0); G_MMA(0, 0, At, B0); BAR;
    G_LDB(B1, 1, 1); WAIT_V(0); BAR; WAIT_L(0); G_MMA(0, 1, At, B1); BAR;
    G_LDA(At, 1, 1); BAR; WAIT_L(0); G_MMA(1, 0, At, B0); G_MMA(1, 1, At, B1); BAR;
  }
  if (wr == 0) BAR;
}
#define GT_VARS \
  const int tid_ = otid(); const int wid = tid_ >> 6, lane = tid_ & 63, wr = wid >> 2, wc = wid & 3, fr = lane & 15, fq = lane >> 4;
#define GT_ROW(ai, m, j) ((ai) * 128 + wr * 64 + (m) * 16 + fq * 4 + (j))
#define GT_COL(bj, n) ((bj) * 128 + wc * 32 + (n) * 16 + fr)
#define GT_FOR                                       \
  _Pragma("unroll") for (int ai = 0; ai < 2; ++ai)   \
  _Pragma("unroll") for (int bj = 0; bj < 2; ++bj)   \
  _Pragma("unroll") for (int m = 0; m < 4; ++m)      \
  _Pragma("unroll") for (int n = 0; n < 2; ++n)      \
  _Pragma("unroll") for (int j = 0; j < 4; ++j)

DI bool tile_of(int round, int bid, int nb, int nM, int nN, int& pm, int& pn) {
  const int vt = round * nb + (bid & 7) * (nb >> 3) + (bid >> 3);
  if (vt >= nM * nN) return false;
  const int nig = 8 * nN, gid = vt / nig, fm = gid * 8, gsz = min(nM - fm, 8);
  pm = fm + (vt % nig) % gsz;
  pn = (vt % nig) / gsz;
  return true;
}


constexpr int CS_LD = 264;
DI void acc_to_lds(const f32x4 (&acc)[2][2][4][2]) {
  GT_VARS
  u16* Cs = (u16*)dsm;
  __syncthreads();
  GT_FOR { Cs[GT_ROW(ai, m, j) * CS_LD + GT_COL(bj, n)] = f2bf(acc[ai][bj][m][n][j]); }
  __syncthreads();
}

__device__ void ph_gemm1(const Params& p, int bid, int nb) {
  const int tid_ = otid();
  const int nM = 261, nN = 18;
  for (int round = 0; round * nb < nM * nN; ++round) {
    int pm, pn;
    if (!tile_of(round, bid, nb, nM, nN, pm, pn)) break;
    f32x4 acc[2][2][4][2];
    gemm256<1024>(p.H, p.WinT, pm * 256, pn * 256, acc);
    acc_to_lds(acc);
    const u16* Cs = (const u16*)dsm;
#pragma unroll 4
    for (int it = 0; it < 16; it++) {
      const int id = it * NTH + tid_, rl = id >> 5, c8 = (id & 31) * 8;
      const int row = pm * 256 + rl;
      const u32x4 v = *(const u32x4*)(Cs + rl * CS_LD + c8);
      *(u32x4*)(p.P + (size_t)row * INC + pn * 256 + c8) = v;
      if (pn == 9) {
        float* dst = nullptr;
        const int c2 = c8 & 127;
        if (row < TP) {
          const int tt = row & 4095;
          if (tt >= 3968) dst = p.out + (c8 < 128 ? OFF_KP : OFF_VP) + ((size_t)(row >> 12) * 128 + (tt - 3968)) * 128 + c2;
        } else if (row < T) {
          dst = p.out + (c8 < 128 ? OFF_KS : OFF_VS) + (size_t)(row - TP) * 128 + c2;
        }
        if (dst) {
          *(float4*)dst = make_float4(bflo(v[0]), bfhi(v[0]), bflo(v[1]), bfhi(v[1]));
          *(float4*)(dst + 4) = make_float4(bflo(v[2]), bfhi(v[2]), bflo(v[3]), bfhi(v[3]));
        }
      }
    }
  }
}

DI int prev_row(int g) {
  if (g < TP) return (g & 4095) ? g - 1 : -1;
  const int r2 = g - TP;
  return (r2 & 63) ? g - 1 : T + (r2 >> 6);
}

__device__ void ph_rwprep(const Params& p, int bid, int nb) {
  const int tid = otid(), lane = tid & 63, wv = tid >> 6, fr = lane & 15, fq = lane >> 4;
  u16* A1 = (u16*)dsm;
  u16* A2 = A1 + 64 * 80;
  u16* A3 = A2 + 64 * 80;
  u16* SA = (u16*)(p.out);
  u16* SB = p.H;
  const int hd = wv;
  for (int tile = bid; tile < T / 64; tile += nb) {
    const int g0 = tile * 64;
    __syncthreads();
    {
      const int row = tid >> 3, part8 = tid & 7, part = part8 >> 1, sub = part8 & 1;
      const int g = g0 + row, pr = prev_row(g);
      const int cb = 1536 + part * 64 + sub * 32;
      const u16* cur = p.P + (size_t)g * INC + cb;
      const u16* prv = p.P + (size_t)(pr < 0 ? 0 : pr) * INC + cb;
#pragma unroll
      for (int q = 0; q < 4; q++) {
        const u32x4 c4 = *(const u32x4*)(cur + q * 8);
        u32x4 p4 = {0u, 0u, 0u, 0u};
        if (pr >= 0) p4 = *(const u32x4*)(prv + q * 8);
        u32x4 ow;
#pragma unroll
        for (int e = 0; e < 4; e++) {
          const float c0 = bflo(c4[e]), c1 = bfhi(c4[e]), q0 = bflo(p4[e]), q1 = bfhi(p4[e]);
          float f0 = c0 + (q0 - c0) * p.mu[cb + q * 8 + 2 * e];
          float f1 = c1 + (q1 - c1) * p.mu[cb + q * 8 + 2 * e + 1];
          if (part == 0) { f0 = tanhf(f0); f1 = tanhf(f1); }
          else if (part >= 2) { f0 = sigmoidf_(f0); f1 = sigmoidf_(f1); }
          ow[e] = pack2(f0, f1);
        }
        u16* dst = part == 0 ? A1 + row * 80 + sub * 32 + q * 8
                 : part == 1 ? A2 + row * 80 + sub * 32 + q * 8
                             : A3 + row * 144 + (part - 2) * 64 + sub * 32 + q * 8;
        *(u32x4*)dst = ow;
      }
    }
    __syncthreads();
#pragma unroll 1
    for (int rg = 0; rg < 4; rg++) {
      f32x4 aw[4], aa[4];
#pragma unroll
      for (int nt = 0; nt < 4; nt++) { aw[nt] = f32x4{0.f, 0.f, 0.f, 0.f}; aa[nt] = f32x4{0.f, 0.f, 0.f, 0.f}; }
#pragma unroll
      for (int ks = 0; ks < 2; ks++) {
        const bf16x8 f1 = *(const bf16x8*)(A1 + (rg * 16 + fr) * 80 + ks * 32 + fq * 8);
        const bf16x8 f2 = *(const bf16x8*)(A2 + (rg * 16 + fr) * 80 + ks * 32 + fq * 8);
#pragma unroll
        for (int nt = 0; nt < 4; nt++) {
          const bf16x8 bw = *(const bf16x8*)(p.W2T + (size_t)(hd * 64 + nt * 16 + fr) * 64 + ks * 32 + fq * 8);
          const bf16x8 ba = *(const bf16x8*)(p.A2T + (size_t)(hd * 64 + nt * 16 + fr) * 64 + ks * 32 + fq * 8);
          aw[nt] = MFMA16(f1, bw, aw[nt]);
          aa[nt] = MFMA16(f2, ba, aa[nt]);
        }
      }
      float ss[4] = {0.f, 0.f, 0.f, 0.f};
      const int rowb = rg * 16 + fq * 4;
      const int gb = g0 + rowb;
      const int pr = (rowb == 0) ? prev_row(gb) : gb - 1;
#pragma unroll
      for (int nt = 0; nt < 4; nt++) {
        const int c = nt * 16 + fr, col = hd * 64 + c;
        const float mu_r = p.mu[col], mu_k = p.mu[512 + col], mu_v = p.mu[1024 + col];
        const float w0c = p.w0[col], a0c = p.a0[col], kkc = p.k_k[col], kac = p.k_a[col];
        float qr = 0.f, qk = 0.f, qv = 0.f;
        if (pr >= 0) {
          const u16* pp = p.P + (size_t)pr * INC + col;
          qr = bf2f(pp[0]); qk = bf2f(pp[512]); qv = bf2f(pp[1024]);
        }
#pragma unroll
        for (int j = 0; j < 4; j++) {
          const int gg = gb + j;
          const u16* pc = p.P + (size_t)gg * INC + col;
          const float cr = bf2f(pc[0]), ck = bf2f(pc[512]), cv = bf2f(pc[1024]);
          const float r = cr + (qr - cr) * mu_r, k = ck + (qk - ck) * mu_k, v = cv + (qv - cv) * mu_v;
          qr = cr; qk = ck; qv = cv;
          const float z = -(w0c + aw[nt][j]);
          const float sp = fmaxf(z, 0.f) + log1pf(__expf(-fabsf(z)));
          const float ed = __expf(-sp - 0.5f);
          const float dm = -expm1f(-ed);
          const float a = sigmoidf_(a0c + aa[nt][j]);
          const float kkv = k * kkc;
          ss[j] += kkv * kkv;
          const float k2 = k * (1.f + (a - 1.f) * kac);
          const size_t ba_ = ((size_t)gg * 8 + hd) * 256 + c;
          SA[ba_] = f2bf(r);
          SA[ba_ + 64] = f2bf(dm);
          SA[ba_ + 128] = f2bf(k2);
          SB[((size_t)gg * 8 + hd) * 128 + c] = f2bf(v);
          aw[nt][j] = kkv;
          aa[nt][j] = a;
        }
      }
#pragma unroll
      for (int j = 0; j < 4; j++) ss[j] = 1.f / fmaxf(sqrtf(red16(ss[j])), 1e-12f);
#pragma unroll
      for (int nt = 0; nt < 4; nt++) {
        const int c = nt * 16 + fr;
#pragma unroll
        for (int j = 0; j < 4; j++) {
          const int gg = gb + j;
          const float kkn = aw[nt][j] * ss[j];
          SA[((size_t)gg * 8 + hd) * 256 + 192 + c] = f2bf(kkn);
          SB[((size_t)gg * 8 + hd) * 128 + 64 + c] = f2bf(kkn * aa[nt][j]);
        }
      }
      f32x4 ag[4];
#pragma unroll
      for (int nt = 0; nt < 4; nt++) ag[nt] = f32x4{0.f, 0.f, 0.f, 0.f};
#pragma unroll
      for (int ks = 0; ks < 4; ks++) {
        const bf16x8 f3 = *(const bf16x8*)(A3 + (rg * 16 + fr) * 144 + ks * 32 + fq * 8);
#pragma unroll
        for (int nt = 0; nt < 4; nt++) {
          const bf16x8 bg = *(const bf16x8*)(p.G2T + (size_t)(hd * 64 + nt * 16 + fr) * 128 + ks * 32 + fq * 8);
          ag[nt] = MFMA16(f3, bg, ag[nt]);
        }
      }
#pragma unroll
      for (int nt = 0; nt < 4; nt++)
#pragma unroll
        for (int j = 0; j < 4; j++) p.G[(size_t)(gb + j) * 512 + hd * 64 + nt * 16 + fr] = f2bf(ag[nt][j]);
    }
  }
}

__device__ void ph_scan(const Params& p, int bid, int nb) {
  const int tid = otid(), lane = tid & 63, wv = tid >> 6;
  float* buf = (float*)dsm;
  const u16* SA = (const u16*)(p.out);
  const u16* SB = p.H;
  constexpr int CH = 32;
  for (int item = bid; item < 512; item += nb) {
    const int type = item >> 8, r_ = item & 255, half = r_ & 1, hb = r_ >> 1, h = hb & 7, b = hb >> 3;
    const int nch = type ? 64 / CH : 4096 / CH;
    const int gbase = type ? TP + b * 64 : b * 4096;
    const int row = half * 32 + wv * 4 + (lane >> 4), j0 = (lane & 15) * 4;
    float S[4] = {0.f, 0.f, 0.f, 0.f};
    if (type) {
      const float4 s0 = *(const float4*)(p.state_wkv + ((size_t)(b * 8 + h) * 64 + row) * 64 + j0);
      S[0] = s0.x; S[1] = s0.y; S[2] = s0.z; S[3] = s0.w;
    }
    u32x4 la[2], lb;
    auto gload = [&](int c) {
#pragma unroll
      for (int q = 0; q < 2; q++) {
        const int idx = tid + q * NTH, step = idx >> 5, u = idx & 31;
        la[q] = *(const u32x4*)(SA + ((size_t)(gbase + c * CH + step) * 8 + h) * 256 + u * 8);
      }
      {
        const int step = tid >> 4, u = tid & 15;
        lb = *(const u32x4*)(SB + ((size_t)(gbase + c * CH + step) * 8 + h) * 128 + u * 8);
      }
    };
    gload(0);
    for (int c = 0; c < nch; c++) {
      __syncthreads();
#pragma unroll
      for (int q = 0; q < 2; q++) {
        const int idx = tid + q * NTH, step = idx >> 5, u = idx & 31, arr = u >> 3, c0 = (u & 7) * 8;
        float* d = buf + step * 384 + arr * 64 + c0;
        float f[8];
#pragma unroll
        for (int e = 0; e < 4; e++) { f[2 * e] = bflo(la[q][e]); f[2 * e + 1] = bfhi(la[q][e]); }
        if (arr == 1) {
#pragma unroll
          for (int e = 0; e < 8; e++) f[e] = 1.f - f[e];
        }
        *(float4*)d = make_float4(f[0], f[1], f[2], f[3]);
        *(float4*)(d + 4) = make_float4(f[4], f[5], f[6], f[7]);
      }
      {
        const int step = tid >> 4, u = tid & 15, arr = u >> 3, c0 = (u & 7) * 8;
        float* d = buf + step * 384 + (4 + arr) * 64 + c0;
        *(float4*)d = make_float4(bflo(lb[0]), bfhi(lb[0]), bflo(lb[1]), bfhi(lb[1]));
        *(float4*)(d + 4) = make_float4(bflo(lb[2]), bfhi(lb[2]), bflo(lb[3]), bfhi(lb[3]));
      }
      __syncthreads();
      if (c + 1 < nch) gload(c + 1);
      float4 rr = *(const float4*)(buf + j0), dd = *(const float4*)(buf + 64 + j0), kk_ = *(const float4*)(buf + 128 + j0);
      float4 kn = *(const float4*)(buf + 192 + j0), bb = *(const float4*)(buf + 320 + j0);
      float vi = buf[256 + row];
      float ykeep = 0.f;
#pragma unroll 16
      for (int s = 0; s < CH; s++) {
        const float* sn = buf + (s + 1 < CH ? s + 1 : s) * 384;
        const float4 rr2 = *(const float4*)(sn + j0), dd2 = *(const float4*)(sn + 64 + j0), kk2 = *(const float4*)(sn + 128 + j0);
        const float4 kn2 = *(const float4*)(sn + 192 + j0), bb2 = *(const float4*)(sn + 320 + j0);
        const float vi2 = sn[256 + row];
        float sa = (S[0] * kn.x + S[1] * kn.y) + (S[2] * kn.z + S[3] * kn.w);
        sa = -red16(sa);
        S[0] = S[0] * dd.x + vi * kk_.x + sa * bb.x;
        S[1] = S[1] * dd.y + vi * kk_.y + sa * bb.y;
        S[2] = S[2] * dd.z + vi * kk_.z + sa * bb.z;
        S[3] = S[3] * dd.w + vi * kk_.w + sa * bb.w;
        float yp = (S[0] * rr.x + S[1] * rr.y) + (S[2] * rr.z + S[3] * rr.w);
        yp = red16(yp);
        ykeep = ((lane & 15) == (s & 15)) ? yp : ykeep;
        if ((s & 15) == 15)
          p.Y[(size_t)(gbase + c * CH + (s - 15) + (lane & 15)) * 512 + h * 64 + row] = f2bf(ykeep);
        rr = rr2; dd = dd2; kk_ = kk2; kn = kn2; bb = bb2; vi = vi2;
      }
    }
    float* so = p.out + (type ? OFF_WKV_S : OFF_WKV_P) + ((size_t)(b * 8 + h) * 64 + row) * 64 + j0;
    *(float4*)so = make_float4(S[0], S[1], S[2], S[3]);
  }
}

__device__ void ph_attn(const Params& p, int bid, int nb, bool dry = false) {
  const int tid = otid(), lane = tid & 63, wv = tid >> 6, fr = lane & 15, fq = lane >> 4;
  u16* Ks = (u16*)dsm;
  u16* Vt = Ks + 192 * 72;
  for (int item = bid; item < 2080; item += nb) {
    const int kvh = item & 1, r = item >> 1;
    const bool samp = r >= 1024;
    const int b = samp ? r - 1024 : r >> 6, c = samp ? 0 : (r & 63);
    const int gq0 = samp ? TP + b * 64 : b * 4096 + c * 64;
    __syncthreads();
#pragma unroll
    for (int q = 0; q < 3; q++) {
      const int idx = tid + q * NTH, j = idx >> 3, d0 = (idx & 7) * 8;
      u32x4 kq = {0u, 0u, 0u, 0u}, vq = {0u, 0u, 0u, 0u};
      if (!samp) {
        const int tok = (c - 2) * 64 + j;
        if (tok >= 0) {
          const u16* src = p.P + (size_t)(b * 4096 + tok) * INC + 2304 + kvh * 64 + d0;
          kq = *(const u32x4*)src;
          vq = *(const u32x4*)(src + 128);
        }
      } else if (j < 128) {
        const float4* ck = (const float4*)(p.cache_k + ((size_t)(b * 128 + j) * 2 + kvh) * 64 + d0);
        const float4* cv = (const float4*)(p.cache_v + ((size_t)(b * 128 + j) * 2 + kvh) * 64 + d0);
        const float4 k0 = ck[0], k1 = ck[1], v0 = cv[0], v1 = cv[1];
        kq = u32x4{pack2(k0.x, k0.y), pack2(k0.z, k0.w), pack2(k1.x, k1.y), pack2(k1.z, k1.w)};
        vq = u32x4{pack2(v0.x, v0.y), pack2(v0.z, v0.w), pack2(v1.x, v1.y), pack2(v1.z, v1.w)};
      } else {
        const u16* src = p.P + (size_t)(TP + b * 64 + (j - 128)) * INC + 2304 + kvh * 64 + d0;
        kq = *(const u32x4*)src;
        vq = *(const u32x4*)(src + 128);
      }
      *(u32x4*)(Ks + j * 72 + d0) = kq;
#pragma unroll
      for (int e = 0; e < 4; e++) {
        Vt[(d0 + 2 * e) * 196 + j] = (u16)(vq[e] & 0xffffu);
        Vt[(d0 + 2 * e + 1) * 196 + j] = (u16)(vq[e] >> 16);
      }
    }
    __syncthreads();
    const int qh = kvh * 4 + (wv & 3);
    const float slope = exp2f(-(float)(qh + 1)), sink = p.sinks[qh];
#pragma unroll 1
    for (int ps = 0; ps < 2; ps++) {
      const int q0 = (wv >> 2) * 32 + ps * 16;
      const int tq = q0 + fr;
      const u16* qp = p.P + (size_t)(gq0 + tq) * INC + 1792 + qh * 64 + fq * 8;
      const bf16x8 qf0 = *(const bf16x8*)(qp), qf1 = *(const bf16x8*)(qp + 32);
      f32x4 sc[12];
#pragma unroll
      for (int kt = 0; kt < 12; kt++) {
        sc[kt] = f32x4{0.f, 0.f, 0.f, 0.f};
        const bf16x8 a0 = *(const bf16x8*)(Ks + (kt * 16 + fr) * 72 + fq * 8);
        const bf16x8 a1 = *(const bf16x8*)(Ks + (kt * 16 + fr) * 72 + 32 + fq * 8);
        sc[kt] = MFMA16(a0, qf0, sc[kt]);
        sc[kt] = MFMA16(a1, qf1, sc[kt]);
        if ((kt & 3) == 3) SCHED;
      }
      float mx = -3e38f;
#pragma unroll
      for (int kt = 0; kt < 12; kt++)
#pragma unroll
        for (int j = 0; j < 4; j++) {
          const int key = kt * 16 + fq * 4 + j;
          float s = sc[kt][j] * 0.125f - slope * fabsf((float)(128 + tq - key));
          if (!samp && (c - 2) * 64 + key < 0) s = -1e30f;
          sc[kt][j] = s;
          mx = fmaxf(mx, s);
        }
      mx = fmaxf(mx, __shfl_xor(mx, 16));
      mx = fmaxf(mx, __shfl_xor(mx, 32));
      mx = fmaxf(mx, sink);
      float sum = 0.f;
#pragma unroll
      for (int kt = 0; kt < 12; kt++)
#pragma unroll
        for (int j = 0; j < 4; j++) {
          const float e = __expf(sc[kt][j] - mx);
          sc[kt][j] = e;
          sum += e;
        }
      sum += __shfl_xor(sum, 16);
      sum += __shfl_xor(sum, 32);
      sum += __expf(sink - mx);
      const float inv = 1.f / sum;
      f32x4 o[4];
#pragma unroll
      for (int dt = 0; dt < 4; dt++) o[dt] = f32x4{0.f, 0.f, 0.f, 0.f};
#pragma unroll
      for (int t2 = 0; t2 < 6; t2++) {
        const u32x4 pw = {pack2(sc[2 * t2][0] * inv, sc[2 * t2][1] * inv), pack2(sc[2 * t2][2] * inv, sc[2 * t2][3] * inv),
                          pack2(sc[2 * t2 + 1][0] * inv, sc[2 * t2 + 1][1] * inv),
                          pack2(sc[2 * t2 + 1][2] * inv, sc[2 * t2 + 1][3] * inv)};
        const bf16x8 pa = __builtin_bit_cast(bf16x8, pw);
#pragma unroll
        for (int dt = 0; dt < 4; dt++) {
          const u16* vp = Vt + (dt * 16 + fr) * 196 + t2 * 32 + fq * 4;
          const uint2 v0 = *(const uint2*)vp, v1 = *(const uint2*)(vp + 16);
          const bf16x8 vb = __builtin_bit_cast(bf16x8, u32x4{v0.x, v0.y, v1.x, v1.y});
          o[dt] = MFMA16(pa, vb, o[dt]);
        }
        SCHED;
      }
#pragma unroll
      for (int dt = 0; dt < 4; dt++)
#pragma unroll
        for (int j = 0; j < 4; j++)
          p.OATT[(size_t)(gq0 + q0 + fq * 4 + j) * 512 + qh * 64 + dt * 16 + fr] = f2bf(o[dt][j]);
    }
  }
  const u16* SA = (const u16*)(p.out);
  const u16* SB = p.H;
  for (int it4 = bid * NW + wv; it4 < T * 2; it4 += nb * NW) {
    const int it = it4 * 4 + (lane >> 4), c0 = (lane & 15) * 4;
    const int g = it >> 3, h = it & 7, col = h * 64 + c0;
    const uint2 yw = *(const uint2*)(p.Y + (size_t)g * 512 + col);
    const uint2 rw = *(const uint2*)(SA + (size_t)it * 256 + c0), kw = *(const uint2*)(SA + (size_t)it * 256 + 128 + c0);
    const uint2 vw = *(const uint2*)(SB + (size_t)it * 128 + c0), gw = *(const uint2*)(p.G + (size_t)g * 512 + col);
    const float4 lw = *(const float4*)(p.lnx_w + col), lb = *(const float4*)(p.lnx_b + col), rk = *(const float4*)(p.r_k + col);
    const float y0 = bflo(yw.x), y1 = bfhi(yw.x), y2 = bflo(yw.y), y3 = bfhi(yw.y);
    const float mean = red16((y0 + y1) + (y2 + y3)) * (1.f / 64.f);
    const float e0 = y0 - mean, e1 = y1 - mean, e2 = y2 - mean, e3 = y3 - mean;
    const float var = red16((e0 * e0 + e1 * e1) + (e2 * e2 + e3 * e3)) * (1.f / 64.f);
    const float bonus = red16((bflo(rw.x) * bflo(kw.x) * rk.x + bfhi(rw.x) * bfhi(kw.x) * rk.y) +
                              (bflo(rw.y) * bflo(kw.y) * rk.z + bfhi(rw.y) * bfhi(kw.y) * rk.w));
    const float rsd = rsqrtf(var + 64e-5f);
    const float o0 = (e0 * rsd * lw.x + lb.x + bonus * bflo(vw.x)) * bflo(gw.x);
    const float o1 = (e1 * rsd * lw.y + lb.y + bonus * bfhi(vw.x)) * bfhi(gw.x);
    const float o2 = (e2 * rsd * lw.z + lb.z + bonus * bflo(vw.y)) * bflo(gw.y);
    const float o3 = (e3 * rsd * lw.w + lb.w + bonus * bfhi(vw.y)) * bfhi(gw.y);
    if (!dry || o0 == 123.456f) *(uint2*)(p.Y + (size_t)g * 512 + col) = make_uint2(pack2(o0, o1), pack2(o2, o3));
  }
}

__device__ void ph_gemm2(const Params& p, int bid, int nb) {
  const int tid_ = otid();
  u16* MG = p.H;
  const u16* Cs = (const u16*)dsm;
  const int nM = 260, nN = 4;
  for (int round = 0; round * nb < nM * nN; ++round) {
    int pm, pn;
    if (!tile_of(round, bid, nb, nM, nN, pm, pn)) break;
    f32x4 acc[2][2][4][2];
#pragma unroll 1
    for (int br = 0; br < 2; br++) {
      gemm256<512>(br ? p.OATT : p.Y, p.WbT + (size_t)br * 1024 * 512, pm * 256, pn * 256, acc);
      acc_to_lds(acc);
#pragma unroll 2
      for (int it = 0; it < 16; it++) {
        const int id = it * NTH + tid_, rl = id >> 5, c8 = (id & 31) * 8;
        const int row = pm * 256 + rl, col = pn * 256 + c8;
        const u32x4 v = *(const u32x4*)(Cs + rl * CS_LD + c8);
        const u32x4 gw = *(const u32x4*)(p.P + (size_t)row * INC + 2560 + br * 1024 + col);
        u32x4 prev = {0u, 0u, 0u, 0u};
        if (br) prev = *(const u32x4*)(MG + (size_t)row * 1024 + col);
        u32x4 o;
#pragma unroll
        for (int e = 0; e < 4; e++) {
          const float r0 = bflo(prev[e]) + sigmoidf_(bflo(gw[e])) * bflo(v[e]);
          const float r1 = bfhi(prev[e]) + sigmoidf_(bfhi(gw[e])) * bfhi(v[e]);
          o[e] = pack2(r0, r1);
        }
        *(u32x4*)(MG + (size_t)row * 1024 + col) = o;
      }
    }
  }
}

__device__ void ph_gemm3(const Params& p, int bid, int nb) {
  const int tid_ = otid();
  const u16* MG = p.H;
  const u16* Cs = (const u16*)dsm;
  const int nM = 260, nN = 4;
  for (int round = 0; round * nb < nM * nN; ++round) {
    int pm, pn;
    if (!tile_of(round, bid, nb, nM, nN, pm, pn)) break;
    f32x4 acc[2][2][4][2];
    gemm256<1024>(MG, p.WoutT, pm * 256, pn * 256, acc);
    acc_to_lds(acc);
#pragma unroll 2
    for (int it = 0; it < 16; it++) {
      const int id = it * NTH + tid_, rl = id >> 5, c8 = (id & 31) * 8;
      const int row = pm * 256 + rl, col = pn * 256 + c8;
      const u32x4 v = *(const u32x4*)(Cs + rl * CS_LD + c8);
      const float* xr = xrow(p, row) + col;
      const float4 x0 = *(const float4*)xr, x1 = *(const float4*)(xr + 4);
      float* dst = p.out + (size_t)row * 1024 + col;
      *(float4*)dst = make_float4(x0.x + bflo(v[0]), x0.y + bfhi(v[0]), x0.z + bflo(v[1]), x0.w + bfhi(v[1]));
      *(float4*)(dst + 4) = make_float4(x1.x + bflo(v[2]), x1.y + bfhi(v[2]), x1.z + bflo(v[3]), x1.w + bfhi(v[3]));
    }
  }
}

__device__ void ph_norm2(const Params& p, int bid, int nb) {
  const int tid = otid(), lane = tid & 63, wv = tid >> 6;
  for (int row = bid * NW + wv; row < T; row += nb * NW) {
    const float4* x = (const float4*)(p.out + (size_t)row * 1024);
    float4 v[4];
    float ss = 0.f;
#pragma unroll
    for (int i = 0; i < 4; i++) {
      v[i] = x[lane + i * 64];
      ss += v[i].x * v[i].x + v[i].y * v[i].y + v[i].z * v[i].z + v[i].w * v[i].w;
    }
    ss = wave_sum(ss);
    const float rs = rsqrtf(ss * (1.f / 1024.f) + 1e-6f);
    u16* hr = p.H + (size_t)row * 1024;
    float4 y[4];
    float am = 0.f;
#pragma unroll
    for (int i = 0; i < 4; i++) {
      const float4 g = ((const float4*)p.norm2_g)[lane + i * 64];
      y[i] = make_float4(v[i].x * rs * g.x, v[i].y * rs * g.y, v[i].z * rs * g.z, v[i].w * rs * g.w);
      ((uint2*)hr)[lane + i * 64] = make_uint2(pack2(y[i].x, y[i].y), pack2(y[i].z, y[i].w));
      am = fmaxf(am, fmaxf(fmaxf(fabsf(y[i].x), fabsf(y[i].y)), fmaxf(fabsf(y[i].z), fabsf(y[i].w))));
    }
    am = fmaxf(wave_max(am), 1e-30f);
    const float sc = 240.f / am;
    if (lane == 0) p.SH[row] = am * (1.f / 240.f);
    u32* h8 = (u32*)((unsigned char*)p.Y + (size_t)row * 1024);
#pragma unroll
    for (int i = 0; i < 4; i++) h8[lane + i * 64] = q4(y[i].x, y[i].y, y[i].z, y[i].w, sc);
  }
}

DI void ins16(float (&l)[16], float x) {
#pragma unroll
  for (int i = 0; i < 16; i++) {
    const float hi = fmaxf(l[i], x);
    x = fminf(l[i], x);
    l[i] = hi;
  }
}

__device__ void ph_peerq(const Params& p, int bid, int nb) {
  GT_VARS
  const int l31 = lane & 31, kh = lane >> 5;
  u16* Qs = (u16*)dsm;
  unsigned char* lt = (unsigned char*)(dsm + 135168 + wid * 1024);
  int* IDX = (int*)p.G;
  float* GATE = (float*)p.OATT;
  const int nM = 260, nN = 4;
  for (int round = 0; round * nb < nM * nN; ++round) {
    int pm, pn;
    if (!tile_of(round, bid, nb, nM, nN, pm, pn)) break;
    {
      f32x4 acc[2][2][4][2];
      gemm256<1024>(p.H, p.WqT, pm * 256, pn * 256, acc);
      acc_to_lds(acc);
    }
#pragma unroll 1
    for (int hh = 0; hh < 2; hh++) {
      const int hp = pn * 2 + hh;
      float l1[16], l2[16];
#pragma unroll
      for (int i = 0; i < 16; i++) { l1[i] = 0.f; l2[i] = 0.f; }
#pragma unroll 1
      for (int pp = 0; pp < 2; pp++) {
        f32x16 sc[4];
#pragma unroll
        for (int m4 = 0; m4 < 4; m4++) {
#pragma unroll
          for (int i = 0; i < 16; i++) sc[m4][i] = 0.f;
#pragma unroll
          for (int kk = 0; kk < 4; kk++) {
            const bf16x8 a = *(const bf16x8*)(p.SK + (size_t)(pp * 128 + m4 * 32 + l31) * 64 + kk * 16 + kh * 8);
            const bf16x8 bq = *(const bf16x8*)(Qs + (wid * 32 + l31) * 264 + hh * 128 + pp * 64 + kk * 16 + kh * 8);
            sc[m4] = MFMA32(a, bq, sc[m4]);
          }
        }
        float l[16];
#pragma unroll
        for (int i = 0; i < 16; i++) l[i] = -3e38f;
#pragma unroll
        for (int m4 = 0; m4 < 4; m4++)
#pragma unroll
          for (int i = 0; i < 16; i++) {
            const u32 nn = m4 * 32 + (i >> 2) * 8 + kh * 4 + (i & 3);
            ins16(l, __uint_as_float((__float_as_uint(sc[m4][i]) & ~0x7Fu) | nn));
          }
        float o[16];
#pragma unroll
        for (int i = 0; i < 16; i++) o[i] = __shfl_xor(l[i], 32);
#pragma unroll
        for (int i = 0; i < 16; i++) ins16(l, o[i]);
#pragma unroll
        for (int i = 0; i < 16; i++) {
          l1[i] = pp == 0 ? l[i] : l1[i];
          l2[i] = pp == 0 ? l2[i] : l[i];
        }
      }
      if (kh == 0) {
        u32 w[8];
#pragma unroll
        for (int q = 0; q < 4; q++) {
          w[q] = (__float_as_uint(l1[4 * q]) & 0x7F) | ((__float_as_uint(l1[4 * q + 1]) & 0x7F) << 8) |
                 ((__float_as_uint(l1[4 * q + 2]) & 0x7F) << 16) | ((__float_as_uint(l1[4 * q + 3]) & 0x7F) << 24);
          w[4 + q] = (__float_as_uint(l2[4 * q]) & 0x7F) | ((__float_as_uint(l2[4 * q + 1]) & 0x7F) << 8) |
                     ((__float_as_uint(l2[4 * q + 2]) & 0x7F) << 16) | ((__float_as_uint(l2[4 * q + 3]) & 0x7F) << 24);
        }
        *(uint4*)(lt + l31 * 32) = make_uint4(w[0], w[1], w[2], w[3]);
        *(uint4*)(lt + l31 * 32 + 16) = make_uint4(w[4], w[5], w[6], w[7]);
      }
      float l3[16];
#pragma unroll
      for (int i = 0; i < 16; i++) l3[i] = -3e38f;
#pragma unroll
      for (int a = 0; a < 16; a++)
#pragma unroll
        for (int b = 0; b < 16; b++)
          if ((a + 1) * (b + 1) <= 16) {
            const float s = __uint_as_float(__float_as_uint(l1[a]) & ~0x7Fu) + __uint_as_float(__float_as_uint(l2[b]) & ~0x7Fu);
            ins16(l3, __uint_as_float((__float_as_uint(s) & ~0xFFu) | (u32)(a * 16 + b)));
          }
      __builtin_amdgcn_fence(__ATOMIC_RELEASE, "workgroup");
      __builtin_amdgcn_wave_barrier();
      if (kh == 0) {
        const int g = pm * 256 + wid * 32 + l31;
        float ev[16];
        int ei[16];
        float sum = 0.f;
        const float mxv = __uint_as_float(__float_as_uint(l3[0]) & ~0xFFu);
#pragma unroll
        for (int k = 0; k < 16; k++) {
          const u32 bits = __float_as_uint(l3[k]);
          const u32 pos = bits & 0xFF;
          ev[k] = __expf(__uint_as_float(bits & ~0xFFu) - mxv);
          sum += ev[k];
          ei[k] = (int)lt[l31 * 32 + (pos >> 4)] * 128 + (int)lt[l31 * 32 + 16 + (pos & 15)];
        }
        const float inv = 1.f / sum;
        int4* ip = (int4*)(IDX + (size_t)g * 128 + hp * 16);
        float4* gp = (float4*)(GATE + (size_t)g * 128 + hp * 16);
#pragma unroll
        for (int q = 0; q < 4; q++) {
          ip[q] = make_int4(ei[4 * q], ei[4 * q + 1], ei[4 * q + 2], ei[4 * q + 3]);
          gp[q] = make_float4(ev[4 * q] * inv, ev[4 * q + 1] * inv, ev[4 * q + 2] * inv, ev[4 * q + 3] * inv);
        }
      }
      __builtin_amdgcn_wave_barrier();
    }
  }
}

__device__ void ph_peer(const Params& p, int bid, int nb, bool dry = false) {
  const int tid = otid(), lane = tid & 63, wv = tid >> 6;
  char* wb = dsm + wv * 2048;
  unsigned char* hs = (unsigned char*)wb;
  float* acts = (float*)(wb + 1024);
  int* idxs = (int*)(wb + 1536);
  const int* IDX = (const int*)p.G;
  const float* GATE = (const float*)p.OATT;
  const unsigned char* H8 = (const unsigned char*)p.Y;
  const int n = lane & 15, quad = lane >> 4;
  for (int g = bid * NW + wv; g < T; g += nb * NW) {
    *(u32x4*)(hs + lane * 16) = *(const u32x4*)(H8 + (size_t)g * 1024 + lane * 16);
    idxs[lane] = IDX[(size_t)g * 128 + lane];
    idxs[lane + 64] = IDX[(size_t)g * 128 + 64 + lane];
    const float shv = p.SH[g];
    __builtin_amdgcn_fence(__ATOMIC_RELEASE, "workgroup");
    __builtin_amdgcn_wave_barrier();
    {
      u32x4 ring[16];
      {
        const unsigned char* ur = p.U8 + (size_t)idxs[n] * 1024 + quad * 16;
#pragma unroll
        for (int i = 0; i < 16; i++) ring[i] = *(const u32x4*)(ur + i * 64);
      }
#pragma unroll 1
      for (int grp = 0; grp < 8; grp++) {
        const unsigned char* un = p.U8 + (size_t)idxs[(grp < 7 ? grp + 1 : grp) * 16 + n] * 1024 + quad * 16;
        const float4 gt = *(const float4*)(GATE + (size_t)g * 128 + grp * 16 + quad * 4);
        const int4 ee = *(const int4*)(idxs + grp * 16 + quad * 4);
        const float su0 = p.SU[ee.x], su1 = p.SU[ee.y], su2 = p.SU[ee.z], su3 = p.SU[ee.w];
        const float sv0 = p.SV[ee.x], sv1 = p.SV[ee.y], sv2 = p.SV[ee.z], sv3 = p.SV[ee.w];
        f32x4 acc = {0.f, 0.f, 0.f, 0.f};
#pragma unroll
        for (int st = 0; st < 16; st++) {
          const u32x4 ua = ring[st];
          if (grp < 7) ring[st] = *(const u32x4*)(un + st * 64);
          const u32x4 hb = *(const u32x4*)(hs + st * 64 + quad * 16);
          const long a0 = (long)(((unsigned long)ua[1] << 32) | ua[0]);
          const long a1 = (long)(((unsigned long)ua[3] << 32) | ua[2]);
          const long b0 = (long)(((unsigned long)hb[1] << 32) | hb[0]);
          const long b1 = (long)(((unsigned long)hb[3] << 32) | hb[2]);
          acc = __builtin_amdgcn_mfma_f32_16x16x32_fp8_fp8(a0, b0, acc, 0, 0, 0);
          acc = __builtin_amdgcn_mfma_f32_16x16x32_fp8_fp8(a1, b1, acc, 0, 0, 0);
        }
        const float d0 = acc[0] * shv * su0, d1 = acc[1] * shv * su1, d2 = acc[2] * shv * su2, d3 = acc[3] * shv * su3;
        float4 av;
        av.x = 0.5f * d0 * (1.f + erff(d0 * 0.70710678118f)) * gt.x * sv0;
        av.y = 0.5f * d1 * (1.f + erff(d1 * 0.70710678118f)) * gt.y * sv1;
        av.z = 0.5f * d2 * (1.f + erff(d2 * 0.70710678118f)) * gt.z * sv2;
        av.w = 0.5f * d3 * (1.f + erff(d3 * 0.70710678118f)) * gt.w * sv3;
        if (n == 0) *(float4*)(acts + grp * 16 + quad * 4) = av;
      }
    }
    __builtin_amdgcn_fence(__ATOMIC_RELEASE, "workgroup");
    __builtin_amdgcn_wave_barrier();
    float o[16];
#pragma unroll
    for (int j = 0; j < 16; j++) o[j] = 0.f;
    {
      u32x4 ring[16];
#pragma unroll
      for (int k = 0; k < 16; k++) ring[k] = *(const u32x4*)(p.V8 + (size_t)idxs[k] * 1024 + lane * 16);
#pragma unroll 1
      for (int kb = 0; kb < 128; kb += 16) {
        const bool more = kb < 112;
        const int kn = more ? kb + 16 : kb;
#pragma unroll
        for (int j = 0; j < 16; j++) {
          const u32x4 vq = ring[j];
          if (more) ring[j] = *(const u32x4*)(p.V8 + (size_t)idxs[kn + j] * 1024 + lane * 16);
          const float a = acts[kb + j];
#pragma unroll
          for (int q = 0; q < 4; q++) {
            const f32x2 lo = __builtin_amdgcn_cvt_pk_f32_fp8((int)vq[q], false);
            const f32x2 hi = __builtin_amdgcn_cvt_pk_f32_fp8((int)vq[q], true);
            o[4 * q] += a * lo[0]; o[4 * q + 1] += a * lo[1]; o[4 * q + 2] += a * hi[0]; o[4 * q + 3] += a * hi[1];
          }
        }
      }
    }
    float* xr = p.out + (size_t)g * 1024 + lane * 16;
    float4 x[4];
#pragma unroll
    for (int q = 0; q < 4; q++) x[q] = *(const float4*)(xr + q * 4);
    float ss = 0.f;
#pragma unroll
    for (int q = 0; q < 4; q++) {
      x[q].x += o[4 * q]; x[q].y += o[4 * q + 1]; x[q].z += o[4 * q + 2]; x[q].w += o[4 * q + 3];
      ss += x[q].x * x[q].x + x[q].y * x[q].y + x[q].z * x[q].z + x[q].w * x[q].w;
    }
    ss = wave_sum(ss);
    if (dry && ss != 123.456f) continue;
    const float rs = rsqrtf(ss * (1.f / 1024.f) + 1e-6f);
#pragma unroll
    for (int q = 0; q < 4; q++) {
      const float4 gq = *(const float4*)(p.final_g + lane * 16 + q * 4);
      *(float4*)(xr + q * 4) = make_float4(x[q].x * rs * gq.x, x[q].y * rs * gq.y, x[q].z * rs * gq.z, x[q].w * rs * gq.w);
    }
  }
}

__global__ void __launch_bounds__(512) mega_kernel(Params p) {
  cg::grid_group grid = cg::this_grid();
  const int bid = blockIdx.x, nb = gridDim.x;
  if (ON(0)) ph_prep(p, bid, nb);
  grid.sync();
  if (ON(1)) ph_gemm1(p, bid, nb);
  grid.sync();
  if (REP == 1) { ph_gemm1(p, bid, nb); grid.sync(); }
  if (ON(2)) ph_rwprep(p, bid, nb);
  grid.sync();
  if (REP == 2) { ph_rwprep(p, bid, nb); grid.sync(); }
  if (ON(3)) ph_scan(p, bid, nb);
  grid.sync();
  if (REP == 3) { ph_scan(p, bid, nb); grid.sync(); }
  if (REP == 4) { ph_attn(p, bid, nb, true); grid.sync(); }
  if (ON(4)) ph_attn(p, bid, nb);
  grid.sync();
  if (ON(5)) ph_gemm2(p, bid, nb);
  grid.sync();
  if (REP == 5) { ph_gemm2(p, bid, nb); grid.sync(); }
  if (ON(6)) ph_gemm3(p, bid, nb);
  grid.sync();
  if (REP == 6) { ph_gemm3(p, bid, nb); grid.sync(); }
  if (ON(7)) ph_norm2(p, bid, nb);
  grid.sync();
  if (ON(8)) ph_peerq(p, bid, nb);
  grid.sync();
  if (REP == 8) { ph_peerq(p, bid, nb); grid.sync(); }
  if (REP == 9) { ph_peer(p, bid, nb, true); grid.sync(); }
  if (ON(9)) ph_peer(p, bid, nb);
}

extern "C" void kernel_launch(void* const* d_in, const int* in_sizes, int n_in, void* d_out, int out_size, void* d_ws,
                              size_t ws_size, hipStream_t stream) {
  Params p{};
  const float** f = (const float**)&p;
  for (int i = 0; i < 28; i++) f[i] = (const float*)d_in[i];
  p.out = (float*)d_out;
  char* w = (char*)d_ws;
  size_t off = 0;
  auto take = [&](size_t bytes) { char* r = w + off; off += (bytes + 255) & ~(size_t)255; return (u16*)r; };
  p.H = take((size_t)MP * 1024 * 2);
  p.P = take((size_t)MP * INC * 2);
  p.U8 = (unsigned char*)take((size_t)16384 * 1024);
  p.V8 = (unsigned char*)take((size_t)16384 * 1024);
  p.SU = (float*)take(16384 * 4);
  p.SV = (float*)take(16384 * 4);
  p.SH = (float*)take((size_t)T * 4);
  p.WinT = take((size_t)4608 * 1024 * 2);
  p.WbT = take((size_t)2 * 1024 * 512 * 2);
  p.WoutT = take((size_t)1024 * 1024 * 2);
  p.WqT = take((size_t)1024 * 1024 * 2);
  p.W2T = take((size_t)512 * 64 * 2);
  p.A2T = take((size_t)512 * 64 * 2);
  p.G2T = take((size_t)512 * 128 * 2);
  p.SK = take((size_t)2 * 128 * 64 * 2);
  p.Y = take((size_t)T * 512 * 2);
  p.G = take((size_t)T * 512 * 2);
  p.OATT = take((size_t)T * 512 * 2);
  static int grid_blocks = 0;
  if (!grid_blocks) {
    int dev = 0, cus = 0, per_cu = 0;
    (void)hipGetDevice(&dev);
    (void)hipDeviceGetAttribute(&cus, hipDeviceAttributeMultiprocessorCount, dev);
    (void)hipFuncSetAttribute((const void*)mega_kernel, hipFuncAttributeMaxDynamicSharedMemorySize, DYN_LDS);
    (void)hipOccupancyMaxActiveBlocksPerMultiprocessor(&per_cu, mega_kernel, NTH, DYN_LDS);
    if (per_cu > 1) per_cu = 1;
    grid_blocks = cus * per_cu;
  }
  void* args[] = {&p};
  hipError_t e = hipLaunchCooperativeKernel((void*)mega_kernel, dim3(grid_blocks), dim3(NTH), args, DYN_LDS, stream);
  if (e != hipSuccess) fprintf(stderr, "cooperative launch failed: %s (grid %d)\n", hipGetErrorString(e), grid_blocks);
}
```

```cpp
#include <hip/hip_runtime.h>
#include <hip/hip_cooperative_groups.h>
#include <cstdio>
namespace cg = cooperative_groups;

#ifndef REP
#define REP -1
#endif
#ifndef ONLY
#define ONLY -1
#endif
#define ON(k) (ONLY < 0 || ONLY == (k))

typedef unsigned short u16;
typedef unsigned int u32;
using bf16x8 = __attribute__((ext_vector_type(8))) short;
using f32x4 = __attribute__((ext_vector_type(4))) float;
using f32x16 = __attribute__((ext_vector_type(16))) float;
using u32x4 = __attribute__((ext_vector_type(4))) u32;
#define DI __device__ __forceinline__

constexpr int TP = 65536, TS = 1024, T = 66560, MP = 66816;
constexpr int INC = 4608;
constexpr int NW = 8;
constexpr int NTH = 512;
constexpr size_t OFF_Y = 0, OFF_SHIFT_P = 68157440, OFF_WKV_P = 68173824, OFF_KP = 68698112, OFF_VP = 68960256,
                 OFF_SHIFT_S = 69222400, OFF_WKV_S = 69238784, OFF_KS = 69763072, OFF_VS = 69894144;
constexpr int DYN_LDS = 147456;

extern __shared__ __attribute__((aligned(16))) char dsm[];

struct Params {
  const float *x_prompt, *x_sample, *state_shift, *state_wkv, *cache_k, *cache_v, *norm1_g, *w_in, *mu, *w0, *w2, *a0,
      *a2, *g2, *k_k, *k_a, *r_k, *lnx_w, *lnx_b, *sinks, *w_branch, *w_out, *norm2_g, *peer_wq, *sub_keys, *peer_u,
      *peer_v, *final_g;
  float* out;
  u16 *H, *P, *WinT, *WbT, *WoutT, *WqT, *W2T, *A2T, *G2T, *SK, *Y, *G, *OATT;
  unsigned char *U8, *V8;
  float *SU, *SV, *SH;
};

DI u16 f2bf(float x) {
  u32 u = __float_as_uint(x);
  u += 0x7fffu + ((u >> 16) & 1u);
  return (u16)(u >> 16);
}
DI float bf2f(u16 b) { return __uint_as_float(((u32)b) << 16); }
DI u32 pack2(float a, float b) { return (u32)f2bf(a) | ((u32)f2bf(b) << 16); }
DI float bflo(u32 w) { return __uint_as_float(w << 16); }
DI float bfhi(u32 w) { return __uint_as_float(w & 0xffff0000u); }
DI float wave_sum(float v) {
#pragma unroll
  for (int o = 32; o; o >>= 1) v += __shfl_xor(v, o);
  return v;
}
DI float sigmoidf_(float x) { return 1.f / (1.f + __expf(-x)); }
DI const float* xrow(const Params& p, int g) {
  return g < TP ? p.x_prompt + (size_t)g * 1024 : p.x_sample + (size_t)(g - TP) * 1024;
}
DI int otid() { int t = threadIdx.x; asm volatile("" : "+v"(t)); return t; }
#define MFMA32(a, b, c) __builtin_amdgcn_mfma_f32_32x32x16_bf16((a), (b), (c), 0, 0, 0)
#define MFMA16(a, b, c) __builtin_amdgcn_mfma_f32_16x16x32_bf16((a), (b), (c), 0, 0, 0)

template <int CTRL>
DI float dppmov(float v) {
  return __int_as_float(__builtin_amdgcn_update_dpp(0, __float_as_int(v), CTRL, 0xF, 0xF, false));
}
DI float red16(float v) {
  v += dppmov<0x128>(v);
  v += dppmov<0x124>(v);
  v += dppmov<0x122>(v);
  v += dppmov<0x121>(v);
  return v;
}


using f32x2 = __attribute__((ext_vector_type(2))) float;
DI float wave_max(float v) {
#pragma unroll
  for (int o = 32; o; o >>= 1) v = fmaxf(v, __shfl_xor(v, o));
  return v;
}
DI u32 q4(float a, float b, float c, float d, float sc) {
  int w = 0;
  w = __builtin_amdgcn_cvt_pk_fp8_f32(a * sc, b * sc, w, false);
  w = __builtin_amdgcn_cvt_pk_fp8_f32(c * sc, d * sc, w, true);
  return (u32)w;
}

DI void tcvt(const float* __restrict__ W, u16* __restrict__ Wt, int K, int N, int gt, int nt) {
  const int total = N * (K / 8);
  for (int i = gt; i < total; i += nt) {
    const int n = i % N, kg = i / N;
    u32 o[4];
#pragma unroll
    for (int j = 0; j < 4; j++)
      o[j] = pack2(W[(size_t)(kg * 8 + 2 * j) * N + n], W[(size_t)(kg * 8 + 2 * j + 1) * N + n]);
    *(uint4*)(Wt + (size_t)n * K + kg * 8) = make_uint4(o[0], o[1], o[2], o[3]);
  }
}
DI void scvt(const float* __restrict__ W, u16* __restrict__ O, int n8, int gt, int nt) {
  for (int i = gt; i < n8; i += nt) {
    const float4 a = ((const float4*)W)[2 * i], b = ((const float4*)W)[2 * i + 1];
    ((uint4*)O)[i] = make_uint4(pack2(a.x, a.y), pack2(a.z, a.w), pack2(b.x, b.y), pack2(b.z, b.w));
  }
}

__device__ void ph_prep(const Params& p, int bid, int nb) {
  const int tid = otid(), lane = tid & 63, wv = tid >> 6;
  for (int row = bid * NW + wv; row < MP; row += nb * NW) {
    u16* hr = p.H + (size_t)row * 1024;
    if (row < T) {
      const float4* x = (const float4*)xrow(p, row);
      float4 v[4];
      float ss = 0.f;
#pragma unroll
      for (int i = 0; i < 4; i++) {
        v[i] = x[lane + i * 64];
        ss += v[i].x * v[i].x + v[i].y * v[i].y + v[i].z * v[i].z + v[i].w * v[i].w;
      }
      ss = wave_sum(ss);
      const float rs = rsqrtf(ss * (1.f / 1024.f) + 1e-6f);
      float* so = nullptr;
      if (row < TP) {
        if ((row & 4095) == 4095) so = p.out + OFF_SHIFT_P + (size_t)(row >> 12) * 1024;
      } else {
        const int r2 = row - TP;
        if ((r2 & 63) == 63) so = p.out + OFF_SHIFT_S + (size_t)(r2 >> 6) * 1024;
      }
#pragma unroll
      for (int i = 0; i < 4; i++) {
        const float4 g = ((const float4*)p.norm1_g)[lane + i * 64];
        float4 y;
        y.x = v[i].x * rs * g.x; y.y = v[i].y * rs * g.y; y.z = v[i].z * rs * g.z; y.w = v[i].w * rs * g.w;
        ((uint2*)hr)[lane + i * 64] = make_uint2(pack2(y.x, y.y), pack2(y.z, y.w));
        if (so) ((float4*)so)[lane + i * 64] = y;
      }
    } else if (row < T + 16) {
      const float4* x = (const float4*)(p.state_shift + (size_t)(row - T) * 1024);
#pragma unroll
      for (int i = 0; i < 4; i++) {
        const float4 y = x[lane + i * 64];
        ((uint2*)hr)[lane + i * 64] = make_uint2(pack2(y.x, y.y), pack2(y.z, y.w));
      }
    } else {
#pragma unroll
      for (int i = 0; i < 4; i++) ((uint2*)hr)[lane + i * 64] = make_uint2(0u, 0u);
    }
  }
  const int gt = bid * NTH + tid, nt = nb * NTH;
  tcvt(p.w_in, p.WinT, 1024, 4608, gt, nt);
  tcvt(p.w_branch, p.WbT, 512, 1024, gt, nt);
  tcvt(p.w_branch + 512 * 1024, p.WbT + 1024 * 512, 512, 1024, gt, nt);
  tcvt(p.w_out, p.WoutT, 1024, 1024, gt, nt);
  tcvt(p.peer_wq, p.WqT, 1024, 1024, gt, nt);
  tcvt(p.w2, p.W2T, 64, 512, gt, nt);
  tcvt(p.a2, p.A2T, 64, 512, gt, nt);
  tcvt(p.g2, p.G2T, 128, 512, gt, nt);
  scvt(p.sub_keys, p.SK, 2 * 128 * 64 / 8, gt, nt);
  for (int r = bid * NW + wv; r < 32768; r += nb * NW) {
    const bool isv = r >= 16384;
    const int e = r & 16383;
    const float4* src = (const float4*)((isv ? p.peer_v : p.peer_u) + (size_t)e * 1024) + lane * 4;
    const float4 a = src[0], b = src[1], c = src[2], d = src[3];
    float am = fmaxf(fmaxf(fmaxf(fabsf(a.x), fabsf(a.y)), fmaxf(fabsf(a.z), fabsf(a.w))),
                     fmaxf(fmaxf(fabsf(b.x), fabsf(b.y)), fmaxf(fabsf(b.z), fabsf(b.w))));
    am = fmaxf(am, fmaxf(fmaxf(fmaxf(fabsf(c.x), fabsf(c.y)), fmaxf(fabsf(c.z), fabsf(c.w))),
                         fmaxf(fmaxf(fabsf(d.x), fabsf(d.y)), fmaxf(fabsf(d.z), fabsf(d.w)))));
    am = fmaxf(wave_max(am), 1e-30f);
    const float sc = 240.f / am;
    if (lane == 0) (isv ? p.SV : p.SU)[e] = am * (1.f / 240.f);
    *(u32x4*)((isv ? p.V8 : p.U8) + (size_t)e * 1024 + lane * 16) =
        u32x4{q4(a.x, a.y, a.z, a.w, sc), q4(b.x, b.y, b.z, b.w, sc), q4(c.x, c.y, c.z, c.w, sc), q4(d.x, d.y, d.z, d.w, sc)};
  }
}

constexpr int GBK = 64, GHALF = 128, GHT = GHALF * GBK;
DI int lds_byte(int r, int c) {
  const int st = (r >> 4) * 2 + (c >> 5), rr = r & 15, cc = c & 31, ob = rr * 64 + cc * 2;
  return st * 1024 + (ob ^ (((ob >> 9) & 1) << 5));
}
DI void stage_rc(int b, int& R, int& C) {
  const int st = b / 1024, sb = b % 1024, swz = sb ^ (((sb >> 9) & 1) << 5);
  R = (st >> 1) * 16 + swz / 64;
  C = (st & 1) * 32 + (swz % 64) / 2;
}
typedef __attribute__((address_space(3))) unsigned lds_u32;
#define G_SA(b, h) (shm + ((b) * 2 + (h)) * GHT)
#define G_SB(b, h) (shm + (4 + (b) * 2 + (h)) * GHT)
#define G_STAGE(P_, RS, br, kt)                                                                                   \
  do {                                                                                                            \
    const int _so = ((br) * K + (kt) * GBK) * 2;                                                                  \
    __builtin_amdgcn_raw_ptr_buffer_load_lds(RS, (lds_u32*)((char*)(P_) + tb0), 16, ob0, _so, 0, 0);              \
    __builtin_amdgcn_raw_ptr_buffer_load_lds(RS, (lds_u32*)((char*)(P_) + tb0 + 8192), 16, ob1, _so, 0, 0);       \
  } while (0)
#define G_LDA(dst, b, h)                                  \
  _Pragma("unroll") for (int m = 0; m < 4; ++m)           \
  _Pragma("unroll") for (int k = 0; k < 2; ++k)           \
    dst[m][k] = *reinterpret_cast<const bf16x8*>((const char*)G_SA(b, h) + lds_byte(wr * 64 + m * 16 + fr, k * 32 + fq * 8))
#define G_LDB(dst, b, h)                                  \
  _Pragma("unroll") for (int n = 0; n < 2; ++n)           \
  _Pragma("unroll") for (int k = 0; k < 2; ++k)           \
    dst[n][k] = *reinterpret_cast<const bf16x8*>((const char*)G_SB(b, h) + lds_byte(wc * 32 + n * 16 + fr, k * 32 + fq * 8))
#define G_MMA(ai, bj, At_, Bt_)                                                                         \
  do {                                                                                                  \
    __builtin_amdgcn_s_setprio(1);                                                                      \
    _Pragma("unroll") for (int m = 0; m < 4; ++m)                                                       \
    _Pragma("unroll") for (int n = 0; n < 2; ++n)                                                       \
    _Pragma("unroll") for (int k = 0; k < 2; ++k)                                                       \
      acc[ai][bj][m][n] = MFMA16(At_[m][k], Bt_[n][k], acc[ai][bj][m][n]);                              \
    __builtin_amdgcn_s_setprio(0);                                                                      \
  } while (0)
#define WAIT_V(n) asm volatile("s_waitcnt vmcnt(" #n ")" ::: "memory")
#define WAIT_L(n) asm volatile("s_waitcnt lgkmcnt(" #n ")" ::: "memory")
#define BAR __builtin_amdgcn_s_barrier()
#define SCHED __builtin_amdgcn_sched_barrier(0)

template <int K>
DI void gemm256(const u16* __restrict__ A, const u16* __restrict__ Bt, const int brow, const int bcol,
                f32x4 (&acc)[2][2][4][2]) {
  u16* shm = (u16*)dsm;
  const int tid_ = otid();
  const int wid = tid_ >> 6, lane = tid_ & 63, wr = wid >> 2, wc = wid & 3, fr = lane & 15, fq = lane >> 4;
#pragma unroll
  for (int a = 0; a < 2; a++)
#pragma unroll
    for (int b = 0; b < 2; b++)
#pragma unroll
      for (int m = 0; m < 4; m++)
#pragma unroll
        for (int n = 0; n < 2; n++) acc[a][b][m][n] = f32x4{0.f, 0.f, 0.f, 0.f};
  bf16x8 At[4][2], B0[2][2], B1[2][2];
  constexpr int nt = K / GBK;
  const __amdgpu_buffer_rsrc_t rsA = __builtin_amdgcn_make_buffer_rsrc((void*)A, 0, 0x7fffffff, 0x00020000);
  const __amdgpu_buffer_rsrc_t rsB = __builtin_amdgcn_make_buffer_rsrc((void*)Bt, 0, 0x7fffffff, 0x00020000);
  const unsigned tb0 = tid_ * 16;
  int ob0, ob1;
  {
    int r_, c_;
    stage_rc((int)tb0, r_, c_);
    ob0 = (r_ * K + c_) * 2;
    stage_rc((int)tb0 + 8192, r_, c_);
    ob1 = (r_ * K + c_) * 2;
  }
  WAIT_V(0);
  __syncthreads();
  G_STAGE(G_SB(0, 0), rsB, bcol, 0); G_STAGE(G_SA(0, 0), rsA, brow, 0);
  G_STAGE(G_SB(0, 1), rsB, bcol + GHALF, 0); G_STAGE(G_SA(0, 1), rsA, brow + GHALF, 0);
  if (wr == 1) BAR;
  WAIT_V(4); BAR;
  G_STAGE(G_SB(1, 0), rsB, bcol, 1); G_STAGE(G_SA(1, 0), rsA, brow, 1); G_STAGE(G_SB(1, 1), rsB, bcol + GHALF, 1);
  WAIT_V(6); BAR;
  for (int t = 0; t < nt - 2; t += 2) {
    G_LDB(B0, 0, 0); SCHED; G_LDA(At, 0, 0); G_STAGE(G_SA(1, 1), rsA, brow + GHALF, t + 1);
    WAIT_L(8); BAR; WAIT_L(0); G_MMA(0, 0, At, B0); BAR; SCHED;
    G_LDB(B1, 0, 1); G_STAGE(G_SB(0, 0), rsB, bcol, t + 2);
    BAR; WAIT_L(0); G_MMA(0, 1, At, B1); BAR;
    G_LDA(At, 0, 1); G_STAGE(G_SA(0, 0), rsA, brow, t + 2);
    BAR; WAIT_L(0); G_MMA(1, 0, At, B0); BAR; SCHED;
    G_STAGE(G_SB(0, 1), rsB, bcol + GHALF, t + 2);
    WAIT_V(6); BAR; G_MMA(1, 1, At, B1); BAR;
    G_LDB(B0, 1, 0); SCHED; G_LDA(At, 1, 0); G_STAGE(G_SA(0, 1), rsA, brow + GHALF, t + 2);
    WAIT_L(8); BAR; WAIT_L(0); G_MMA(0, 0, At, B0); BAR; SCHED;
    G_LDB(B1, 1, 1); G_STAGE(G_SB(1, 0), rsB, bcol, t + 3);
    BAR; WAIT_L(0); G_MMA(0, 1, At, B1); BAR;
    G_LDA(At, 1, 1); G_STAGE(G_SA(1, 0), rsA, brow, t + 3);
    BAR; WAIT_L(0); G_MMA(1, 0, At, B0); BAR; SCHED;
    G_STAGE(G_SB(1, 1), rsB, bcol + GHALF, t + 3);
    WAIT_V(6); BAR; G_MMA(1, 1, At, B1); BAR;
  }
  {
    G_LDB(B0, 0, 0); G_LDA(At, 0, 0); G_STAGE(G_SA(1, 1), rsA, brow + GHALF, nt - 1);
    BAR; WAIT_L(0); G_MMA(0, 0, At, B0); BAR;
    G_LDB(B1, 0, 1); BAR; WAIT_L(0); G_MMA(0, 1, At, B1); BAR;
    G_LDA(At, 0, 1); WAIT_V(4); BAR; WAIT_L(0); G_MMA(1, 0, At, B0); G_MMA(1, 1, At, B1); BAR;
  }
  {
    G_LDB(B0, 1, 0); G_LDA(At, 1, 0); WAIT_V(2); BAR; WAIT_L(0); G_MMA(0, 0, At, B0); BAR;
    G_LDB(B1, 1, 1); WAIT_V(0); BAR; WAIT_L(0); G_MMA(0, 1, At, B1); BAR;
    G_LDA(At, 1, 1); BAR; WAIT_L(0); G_MMA(1, 0, At, B0); G_MMA(1, 1, At, B1); BAR;
  }
  if (wr == 0) BAR;
}
#define GT_VARS \
  const int tid_ = otid(); const int wid = tid_ >> 6, lane = tid_ & 63, wr = wid >> 2, wc = wid & 3, fr = lane & 15, fq = lane >> 4;
#define GT_ROW(ai, m, j) ((ai) * 128 + wr * 64 + (m) * 16 + fq * 4 + (j))
#define GT_COL(bj, n) ((bj) * 128 + wc * 32 + (n) * 16 + fr)
#define GT_FOR                                       \
  _Pragma("unroll") for (int ai = 0; ai < 2; ++ai)   \
  _Pragma("unroll") for (int bj = 0; bj < 2; ++bj)   \
  _Pragma("unroll") for (int m = 0; m < 4; ++m)      \
  _Pragma("unroll") for (int n = 0; n < 2; ++n)      \
  _Pragma("unroll") for (int j = 0; j < 4; ++j)

DI bool tile_of(int round, int bid, int nb, int nM, int nN, int& pm, int& pn) {
  const int vt = round * nb + (bid & 7) * (nb >> 3) + (bid >> 3);
  if (vt >= nM * nN) return false;
  const int nig = 8 * nN, gid = vt / nig, fm = gid * 8, gsz = min(nM - fm, 8);
  pm = fm + (vt % nig) % gsz;
  pn = (vt % nig) / gsz;
  return true;
}


constexpr int CS_LD = 264;
DI void acc_to_lds(const f32x4 (&acc)[2][2][4][2]) {
  GT_VARS
  u16* Cs = (u16*)dsm;
  __syncthreads();
  GT_FOR { Cs[GT_ROW(ai, m, j) * CS_LD + GT_COL(bj, n)] = f2bf(acc[ai][bj][m][n][j]); }
  __syncthreads();
}

__device__ void ph_gemm1(const Params& p, int bid, int nb) {
  const int tid_ = otid();
  const int nM = 261, nN = 18;
  for (int round = 0; round * nb < nM * nN; ++round) {
    int pm, pn;
    if (!tile_of(round, bid, nb, nM, nN, pm, pn)) break;
    f32x4 acc[2][2][4][2];
    gemm256<1024>(p.H, p.WinT, pm * 256, pn * 256, acc);
    acc_to_lds(acc);
    const u16* Cs = (const u16*)dsm;
#pragma unroll 4
    for (int it = 0; it < 16; it++) {
      const int id = it * NTH + tid_, rl = id >> 5, c8 = (id & 31) * 8;
      const int row = pm * 256 + rl;
      const u32x4 v = *(const u32x4*)(Cs + rl * CS_LD + c8);
      *(u32x4*)(p.P + (size_t)row * INC + pn * 256 + c8) = v;
      if (pn == 9) {
        float* dst = nullptr;
        const int c2 = c8 & 127;
        if (row < TP) {
          const int tt = row & 4095;
          if (tt >= 3968) dst = p.out + (c8 < 128 ? OFF_KP : OFF_VP) + ((size_t)(row >> 12) * 128 + (tt - 3968)) * 128 + c2;
        } else if (row < T) {
          dst = p.out + (c8 < 128 ? OFF_KS : OFF_VS) + (size_t)(row - TP) * 128 + c2;
        }
        if (dst) {
          *(float4*)dst = make_float4(bflo(v[0]), bfhi(v[0]), bflo(v[1]), bfhi(v[1]));
          *(float4*)(dst + 4) = make_float4(bflo(v[2]), bfhi(v[2]), bflo(v[3]), bfhi(v[3]));
        }
      }
    }
  }
}

DI int prev_row(int g) {
  if (g < TP) return (g & 4095) ? g - 1 : -1;
  const int r2 = g - TP;
  return (r2 & 63) ? g - 1 : T + (r2 >> 6);
}

__device__ void ph_rwprep(const Params& p, int bid, int nb) {
  const int tid = otid(), lane = tid & 63, wv = tid >> 6, fr = lane & 15, fq = lane >> 4;
  u16* A1 = (u16*)dsm;
  u16* A2 = A1 + 64 * 80;
  u16* A3 = A2 + 64 * 80;
  u16* SA = (u16*)(p.out);
  u16* SB = p.H;
  const int hd = wv;
  u16* OT = (u16*)(dsm + 38912 + wv * 12288);
  for (int tile = bid; tile < T / 64; tile += nb) {
    const int g0 = tile * 64;
    __syncthreads();
    {
      const int row = tid >> 3, part8 = tid & 7, part = part8 >> 1, sub = part8 & 1;
      const int g = g0 + row, pr = prev_row(g);
      const int cb = 1536 + part * 64 + sub * 32;
      const u16* cur = p.P + (size_t)g * INC + cb;
      const u16* prv = p.P + (size_t)(pr < 0 ? 0 : pr) * INC + cb;
#pragma unroll
      for (int q = 0; q < 4; q++) {
        const u32x4 c4 = *(const u32x4*)(cur + q * 8);
        u32x4 p4 = {0u, 0u, 0u, 0u};
        if (pr >= 0) p4 = *(const u32x4*)(prv + q * 8);
        u32x4 ow;
#pragma unroll
        for (int e = 0; e < 4; e++) {
          const float c0 = bflo(c4[e]), c1 = bfhi(c4[e]), q0 = bflo(p4[e]), q1 = bfhi(p4[e]);
          float f0 = c0 + (q0 - c0) * p.mu[cb + q * 8 + 2 * e];
          float f1 = c1 + (q1 - c1) * p.mu[cb + q * 8 + 2 * e + 1];
          if (part == 0) { f0 = 1.f - 2.f / (1.f + __expf(2.f * f0)); f1 = 1.f - 2.f / (1.f + __expf(2.f * f1)); }
          else if (part >= 2) { f0 = sigmoidf_(f0); f1 = sigmoidf_(f1); }
          ow[e] = pack2(f0, f1);
        }
        u16* dst = part == 0 ? A1 + row * 80 + sub * 32 + q * 8
                 : part == 1 ? A2 + row * 80 + sub * 32 + q * 8
                             : A3 + row * 144 + (part - 2) * 64 + sub * 32 + q * 8;
        *(u32x4*)dst = ow;
      }
    }
    __syncthreads();
#pragma unroll 1
    for (int rg = 0; rg < 4; rg++) {
      f32x4 aw[4], aa[4];
#pragma unroll
      for (int nt = 0; nt < 4; nt++) { aw[nt] = f32x4{0.f, 0.f, 0.f, 0.f}; aa[nt] = f32x4{0.f, 0.f, 0.f, 0.f}; }
#pragma unroll
      for (int ks = 0; ks < 2; ks++) {
        const bf16x8 f1 = *(const bf16x8*)(A1 + (rg * 16 + fr) * 80 + ks * 32 + fq * 8);
        const bf16x8 f2 = *(const bf16x8*)(A2 + (rg * 16 + fr) * 80 + ks * 32 + fq * 8);
#pragma unroll
        for (int nt = 0; nt < 4; nt++) {
          const bf16x8 bw = *(const bf16x8*)(p.W2T + (size_t)(hd * 64 + nt * 16 + fr) * 64 + ks * 32 + fq * 8);
          const bf16x8 ba = *(const bf16x8*)(p.A2T + (size_t)(hd * 64 + nt * 16 + fr) * 64 + ks * 32 + fq * 8);
          aw[nt] = MFMA16(f1, bw, aw[nt]);
          aa[nt] = MFMA16(f2, ba, aa[nt]);
        }
      }
      float ss[4] = {0.f, 0.f, 0.f, 0.f};
      const int rowb = rg * 16 + fq * 4;
      const int gb = g0 + rowb;
      const int pr = (rowb == 0) ? prev_row(gb) : gb - 1;
#pragma unroll
      for (int nt = 0; nt < 4; nt++) {
        const int c = nt * 16 + fr, col = hd * 64 + c;
        const float mu_r = p.mu[col], mu_k = p.mu[512 + col], mu_v = p.mu[1024 + col];
        const float w0c = p.w0[col], a0c = p.a0[col], kkc = p.k_k[col], kac = p.k_a[col];
        float qr = 0.f, qk = 0.f, qv = 0.f;
        if (pr >= 0) {
          const u16* pp = p.P + (size_t)pr * INC + col;
          qr = bf2f(pp[0]); qk = bf2f(pp[512]); qv = bf2f(pp[1024]);
        }
#pragma unroll
        for (int j = 0; j < 4; j++) {
          const int gg = gb + j;
          const u16* pc = p.P + (size_t)gg * INC + col;
          const float cr = bf2f(pc[0]), ck = bf2f(pc[512]), cv = bf2f(pc[1024]);
          const float r = cr + (qr - cr) * mu_r, k = ck + (qk - ck) * mu_k, v = cv + (qv - cv) * mu_v;
          qr = cr; qk = ck; qv = cv;
          const float ed = 0.6065306597126334f * sigmoidf_(w0c + aw[nt][j]);
          const float dm = 1.f - __expf(-ed);
          const float a = sigmoidf_(a0c + aa[nt][j]);
          const float kkv = k * kkc;
          ss[j] += kkv * kkv;
          const float k2 = k * (1.f + (a - 1.f) * kac);
          u16* ot = OT + (fq * 4 + j) * 384 + c;
          ot[0] = f2bf(r);
          ot[64] = f2bf(dm);
          ot[128] = f2bf(k2);
          ot[256] = f2bf(v);
          aw[nt][j] = kkv;
          aa[nt][j] = a;
        }
        SCHED;
      }
#pragma unroll
      for (int j = 0; j < 4; j++) ss[j] = 1.f / fmaxf(sqrtf(red16(ss[j])), 1e-12f);
#pragma unroll
      for (int nt = 0; nt < 4; nt++) {
        const int c = nt * 16 + fr;
#pragma unroll
        for (int j = 0; j < 4; j++) {
          const float kkn = aw[nt][j] * ss[j];
          u16* ot = OT + (fq * 4 + j) * 384 + c;
          ot[192] = f2bf(kkn);
          ot[320] = f2bf(kkn * aa[nt][j]);
        }
      }
      __builtin_amdgcn_fence(__ATOMIC_RELEASE, "workgroup");
      __builtin_amdgcn_wave_barrier();
      {
        const int gr0 = g0 + rg * 16;
#pragma unroll 4
        for (int it = 0; it < 12; it++) {
          const int id = it * 64 + lane, rowi = id / 48, pc = id % 48;
          const u32x4 v4 = *(const u32x4*)(OT + rowi * 384 + pc * 8);
          const size_t gh = (size_t)(gr0 + rowi) * 8 + hd;
          if (pc < 32) *(u32x4*)(SA + gh * 256 + pc * 8) = v4;
          else *(u32x4*)(SB + gh * 128 + (pc - 32) * 8) = v4;
        }
      }
      __builtin_amdgcn_wave_barrier();
      f32x4 ag[4];
#pragma unroll
      for (int nt = 0; nt < 4; nt++) ag[nt] = f32x4{0.f, 0.f, 0.f, 0.f};
#pragma unroll
      for (int ks = 0; ks < 4; ks++) {
        const bf16x8 f3 = *(const bf16x8*)(A3 + (rg * 16 + fr) * 144 + ks * 32 + fq * 8);
#pragma unroll
        for (int nt = 0; nt < 4; nt++) {
          const bf16x8 bg = *(const bf16x8*)(p.G2T + (size_t)(hd * 64 + nt * 16 + fr) * 128 + ks * 32 + fq * 8);
          ag[nt] = MFMA16(f3, bg, ag[nt]);
        }
      }
#pragma unroll
      for (int nt = 0; nt < 4; nt++)
#pragma unroll
        for (int j = 0; j < 4; j++) p.G[(size_t)(gb + j) * 512 + hd * 64 + nt * 16 + fr] = f2bf(ag[nt][j]);
    }
  }
}

DI float red8(float v) {
  v += dppmov<0xB1>(v);
  v += dppmov<0x4E>(v);
  v += dppmov<0x141>(v);
  return v;
}
struct ScanOps { f32x4 r, d, k, n, b; float v; };
DI void scan_ld(ScanOps& o, const float* sb, int j0, int row) {
  o.r = *(const f32x4*)(sb + j0);
  o.d = *(const f32x4*)(sb + 64 + j0);
  o.k = *(const f32x4*)(sb + 128 + j0);
  o.n = *(const f32x4*)(sb + 192 + j0);
  o.b = *(const f32x4*)(sb + 320 + j0);
  o.v = sb[256 + row];
}
#define LO2(x) __builtin_shufflevector((x), (x), 0, 1)
#define HI2(x) __builtin_shufflevector((x), (x), 2, 3)
DI float scan_step(f32x2 (&S)[2], const ScanOps& o) {
  const f32x2 vv = {o.v, o.v};
  const f32x2 tt = S[0] * LO2(o.n) + S[1] * HI2(o.n);
  const f32x2 m0 = S[0] * LO2(o.d) + vv * LO2(o.k);
  const f32x2 m1 = S[1] * HI2(o.d) + vv * HI2(o.k);
  const float sa = -red16(tt[0] + tt[1]);
  const f32x2 sv = {sa, sa};
  S[0] = m0 + sv * LO2(o.b);
  S[1] = m1 + sv * HI2(o.b);
  const f32x2 yy = S[0] * LO2(o.r) + S[1] * HI2(o.r);
  return red16(yy[0] + yy[1]);
}

__device__ void ph_scan(const Params& p, int bid, int nb) {
  const int tid = otid(), lane = tid & 63, wv = tid >> 6;
  float* buf = (float*)dsm;
  const u16* SA = (const u16*)(p.out);
  const u16* SB = p.H;
  constexpr int CH = 32;
  for (int item = bid; item < 512; item += nb) {
    const int type = item >> 8, r_ = item & 255, half = r_ & 1, hb = r_ >> 1, h = hb & 7, b = hb >> 3;
    const int nch = type ? 64 / CH : 4096 / CH;
    const int gbase = type ? TP + b * 64 : b * 4096;
    const bool active = true;
    const int row = half * 32 + wv * 4 + (lane >> 4), j0 = (lane & 15) * 4;
    f32x2 S[2];
#pragma unroll
    for (int j = 0; j < 2; j++) S[j] = f32x2{0.f, 0.f};
    if (type && active) {
      const float* s0 = p.state_wkv + ((size_t)(b * 8 + h) * 64 + row) * 64 + j0;
#pragma unroll
      for (int j = 0; j < 2; j++) S[j] = f32x2{s0[2 * j], s0[2 * j + 1]};
    }
    u32x4 la[2], lb;
    auto gload = [&](int c) {
#pragma unroll
      for (int q = 0; q < 2; q++) {
        const int idx = tid + q * NTH, step = idx >> 5, u = idx & 31;
        la[q] = *(const u32x4*)(SA + ((size_t)(gbase + c * CH + step) * 8 + h) * 256 + u * 8);
      }
      {
        const int step = tid >> 4, u = tid & 15;
        lb = *(const u32x4*)(SB + ((size_t)(gbase + c * CH + step) * 8 + h) * 128 + u * 8);
      }
    };
    gload(0);
    for (int c = 0; c < nch; c++) {
      __syncthreads();
#pragma unroll
      for (int q = 0; q < 2; q++) {
        const int idx = tid + q * NTH, step = idx >> 5, u = idx & 31, arr = u >> 3, c0 = (u & 7) * 8;
        float* d = buf + step * 384 + arr * 64 + c0;
        float f[8];
#pragma unroll
        for (int e = 0; e < 4; e++) { f[2 * e] = bflo(la[q][e]); f[2 * e + 1] = bfhi(la[q][e]); }
        if (arr == 1) {
#pragma unroll
          for (int e = 0; e < 8; e++) f[e] = 1.f - f[e];
        }
        *(float4*)d = make_float4(f[0], f[1], f[2], f[3]);
        *(float4*)(d + 4) = make_float4(f[4], f[5], f[6], f[7]);
      }
      {
        const int step = tid >> 4, u = tid & 15, arr = u >> 3, c0 = (u & 7) * 8;
        float* d = buf + step * 384 + (4 + arr) * 64 + c0;
        *(float4*)d = make_float4(bflo(lb[0]), bfhi(lb[0]), bflo(lb[1]), bfhi(lb[1]));
        *(float4*)(d + 4) = make_float4(bflo(lb[2]), bfhi(lb[2]), bflo(lb[3]), bfhi(lb[3]));
      }
      __syncthreads();
      if (c + 1 < nch) gload(c + 1);
      if (active) {
        ScanOps A0, A1, B0, B1;
        scan_ld(A0, buf, j0, row);
        scan_ld(A1, buf + 384, j0, row);
        float ykeep = 0.f;
#pragma unroll 1
        for (int s = 0; s < CH; s += 4) {
          scan_ld(B0, buf + (s + 2) * 384, j0, row);
          scan_ld(B1, buf + (s + 3) * 384, j0, row);
          SCHED;
          {
            const float y0 = scan_step(S, A0);
            ykeep = ((lane & 15) == (s & 15)) ? y0 : ykeep;
            const float y1 = scan_step(S, A1);
            ykeep = ((lane & 15) == ((s + 1) & 15)) ? y1 : ykeep;
          }
          SCHED;
          const int sn = (s + 4 < CH) ? s + 4 : s;
          scan_ld(A0, buf + sn * 384, j0, row);
          scan_ld(A1, buf + (sn + 1) * 384, j0, row);
          SCHED;
          {
            const float y2 = scan_step(S, B0);
            ykeep = ((lane & 15) == ((s + 2) & 15)) ? y2 : ykeep;
            const float y3 = scan_step(S, B1);
            ykeep = ((lane & 15) == ((s + 3) & 15)) ? y3 : ykeep;
          }
          SCHED;
          if ((s & 15) == 12)
            p.Y[(size_t)(gbase + c * CH + (s - 12) + (lane & 15)) * 512 + h * 64 + row] = f2bf(ykeep);
        }
      }
    }
    if (active) {
      float* so = p.out + (type ? OFF_WKV_S : OFF_WKV_P) + ((size_t)(b * 8 + h) * 64 + row) * 64 + j0;
      *(float4*)so = make_float4(S[0][0], S[0][1], S[1][0], S[1][1]);
    }
  }
}

__device__ void ph_attn(const Params& p, int bid, int nb, bool dry = false) {
  const int tid = otid(), lane = tid & 63, wv = tid >> 6, fr = lane & 15, fq = lane >> 4;
  u16* Ks = (u16*)dsm;
  u16* Vt = Ks + 192 * 72;
  for (int item = bid; item < 2080; item += nb) {
    const int kvh = item & 1, r = item >> 1;
    const bool samp = r >= 1024;
    const int b = samp ? r - 1024 : r >> 6, c = samp ? 0 : (r & 63);
    const int gq0 = samp ? TP + b * 64 : b * 4096 + c * 64;
    __syncthreads();
#pragma unroll
    for (int q = 0; q < 3; q++) {
      const int idx = tid + q * NTH, j = idx >> 3, d0 = (idx & 7) * 8;
      u32x4 kq = {0u, 0u, 0u, 0u}, vq = {0u, 0u, 0u, 0u};
      if (!samp) {
        const int tok = (c - 2) * 64 + j;
        if (tok >= 0) {
          const u16* src = p.P + (size_t)(b * 4096 + tok) * INC + 2304 + kvh * 64 + d0;
          kq = *(const u32x4*)src;
          vq = *(const u32x4*)(src + 128);
        }
      } else if (j < 128) {
        const float4* ck = (const float4*)(p.cache_k + ((size_t)(b * 128 + j) * 2 + kvh) * 64 + d0);
        const float4* cv = (const float4*)(p.cache_v + ((size_t)(b * 128 + j) * 2 + kvh) * 64 + d0);
        const float4 k0 = ck[0], k1 = ck[1], v0 = cv[0], v1 = cv[1];
        kq = u32x4{pack2(k0.x, k0.y), pack2(k0.z, k0.w), pack2(k1.x, k1.y), pack2(k1.z, k1.w)};
        vq = u32x4{pack2(v0.x, v0.y), pack2(v0.z, v0.w), pack2(v1.x, v1.y), pack2(v1.z, v1.w)};
      } else {
        const u16* src = p.P + (size_t)(TP + b * 64 + (j - 128)) * INC + 2304 + kvh * 64 + d0;
        kq = *(const u32x4*)src;
        vq = *(const u32x4*)(src + 128);
      }
      *(u32x4*)(Ks + j * 72 + d0) = kq;
#pragma unroll
      for (int e = 0; e < 4; e++) {
        Vt[(d0 + 2 * e) * 196 + j] = (u16)(vq[e] & 0xffffu);
        Vt[(d0 + 2 * e + 1) * 196 + j] = (u16)(vq[e] >> 16);
      }
    }
    __syncthreads();
    const int qh = kvh * 4 + (wv & 3);
    const float slope = exp2f(-(float)(qh + 1)), sink = p.sinks[qh];
#pragma unroll 1
    for (int ps = 0; ps < 2; ps++) {
      const int q0 = (wv >> 2) * 32 + ps * 16;
      const int tq = q0 + fr;
      const u16* qp = p.P + (size_t)(gq0 + tq) * INC + 1792 + qh * 64 + fq * 8;
      const bf16x8 qf0 = *(const bf16x8*)(qp), qf1 = *(const bf16x8*)(qp + 32);
      f32x4 sc[12];
#pragma unroll
      for (int kt = 0; kt < 12; kt++) {
        sc[kt] = f32x4{0.f, 0.f, 0.f, 0.f};
        const bf16x8 a0 = *(const bf16x8*)(Ks + (kt * 16 + fr) * 72 + fq * 8);
        const bf16x8 a1 = *(const bf16x8*)(Ks + (kt * 16 + fr) * 72 + 32 + fq * 8);
        sc[kt] = MFMA16(a0, qf0, sc[kt]);
        sc[kt] = MFMA16(a1, qf1, sc[kt]);
        if ((kt & 3) == 3) SCHED;
      }
      float mx = -3e38f;
#pragma unroll
      for (int kt = 0; kt < 12; kt++)
#pragma unroll
        for (int j = 0; j < 4; j++) {
          const int key = kt * 16 + fq * 4 + j;
          float s = sc[kt][j] * 0.125f - slope * fabsf((float)(128 + tq - key));
          if (!samp && (c - 2) * 64 + key < 0) s = -1e30f;
          sc[kt][j] = s;
          mx = fmaxf(mx, s);
        }
      mx = fmaxf(mx, __shfl_xor(mx, 16));
      mx = fmaxf(mx, __shfl_xor(mx, 32));
      mx = fmaxf(mx, sink);
      float sum = 0.f;
#pragma unroll
      for (int kt = 0; kt < 12; kt++)
#pragma unroll
        for (int j = 0; j < 4; j++) {
          const float e = __expf(sc[kt][j] - mx);
          sc[kt][j] = e;
          sum += e;
        }
      sum += __shfl_xor(sum, 16);
      sum += __shfl_xor(sum, 32);
      sum += __expf(sink - mx);
      const float inv = 1.f / sum;
      f32x4 o[4];
#pragma unroll
      for (int dt = 0; dt < 4; dt++) o[dt] = f32x4{0.f, 0.f, 0.f, 0.f};
#pragma unroll
      for (int t2 = 0; t2 < 6; t2++) {
        const u32x4 pw = {pack2(sc[2 * t2][0] * inv, sc[2 * t2][1] * inv), pack2(sc[2 * t2][2] * inv, sc[2 * t2][3] * inv),
                          pack2(sc[2 * t2 + 1][0] * inv, sc[2 * t2 + 1][1] * inv),
                          pack2(sc[2 * t2 + 1][2] * inv, sc[2 * t2 + 1][3] * inv)};
        const bf16x8 pa = __builtin_bit_cast(bf16x8, pw);
#pragma unroll
        for (int dt = 0; dt < 4; dt++) {
          const u16* vp = Vt + (dt * 16 + fr) * 196 + t2 * 32 + fq * 4;
          const uint2 v0 = *(const uint2*)vp, v1 = *(const uint2*)(vp + 16);
          const bf16x8 vb = __builtin_bit_cast(bf16x8, u32x4{v0.x, v0.y, v1.x, v1.y});
          o[dt] = MFMA16(pa, vb, o[dt]);
        }
        SCHED;
      }
#pragma unroll
      for (int dt = 0; dt < 4; dt++)
#pragma unroll
        for (int j = 0; j < 4; j++)
          p.OATT[(size_t)(gq0 + q0 + fq * 4 + j) * 512 + qh * 64 + dt * 16 + fr] = f2bf(o[dt][j]);
    }
  }
  const u16* SA = (const u16*)(p.out);
  const u16* SB = p.H;
  for (int it4 = bid * NW + wv; it4 < T * 2; it4 += nb * NW) {
    const int it = it4 * 4 + (lane >> 4), c0 = (lane & 15) * 4;
    const int g = it >> 3, h = it & 7, col = h * 64 + c0;
    const uint2 yw = *(const uint2*)(p.Y + (size_t)g * 512 + col);
    const uint2 rw = *(const uint2*)(SA + (size_t)it * 256 + c0), kw = *(const uint2*)(SA + (size_t)it * 256 + 128 + c0);
    const uint2 vw = *(const uint2*)(SB + (size_t)it * 128 + c0), gw = *(const uint2*)(p.G + (size_t)g * 512 + col);
    const float4 lw = *(const float4*)(p.lnx_w + col), lb = *(const float4*)(p.lnx_b + col), rk = *(const float4*)(p.r_k + col);
    const float y0 = bflo(yw.x), y1 = bfhi(yw.x), y2 = bflo(yw.y), y3 = bfhi(yw.y);
    const float mean = red16((y0 + y1) + (y2 + y3)) * (1.f / 64.f);
    const float e0 = y0 - mean, e1 = y1 - mean, e2 = y2 - mean, e3 = y3 - mean;
    const float var = red16((e0 * e0 + e1 * e1) + (e2 * e2 + e3 * e3)) * (1.f / 64.f);
    const float bonus = red16((bflo(rw.x) * bflo(kw.x) * rk.x + bfhi(rw.x) * bfhi(kw.x) * rk.y) +
                              (bflo(rw.y) * bflo(kw.y) * rk.z + bfhi(rw.y) * bfhi(kw.y) * rk.w));
    const float rsd = rsqrtf(var + 64e-5f);
    const float o0 = (e0 * rsd * lw.x + lb.x + bonus * bflo(vw.x)) * bflo(gw.x);
    const float o1 = (e1 * rsd * lw.y + lb.y + bonus * bfhi(vw.x)) * bfhi(gw.x);
    const float o2 = (e2 * rsd * lw.z + lb.z + bonus * bflo(vw.y)) * bflo(gw.y);
    const float o3 = (e3 * rsd * lw.w + lb.w + bonus * bfhi(vw.y)) * bfhi(gw.y);
    if (!dry || o0 == 123.456f) *(uint2*)(p.Y + (size_t)g * 512 + col) = make_uint2(pack2(o0, o1), pack2(o2, o3));
  }
}

__device__ void ph_gemm2(const Params& p, int bid, int nb) {
  const int tid_ = otid();
  u16* MG = p.H;
  const u16* Cs = (const u16*)dsm;
  const int nM = 260, nN = 4;
  for (int round = 0; round * nb < nM * nN; ++round) {
    int pm, pn;
    if (!tile_of(round, bid, nb, nM, nN, pm, pn)) break;
    f32x4 acc[2][2][4][2];
#pragma unroll 1
    for (int br = 0; br < 2; br++) {
      gemm256<512>(br ? p.OATT : p.Y, p.WbT + (size_t)br * 1024 * 512, pm * 256, pn * 256, acc);
      acc_to_lds(acc);
#pragma unroll 2
      for (int it = 0; it < 16; it++) {
        const int id = it * NTH + tid_, rl = id >> 5, c8 = (id & 31) * 8;
        const int row = pm * 256 + rl, col = pn * 256 + c8;
        const u32x4 v = *(const u32x4*)(Cs + rl * CS_LD + c8);
        const u32x4 gw = *(const u32x4*)(p.P + (size_t)row * INC + 2560 + br * 1024 + col);
        u32x4 prev = {0u, 0u, 0u, 0u};
        if (br) prev = *(const u32x4*)(MG + (size_t)row * 1024 + col);
        u32x4 o;
#pragma unroll
        for (int e = 0; e < 4; e++) {
          const float r0 = bflo(prev[e]) + sigmoidf_(bflo(gw[e])) * bflo(v[e]);
          const float r1 = bfhi(prev[e]) + sigmoidf_(bfhi(gw[e])) * bfhi(v[e]);
          o[e] = pack2(r0, r1);
        }
        *(u32x4*)(MG + (size_t)row * 1024 + col) = o;
      }
    }
  }
}

__device__ void ph_gemm3(const Params& p, int bid, int nb) {
  const int tid_ = otid();
  const u16* MG = p.H;
  const u16* Cs = (const u16*)dsm;
  const int nM = 260, nN = 4;
  for (int round = 0; round * nb < nM * nN; ++round) {
    int pm, pn;
    if (!tile_of(round, bid, nb, nM, nN, pm, pn)) break;
    f32x4 acc[2][2][4][2];
    gemm256<1024>(MG, p.WoutT, pm * 256, pn * 256, acc);
    acc_to_lds(acc);
#pragma unroll 2
    for (int it = 0; it < 16; it++) {
      const int id = it * NTH + tid_, rl = id >> 5, c8 = (id & 31) * 8;
      const int row = pm * 256 + rl, col = pn * 256 + c8;
      const u32x4 v = *(const u32x4*)(Cs + rl * CS_LD + c8);
      const float* xr = xrow(p, row) + col;
      const float4 x0 = *(const float4*)xr, x1 = *(const float4*)(xr + 4);
      float* dst = p.out + (size_t)row * 1024 + col;
      *(float4*)dst = make_float4(x0.x + bflo(v[0]), x0.y + bfhi(v[0]), x0.z + bflo(v[1]), x0.w + bfhi(v[1]));
      *(float4*)(dst + 4) = make_float4(x1.x + bflo(v[2]), x1.y + bfhi(v[2]), x1.z + bflo(v[3]), x1.w + bfhi(v[3]));
    }
  }
}

__device__ void ph_norm2(const Params& p, int bid, int nb) {
  const int tid = otid(), lane = tid & 63, wv = tid >> 6;
  for (int row = bid * NW + wv; row < T; row += nb * NW) {
    const float4* x = (const float4*)(p.out + (size_t)row * 1024);
    float4 v[4];
    float ss = 0.f;
#pragma unroll
    for (int i = 0; i < 4; i++) {
      v[i] = x[lane + i * 64];
      ss += v[i].x * v[i].x + v[i].y * v[i].y + v[i].z * v[i].z + v[i].w * v[i].w;
    }
    ss = wave_sum(ss);
    const float rs = rsqrtf(ss * (1.f / 1024.f) + 1e-6f);
    u16* hr = p.H + (size_t)row * 1024;
    float4 y[4];
    float am = 0.f;
#pragma unroll
    for (int i = 0; i < 4; i++) {
      const float4 g = ((const float4*)p.norm2_g)[lane + i * 64];
      y[i] = make_float4(v[i].x * rs * g.x, v[i].y * rs * g.y, v[i].z * rs * g.z, v[i].w * rs * g.w);
      ((uint2*)hr)[lane + i * 64] = make_uint2(pack2(y[i].x, y[i].y), pack2(y[i].z, y[i].w));
      am = fmaxf(am, fmaxf(fmaxf(fabsf(y[i].x), fabsf(y[i].y)), fmaxf(fabsf(y[i].z), fabsf(y[i].w))));
    }
    am = fmaxf(wave_max(am), 1e-30f);
    const float sc = 240.f / am;
    if (lane == 0) p.SH[row] = am * (1.f / 240.f);
    u32* h8 = (u32*)((unsigned char*)p.Y + (size_t)row * 1024);
#pragma unroll
    for (int i = 0; i < 4; i++) h8[lane + i * 64] = q4(y[i].x, y[i].y, y[i].z, y[i].w, sc);
  }
}

DI void ins16(float (&l)[16], float x) {
#pragma unroll
  for (int i = 0; i < 16; i++) {
    const float hi = fmaxf(l[i], x);
    x = fminf(l[i], x);
    l[i] = hi;
  }
}

__device__ void ph_peerq(const Params& p, int bid, int nb) {
  GT_VARS
  const int l31 = lane & 31, kh = lane >> 5;
  u16* Qs = (u16*)dsm;
  unsigned char* lt = (unsigned char*)(dsm + 135168 + wid * 1024);
  int* IDX = (int*)p.G;
  float* GATE = (float*)p.OATT;
  const int nM = 260, nN = 4;
  for (int round = 0; round * nb < nM * nN; ++round) {
    int pm, pn;
    if (!tile_of(round, bid, nb, nM, nN, pm, pn)) break;
    {
      f32x4 acc[2][2][4][2];
      gemm256<1024>(p.H, p.WqT, pm * 256, pn * 256, acc);
      acc_to_lds(acc);
    }
#pragma unroll 1
    for (int hh = 0; hh < 2; hh++) {
      const int hp = pn * 2 + hh;
      float l1[16], l2[16];
#pragma unroll
      for (int i = 0; i < 16; i++) { l1[i] = 0.f; l2[i] = 0.f; }
#pragma unroll 1
      for (int pp = 0; pp < 2; pp++) {
        f32x16 sc[4];
#pragma unroll
        for (int m4 = 0; m4 < 4; m4++) {
#pragma unroll
          for (int i = 0; i < 16; i++) sc[m4][i] = 0.f;
#pragma unroll
          for (int kk = 0; kk < 4; kk++) {
            const bf16x8 a = *(const bf16x8*)(p.SK + (size_t)(pp * 128 + m4 * 32 + l31) * 64 + kk * 16 + kh * 8);
            const bf16x8 bq = *(const bf16x8*)(Qs + (wid * 32 + l31) * 264 + hh * 128 + pp * 64 + kk * 16 + kh * 8);
            sc[m4] = MFMA32(a, bq, sc[m4]);
          }
        }
        float l[16];
#pragma unroll
        for (int i = 0; i < 16; i++) l[i] = -3e38f;
#pragma unroll
        for (int m4 = 0; m4 < 4; m4++)
#pragma unroll
          for (int i = 0; i < 16; i++) {
            const u32 nn = m4 * 32 + (i >> 2) * 8 + kh * 4 + (i & 3);
            ins16(l, __uint_as_float((__float_as_uint(sc[m4][i]) & ~0x7Fu) | nn));
          }
        float o[16];
#pragma unroll
        for (int i = 0; i < 16; i++) o[i] = __shfl_xor(l[i], 32);
#pragma unroll
        for (int i = 0; i < 16; i++) ins16(l, o[i]);
#pragma unroll
        for (int i = 0; i < 16; i++) {
          l1[i] = pp == 0 ? l[i] : l1[i];
          l2[i] = pp == 0 ? l2[i] : l[i];
        }
      }
      if (kh == 0) {
        u32 w[8];
#pragma unroll
        for (int q = 0; q < 4; q++) {
          w[q] = (__float_as_uint(l1[4 * q]) & 0x7F) | ((__float_as_uint(l1[4 * q + 1]) & 0x7F) << 8) |
                 ((__float_as_uint(l1[4 * q + 2]) & 0x7F) << 16) | ((__float_as_uint(l1[4 * q + 3]) & 0x7F) << 24);
          w[4 + q] = (__float_as_uint(l2[4 * q]) & 0x7F) | ((__float_as_uint(l2[4 * q + 1]) & 0x7F) << 8) |
                     ((__float_as_uint(l2[4 * q + 2]) & 0x7F) << 16) | ((__float_as_uint(l2[4 * q + 3]) & 0x7F) << 24);
        }
        *(uint4*)(lt + l31 * 32) = make_uint4(w[0], w[1], w[2], w[3]);
        *(uint4*)(lt + l31 * 32 + 16) = make_uint4(w[4], w[5], w[6], w[7]);
      }
      float l3[16];
#pragma unroll
      for (int i = 0; i < 16; i++) l3[i] = -3e38f;
#pragma unroll
      for (int a = 0; a < 16; a++)
#pragma unroll
        for (int b = 0; b < 16; b++)
          if ((a + 1) * (b + 1) <= 16) {
            const float s = __uint_as_float(__float_as_uint(l1[a]) & ~0x7Fu) + __uint_as_float(__float_as_uint(l2[b]) & ~0x7Fu);
            ins16(l3, __uint_as_float((__float_as_uint(s) & ~0xFFu) | (u32)(a * 16 + b)));
          }
      __builtin_amdgcn_fence(__ATOMIC_RELEASE, "workgroup");
      __builtin_amdgcn_wave_barrier();
      if (kh == 0) {
        const int g = pm * 256 + wid * 32 + l31;
        float ev[16];
        int ei[16];
        float sum = 0.f;
        const float mxv = __uint_as_float(__float_as_uint(l3[0]) & ~0xFFu);
#pragma unroll
        for (int k = 0; k < 16; k++) {
          const u32 bits = __float_as_uint(l3[k]);
          const u32 pos = bits & 0xFF;
          ev[k] = __expf(__uint_as_float(bits & ~0xFFu) - mxv);
          sum += ev[k];
          ei[k] = (int)lt[l31 * 32 + (pos >> 4)] * 128 + (int)lt[l31 * 32 + 16 + (pos & 15)];
        }
        const float inv = 1.f / sum;
        int4* ip = (int4*)(IDX + (size_t)g * 128 + hp * 16);
        float4* gp = (float4*)(GATE + (size_t)g * 128 + hp * 16);
#pragma unroll
        for (int q = 0; q < 4; q++) {
          ip[q] = make_int4(ei[4 * q], ei[4 * q + 1], ei[4 * q + 2], ei[4 * q + 3]);
          gp[q] = make_float4(ev[4 * q] * inv, ev[4 * q + 1] * inv, ev[4 * q + 2] * inv, ev[4 * q + 3] * inv);
        }
      }
      __builtin_amdgcn_wave_barrier();
    }
  }
}

__device__ void ph_peer(const Params& p, int bid, int nb, bool dry = false) {
  const int tid = otid(), lane = tid & 63, wv = tid >> 6;
  char* wb = dsm + wv * 2048;
  unsigned char* hs = (unsigned char*)wb;
  float* acts = (float*)(wb + 1024);
  int* idxs = (int*)(wb + 1536);
  const int* IDX = (const int*)p.G;
  const float* GATE = (const float*)p.OATT;
  const unsigned char* H8 = (const unsigned char*)p.Y;
  const int n = lane & 15, quad = lane >> 4;
  for (int g = bid * NW + wv; g < T; g += nb * NW) {
    *(u32x4*)(hs + lane * 16) = *(const u32x4*)(H8 + (size_t)g * 1024 + lane * 16);
    idxs[lane] = IDX[(size_t)g * 128 + lane];
    idxs[lane + 64] = IDX[(size_t)g * 128 + 64 + lane];
    const float shv = p.SH[g];
    __builtin_amdgcn_fence(__ATOMIC_RELEASE, "workgroup");
    __builtin_amdgcn_wave_barrier();
    {
      u32x4 ring[16];
      {
        const unsigned char* ur = p.U8 + (size_t)idxs[n] * 1024 + quad * 16;
#pragma unroll
        for (int i = 0; i < 16; i++) ring[i] = *(const u32x4*)(ur + i * 64);
      }
#pragma unroll 1
      for (int grp = 0; grp < 8; grp++) {
        const unsigned char* un = p.U8 + (size_t)idxs[(grp < 7 ? grp + 1 : grp) * 16 + n] * 1024 + quad * 16;
        const float4 gt = *(const float4*)(GATE + (size_t)g * 128 + grp * 16 + quad * 4);
        const int4 ee = *(const int4*)(idxs + grp * 16 + quad * 4);
        const float su0 = p.SU[ee.x], su1 = p.SU[ee.y], su2 = p.SU[ee.z], su3 = p.SU[ee.w];
        const float sv0 = p.SV[ee.x], sv1 = p.SV[ee.y], sv2 = p.SV[ee.z], sv3 = p.SV[ee.w];
        f32x4 acc = {0.f, 0.f, 0.f, 0.f};
#pragma unroll
        for (int st = 0; st < 16; st++) {
          const u32x4 ua = ring[st];
          if (grp < 7) ring[st] = *(const u32x4*)(un + st * 64);
          const u32x4 hb = *(const u32x4*)(hs + st * 64 + quad * 16);
          const long a0 = (long)(((unsigned long)ua[1] << 32) | ua[0]);
          const long a1 = (long)(((unsigned long)ua[3] << 32) | ua[2]);
          const long b0 = (long)(((unsigned long)hb[1] << 32) | hb[0]);
          const long b1 = (long)(((unsigned long)hb[3] << 32) | hb[2]);
          acc = __builtin_amdgcn_mfma_f32_16x16x32_fp8_fp8(a0, b0, acc, 0, 0, 0);
          acc = __builtin_amdgcn_mfma_f32_16x16x32_fp8_fp8(a1, b1, acc, 0, 0, 0);
        }
        const float d0 = acc[0] * shv * su0, d1 = acc[1] * shv * su1, d2 = acc[2] * shv * su2, d3 = acc[3] * shv * su3;
        float4 av;
        av.x = 0.5f * d0 * (1.f + erff(d0 * 0.70710678118f)) * gt.x * sv0;
        av.y = 0.5f * d1 * (1.f + erff(d1 * 0.70710678118f)) * gt.y * sv1;
        av.z = 0.5f * d2 * (1.f + erff(d2 * 0.70710678118f)) * gt.z * sv2;
        av.w = 0.5f * d3 * (1.f + erff(d3 * 0.70710678118f)) * gt.w * sv3;
        if (n == 0) *(float4*)(acts + grp * 16 + quad * 4) = av;
      }
    }
    __builtin_amdgcn_fence(__ATOMIC_RELEASE, "workgroup");
    __builtin_amdgcn_wave_barrier();
    float o[16];
#pragma unroll
    for (int j = 0; j < 16; j++) o[j] = 0.f;
    {
      u32x4 ring[16];
#pragma unroll
      for (int k = 0; k < 16; k++) ring[k] = *(const u32x4*)(p.V8 + (size_t)idxs[k] * 1024 + lane * 16);
#pragma unroll 1
      for (int kb = 0; kb < 128; kb += 16) {
        const bool more = kb < 112;
        const int kn = more ? kb + 16 : kb;
#pragma unroll
        for (int j = 0; j < 16; j++) {
          const u32x4 vq = ring[j];
          if (more) ring[j] = *(const u32x4*)(p.V8 + (size_t)idxs[kn + j] * 1024 + lane * 16);
          const float a = acts[kb + j];
#pragma unroll
          for (int q = 0; q < 4; q++) {
            const f32x2 lo = __builtin_amdgcn_cvt_pk_f32_fp8((int)vq[q], false);
            const f32x2 hi = __builtin_amdgcn_cvt_pk_f32_fp8((int)vq[q], true);
            o[4 * q] += a * lo[0]; o[4 * q + 1] += a * lo[1]; o[4 * q + 2] += a * hi[0]; o[4 * q + 3] += a * hi[1];
          }
        }
      }
    }
    float* xr = p.out + (size_t)g * 1024 + lane * 16;
    float4 x[4];
#pragma unroll
    for (int q = 0; q < 4; q++) x[q] = *(const float4*)(xr + q * 4);
    float ss = 0.f;
#pragma unroll
    for (int q = 0; q < 4; q++) {
      x[q].x += o[4 * q]; x[q].y += o[4 * q + 1]; x[q].z += o[4 * q + 2]; x[q].w += o[4 * q + 3];
      ss += x[q].x * x[q].x + x[q].y * x[q].y + x[q].z * x[q].z + x[q].w * x[q].w;
    }
    ss = wave_sum(ss);
    if (dry && ss != 123.456f) continue;
    const float rs = rsqrtf(ss * (1.f / 1024.f) + 1e-6f);
#pragma unroll
    for (int q = 0; q < 4; q++) {
      const float4 gq = *(const float4*)(p.final_g + lane * 16 + q * 4);
      *(float4*)(xr + q * 4) = make_float4(x[q].x * rs * gq.x, x[q].y * rs * gq.y, x[q].z * rs * gq.z, x[q].w * rs * gq.w);
    }
  }
}

__global__ void __launch_bounds__(512) mega_kernel(Params p) {
  cg::grid_group grid = cg::this_grid();
  const int bid = blockIdx.x, nb = gridDim.x;
  if (ON(0)) ph_prep(p, bid, nb);
  grid.sync();
  if (ON(1)) ph_gemm1(p, bid, nb);
  grid.sync();
  if (REP == 1) { ph_gemm1(p, bid, nb); grid.sync(); }
  if (ON(2)) ph_rwprep(p, bid, nb);
  grid.sync();
  if (REP == 2) { ph_rwprep(p, bid, nb); grid.sync(); }
  if (ON(3)) ph_scan(p, bid, nb);
  grid.sync();
  if (REP == 3) { ph_scan(p, bid, nb); grid.sync(); }
  if (REP == 4) { ph_attn(p, bid, nb, true); grid.sync(); }
  if (ON(4)) ph_attn(p, bid, nb);
  grid.sync();
  if (ON(5)) ph_gemm2(p, bid, nb);
  grid.sync();
  if (REP == 5) { ph_gemm2(p, bid, nb); grid.sync(); }
  if (ON(6)) ph_gemm3(p, bid, nb);
  grid.sync();
  if (REP == 6) { ph_gemm3(p, bid, nb); grid.sync(); }
  if (ON(7)) ph_norm2(p, bid, nb);
  grid.sync();
  if (ON(8)) ph_peerq(p, bid, nb);
  grid.sync();
  if (REP == 8) { ph_peerq(p, bid, nb); grid.sync(); }
  if (REP == 9) { ph_peer(p, bid, nb, true); grid.sync(); }
  if (ON(9)) ph_peer(p, bid, nb);
}

extern "C" void kernel_launch(void* const* d_in, const int* in_sizes, int n_in, void* d_out, int out_size, void* d_ws,
                              size_t ws_size, hipStream_t stream) {
  Params p{};
  const float** f = (const float**)&p;
  for (int i = 0; i < 28; i++) f[i] = (const float*)d_in[i];
  p.out = (float*)d_out;
  char* w = (char*)d_ws;
  size_t off = 0;
  auto take = [&](size_t bytes) { char* r = w + off; off += (bytes + 255) & ~(size_t)255; return (u16*)r; };
  p.H = take((size_t)MP * 1024 * 2);
  p.P = take((size_t)MP * INC * 2);
  p.U8 = (unsigned char*)take((size_t)16384 * 1024);
  p.V8 = (unsigned char*)take((size_t)16384 * 1024);
  p.SU = (float*)take(16384 * 4);
  p.SV = (float*)take(16384 * 4);
  p.SH = (float*)take((size_t)T * 4);
  p.WinT = take((size_t)4608 * 1024 * 2);
  p.WbT = take((size_t)2 * 1024 * 512 * 2);
  p.WoutT = take((size_t)1024 * 1024 * 2);
  p.WqT = take((size_t)1024 * 1024 * 2);
  p.W2T = take((size_t)512 * 64 * 2);
  p.A2T = take((size_t)512 * 64 * 2);
  p.G2T = take((size_t)512 * 128 * 2);
  p.SK = take((size_t)2 * 128 * 64 * 2);
  p.Y = take((size_t)T * 512 * 2);
  p.G = take((size_t)T * 512 * 2);
  p.OATT = take((size_t)T * 512 * 2);
  static int grid_blocks = 0;
  if (!grid_blocks) {
    int dev = 0, cus = 0, per_cu = 0;
    (void)hipGetDevice(&dev);
    (void)hipDeviceGetAttribute(&cus, hipDeviceAttributeMultiprocessorCount, dev);
    (void)hipFuncSetAttribute((const void*)mega_kernel, hipFuncAttributeMaxDynamicSharedMemorySize, DYN_LDS);
    (void)hipOccupancyMaxActiveBlocksPerMultiprocessor(&per_cu, mega_kernel, NTH, DYN_LDS);
    if (per_cu > 1) per_cu = 1;
    grid_blocks = cus * per_cu;
  }
  void* args[] = {&p};
  hipError_t e = hipLaunchCooperativeKernel((void*)mega_kernel, dim3(grid_blocks), dim3(NTH), args, DYN_LDS, stream);
  if (e != hipSuccess) fprintf(stderr, "cooperative launch failed: %s (grid %d)\n", hipGetErrorString(e), grid_blocks);
}
```

```cpp
#include <hip/hip_runtime.h>
#include <hip/hip_cooperative_groups.h>
#include <cstdio>
namespace cg = cooperative_groups;

#ifndef REP
#define REP -1
#endif
#ifndef ONLY
#define ONLY -1
#endif
#define ON(k) (ONLY < 0 || ONLY == (k))

typedef unsigned short u16;
typedef unsigned int u32;
using bf16x8 = __attribute__((ext_vector_type(8))) short;
using f32x4 = __attribute__((ext_vector_type(4))) float;
using f32x16 = __attribute__((ext_vector_type(16))) float;
using u32x4 = __attribute__((ext_vector_type(4))) u32;
#define DI __device__ __forceinline__

constexpr int TP = 65536, TS = 1024, T = 66560, MP = 66816;
constexpr int INC = 4608;
constexpr int NW = 8;
constexpr int NTH = 512;
constexpr size_t OFF_Y = 0, OFF_SHIFT_P = 68157440, OFF_WKV_P = 68173824, OFF_KP = 68698112, OFF_VP = 68960256,
                 OFF_SHIFT_S = 69222400, OFF_WKV_S = 69238784, OFF_KS = 69763072, OFF_VS = 69894144;
constexpr int DYN_LDS = 163840;

extern __shared__ __attribute__((aligned(16))) char dsm[];

struct Params {
  const float *x_prompt, *x_sample, *state_shift, *state_wkv, *cache_k, *cache_v, *norm1_g, *w_in, *mu, *w0, *w2, *a0,
      *a2, *g2, *k_k, *k_a, *r_k, *lnx_w, *lnx_b, *sinks, *w_branch, *w_out, *norm2_g, *peer_wq, *sub_keys, *peer_u,
      *peer_v, *final_g;
  float* out;
  u16 *H, *P, *WinT, *WbT, *WoutT, *WqT, *W2T, *A2T, *G2T, *SK, *Y, *G, *OATT;
  unsigned char *U8, *V8;
  float *SU, *SV, *SH;
};

DI u16 f2bf(float x) {
  u32 u = __float_as_uint(x);
  u += 0x7fffu + ((u >> 16) & 1u);
  return (u16)(u >> 16);
}
DI float bf2f(u16 b) { return __uint_as_float(((u32)b) << 16); }
DI u32 pack2(float a, float b) { return (u32)f2bf(a) | ((u32)f2bf(b) << 16); }
DI float bflo(u32 w) { return __uint_as_float(w << 16); }
DI float bfhi(u32 w) { return __uint_as_float(w & 0xffff0000u); }
DI float wave_sum(float v) {
#pragma unroll
  for (int o = 32; o; o >>= 1) v += __shfl_xor(v, o);
  return v;
}
DI float sigmoidf_(float x) { return 1.f / (1.f + __expf(-x)); }
DI const float* xrow(const Params& p, int g) {
  return g < TP ? p.x_prompt + (size_t)g * 1024 : p.x_sample + (size_t)(g - TP) * 1024;
}
DI int otid() { int t = threadIdx.x; asm volatile("" : "+v"(t)); return t; }
#define MFMA32(a, b, c) __builtin_amdgcn_mfma_f32_32x32x16_bf16((a), (b), (c), 0, 0, 0)
#define MFMA16(a, b, c) __builtin_amdgcn_mfma_f32_16x16x32_bf16((a), (b), (c), 0, 0, 0)

template <int CTRL>
DI float dppmov(float v) {
  return __int_as_float(__builtin_amdgcn_update_dpp(0, __float_as_int(v), CTRL, 0xF, 0xF, false));
}
DI float red16(float v) {
  v += dppmov<0x128>(v);
  v += dppmov<0x124>(v);
  v += dppmov<0x122>(v);
  v += dppmov<0x121>(v);
  return v;
}


using f32x2 = __attribute__((ext_vector_type(2))) float;
DI float wave_max(float v) {
#pragma unroll
  for (int o = 32; o; o >>= 1) v = fmaxf(v, __shfl_xor(v, o));
  return v;
}
DI u32 q4(float a, float b, float c, float d, float sc) {
  int w = 0;
  w = __builtin_amdgcn_cvt_pk_fp8_f32(a * sc, b * sc, w, false);
  w = __builtin_amdgcn_cvt_pk_fp8_f32(c * sc, d * sc, w, true);
  return (u32)w;
}

DI void tcvt(const float* __restrict__ W, u16* __restrict__ Wt, int K, int N, int gt, int nt) {
  const int total = N * (K / 8);
  for (int i = gt; i < total; i += nt) {
    const int n = i % N, kg = i / N;
    u32 o[4];
#pragma unroll
    for (int j = 0; j < 4; j++)
      o[j] = pack2(W[(size_t)(kg * 8 + 2 * j) * N + n], W[(size_t)(kg * 8 + 2 * j + 1) * N + n]);
    *(uint4*)(Wt + (size_t)n * K + kg * 8) = make_uint4(o[0], o[1], o[2], o[3]);
  }
}
DI void scvt(const float* __restrict__ W, u16* __restrict__ O, int n8, int gt, int nt) {
  for (int i = gt; i < n8; i += nt) {
    const float4 a = ((const float4*)W)[2 * i], b = ((const float4*)W)[2 * i + 1];
    ((uint4*)O)[i] = make_uint4(pack2(a.x, a.y), pack2(a.z, a.w), pack2(b.x, b.y), pack2(b.z, b.w));
  }
}

__device__ void ph_prep(const Params& p, int bid, int nb) {
  const int tid = otid(), lane = tid & 63, wv = tid >> 6;
  for (int row = bid * NW + wv; row < MP; row += nb * NW) {
    u16* hr = p.H + (size_t)row * 1024;
    if (row < T) {
      const float4* x = (const float4*)xrow(p, row);
      float4 v[4];
      float ss = 0.f;
#pragma unroll
      for (int i = 0; i < 4; i++) {
        v[i] = x[lane + i * 64];
        ss += v[i].x * v[i].x + v[i].y * v[i].y + v[i].z * v[i].z + v[i].w * v[i].w;
      }
      ss = wave_sum(ss);
      const float rs = rsqrtf(ss * (1.f / 1024.f) + 1e-6f);
      float* so = nullptr;
      if (row < TP) {
        if ((row & 4095) == 4095) so = p.out + OFF_SHIFT_P + (size_t)(row >> 12) * 1024;
      } else {
        const int r2 = row - TP;
        if ((r2 & 63) == 63) so = p.out + OFF_SHIFT_S + (size_t)(r2 >> 6) * 1024;
      }
#pragma unroll
      for (int i = 0; i < 4; i++) {
        const float4 g = ((const float4*)p.norm1_g)[lane + i * 64];
        float4 y;
        y.x = v[i].x * rs * g.x; y.y = v[i].y * rs * g.y; y.z = v[i].z * rs * g.z; y.w = v[i].w * rs * g.w;
        ((uint2*)hr)[lane + i * 64] = make_uint2(pack2(y.x, y.y), pack2(y.z, y.w));
        if (so) ((float4*)so)[lane + i * 64] = y;
      }
    } else if (row < T + 16) {
      const float4* x = (const float4*)(p.state_shift + (size_t)(row - T) * 1024);
#pragma unroll
      for (int i = 0; i < 4; i++) {
        const float4 y = x[lane + i * 64];
        ((uint2*)hr)[lane + i * 64] = make_uint2(pack2(y.x, y.y), pack2(y.z, y.w));
      }
    } else {
#pragma unroll
      for (int i = 0; i < 4; i++) ((uint2*)hr)[lane + i * 64] = make_uint2(0u, 0u);
    }
  }
  const int gt = bid * NTH + tid, nt = nb * NTH;
  tcvt(p.w_in, p.WinT, 1024, 4608, gt, nt);
  tcvt(p.w_branch, p.WbT, 512, 1024, gt, nt);
  tcvt(p.w_branch + 512 * 1024, p.WbT + 1024 * 512, 512, 1024, gt, nt);
  tcvt(p.w_out, p.WoutT, 1024, 1024, gt, nt);
  tcvt(p.peer_wq, p.WqT, 1024, 1024, gt, nt);
  tcvt(p.w2, p.W2T, 64, 512, gt, nt);
  tcvt(p.a2, p.A2T, 64, 512, gt, nt);
  tcvt(p.g2, p.G2T, 128, 512, gt, nt);
  scvt(p.sub_keys, p.SK, 2 * 128 * 64 / 8, gt, nt);
  for (int r = bid * NW + wv; r < 32768; r += nb * NW) {
    const bool isv = r >= 16384;
    const int e = r & 16383;
    const float4* src = (const float4*)((isv ? p.peer_v : p.peer_u) + (size_t)e * 1024) + lane * 4;
    const float4 a = src[0], b = src[1], c = src[2], d = src[3];
    float am = fmaxf(fmaxf(fmaxf(fabsf(a.x), fabsf(a.y)), fmaxf(fabsf(a.z), fabsf(a.w))),
                     fmaxf(fmaxf(fabsf(b.x), fabsf(b.y)), fmaxf(fabsf(b.z), fabsf(b.w))));
    am = fmaxf(am, fmaxf(fmaxf(fmaxf(fabsf(c.x), fabsf(c.y)), fmaxf(fabsf(c.z), fabsf(c.w))),
                         fmaxf(fmaxf(fabsf(d.x), fabsf(d.y)), fmaxf(fabsf(d.z), fabsf(d.w)))));
    am = fmaxf(wave_max(am), 1e-30f);
    const float sc = 240.f / am;
    if (lane == 0) (isv ? p.SV : p.SU)[e] = am * (1.f / 240.f);
    *(u32x4*)((isv ? p.V8 : p.U8) + (size_t)e * 1024 + lane * 16) =
        u32x4{q4(a.x, a.y, a.z, a.w, sc), q4(b.x, b.y, b.z, b.w, sc), q4(c.x, c.y, c.z, c.w, sc), q4(d.x, d.y, d.z, d.w, sc)};
  }
}

constexpr int GBK = 64, GHALF = 128, GHT = GHALF * GBK;
DI int lds_byte(int r, int c) {
  const int st = (r >> 4) * 2 + (c >> 5), rr = r & 15, cc = c & 31, ob = rr * 64 + cc * 2;
  return st * 1024 + (ob ^ (((ob >> 9) & 1) << 5));
}
DI void stage_rc(int b, int& R, int& C) {
  const int st = b / 1024, sb = b % 1024, swz = sb ^ (((sb >> 9) & 1) << 5);
  R = (st >> 1) * 16 + swz / 64;
  C = (st & 1) * 32 + (swz % 64) / 2;
}
typedef __attribute__((address_space(3))) unsigned lds_u32;
#define G_SA(b, h) (shm + ((b) * 2 + (h)) * GHT)
#define G_SB(b, h) (shm + (4 + (b) * 2 + (h)) * GHT)
#define G_STAGE(P_, RS, br, kt)                                                                                   \
  do {                                                                                                            \
    const int _so = ((br) * K + (kt) * GBK) * 2;                                                                  \
    __builtin_amdgcn_raw_ptr_buffer_load_lds(RS, (lds_u32*)((char*)(P_) + tb0), 16, ob0, _so, 0, 0);              \
    __builtin_amdgcn_raw_ptr_buffer_load_lds(RS, (lds_u32*)((char*)(P_) + tb0 + 8192), 16, ob1, _so, 0, 0);       \
  } while (0)
#define G_LDA(dst, b, h)                                  \
  _Pragma("unroll") for (int m = 0; m < 4; ++m)           \
  _Pragma("unroll") for (int k = 0; k < 2; ++k)           \
    dst[m][k] = *reinterpret_cast<const bf16x8*>((const char*)G_SA(b, h) + lds_byte(wr * 64 + m * 16 + fr, k * 32 + fq * 8))
#define G_LDB(dst, b, h)                                  \
  _Pragma("unroll") for (int n = 0; n < 2; ++n)           \
  _Pragma("unroll") for (int k = 0; k < 2; ++k)           \
    dst[n][k] = *reinterpret_cast<const bf16x8*>((const char*)G_SB(b, h) + lds_byte(wc * 32 + n * 16 + fr, k * 32 + fq * 8))
#define G_MMA(ai, bj, At_, Bt_)                                                                         \
  do {                                                                                                  \
    __builtin_amdgcn_s_setprio(1);                                                                      \
    _Pragma("unroll") for (int m = 0; m < 4; ++m)                                                       \
    _Pragma("unroll") for (int n = 0; n < 2; ++n)                                                       \
    _Pragma("unroll") for (int k = 0; k < 2; ++k)                                                       \
      acc[ai][bj][m][n] = MFMA16(At_[m][k], Bt_[n][k], acc[ai][bj][m][n]);                              \
    __builtin_amdgcn_s_setprio(0);                                                                      \
  } while (0)
#define WAIT_V(n) asm volatile("s_waitcnt vmcnt(" #n ")" ::: "memory")
#define WAIT_L(n) asm volatile("s_waitcnt lgkmcnt(" #n ")" ::: "memory")
#define BAR __builtin_amdgcn_s_barrier()
#define SCHED __builtin_amdgcn_sched_barrier(0)

template <int K>
DI void gemm256(const u16* __restrict__ A, const u16* __restrict__ Bt, const int brow, const int bcol,
                f32x4 (&acc)[2][2][4][2]) {
  u16* shm = (u16*)dsm;
  const int tid_ = otid();
  const int wid = tid_ >> 6, lane = tid_ & 63, wr = wid >> 2, wc = wid & 3, fr = lane & 15, fq = lane >> 4;
#pragma unroll
  for (int a = 0; a < 2; a++)
#pragma unroll
    for (int b = 0; b < 2; b++)
#pragma unroll
      for (int m = 0; m < 4; m++)
#pragma unroll
        for (int n = 0; n < 2; n++) acc[a][b][m][n] = f32x4{0.f, 0.f, 0.f, 0.f};
  bf16x8 At[4][2], B0[2][2], B1[2][2];
  constexpr int nt = K / GBK;
  const __amdgpu_buffer_rsrc_t rsA = __builtin_amdgcn_make_buffer_rsrc((void*)A, 0, 0x7fffffff, 0x00020000);
  const __amdgpu_buffer_rsrc_t rsB = __builtin_amdgcn_make_buffer_rsrc((void*)Bt, 0, 0x7fffffff, 0x00020000);
  const unsigned tb0 = tid_ * 16;
  int ob0, ob1;
  {
    int r_, c_;
    stage_rc((int)tb0, r_, c_);
    ob0 = (r_ * K + c_) * 2;
    stage_rc((int)tb0 + 8192, r_, c_);
    ob1 = (r_ * K + c_) * 2;
  }
  WAIT_V(0);
  __syncthreads();
  G_STAGE(G_SB(0, 0), rsB, bcol, 0); G_STAGE(G_SA(0, 0), rsA, brow, 0);
  G_STAGE(G_SB(0, 1), rsB, bcol + GHALF, 0); G_STAGE(G_SA(0, 1), rsA, brow + GHALF, 0);
  if (wr == 1) BAR;
  WAIT_V(4); BAR;
  G_STAGE(G_SB(1, 0), rsB, bcol, 1); G_STAGE(G_SA(1, 0), rsA, brow, 1); G_STAGE(G_SB(1, 1), rsB, bcol + GHALF, 1);
  WAIT_V(6); BAR;
  for (int t = 0; t < nt - 2; t += 2) {
    G_LDB(B0, 0, 0); SCHED; G_LDA(At, 0, 0); G_STAGE(G_SA(1, 1), rsA, brow + GHALF, t + 1);
    WAIT_L(8); BAR; WAIT_L(0); G_MMA(0, 0, At, B0); BAR; SCHED;
    G_LDB(B1, 0, 1); G_STAGE(G_SB(0, 0), rsB, bcol, t + 2);
    BAR; WAIT_L(0); G_MMA(0, 1, At, B1); BAR;
    G_LDA(At, 0, 1); G_STAGE(G_SA(0, 0), rsA, brow, t + 2);
    BAR; WAIT_L(0); G_MMA(1, 0, At, B0); BAR; SCHED;
    G_STAGE(G_SB(0, 1), rsB, bcol + GHALF, t + 2);
    WAIT_V(6); BAR; G_MMA(1, 1, At, B1); BAR;
    G_LDB(B0, 1, 0); SCHED; G_LDA(At, 1, 0); G_STAGE(G_SA(0, 1), rsA, brow + GHALF, t + 2);
    WAIT_L(8); BAR; WAIT_L(0); G_MMA(0, 0, At, B0); BAR; SCHED;
    G_LDB(B1, 1, 1); G_STAGE(G_SB(1, 0), rsB, bcol, t + 3);
    BAR; WAIT_L(0); G_MMA(0, 1, At, B1); BAR;
    G_LDA(At, 1, 1); G_STAGE(G_SA(1, 0), rsA, brow, t + 3);
    BAR; WAIT_L(0); G_MMA(1, 0, At, B0); BAR; SCHED;
    G_STAGE(G_SB(1, 1), rsB, bcol + GHALF, t + 3);
    WAIT_V(6); BAR; G_MMA(1, 1, At, B1); BAR;
  }
  {
    G_LDB(B0, 0, 0); G_LDA(At, 0, 0); G_STAGE(G_SA(1, 1), rsA, brow + GHALF, nt - 1);
    BAR; WAIT_L(0); G_MMA(0, 0, At, B0); BAR;
    G_LDB(B1, 0, 1); BAR; WAIT_L(0); G_MMA(0, 1, At, B1); BAR;
    G_LDA(At, 0, 1); WAIT_V(4); BAR; WAIT_L(0); G_MMA(1, 0, At, B0); G_MMA(1, 1, At, B1); BAR;
  }
  {
    G_LDB(B0, 1, 0); G_LDA(At, 1, 0); WAIT_V(2); BAR; WAIT_L(0); G_MMA(0, 0, At, B0); BAR;
    G_LDB(B1, 1, 1); WAIT_V(0); BAR; WAIT_L(0); G_MMA(0, 1, At, B1); BAR;
    G_LDA(At, 1, 1); BAR; WAIT_L(0); G_MMA(1, 0, At, B0); G_MMA(1, 1, At, B1); BAR;
  }
  if (wr == 0) BAR;
}
#define GT_VARS \
  const int tid_ = otid(); const int wid = tid_ >> 6, lane = tid_ & 63, wr = wid >> 2, wc = wid & 3, fr = lane & 15, fq = lane >> 4;
#define GT_ROW(ai, m, j) ((ai) * 128 + wr * 64 + (m) * 16 + fq * 4 + (j))
#define GT_COL(bj, n) ((bj) * 128 + wc * 32 + (n) * 16 + fr)
#define GT_FOR                                       \
  _Pragma("unroll") for (int ai = 0; ai < 2; ++ai)   \
  _Pragma("unroll") for (int bj = 0; bj < 2; ++bj)   \
  _Pragma("unroll") for (int m = 0; m < 4; ++m)      \
  _Pragma("unroll") for (int n = 0; n < 2; ++n)      \
  _Pragma("unroll") for (int j = 0; j < 4; ++j)

DI bool tile_of(int round, int bid, int nb, int nM, int nN, int& pm, int& pn) {
  const int vt = round * nb + (bid & 7) * (nb >> 3) + (bid >> 3);
  if (vt >= nM * nN) return false;
  const int nig = 8 * nN, gid = vt / nig, fm = gid * 8, gsz = min(nM - fm, 8);
  pm = fm + (vt % nig) % gsz;
  pn = (vt % nig) / gsz;
  return true;
}


constexpr int CS_LD = 264;
DI void acc_to_lds(const f32x4 (&acc)[2][2][4][2]) {
  GT_VARS
  u16* Cs = (u16*)dsm;
  __syncthreads();
  GT_FOR { Cs[GT_ROW(ai, m, j) * CS_LD + GT_COL(bj, n)] = f2bf(acc[ai][bj][m][n][j]); }
  __syncthreads();
}

__device__ void ph_gemm1(const Params& p, int bid, int nb) {
  const int tid_ = otid();
  const int nM = 261, nN = 18;
  for (int round = 0; round * nb < nM * nN; ++round) {
    int pm, pn;
    if (!tile_of(round, bid, nb, nM, nN, pm, pn)) break;
    f32x4 acc[2][2][4][2];
    gemm256<1024>(p.H, p.WinT, pm * 256, pn * 256, acc);
    acc_to_lds(acc);
    const u16* Cs = (const u16*)dsm;
#pragma unroll 4
    for (int it = 0; it < 16; it++) {
      const int id = it * NTH + tid_, rl = id >> 5, c8 = (id & 31) * 8;
      const int row = pm * 256 + rl;
      const u32x4 v = *(const u32x4*)(Cs + rl * CS_LD + c8);
      *(u32x4*)(p.P + (size_t)row * INC + pn * 256 + c8) = v;
      if (pn == 9) {
        float* dst = nullptr;
        const int c2 = c8 & 127;
        if (row < TP) {
          const int tt = row & 4095;
          if (tt >= 3968) dst = p.out + (c8 < 128 ? OFF_KP : OFF_VP) + ((size_t)(row >> 12) * 128 + (tt - 3968)) * 128 + c2;
        } else if (row < T) {
          dst = p.out + (c8 < 128 ? OFF_KS : OFF_VS) + (size_t)(row - TP) * 128 + c2;
        }
        if (dst) {
          *(float4*)dst = make_float4(bflo(v[0]), bfhi(v[0]), bflo(v[1]), bfhi(v[1]));
          *(float4*)(dst + 4) = make_float4(bflo(v[2]), bfhi(v[2]), bflo(v[3]), bfhi(v[3]));
        }
      }
    }
  }
}

DI int prev_row(int g) {
  if (g < TP) return (g & 4095) ? g - 1 : -1;
  const int r2 = g - TP;
  return (r2 & 63) ? g - 1 : T + (r2 >> 6);
}

__device__ void ph_rwprep(const Params& p, int bid, int nb) {
  const int tid = otid(), lane = tid & 63, wv = tid >> 6, fr = lane & 15, fq = lane >> 4;
  u16* A1 = (u16*)dsm;
  u16* A2 = A1 + 64 * 80;
  u16* A3 = A2 + 64 * 80;
  u16* SA = (u16*)(p.out);
  u16* SB = p.H;
  const int hd = wv;
  u16* OT = (u16*)(dsm + 38912 + wv * 12288);
  for (int tile = bid; tile < T / 64; tile += nb) {
    const int g0 = tile * 64;
    __syncthreads();
    {
      const int row = tid >> 3, part8 = tid & 7, part = part8 >> 1, sub = part8 & 1;
      const int g = g0 + row, pr = prev_row(g);
      const int cb = 1536 + part * 64 + sub * 32;
      const u16* cur = p.P + (size_t)g * INC + cb;
      const u16* prv = p.P + (size_t)(pr < 0 ? 0 : pr) * INC + cb;
#pragma unroll
      for (int q = 0; q < 4; q++) {
        const u32x4 c4 = *(const u32x4*)(cur + q * 8);
        u32x4 p4 = {0u, 0u, 0u, 0u};
        if (pr >= 0) p4 = *(const u32x4*)(prv + q * 8);
        u32x4 ow;
#pragma unroll
        for (int e = 0; e < 4; e++) {
          const float c0 = bflo(c4[e]), c1 = bfhi(c4[e]), q0 = bflo(p4[e]), q1 = bfhi(p4[e]);
          float f0 = c0 + (q0 - c0) * p.mu[cb + q * 8 + 2 * e];
          float f1 = c1 + (q1 - c1) * p.mu[cb + q * 8 + 2 * e + 1];
          if (part == 0) { f0 = 1.f - 2.f / (1.f + __expf(2.f * f0)); f1 = 1.f - 2.f / (1.f + __expf(2.f * f1)); }
          else if (part >= 2) { f0 = sigmoidf_(f0); f1 = sigmoidf_(f1); }
          ow[e] = pack2(f0, f1);
        }
        u16* dst = part == 0 ? A1 + row * 80 + sub * 32 + q * 8
                 : part == 1 ? A2 + row * 80 + sub * 32 + q * 8
                             : A3 + row * 144 + (part - 2) * 64 + sub * 32 + q * 8;
        *(u32x4*)dst = ow;
      }
    }
    __syncthreads();
#pragma unroll 1
    for (int rg = 0; rg < 4; rg++) {
      f32x4 aw[4], aa[4];
#pragma unroll
      for (int nt = 0; nt < 4; nt++) { aw[nt] = f32x4{0.f, 0.f, 0.f, 0.f}; aa[nt] = f32x4{0.f, 0.f, 0.f, 0.f}; }
#pragma unroll
      for (int ks = 0; ks < 2; ks++) {
        const bf16x8 f1 = *(const bf16x8*)(A1 + (rg * 16 + fr) * 80 + ks * 32 + fq * 8);
        const bf16x8 f2 = *(const bf16x8*)(A2 + (rg * 16 + fr) * 80 + ks * 32 + fq * 8);
#pragma unroll
        for (int nt = 0; nt < 4; nt++) {
          const bf16x8 bw = *(const bf16x8*)(p.W2T + (size_t)(hd * 64 + nt * 16 + fr) * 64 + ks * 32 + fq * 8);
          const bf16x8 ba = *(const bf16x8*)(p.A2T + (size_t)(hd * 64 + nt * 16 + fr) * 64 + ks * 32 + fq * 8);
          aw[nt] = MFMA16(f1, bw, aw[nt]);
          aa[nt] = MFMA16(f2, ba, aa[nt]);
        }
      }
      float ss[4] = {0.f, 0.f, 0.f, 0.f};
      const int rowb = rg * 16 + fq * 4;
      const int gb = g0 + rowb;
      const int pr = (rowb == 0) ? prev_row(gb) : gb - 1;
#pragma unroll
      for (int nt = 0; nt < 4; nt++) {
        const int c = nt * 16 + fr, col = hd * 64 + c;
        const float mu_r = p.mu[col], mu_k = p.mu[512 + col], mu_v = p.mu[1024 + col];
        const float w0c = p.w0[col], a0c = p.a0[col], kkc = p.k_k[col], kac = p.k_a[col];
        float qr = 0.f, qk = 0.f, qv = 0.f;
        if (pr >= 0) {
          const u16* pp = p.P + (size_t)pr * INC + col;
          qr = bf2f(pp[0]); qk = bf2f(pp[512]); qv = bf2f(pp[1024]);
        }
#pragma unroll
        for (int j = 0; j < 4; j++) {
          const int gg = gb + j;
          const u16* pc = p.P + (size_t)gg * INC + col;
          const float cr = bf2f(pc[0]), ck = bf2f(pc[512]), cv = bf2f(pc[1024]);
          const float r = cr + (qr - cr) * mu_r, k = ck + (qk - ck) * mu_k, v = cv + (qv - cv) * mu_v;
          qr = cr; qk = ck; qv = cv;
          const float ed = 0.6065306597126334f * sigmoidf_(w0c + aw[nt][j]);
          const float dm = 1.f - __expf(-ed);
          const float a = sigmoidf_(a0c + aa[nt][j]);
          const float kkv = k * kkc;
          ss[j] += kkv * kkv;
          const float k2 = k * (1.f + (a - 1.f) * kac);
          u16* ot = OT + (fq * 4 + j) * 384 + c;
          ot[0] = f2bf(r);
          ot[64] = f2bf(dm);
          ot[128] = f2bf(k2);
          ot[256] = f2bf(v);
          aw[nt][j] = kkv;
          aa[nt][j] = a;
        }
        SCHED;
      }
#pragma unroll
      for (int j = 0; j < 4; j++) ss[j] = 1.f / fmaxf(sqrtf(red16(ss[j])), 1e-12f);
#pragma unroll
      for (int nt = 0; nt < 4; nt++) {
        const int c = nt * 16 + fr;
#pragma unroll
        for (int j = 0; j < 4; j++) {
          const float kkn = aw[nt][j] * ss[j];
          u16* ot = OT + (fq * 4 + j) * 384 + c;
          ot[192] = f2bf(kkn);
          ot[320] = f2bf(kkn * aa[nt][j]);
        }
      }
      __builtin_amdgcn_fence(__ATOMIC_RELEASE, "workgroup");
      __builtin_amdgcn_wave_barrier();
      {
        const int gr0 = g0 + rg * 16;
#pragma unroll 4
        for (int it = 0; it < 12; it++) {
          const int id = it * 64 + lane, rowi = id / 48, pc = id % 48;
          const u32x4 v4 = *(const u32x4*)(OT + rowi * 384 + pc * 8);
          const size_t gh = (size_t)(gr0 + rowi) * 8 + hd;
          if (pc < 32) *(u32x4*)(SA + gh * 256 + pc * 8) = v4;
          else *(u32x4*)(SB + gh * 128 + (pc - 32) * 8) = v4;
        }
      }
      __builtin_amdgcn_wave_barrier();
      f32x4 ag[4];
#pragma unroll
      for (int nt = 0; nt < 4; nt++) ag[nt] = f32x4{0.f, 0.f, 0.f, 0.f};
#pragma unroll
      for (int ks = 0; ks < 4; ks++) {
        const bf16x8 f3 = *(const bf16x8*)(A3 + (rg * 16 + fr) * 144 + ks * 32 + fq * 8);
#pragma unroll
        for (int nt = 0; nt < 4; nt++) {
          const bf16x8 bg = *(const bf16x8*)(p.G2T + (size_t)(hd * 64 + nt * 16 + fr) * 128 + ks * 32 + fq * 8);
          ag[nt] = MFMA16(f3, bg, ag[nt]);
        }
      }
#pragma unroll
      for (int nt = 0; nt < 4; nt++)
#pragma unroll
        for (int j = 0; j < 4; j++) p.G[(size_t)(gb + j) * 512 + hd * 64 + nt * 16 + fr] = f2bf(ag[nt][j]);
    }
  }
}

DI float red8(float v) {
  v += dppmov<0xB1>(v);
  v += dppmov<0x4E>(v);
  v += dppmov<0x141>(v);
  return v;
}
struct ScanOps { f32x4 r, d, k, n, b; float v; };
DI void scan_ld(ScanOps& o, const float* sb, int j0, int row) {
  o.r = *(const f32x4*)(sb + j0);
  o.d = *(const f32x4*)(sb + 64 + j0);
  o.k = *(const f32x4*)(sb + 128 + j0);
  o.n = *(const f32x4*)(sb + 192 + j0);
  o.b = *(const f32x4*)(sb + 320 + j0);
  o.v = sb[256 + row];
}
#define LO2(x) __builtin_shufflevector((x), (x), 0, 1)
#define HI2(x) __builtin_shufflevector((x), (x), 2, 3)
DI float scan_step(f32x2 (&S)[2], const ScanOps& o) {
  const f32x2 vv = {o.v, o.v};
  const f32x2 tt = S[0] * LO2(o.n) + S[1] * HI2(o.n);
  const f32x2 m0 = S[0] * LO2(o.d) + vv * LO2(o.k);
  const f32x2 m1 = S[1] * HI2(o.d) + vv * HI2(o.k);
  const float sa = -red16(tt[0] + tt[1]);
  const f32x2 sv = {sa, sa};
  S[0] = m0 + sv * LO2(o.b);
  S[1] = m1 + sv * HI2(o.b);
  const f32x2 yy = S[0] * LO2(o.r) + S[1] * HI2(o.r);
  return red16(yy[0] + yy[1]);
}

__device__ void ph_scan(const Params& p, int bid, int nb) {
  const int tid = otid(), lane = tid & 63, wv = tid >> 6;
  float* buf = (float*)dsm;
  const u16* SA = (const u16*)(p.out);
  const u16* SB = p.H;
  constexpr int CH = 32;
  for (int item = bid; item < 512; item += nb) {
    const int type = item >> 8, r_ = item & 255, half = r_ & 1, hb = r_ >> 1, h = hb & 7, b = hb >> 3;
    const int nch = type ? 64 / CH : 4096 / CH;
    const int gbase = type ? TP + b * 64 : b * 4096;
    const bool active = true;
    const int row = half * 32 + wv * 4 + (lane >> 4), j0 = (lane & 15) * 4;
    f32x2 S[2];
#pragma unroll
    for (int j = 0; j < 2; j++) S[j] = f32x2{0.f, 0.f};
    if (type && active) {
      const float* s0 = p.state_wkv + ((size_t)(b * 8 + h) * 64 + row) * 64 + j0;
#pragma unroll
      for (int j = 0; j < 2; j++) S[j] = f32x2{s0[2 * j], s0[2 * j + 1]};
    }
    u32x4 la[2], lb;
    auto gload = [&](int c) {
#pragma unroll
      for (int q = 0; q < 2; q++) {
        const int idx = tid + q * NTH, step = idx >> 5, u = idx & 31;
        la[q] = *(const u32x4*)(SA + ((size_t)(gbase + c * CH + step) * 8 + h) * 256 + u * 8);
      }
      {
        const int step = tid >> 4, u = tid & 15;
        lb = *(const u32x4*)(SB + ((size_t)(gbase + c * CH + step) * 8 + h) * 128 + u * 8);
      }
    };
    gload(0);
    for (int c = 0; c < nch; c++) {
      __syncthreads();
#pragma unroll
      for (int q = 0; q < 2; q++) {
        const int idx = tid + q * NTH, step = idx >> 5, u = idx & 31, arr = u >> 3, c0 = (u & 7) * 8;
        float* d = buf + step * 384 + arr * 64 + c0;
        float f[8];
#pragma unroll
        for (int e = 0; e < 4; e++) { f[2 * e] = bflo(la[q][e]); f[2 * e + 1] = bfhi(la[q][e]); }
        if (arr == 1) {
#pragma unroll
          for (int e = 0; e < 8; e++) f[e] = 1.f - f[e];
        }
        *(float4*)d = make_float4(f[0], f[1], f[2], f[3]);
        *(float4*)(d + 4) = make_float4(f[4], f[5], f[6], f[7]);
      }
      {
        const int step = tid >> 4, u = tid & 15, arr = u >> 3, c0 = (u & 7) * 8;
        float* d = buf + step * 384 + (4 + arr) * 64 + c0;
        *(float4*)d = make_float4(bflo(lb[0]), bfhi(lb[0]), bflo(lb[1]), bfhi(lb[1]));
        *(float4*)(d + 4) = make_float4(bflo(lb[2]), bfhi(lb[2]), bflo(lb[3]), bfhi(lb[3]));
      }
      __syncthreads();
      if (c + 1 < nch) gload(c + 1);
      if (active) {
        ScanOps A0, A1, B0, B1;
        scan_ld(A0, buf, j0, row);
        scan_ld(A1, buf + 384, j0, row);
        float ykeep = 0.f;
#pragma unroll 1
        for (int s = 0; s < CH; s += 4) {
          scan_ld(B0, buf + (s + 2) * 384, j0, row);
          scan_ld(B1, buf + (s + 3) * 384, j0, row);
          SCHED;
          {
            const float y0 = scan_step(S, A0);
            ykeep = ((lane & 15) == (s & 15)) ? y0 : ykeep;
            const float y1 = scan_step(S, A1);
            ykeep = ((lane & 15) == ((s + 1) & 15)) ? y1 : ykeep;
          }
          SCHED;
          const int sn = (s + 4 < CH) ? s + 4 : s;
          scan_ld(A0, buf + sn * 384, j0, row);
          scan_ld(A1, buf + (sn + 1) * 384, j0, row);
          SCHED;
          {
            const float y2 = scan_step(S, B0);
            ykeep = ((lane & 15) == ((s + 2) & 15)) ? y2 : ykeep;
            const float y3 = scan_step(S, B1);
            ykeep = ((lane & 15) == ((s + 3) & 15)) ? y3 : ykeep;
          }
          SCHED;
          if ((s & 15) == 12)
            p.Y[(size_t)(gbase + c * CH + (s - 12) + (lane & 15)) * 512 + h * 64 + row] = f2bf(ykeep);
        }
      }
    }
    if (active) {
      float* so = p.out + (type ? OFF_WKV_S : OFF_WKV_P) + ((size_t)(b * 8 + h) * 64 + row) * 64 + j0;
      *(float4*)so = make_float4(S[0][0], S[0][1], S[1][0], S[1][1]);
    }
  }
}

__device__ void ph_attn(const Params& p, int bid, int nb, bool dry = false) {
  const int tid = otid(), lane = tid & 63, wv = tid >> 6, fr = lane & 15, fq = lane >> 4;
  u16* Ks = (u16*)dsm;
  u16* Vt = Ks + 192 * 72;
  for (int item = bid; item < 2080; item += nb) {
    const int kvh = item & 1, r = item >> 1;
    const bool samp = r >= 1024;
    const int b = samp ? r - 1024 : r >> 6, c = samp ? 0 : (r & 63);
    const int gq0 = samp ? TP + b * 64 : b * 4096 + c * 64;
    __syncthreads();
#pragma unroll
    for (int q = 0; q < 3; q++) {
      const int idx = tid + q * NTH, j = idx >> 3, d0 = (idx & 7) * 8;
      u32x4 kq = {0u, 0u, 0u, 0u}, vq = {0u, 0u, 0u, 0u};
      if (!samp) {
        const int tok = (c - 2) * 64 + j;
        if (tok >= 0) {
          const u16* src = p.P + (size_t)(b * 4096 + tok) * INC + 2304 + kvh * 64 + d0;
          kq = *(const u32x4*)src;
          vq = *(const u32x4*)(src + 128);
        }
      } else if (j < 128) {
        const float4* ck = (const float4*)(p.cache_k + ((size_t)(b * 128 + j) * 2 + kvh) * 64 + d0);
        const float4* cv = (const float4*)(p.cache_v + ((size_t)(b * 128 + j) * 2 + kvh) * 64 + d0);
        const float4 k0 = ck[0], k1 = ck[1], v0 = cv[0], v1 = cv[1];
        kq = u32x4{pack2(k0.x, k0.y), pack2(k0.z, k0.w), pack2(k1.x, k1.y), pack2(k1.z, k1.w)};
        vq = u32x4{pack2(v0.x, v0.y), pack2(v0.z, v0.w), pack2(v1.x, v1.y), pack2(v1.z, v1.w)};
      } else {
        const u16* src = p.P + (size_t)(TP + b * 64 + (j - 128)) * INC + 2304 + kvh * 64 + d0;
        kq = *(const u32x4*)src;
        vq = *(const u32x4*)(src + 128);
      }
      *(u32x4*)(Ks + j * 72 + d0) = kq;
#pragma unroll
      for (int e = 0; e < 4; e++) {
        Vt[(d0 + 2 * e) * 196 + j] = (u16)(vq[e] & 0xffffu);
        Vt[(d0 + 2 * e + 1) * 196 + j] = (u16)(vq[e] >> 16);
      }
    }
    __syncthreads();
    const int qh = kvh * 4 + (wv & 3);
    const float slope = exp2f(-(float)(qh + 1)), sink = p.sinks[qh];
#pragma unroll 1
    for (int ps = 0; ps < 2; ps++) {
      const int q0 = (wv >> 2) * 32 + ps * 16;
      const int tq = q0 + fr;
      const u16* qp = p.P + (size_t)(gq0 + tq) * INC + 1792 + qh * 64 + fq * 8;
      const bf16x8 qf0 = *(const bf16x8*)(qp), qf1 = *(const bf16x8*)(qp + 32);
      f32x4 sc[12];
#pragma unroll
      for (int kt = 0; kt < 12; kt++) {
        sc[kt] = f32x4{0.f, 0.f, 0.f, 0.f};
        const bf16x8 a0 = *(const bf16x8*)(Ks + (kt * 16 + fr) * 72 + fq * 8);
        const bf16x8 a1 = *(const bf16x8*)(Ks + (kt * 16 + fr) * 72 + 32 + fq * 8);
        sc[kt] = MFMA16(a0, qf0, sc[kt]);
        sc[kt] = MFMA16(a1, qf1, sc[kt]);
        if ((kt & 3) == 3) SCHED;
      }
      float mx = -3e38f;
#pragma unroll
      for (int kt = 0; kt < 12; kt++)
#pragma unroll
        for (int j = 0; j < 4; j++) {
          const int key = kt * 16 + fq * 4 + j;
          float s = sc[kt][j] * 0.125f - slope * fabsf((float)(128 + tq - key));
          if (!samp && (c - 2) * 64 + key < 0) s = -1e30f;
          sc[kt][j] = s;
          mx = fmaxf(mx, s);
        }
      mx = fmaxf(mx, __shfl_xor(mx, 16));
      mx = fmaxf(mx, __shfl_xor(mx, 32));
      mx = fmaxf(mx, sink);
      float sum = 0.f;
#pragma unroll
      for (int kt = 0; kt < 12; kt++)
#pragma unroll
        for (int j = 0; j < 4; j++) {
          const float e = __expf(sc[kt][j] - mx);
          sc[kt][j] = e;
          sum += e;
        }
      sum += __shfl_xor(sum, 16);
      sum += __shfl_xor(sum, 32);
      sum += __expf(sink - mx);
      const float inv = 1.f / sum;
      f32x4 o[4];
#pragma unroll
      for (int dt = 0; dt < 4; dt++) o[dt] = f32x4{0.f, 0.f, 0.f, 0.f};
#pragma unroll
      for (int t2 = 0; t2 < 6; t2++) {
        const u32x4 pw = {pack2(sc[2 * t2][0] * inv, sc[2 * t2][1] * inv), pack2(sc[2 * t2][2] * inv, sc[2 * t2][3] * inv),
                          pack2(sc[2 * t2 + 1][0] * inv, sc[2 * t2 + 1][1] * inv),
                          pack2(sc[2 * t2 + 1][2] * inv, sc[2 * t2 + 1][3] * inv)};
        const bf16x8 pa = __builtin_bit_cast(bf16x8, pw);
#pragma unroll
        for (int dt = 0; dt < 4; dt++) {
          const u16* vp = Vt + (dt * 16 + fr) * 196 + t2 * 32 + fq * 4;
          const uint2 v0 = *(const uint2*)vp, v1 = *(const uint2*)(vp + 16);
          const bf16x8 vb = __builtin_bit_cast(bf16x8, u32x4{v0.x, v0.y, v1.x, v1.y});
          o[dt] = MFMA16(pa, vb, o[dt]);
        }
        SCHED;
      }
#pragma unroll
      for (int dt = 0; dt < 4; dt++)
#pragma unroll
        for (int j = 0; j < 4; j++)
          p.OATT[(size_t)(gq0 + q0 + fq * 4 + j) * 512 + qh * 64 + dt * 16 + fr] = f2bf(o[dt][j]);
    }
  }
  const u16* SA = (const u16*)(p.out);
  const u16* SB = p.H;
  for (int it4 = bid * NW + wv; it4 < T * 2; it4 += nb * NW) {
    const int it = it4 * 4 + (lane >> 4), c0 = (lane & 15) * 4;
    const int g = it >> 3, h = it & 7, col = h * 64 + c0;
    const uint2 yw = *(const uint2*)(p.Y + (size_t)g * 512 + col);
    const uint2 rw = *(const uint2*)(SA + (size_t)it * 256 + c0), kw = *(const uint2*)(SA + (size_t)it * 256 + 128 + c0);
    const uint2 vw = *(const uint2*)(SB + (size_t)it * 128 + c0), gw = *(const uint2*)(p.G + (size_t)g * 512 + col);
    const float4 lw = *(const float4*)(p.lnx_w + col), lb = *(const float4*)(p.lnx_b + col), rk = *(const float4*)(p.r_k + col);
    const float y0 = bflo(yw.x), y1 = bfhi(yw.x), y2 = bflo(yw.y), y3 = bfhi(yw.y);
    const float mean = red16((y0 + y1) + (y2 + y3)) * (1.f / 64.f);
    const float e0 = y0 - mean, e1 = y1 - mean, e2 = y2 - mean, e3 = y3 - mean;
    const float var = red16((e0 * e0 + e1 * e1) + (e2 * e2 + e3 * e3)) * (1.f / 64.f);
    const float bonus = red16((bflo(rw.x) * bflo(kw.x) * rk.x + bfhi(rw.x) * bfhi(kw.x) * rk.y) +
                              (bflo(rw.y) * bflo(kw.y) * rk.z + bfhi(rw.y) * bfhi(kw.y) * rk.w));
    const float rsd = rsqrtf(var + 64e-5f);
    const float o0 = (e0 * rsd * lw.x + lb.x + bonus * bflo(vw.x)) * bflo(gw.x);
    const float o1 = (e1 * rsd * lw.y + lb.y + bonus * bfhi(vw.x)) * bfhi(gw.x);
    const float o2 = (e2 * rsd * lw.z + lb.z + bonus * bflo(vw.y)) * bflo(gw.y);
    const float o3 = (e3 * rsd * lw.w + lb.w + bonus * bfhi(vw.y)) * bfhi(gw.y);
    if (!dry || o0 == 123.456f) *(uint2*)(p.Y + (size_t)g * 512 + col) = make_uint2(pack2(o0, o1), pack2(o2, o3));
  }
}

__device__ void ph_gemm2(const Params& p, int bid, int nb) {
  const int tid_ = otid();
  u16* MG = p.H;
  const u16* Cs = (const u16*)dsm;
  const int nM = 260, nN = 4;
  for (int round = 0; round * nb < nM * nN; ++round) {
    int pm, pn;
    if (!tile_of(round, bid, nb, nM, nN, pm, pn)) break;
    f32x4 acc[2][2][4][2];
#pragma unroll 1
    for (int br = 0; br < 2; br++) {
      gemm256<512>(br ? p.OATT : p.Y, p.WbT + (size_t)br * 1024 * 512, pm * 256, pn * 256, acc);
      acc_to_lds(acc);
#pragma unroll 2
      for (int it = 0; it < 16; it++) {
        const int id = it * NTH + tid_, rl = id >> 5, c8 = (id & 31) * 8;
        const int row = pm * 256 + rl, col = pn * 256 + c8;
        const u32x4 v = *(const u32x4*)(Cs + rl * CS_LD + c8);
        const u32x4 gw = *(const u32x4*)(p.P + (size_t)row * INC + 2560 + br * 1024 + col);
        u32x4 prev = {0u, 0u, 0u, 0u};
        if (br) prev = *(const u32x4*)(MG + (size_t)row * 1024 + col);
        u32x4 o;
#pragma unroll
        for (int e = 0; e < 4; e++) {
          const float r0 = bflo(prev[e]) + sigmoidf_(bflo(gw[e])) * bflo(v[e]);
          const float r1 = bfhi(prev[e]) + sigmoidf_(bfhi(gw[e])) * bfhi(v[e]);
          o[e] = pack2(r0, r1);
        }
        *(u32x4*)(MG + (size_t)row * 1024 + col) = o;
      }
    }
  }
}

__device__ void ph_gemm3(const Params& p, int bid, int nb) {
  const int tid_ = otid();
  const u16* MG = p.H;
  const u16* Cs = (const u16*)dsm;
  const int nM = 260, nN = 4;
  for (int round = 0; round * nb < nM * nN; ++round) {
    int pm, pn;
    if (!tile_of(round, bid, nb, nM, nN, pm, pn)) break;
    f32x4 acc[2][2][4][2];
    gemm256<1024>(MG, p.WoutT, pm * 256, pn * 256, acc);
    acc_to_lds(acc);
#pragma unroll 2
    for (int it = 0; it < 16; it++) {
      const int id = it * NTH + tid_, rl = id >> 5, c8 = (id & 31) * 8;
      const int row = pm * 256 + rl, col = pn * 256 + c8;
      const u32x4 v = *(const u32x4*)(Cs + rl * CS_LD + c8);
      const float* xr = xrow(p, row) + col;
      const float4 x0 = *(const float4*)xr, x1 = *(const float4*)(xr + 4);
      float* dst = p.out + (size_t)row * 1024 + col;
      *(float4*)dst = make_float4(x0.x + bflo(v[0]), x0.y + bfhi(v[0]), x0.z + bflo(v[1]), x0.w + bfhi(v[1]));
      *(float4*)(dst + 4) = make_float4(x1.x + bflo(v[2]), x1.y + bfhi(v[2]), x1.z + bflo(v[3]), x1.w + bfhi(v[3]));
    }
  }
}

__device__ void ph_norm2(const Params& p, int bid, int nb) {
  const int tid = otid(), lane = tid & 63, wv = tid >> 6;
  for (int row = bid * NW + wv; row < T; row += nb * NW) {
    const float4* x = (const float4*)(p.out + (size_t)row * 1024);
    float4 v[4];
    float ss = 0.f;
#pragma unroll
    for (int i = 0; i < 4; i++) {
      v[i] = x[lane + i * 64];
      ss += v[i].x * v[i].x + v[i].y * v[i].y + v[i].z * v[i].z + v[i].w * v[i].w;
    }
    ss = wave_sum(ss);
    const float rs = rsqrtf(ss * (1.f / 1024.f) + 1e-6f);
    u16* hr = p.H + (size_t)row * 1024;
    float4 y[4];
    float am = 0.f;
#pragma unroll
    for (int i = 0; i < 4; i++) {
      const float4 g = ((const float4*)p.norm2_g)[lane + i * 64];
      y[i] = make_float4(v[i].x * rs * g.x, v[i].y * rs * g.y, v[i].z * rs * g.z, v[i].w * rs * g.w);
      ((uint2*)hr)[lane + i * 64] = make_uint2(pack2(y[i].x, y[i].y), pack2(y[i].z, y[i].w));
      am = fmaxf(am, fmaxf(fmaxf(fabsf(y[i].x), fabsf(y[i].y)), fmaxf(fabsf(y[i].z), fabsf(y[i].w))));
    }
    am = fmaxf(wave_max(am), 1e-30f);
    const float sc = 240.f / am;
    if (lane == 0) p.SH[row] = am * (1.f / 240.f);
    u32* h8 = (u32*)((unsigned char*)p.Y + (size_t)row * 1024);
#pragma unroll
    for (int i = 0; i < 4; i++) h8[lane + i * 64] = q4(y[i].x, y[i].y, y[i].z, y[i].w, sc);
  }
}

DI void ins16(float (&l)[16], float x) {
#pragma unroll
  for (int i = 0; i < 16; i++) {
    const float hi = fmaxf(l[i], x);
    x = fminf(l[i], x);
    l[i] = hi;
  }
}


DI void ce_desc(float& a, float& b) { const float hi = fmaxf(a, b), lo = fminf(a, b); a = hi; b = lo; }
DI void bitonic_sort16_desc(float (&a)[16]) {
#pragma unroll
  for (int k = 2; k <= 16; k <<= 1)
#pragma unroll
    for (int j = k >> 1; j > 0; j >>= 1)
#pragma unroll
      for (int i = 0; i < 16; i++) {
        const int l = i ^ j;
        if (l > i) {
          if ((i & k) == 0) ce_desc(a[i], a[l]);
          else ce_desc(a[l], a[i]);
        }
      }
}
DI void bitonic_merge16_desc(float (&a)[16]) {
#pragma unroll
  for (int j = 8; j > 0; j >>= 1)
#pragma unroll
    for (int i = 0; i < 16; i++) {
      const int l = i ^ j;
      if (l > i) ce_desc(a[i], a[l]);
    }
}
DI void top16_merge(float (&a)[16], const float (&b)[16]) {
#pragma unroll
  for (int i = 0; i < 16; i++) a[i] = fmaxf(a[i], b[15 - i]);
  bitonic_merge16_desc(a);
}

__device__ void ph_peerq(const Params& p, int bid, int nb) {
  GT_VARS
  const int l31 = lane & 31, kh = lane >> 5;
  u16* Qs = (u16*)dsm;
  unsigned char* lt = (unsigned char*)(dsm + 135168 + wid * 1024);
  int* IDX = (int*)p.G;
  float* GATE = (float*)p.OATT;
  const int nM = 260, nN = 4;
  for (int round = 0; round * nb < nM * nN; ++round) {
    int pm, pn;
    if (!tile_of(round, bid, nb, nM, nN, pm, pn)) break;
    {
      f32x4 acc[2][2][4][2];
      gemm256<1024>(p.H, p.WqT, pm * 256, pn * 256, acc);
      acc_to_lds(acc);
    }
#pragma unroll 1
    for (int hh = 0; hh < 2; hh++) {
      const int hp = pn * 2 + hh;
      float l1[16], l2[16];
#pragma unroll
      for (int i = 0; i < 16; i++) { l1[i] = 0.f; l2[i] = 0.f; }
#pragma unroll 1
      for (int pp = 0; pp < 2; pp++) {
        f32x16 sc[4];
#pragma unroll
        for (int m4 = 0; m4 < 4; m4++) {
#pragma unroll
          for (int i = 0; i < 16; i++) sc[m4][i] = 0.f;
#pragma unroll
          for (int kk = 0; kk < 4; kk++) {
            const bf16x8 a = *(const bf16x8*)(p.SK + (size_t)(pp * 128 + m4 * 32 + l31) * 64 + kk * 16 + kh * 8);
            const bf16x8 bq = *(const bf16x8*)(Qs + (wid * 32 + l31) * 264 + hh * 128 + pp * 64 + kk * 16 + kh * 8);
            sc[m4] = MFMA32(a, bq, sc[m4]);
          }
        }
        float l[16], q1[16], q2[16], q3[16];
#pragma unroll
        for (int i = 0; i < 16; i++) {
          const u32 nb_ = (i >> 2) * 8 + kh * 4 + (i & 3);
          l[i] = __uint_as_float((__float_as_uint(sc[0][i]) & ~0x7Fu) | nb_);
          q1[i] = __uint_as_float((__float_as_uint(sc[1][i]) & ~0x7Fu) | (32u + nb_));
          q2[i] = __uint_as_float((__float_as_uint(sc[2][i]) & ~0x7Fu) | (64u + nb_));
          q3[i] = __uint_as_float((__float_as_uint(sc[3][i]) & ~0x7Fu) | (96u + nb_));
        }
        bitonic_sort16_desc(l);
        bitonic_sort16_desc(q1);
        bitonic_sort16_desc(q2);
        bitonic_sort16_desc(q3);
        top16_merge(l, q1);
        top16_merge(q2, q3);
        top16_merge(l, q2);
        float o[16];
#pragma unroll
        for (int i = 0; i < 16; i++) o[i] = __shfl_xor(l[i], 32);
        top16_merge(l, o);
#pragma unroll
        for (int i = 0; i < 16; i++) {
          l1[i] = pp == 0 ? l[i] : l1[i];
          l2[i] = pp == 0 ? l2[i] : l[i];
        }
      }
      if (kh == 0) {
        u32 w[8];
#pragma unroll
        for (int q = 0; q < 4; q++) {
          w[q] = (__float_as_uint(l1[4 * q]) & 0x7F) | ((__float_as_uint(l1[4 * q + 1]) & 0x7F) << 8) |
                 ((__float_as_uint(l1[4 * q + 2]) & 0x7F) << 16) | ((__float_as_uint(l1[4 * q + 3]) & 0x7F) << 24);
          w[4 + q] = (__float_as_uint(l2[4 * q]) & 0x7F) | ((__float_as_uint(l2[4 * q + 1]) & 0x7F) << 8) |
                     ((__float_as_uint(l2[4 * q + 2]) & 0x7F) << 16) | ((__float_as_uint(l2[4 * q + 3]) & 0x7F) << 24);
        }
        *(uint4*)(lt + l31 * 32) = make_uint4(w[0], w[1], w[2], w[3]);
        *(uint4*)(lt + l31 * 32 + 16) = make_uint4(w[4], w[5], w[6], w[7]);
      }
      float l3[16];
#pragma unroll
      for (int i = 0; i < 16; i++) l3[i] = -3e38f;
#pragma unroll
      for (int a = 0; a < 16; a++)
#pragma unroll
        for (int b = 0; b < 16; b++)
          if ((a + 1) * (b + 1) <= 16) {
            const float s = __uint_as_float(__float_as_uint(l1[a]) & ~0x7Fu) + __uint_as_float(__float_as_uint(l2[b]) & ~0x7Fu);
            ins16(l3, __uint_as_float((__float_as_uint(s) & ~0xFFu) | (u32)(a * 16 + b)));
          }
      __builtin_amdgcn_fence(__ATOMIC_RELEASE, "workgroup");
      __builtin_amdgcn_wave_barrier();
      if (kh == 0) {
        const int g = pm * 256 + wid * 32 + l31;
        float ev[16];
        int ei[16];
        float sum = 0.f;
        const float mxv = __uint_as_float(__float_as_uint(l3[0]) & ~0xFFu);
#pragma unroll
        for (int k = 0; k < 16; k++) {
          const u32 bits = __float_as_uint(l3[k]);
          const u32 pos = bits & 0xFF;
          ev[k] = __expf(__uint_as_float(bits & ~0xFFu) - mxv);
          sum += ev[k];
          ei[k] = (int)lt[l31 * 32 + (pos >> 4)] * 128 + (int)lt[l31 * 32 + 16 + (pos & 15)];
        }
        const float inv = 1.f / sum;
        int4* ip = (int4*)(IDX + (size_t)g * 128 + hp * 16);
        float4* gp = (float4*)(GATE + (size_t)g * 128 + hp * 16);
#pragma unroll
        for (int q = 0; q < 4; q++) {
          ip[q] = make_int4(ei[4 * q], ei[4 * q + 1], ei[4 * q + 2], ei[4 * q + 3]);
          gp[q] = make_float4(ev[4 * q] * inv, ev[4 * q + 1] * inv, ev[4 * q + 2] * inv, ev[4 * q + 3] * inv);
        }
      }
      __builtin_amdgcn_wave_barrier();
    }
  }
}

__device__ void ph_peer(const Params& p, int bid, int nb, bool dry = false) {
  const int tid = otid(), lane = tid & 63, wv = tid >> 6;
  constexpr int ST = 1104;
  char* wb = dsm + wv * (16 * ST + 2048);
  unsigned char* stg = (unsigned char*)wb;
  unsigned char* hs = stg + 16 * ST;
  float* acts = (float*)(hs + 1024);
  int* idxs = (int*)(hs + 1536);
  const int gr = lane >> 3, gc = lane & 7;
  const int* IDX = (const int*)p.G;
  const float* GATE = (const float*)p.OATT;
  const unsigned char* H8 = (const unsigned char*)p.Y;
  const int n = lane & 15, quad = lane >> 4;
  for (int g = bid * NW + wv; g < T; g += nb * NW) {
    *(u32x4*)(hs + lane * 16) = *(const u32x4*)(H8 + (size_t)g * 1024 + lane * 16);
    idxs[lane] = IDX[(size_t)g * 128 + lane];
    idxs[lane + 64] = IDX[(size_t)g * 128 + 64 + lane];
    const float shv = p.SH[g];
    __builtin_amdgcn_fence(__ATOMIC_RELEASE, "workgroup");
    __builtin_amdgcn_wave_barrier();
    {
      u32x4 ring[16];
      {
        const unsigned char* ua = p.U8 + (size_t)idxs[gr] * 1024 + gc * 16;
        const unsigned char* ub = p.U8 + (size_t)idxs[8 + gr] * 1024 + gc * 16;
#pragma unroll
        for (int i = 0; i < 8; i++) { ring[i] = *(const u32x4*)(ua + i * 128); ring[8 + i] = *(const u32x4*)(ub + i * 128); }
      }
#pragma unroll 1
      for (int grp = 0; grp < 8; grp++) {
        const int gn = grp < 7 ? grp + 1 : grp;
        const unsigned char* ua = p.U8 + (size_t)idxs[gn * 16 + gr] * 1024 + gc * 16;
        const unsigned char* ub = p.U8 + (size_t)idxs[gn * 16 + 8 + gr] * 1024 + gc * 16;
        const float4 gt = *(const float4*)(GATE + (size_t)g * 128 + grp * 16 + quad * 4);
        const int4 ee = *(const int4*)(idxs + grp * 16 + quad * 4);
        const float su0 = p.SU[ee.x], su1 = p.SU[ee.y], su2 = p.SU[ee.z], su3 = p.SU[ee.w];
        const float sv0 = p.SV[ee.x], sv1 = p.SV[ee.y], sv2 = p.SV[ee.z], sv3 = p.SV[ee.w];
#pragma unroll
        for (int i = 0; i < 8; i++) {
          *(u32x4*)(stg + gr * ST + i * 128 + gc * 16) = ring[i];
          *(u32x4*)(stg + (8 + gr) * ST + i * 128 + gc * 16) = ring[8 + i];
          if (grp < 7) { ring[i] = *(const u32x4*)(ua + i * 128); ring[8 + i] = *(const u32x4*)(ub + i * 128); }
        }
        __builtin_amdgcn_fence(__ATOMIC_RELEASE, "workgroup");
        __builtin_amdgcn_wave_barrier();
        f32x4 acc = {0.f, 0.f, 0.f, 0.f};
#pragma unroll
        for (int st = 0; st < 16; st++) {
          const u32x4 ua4 = *(const u32x4*)(stg + n * ST + st * 64 + quad * 16);
          const u32x4 hb = *(const u32x4*)(hs + st * 64 + quad * 16);
          const long a0 = (long)(((unsigned long)ua4[1] << 32) | ua4[0]);
          const long a1 = (long)(((unsigned long)ua4[3] << 32) | ua4[2]);
          const long b0 = (long)(((unsigned long)hb[1] << 32) | hb[0]);
          const long b1 = (long)(((unsigned long)hb[3] << 32) | hb[2]);
          acc = __builtin_amdgcn_mfma_f32_16x16x32_fp8_fp8(a0, b0, acc, 0, 0, 0);
          acc = __builtin_amdgcn_mfma_f32_16x16x32_fp8_fp8(a1, b1, acc, 0, 0, 0);
        }
        __builtin_amdgcn_wave_barrier();
        const float d0 = acc[0] * shv * su0, d1 = acc[1] * shv * su1, d2 = acc[2] * shv * su2, d3 = acc[3] * shv * su3;
        float4 av;
        av.x = 0.5f * d0 * (1.f + erff(d0 * 0.70710678118f)) * gt.x * sv0;
        av.y = 0.5f * d1 * (1.f + erff(d1 * 0.70710678118f)) * gt.y * sv1;
        av.z = 0.5f * d2 * (1.f + erff(d2 * 0.70710678118f)) * gt.z * sv2;
        av.w = 0.5f * d3 * (1.f + erff(d3 * 0.70710678118f)) * gt.w * sv3;
        if (n == 0) *(float4*)(acts + grp * 16 + quad * 4) = av;
      }
    }
    __builtin_amdgcn_fence(__ATOMIC_RELEASE, "workgroup");
    __builtin_amdgcn_wave_barrier();
    float o[16];
#pragma unroll
    for (int j = 0; j < 16; j++) o[j] = 0.f;
    {
      u32x4 ring[16];
#pragma unroll
      for (int k = 0; k < 16; k++) ring[k] = *(const u32x4*)(p.V8 + (size_t)idxs[k] * 1024 + lane * 16);
#pragma unroll 1
      for (int kb = 0; kb < 128; kb += 16) {
        const bool more = kb < 112;
        const int kn = more ? kb + 16 : kb;
#pragma unroll
        for (int j = 0; j < 16; j++) {
          const u32x4 vq = ring[j];
          if (more) ring[j] = *(const u32x4*)(p.V8 + (size_t)idxs[kn + j] * 1024 + lane * 16);
          const float a = acts[kb + j];
#pragma unroll
          for (int q = 0; q < 4; q++) {
            const f32x2 lo = __builtin_amdgcn_cvt_pk_f32_fp8((int)vq[q], false);
            const f32x2 hi = __builtin_amdgcn_cvt_pk_f32_fp8((int)vq[q], true);
            o[4 * q] += a * lo[0]; o[4 * q + 1] += a * lo[1]; o[4 * q + 2] += a * hi[0]; o[4 * q + 3] += a * hi[1];
          }
        }
      }
    }
    float* xr = p.out + (size_t)g * 1024 + lane * 16;
    float4 x[4];
#pragma unroll
    for (int q = 0; q < 4; q++) x[q] = *(const float4*)(xr + q * 4);
    float ss = 0.f;
#pragma unroll
    for (int q = 0; q < 4; q++) {
      x[q].x += o[4 * q]; x[q].y += o[4 * q + 1]; x[q].z += o[4 * q + 2]; x[q].w += o[4 * q + 3];
      ss += x[q].x * x[q].x + x[q].y * x[q].y + x[q].z * x[q].z + x[q].w * x[q].w;
    }
    ss = wave_sum(ss);
    if (dry && ss != 123.456f) continue;
    const float rs = rsqrtf(ss * (1.f / 1024.f) + 1e-6f);
#pragma unroll
    for (int q = 0; q < 4; q++) {
      const float4 gq = *(const float4*)(p.final_g + lane * 16 + q * 4);
      *(float4*)(xr + q * 4) = make_float4(x[q].x * rs * gq.x, x[q].y * rs * gq.y, x[q].z * rs * gq.z, x[q].w * rs * gq.w);
    }
  }
}

__global__ void __launch_bounds__(512) mega_kernel(Params p) {
  cg::grid_group grid = cg::this_grid();
  const int bid = blockIdx.x, nb = gridDim.x;
  if (ON(0)) ph_prep(p, bid, nb);
  grid.sync();
  if (ON(1)) ph_gemm1(p, bid, nb);
  grid.sync();
  if (REP == 1) { ph_gemm1(p, bid, nb); grid.sync(); }
  if (ON(2)) ph_rwprep(p, bid, nb);
  grid.sync();
  if (REP == 2) { ph_rwprep(p, bid, nb); grid.sync(); }
  if (ON(3)) ph_scan(p, bid, nb);
  grid.sync();
  if (REP == 3) { ph_scan(p, bid, nb); grid.sync(); }
  if (REP == 4) { ph_attn(p, bid, nb, true); grid.sync(); }
  if (ON(4)) ph_attn(p, bid, nb);
  grid.sync();
  if (ON(5)) ph_gemm2(p, bid, nb);
  grid.sync();
  if (REP == 5) { ph_gemm2(p, bid, nb); grid.sync(); }
  if (ON(6)) ph_gemm3(p, bid, nb);
  grid.sync();
  if (REP == 6) { ph_gemm3(p, bid, nb); grid.sync(); }
  if (ON(7)) ph_norm2(p, bid, nb);
  grid.sync();
  if (ON(8)) ph_peerq(p, bid, nb);
  grid.sync();
  if (REP == 8) { ph_peerq(p, bid, nb); grid.sync(); }
  if (REP == 9) { ph_peer(p, bid, nb, true); grid.sync(); }
  if (ON(9)) ph_peer(p, bid, nb);
}

extern "C" void kernel_launch(void* const* d_in, const int* in_sizes, int n_in, void* d_out, int out_size, void* d_ws,
                              size_t ws_size, hipStream_t stream) {
  Params p{};
  const float** f = (const float**)&p;
  for (int i = 0; i < 28; i++) f[i] = (const float*)d_in[i];
  p.out = (float*)d_out;
  char* w = (char*)d_ws;
  size_t off = 0;
  auto take = [&](size_t bytes) { char* r = w + off; off += (bytes + 255) & ~(size_t)255; return (u16*)r; };
  p.H = take((size_t)MP * 1024 * 2);
  p.P = take((size_t)MP * INC * 2);
  p.U8 = (unsigned char*)take((size_t)16384 * 1024);
  p.V8 = (unsigned char*)take((size_t)16384 * 1024);
  p.SU = (float*)take(16384 * 4);
  p.SV = (float*)take(16384 * 4);
  p.SH = (float*)take((size_t)T * 4);
  p.WinT = take((size_t)4608 * 1024 * 2);
  p.WbT = take((size_t)2 * 1024 * 512 * 2);
  p.WoutT = take((size_t)1024 * 1024 * 2);
  p.WqT = take((size_t)1024 * 1024 * 2);
  p.W2T = take((size_t)512 * 64 * 2);
  p.A2T = take((size_t)512 * 64 * 2);
  p.G2T = take((size_t)512 * 128 * 2);
  p.SK = take((size_t)2 * 128 * 64 * 2);
  p.Y = take((size_t)T * 512 * 2);
  p.G = take((size_t)T * 512 * 2);
  p.OATT = take((size_t)T * 512 * 2);
  static int grid_blocks = 0;
  if (!grid_blocks) {
    int dev = 0, cus = 0, per_cu = 0;
    (void)hipGetDevice(&dev);
    (void)hipDeviceGetAttribute(&cus, hipDeviceAttributeMultiprocessorCount, dev);
    (void)hipFuncSetAttribute((const void*)mega_kernel, hipFuncAttributeMaxDynamicSharedMemorySize, DYN_LDS);
    (void)hipOccupancyMaxActiveBlocksPerMultiprocessor(&per_cu, mega_kernel, NTH, DYN_LDS);
    if (per_cu > 1) per_cu = 1;
    grid_blocks = cus * per_cu;
  }
  void* args[] = {&p};
  hipError_t e = hipLaunchCooperativeKernel((void*)mega_kernel, dim3(grid_blocks), dim3(NTH), args, DYN_LDS, stream);
  if (e != hipSuccess) fprintf(stderr, "cooperative launch failed: %s (grid %d)\n", hipGetErrorString(e), grid_blocks);
}
```

```cpp
#include <hip/hip_runtime.h>
#include <hip/hip_cooperative_groups.h>
#include <cstdio>
namespace cg = cooperative_groups;

#ifndef REP
#define REP -1
#endif
#ifndef ONLY
#define ONLY -1
#endif
#define ON(k) (ONLY < 0 || ONLY == (k))

typedef unsigned short u16;
typedef unsigned int u32;
using bf16x8 = __attribute__((ext_vector_type(8))) short;
using f32x4 = __attribute__((ext_vector_type(4))) float;
using f32x16 = __attribute__((ext_vector_type(16))) float;
using u32x4 = __attribute__((ext_vector_type(4))) u32;
#define DI __device__ __forceinline__

constexpr int TP = 65536, TS = 1024, T = 66560, MP = 66816;
constexpr int INC = 4608;
constexpr int NW = 8;
constexpr int NTH = 512;
constexpr size_t OFF_Y = 0, OFF_SHIFT_P = 68157440, OFF_WKV_P = 68173824, OFF_KP = 68698112, OFF_VP = 68960256,
                 OFF_SHIFT_S = 69222400, OFF_WKV_S = 69238784, OFF_KS = 69763072, OFF_VS = 69894144;
constexpr int DYN_LDS = 163840;

extern __shared__ __attribute__((aligned(16))) char dsm[];

struct Params {
  const float *x_prompt, *x_sample, *state_shift, *state_wkv, *cache_k, *cache_v, *norm1_g, *w_in, *mu, *w0, *w2, *a0,
      *a2, *g2, *k_k, *k_a, *r_k, *lnx_w, *lnx_b, *sinks, *w_branch, *w_out, *norm2_g, *peer_wq, *sub_keys, *peer_u,
      *peer_v, *final_g;
  float* out;
  u16 *H, *P, *WinT, *WbT, *WoutT, *WqT, *W2T, *A2T, *G2T, *SK, *Y, *G, *OATT;
  unsigned char *U8, *V8;
  float *SU, *SV, *SH;
};

DI u16 f2bf(float x) {
  u32 u = __float_as_uint(x);
  u += 0x7fffu + ((u >> 16) & 1u);
  return (u16)(u >> 16);
}
DI float bf2f(u16 b) { return __uint_as_float(((u32)b) << 16); }
DI u32 pack2(float a, float b) { return (u32)f2bf(a) | ((u32)f2bf(b) << 16); }
DI float bflo(u32 w) { return __uint_as_float(w << 16); }
DI float bfhi(u32 w) { return __uint_as_float(w & 0xffff0000u); }
DI float wave_sum(float v) {
#pragma unroll
  for (int o = 32; o; o >>= 1) v += __shfl_xor(v, o);
  return v;
}
DI float sigmoidf_(float x) { return 1.f / (1.f + __expf(-x)); }
DI const float* xrow(const Params& p, int g) {
  return g < TP ? p.x_prompt + (size_t)g * 1024 : p.x_sample + (size_t)(g - TP) * 1024;
}
DI int otid() { int t = threadIdx.x; asm volatile("" : "+v"(t)); return t; }
#define MFMA32(a, b, c) __builtin_amdgcn_mfma_f32_32x32x16_bf16((a), (b), (c), 0, 0, 0)
#define MFMA16(a, b, c) __builtin_amdgcn_mfma_f32_16x16x32_bf16((a), (b), (c), 0, 0, 0)

template <int CTRL>
DI float dppmov(float v) {
  return __int_as_float(__builtin_amdgcn_update_dpp(0, __float_as_int(v), CTRL, 0xF, 0xF, false));
}
DI float red16(float v) {
  v += dppmov<0x128>(v);
  v += dppmov<0x124>(v);
  v += dppmov<0x122>(v);
  v += dppmov<0x121>(v);
  return v;
}


using f32x2 = __attribute__((ext_vector_type(2))) float;
DI float wave_max(float v) {
#pragma unroll
  for (int o = 32; o; o >>= 1) v = fmaxf(v, __shfl_xor(v, o));
  return v;
}
DI u32 q4(float a, float b, float c, float d, float sc) {
  int w = 0;
  w = __builtin_amdgcn_cvt_pk_fp8_f32(a * sc, b * sc, w, false);
  w = __builtin_amdgcn_cvt_pk_fp8_f32(c * sc, d * sc, w, true);
  return (u32)w;
}

DI void tcvt(const float* __restrict__ W, u16* __restrict__ Wt, int K, int N, int gt, int nt) {
  const int total = N * (K / 8);
  for (int i = gt; i < total; i += nt) {
    const int n = i % N, kg = i / N;
    u32 o[4];
#pragma unroll
    for (int j = 0; j < 4; j++)
      o[j] = pack2(W[(size_t)(kg * 8 + 2 * j) * N + n], W[(size_t)(kg * 8 + 2 * j + 1) * N + n]);
    *(uint4*)(Wt + (size_t)n * K + kg * 8) = make_uint4(o[0], o[1], o[2], o[3]);
  }
}
DI void scvt(const float* __restrict__ W, u16* __restrict__ O, int n8, int gt, int nt) {
  for (int i = gt; i < n8; i += nt) {
    const float4 a = ((const float4*)W)[2 * i], b = ((const float4*)W)[2 * i + 1];
    ((uint4*)O)[i] = make_uint4(pack2(a.x, a.y), pack2(a.z, a.w), pack2(b.x, b.y), pack2(b.z, b.w));
  }
}

__device__ void ph_prep(const Params& p, int bid, int nb) {
  const int tid = otid(), lane = tid & 63, wv = tid >> 6;
  for (int row = bid * NW + wv; row < MP; row += nb * NW) {
    u16* hr = p.H + (size_t)row * 1024;
    if (row < T) {
      const float4* x = (const float4*)xrow(p, row);
      float4 v[4];
      float ss = 0.f;
#pragma unroll
      for (int i = 0; i < 4; i++) {
        v[i] = x[lane + i * 64];
        ss += v[i].x * v[i].x + v[i].y * v[i].y + v[i].z * v[i].z + v[i].w * v[i].w;
      }
      ss = wave_sum(ss);
      const float rs = rsqrtf(ss * (1.f / 1024.f) + 1e-6f);
      float* so = nullptr;
      if (row < TP) {
        if ((row & 4095) == 4095) so = p.out + OFF_SHIFT_P + (size_t)(row >> 12) * 1024;
      } else {
        const int r2 = row - TP;
        if ((r2 & 63) == 63) so = p.out + OFF_SHIFT_S + (size_t)(r2 >> 6) * 1024;
      }
#pragma unroll
      for (int i = 0; i < 4; i++) {
        const float4 g = ((const float4*)p.norm1_g)[lane + i * 64];
        float4 y;
        y.x = v[i].x * rs * g.x; y.y = v[i].y * rs * g.y; y.z = v[i].z * rs * g.z; y.w = v[i].w * rs * g.w;
        ((uint2*)hr)[lane + i * 64] = make_uint2(pack2(y.x, y.y), pack2(y.z, y.w));
        if (so) ((float4*)so)[lane + i * 64] = y;
      }
    } else if (row < T + 16) {
      const float4* x = (const float4*)(p.state_shift + (size_t)(row - T) * 1024);
#pragma unroll
      for (int i = 0; i < 4; i++) {
        const float4 y = x[lane + i * 64];
        ((uint2*)hr)[lane + i * 64] = make_uint2(pack2(y.x, y.y), pack2(y.z, y.w));
      }
    } else {
#pragma unroll
      for (int i = 0; i < 4; i++) ((uint2*)hr)[lane + i * 64] = make_uint2(0u, 0u);
    }
  }
  const int gt = bid * NTH + tid, nt = nb * NTH;
  tcvt(p.w_in, p.WinT, 1024, 4608, gt, nt);
  tcvt(p.w_branch, p.WbT, 512, 1024, gt, nt);
  tcvt(p.w_branch + 512 * 1024, p.WbT + 1024 * 512, 512, 1024, gt, nt);
  tcvt(p.w_out, p.WoutT, 1024, 1024, gt, nt);
  tcvt(p.peer_wq, p.WqT, 1024, 1024, gt, nt);
  tcvt(p.w2, p.W2T, 64, 512, gt, nt);
  tcvt(p.a2, p.A2T, 64, 512, gt, nt);
  tcvt(p.g2, p.G2T, 128, 512, gt, nt);
  scvt(p.sub_keys, p.SK, 2 * 128 * 64 / 8, gt, nt);
  for (int r = bid * NW + wv; r < 32768; r += nb * NW) {
    const bool isv = r >= 16384;
    const int e = r & 16383;
    const float4* src = (const float4*)((isv ? p.peer_v : p.peer_u) + (size_t)e * 1024) + lane * 4;
    const float4 a = src[0], b = src[1], c = src[2], d = src[3];
    float am = fmaxf(fmaxf(fmaxf(fabsf(a.x), fabsf(a.y)), fmaxf(fabsf(a.z), fabsf(a.w))),
                     fmaxf(fmaxf(fabsf(b.x), fabsf(b.y)), fmaxf(fabsf(b.z), fabsf(b.w))));
    am = fmaxf(am, fmaxf(fmaxf(fmaxf(fabsf(c.x), fabsf(c.y)), fmaxf(fabsf(c.z), fabsf(c.w))),
                         fmaxf(fmaxf(fabsf(d.x), fabsf(d.y)), fmaxf(fabsf(d.z), fabsf(d.w)))));
    am = fmaxf(wave_max(am), 1e-30f);
    const float sc = 240.f / am;
    if (lane == 0) (isv ? p.SV : p.SU)[e] = am * (1.f / 240.f);
    *(u32x4*)((isv ? p.V8 : p.U8) + (size_t)e * 1024 + lane * 16) =
        u32x4{q4(a.x, a.y, a.z, a.w, sc), q4(b.x, b.y, b.z, b.w, sc), q4(c.x, c.y, c.z, c.w, sc), q4(d.x, d.y, d.z, d.w, sc)};
  }
}

constexpr int GBK = 64, GHALF = 128, GHT = GHALF * GBK;
DI int lds_byte(int r, int c) {
  const int st = (r >> 4) * 2 + (c >> 5), rr = r & 15, cc = c & 31, ob = rr * 64 + cc * 2;
  return st * 1024 + (ob ^ (((ob >> 9) & 1) << 5));
}
DI void stage_rc(int b, int& R, int& C) {
  const int st = b / 1024, sb = b % 1024, swz = sb ^ (((sb >> 9) & 1) << 5);
  R = (st >> 1) * 16 + swz / 64;
  C = (st & 1) * 32 + (swz % 64) / 2;
}
typedef __attribute__((address_space(3))) unsigned lds_u32;
#define G_SA(b, h) (shm + ((b) * 2 + (h)) * GHT)
#define G_SB(b, h) (shm + (4 + (b) * 2 + (h)) * GHT)
#define G_STAGE(P_, RS, br, kt)                                                                                   \
  do {                                                                                                            \
    const int _so = ((br) * K + (kt) * GBK) * 2;                                                                  \
    __builtin_amdgcn_raw_ptr_buffer_load_lds(RS, (lds_u32*)((char*)(P_) + tb0), 16, ob0, _so, 0, 0);              \
    __builtin_amdgcn_raw_ptr_buffer_load_lds(RS, (lds_u32*)((char*)(P_) + tb0 + 8192), 16, ob1, _so, 0, 0);       \
  } while (0)
#define G_LDA(dst, b, h)                                  \
  _Pragma("unroll") for (int m = 0; m < 4; ++m)           \
  _Pragma("unroll") for (int k = 0; k < 2; ++k)           \
    dst[m][k] = *reinterpret_cast<const bf16x8*>((const char*)G_SA(b, h) + lds_byte(wr * 64 + m * 16 + fr, k * 32 + fq * 8))
#define G_LDB(dst, b, h)                                  \
  _Pragma("unroll") for (int n = 0; n < 2; ++n)           \
  _Pragma("unroll") for (int k = 0; k < 2; ++k)           \
    dst[n][k] = *reinterpret_cast<const bf16x8*>((const char*)G_SB(b, h) + lds_byte(wc * 32 + n * 16 + fr, k * 32 + fq * 8))
#define G_MMA(ai, bj, At_, Bt_)                                                                         \
  do {                                                                                                  \
    __builtin_amdgcn_s_setprio(1);                                                                      \
    _Pragma("unroll") for (int m = 0; m < 4; ++m)                                                       \
    _Pragma("unroll") for (int n = 0; n < 2; ++n)                                                       \
    _Pragma("unroll") for (int k = 0; k < 2; ++k)                                                       \
      acc[ai][bj][m][n] = MFMA16(At_[m][k], Bt_[n][k], acc[ai][bj][m][n]);                              \
    __builtin_amdgcn_s_setprio(0);                                                                      \
  } while (0)
#define WAIT_V(n) asm volatile("s_waitcnt vmcnt(" #n ")" ::: "memory")
#define WAIT_L(n) asm volatile("s_waitcnt lgkmcnt(" #n ")" ::: "memory")
#define BAR __builtin_amdgcn_s_barrier()
#define SCHED __builtin_amdgcn_sched_barrier(0)

template <int K>
DI void gemm256(const u16* __restrict__ A, const u16* __restrict__ Bt, const int brow, const int bcol,
                f32x4 (&acc)[2][2][4][2]) {
  u16* shm = (u16*)dsm;
  const int tid_ = otid();
  const int wid = tid_ >> 6, lane = tid_ & 63, wr = wid >> 2, wc = wid & 3, fr = lane & 15, fq = lane >> 4;
#pragma unroll
  for (int a = 0; a < 2; a++)
#pragma unroll
    for (int b = 0; b < 2; b++)
#pragma unroll
      for (int m = 0; m < 4; m++)
#pragma unroll
        for (int n = 0; n < 2; n++) acc[a][b][m][n] = f32x4{0.f, 0.f, 0.f, 0.f};
  bf16x8 At[4][2], B0[2][2], B1[2][2];
  constexpr int nt = K / GBK;
  const __amdgpu_buffer_rsrc_t rsA = __builtin_amdgcn_make_buffer_rsrc((void*)A, 0, 0x7fffffff, 0x00020000);
  const __amdgpu_buffer_rsrc_t rsB = __builtin_amdgcn_make_buffer_rsrc((void*)Bt, 0, 0x7fffffff, 0x00020000);
  const unsigned tb0 = tid_ * 16;
  int ob0, ob1;
  {
    int r_, c_;
    stage_rc((int)tb0, r_, c_);
    ob0 = (r_ * K + c_) * 2;
    stage_rc((int)tb0 + 8192, r_, c_);
    ob1 = (r_ * K + c_) * 2;
  }
  WAIT_V(0);
  __syncthreads();
  G_STAGE(G_SB(0, 0), rsB, bcol, 0); G_STAGE(G_SA(0, 0), rsA, brow, 0);
  G_STAGE(G_SB(0, 1), rsB, bcol + GHALF, 0); G_STAGE(G_SA(0, 1), rsA, brow + GHALF, 0);
  if (wr == 1) BAR;
  WAIT_V(4); BAR;
  G_STAGE(G_SB(1, 0), rsB, bcol, 1); G_STAGE(G_SA(1, 0), rsA, brow, 1); G_STAGE(G_SB(1, 1), rsB, bcol + GHALF, 1);
  WAIT_V(6); BAR;
  for (int t = 0; t < nt - 2; t += 2) {
    G_LDB(B0, 0, 0); SCHED; G_LDA(At, 0, 0); G_STAGE(G_SA(1, 1), rsA, brow + GHALF, t + 1);
    WAIT_L(8); BAR; WAIT_L(0); G_MMA(0, 0, At, B0); BAR; SCHED;
    G_LDB(B1, 0, 1); G_STAGE(G_SB(0, 0), rsB, bcol, t + 2);
    BAR; WAIT_L(0); G_MMA(0, 1, At, B1); BAR;
    G_LDA(At, 0, 1); G_STAGE(G_SA(0, 0), rsA, brow, t + 2);
    BAR; WAIT_L(0); G_MMA(1, 0, At, B0); BAR; SCHED;
    G_STAGE(G_SB(0, 1), rsB, bcol + GHALF, t + 2);
    WAIT_V(6); BAR; G_MMA(1, 1, At, B1); BAR;
    G_LDB(B0, 1, 0); SCHED; G_LDA(At, 1, 0); G_STAGE(G_SA(0, 1), rsA, brow + GHALF, t + 2);
    WAIT_L(8); BAR; WAIT_L(0); G_MMA(0, 0, At, B0); BAR; SCHED;
    G_LDB(B1, 1, 1); G_STAGE(G_SB(1, 0), rsB, bcol, t + 3);
    BAR; WAIT_L(0); G_MMA(0, 1, At, B1); BAR;
    G_LDA(At, 1, 1); G_STAGE(G_SA(1, 0), rsA, brow, t + 3);
    BAR; WAIT_L(0); G_MMA(1, 0, At, B0); BAR; SCHED;
    G_STAGE(G_SB(1, 1), rsB, bcol + GHALF, t + 3);
    WAIT_V(6); BAR; G_MMA(1, 1, At, B1); BAR;
  }
  {
    G_LDB(B0, 0, 0); G_LDA(At, 0, 0); G_STAGE(G_SA(1, 1), rsA, brow + GHALF, nt - 1);
    BAR; WAIT_L(0); G_MMA(0, 0, At, B0); BAR;
    G_LDB(B1, 0, 1); BAR; WAIT_L(0); G_MMA(0, 1, At, B1); BAR;
    G_LDA(At, 0, 1); WAIT_V(4); BAR; WAIT_L(0); G_MMA(1, 0, At, B0); G_MMA(1, 1, At, B1); BAR;
  }
  {
    G_LDB(B0, 1, 0); G_LDA(At, 1, 0); WAIT_V(2); BAR; WAIT_L(0); G_MMA(0, 0, At, B0); BAR;
    G_LDB(B1, 1, 1); WAIT_V(0); BAR; WAIT_L(0); G_MMA(0, 1, At, B1); BAR;
    G_LDA(At, 1, 1); BAR; WAIT_L(0); G_MMA(1, 0, At, B0); G_MMA(1, 1, At, B1); BAR;
  }
  if (wr == 0) BAR;
}
#define GT_VARS \
  const int tid_ = otid(); const int wid = tid_ >> 6, lane = tid_ & 63, wr = wid >> 2, wc = wid & 3, fr = lane & 15, fq = lane >> 4;
#define GT_ROW(ai, m, j) ((ai) * 128 + wr * 64 + (m) * 16 + fq * 4 + (j))
#define GT_COL(bj, n) ((bj) * 128 + wc * 32 + (n) * 16 + fr)
#define GT_FOR                                       \
  _Pragma("unroll") for (int ai = 0; ai < 2; ++ai)   \
  _Pragma("unroll") for (int bj = 0; bj < 2; ++bj)   \
  _Pragma("unroll") for (int m = 0; m < 4; ++m)      \
  _Pragma("unroll") for (int n = 0; n < 2; ++n)      \
  _Pragma("unroll") for (int j = 0; j < 4; ++j)

DI bool tile_of(int round, int bid, int nb, int nM, int nN, int& pm, int& pn) {
  const int vt = round * nb + (bid & 7) * (nb >> 3) + (bid >> 3);
  if (vt >= nM * nN) return false;
  const int nig = 8 * nN, gid = vt / nig, fm = gid * 8, gsz = min(nM - fm, 8);
  pm = fm + (vt % nig) % gsz;
  pn = (vt % nig) / gsz;
  return true;
}


constexpr int CS_LD = 264;
DI void acc_to_lds(const f32x4 (&acc)[2][2][4][2]) {
  GT_VARS
  u16* Cs = (u16*)dsm;
  __syncthreads();
  GT_FOR { Cs[GT_ROW(ai, m, j) * CS_LD + GT_COL(bj, n)] = f2bf(acc[ai][bj][m][n][j]); }
  __syncthreads();
}

__device__ void ph_gemm1(const Params& p, int bid, int nb) {
  const int tid_ = otid();
  const int nM = 261, nN = 18;
  for (int round = 0; round * nb < nM * nN; ++round) {
    int pm, pn;
    if (!tile_of(round, bid, nb, nM, nN, pm, pn)) break;
    f32x4 acc[2][2][4][2];
    gemm256<1024>(p.H, p.WinT, pm * 256, pn * 256, acc);
    acc_to_lds(acc);
    const u16* Cs = (const u16*)dsm;
#pragma unroll 4
    for (int it = 0; it < 16; it++) {
      const int id = it * NTH + tid_, rl = id >> 5, c8 = (id & 31) * 8;
      const int row = pm * 256 + rl;
      const u32x4 v = *(const u32x4*)(Cs + rl * CS_LD + c8);
      *(u32x4*)(p.P + (size_t)row * INC + pn * 256 + c8) = v;
      if (pn == 9) {
        float* dst = nullptr;
        const int c2 = c8 & 127;
        if (row < TP) {
          const int tt = row & 4095;
          if (tt >= 3968) dst = p.out + (c8 < 128 ? OFF_KP : OFF_VP) + ((size_t)(row >> 12) * 128 + (tt - 3968)) * 128 + c2;
        } else if (row < T) {
          dst = p.out + (c8 < 128 ? OFF_KS : OFF_VS) + (size_t)(row - TP) * 128 + c2;
        }
        if (dst) {
          *(float4*)dst = make_float4(bflo(v[0]), bfhi(v[0]), bflo(v[1]), bfhi(v[1]));
          *(float4*)(dst + 4) = make_float4(bflo(v[2]), bfhi(v[2]), bflo(v[3]), bfhi(v[3]));
        }
      }
    }
  }
}

DI int prev_row(int g) {
  if (g < TP) return (g & 4095) ? g - 1 : -1;
  const int r2 = g - TP;
  return (r2 & 63) ? g - 1 : T + (r2 >> 6);
}

__device__ void ph_rwprep(const Params& p, int bid, int nb) {
  const int tid = otid(), lane = tid & 63, wv = tid >> 6, fr = lane & 15, fq = lane >> 4;
  u16* A1 = (u16*)dsm;
  u16* A2 = A1 + 64 * 80;
  u16* A3 = A2 + 64 * 80;
  u16* SA = (u16*)(p.out);
  u16* SB = p.H;
  const int hd = wv;
  u16* OT = (u16*)(dsm + 38912 + wv * 12288);
  for (int tile = bid; tile < T / 64; tile += nb) {
    const int g0 = tile * 64;
    __syncthreads();
    {
      const int row = tid >> 3, part8 = tid & 7, part = part8 >> 1, sub = part8 & 1;
      const int g = g0 + row, pr = prev_row(g);
      const int cb = 1536 + part * 64 + sub * 32;
      const u16* cur = p.P + (size_t)g * INC + cb;
      const u16* prv = p.P + (size_t)(pr < 0 ? 0 : pr) * INC + cb;
#pragma unroll
      for (int q = 0; q < 4; q++) {
        const u32x4 c4 = *(const u32x4*)(cur + q * 8);
        u32x4 p4 = {0u, 0u, 0u, 0u};
        if (pr >= 0) p4 = *(const u32x4*)(prv + q * 8);
        u32x4 ow;
#pragma unroll
        for (int e = 0; e < 4; e++) {
          const float c0 = bflo(c4[e]), c1 = bfhi(c4[e]), q0 = bflo(p4[e]), q1 = bfhi(p4[e]);
          float f0 = c0 + (q0 - c0) * p.mu[cb + q * 8 + 2 * e];
          float f1 = c1 + (q1 - c1) * p.mu[cb + q * 8 + 2 * e + 1];
          if (part == 0) { f0 = 1.f - 2.f / (1.f + __expf(2.f * f0)); f1 = 1.f - 2.f / (1.f + __expf(2.f * f1)); }
          else if (part >= 2) { f0 = sigmoidf_(f0); f1 = sigmoidf_(f1); }
          ow[e] = pack2(f0, f1);
        }
        u16* dst = part == 0 ? A1 + row * 80 + sub * 32 + q * 8
                 : part == 1 ? A2 + row * 80 + sub * 32 + q * 8
                             : A3 + row * 144 + (part - 2) * 64 + sub * 32 + q * 8;
        *(u32x4*)dst = ow;
      }
    }
    __syncthreads();
#pragma unroll 1
    for (int rg = 0; rg < 4; rg++) {
      f32x4 aw[4], aa[4];
#pragma unroll
      for (int nt = 0; nt < 4; nt++) { aw[nt] = f32x4{0.f, 0.f, 0.f, 0.f}; aa[nt] = f32x4{0.f, 0.f, 0.f, 0.f}; }
#pragma unroll
      for (int ks = 0; ks < 2; ks++) {
        const bf16x8 f1 = *(const bf16x8*)(A1 + (rg * 16 + fr) * 80 + ks * 32 + fq * 8);
        const bf16x8 f2 = *(const bf16x8*)(A2 + (rg * 16 + fr) * 80 + ks * 32 + fq * 8);
#pragma unroll
        for (int nt = 0; nt < 4; nt++) {
          const bf16x8 bw = *(const bf16x8*)(p.W2T + (size_t)(hd * 64 + nt * 16 + fr) * 64 + ks * 32 + fq * 8);
          const bf16x8 ba = *(const bf16x8*)(p.A2T + (size_t)(hd * 64 + nt * 16 + fr) * 64 + ks * 32 + fq * 8);
          aw[nt] = MFMA16(f1, bw, aw[nt]);
          aa[nt] = MFMA16(f2, ba, aa[nt]);
        }
      }
      float ss[4] = {0.f, 0.f, 0.f, 0.f};
      const int rowb = rg * 16 + fq * 4;
      const int gb = g0 + rowb;
      const int pr = (rowb == 0) ? prev_row(gb) : gb - 1;
#pragma unroll
      for (int nt = 0; nt < 4; nt++) {
        const int c = nt * 16 + fr, col = hd * 64 + c;
        const float mu_r = p.mu[col], mu_k = p.mu[512 + col], mu_v = p.mu[1024 + col];
        const float w0c = p.w0[col], a0c = p.a0[col], kkc = p.k_k[col], kac = p.k_a[col];
        float qr = 0.f, qk = 0.f, qv = 0.f;
        if (pr >= 0) {
          const u16* pp = p.P + (size_t)pr * INC + col;
          qr = bf2f(pp[0]); qk = bf2f(pp[512]); qv = bf2f(pp[1024]);
        }
#pragma unroll
        for (int j = 0; j < 4; j++) {
          const int gg = gb + j;
          const u16* pc = p.P + (size_t)gg * INC + col;
          const float cr = bf2f(pc[0]), ck = bf2f(pc[512]), cv = bf2f(pc[1024]);
          const float r = cr + (qr - cr) * mu_r, k = ck + (qk - ck) * mu_k, v = cv + (qv - cv) * mu_v;
          qr = cr; qk = ck; qv = cv;
          const float ed = 0.6065306597126334f * sigmoidf_(w0c + aw[nt][j]);
          const float dm = 1.f - __expf(-ed);
          const float a = sigmoidf_(a0c + aa[nt][j]);
          const float kkv = k * kkc;
          ss[j] += kkv * kkv;
          const float k2 = k * (1.f + (a - 1.f) * kac);
          u16* ot = OT + (fq * 4 + j) * 384 + c;
          ot[0] = f2bf(r);
          ot[64] = f2bf(dm);
          ot[128] = f2bf(k2);
          ot[256] = f2bf(v);
          aw[nt][j] = kkv;
          aa[nt][j] = a;
        }
        SCHED;
      }
#pragma unroll
      for (int j = 0; j < 4; j++) ss[j] = 1.f / fmaxf(sqrtf(red16(ss[j])), 1e-12f);
#pragma unroll
      for (int nt = 0; nt < 4; nt++) {
        const int c = nt * 16 + fr;
#pragma unroll
        for (int j = 0; j < 4; j++) {
          const float kkn = aw[nt][j] * ss[j];
          u16* ot = OT + (fq * 4 + j) * 384 + c;
          ot[192] = f2bf(kkn);
          ot[320] = f2bf(kkn * aa[nt][j]);
        }
      }
      __builtin_amdgcn_fence(__ATOMIC_RELEASE, "workgroup");
      __builtin_amdgcn_wave_barrier();
      {
        const int gr0 = g0 + rg * 16;
#pragma unroll 4
        for (int it = 0; it < 12; it++) {
          const int id = it * 64 + lane, rowi = id / 48, pc = id % 48;
          const u32x4 v4 = *(const u32x4*)(OT + rowi * 384 + pc * 8);
          const size_t gh = (size_t)(gr0 + rowi) * 8 + hd;
          if (pc < 32) *(u32x4*)(SA + gh * 256 + pc * 8) = v4;
          else *(u32x4*)(SB + gh * 128 + (pc - 32) * 8) = v4;
        }
      }
      __builtin_amdgcn_wave_barrier();
      f32x4 ag[4];
#pragma unroll
      for (int nt = 0; nt < 4; nt++) ag[nt] = f32x4{0.f, 0.f, 0.f, 0.f};
#pragma unroll
      for (int ks = 0; ks < 4; ks++) {
        const bf16x8 f3 = *(const bf16x8*)(A3 + (rg * 16 + fr) * 144 + ks * 32 + fq * 8);
#pragma unroll
        for (int nt = 0; nt < 4; nt++) {
          const bf16x8 bg = *(const bf16x8*)(p.G2T + (size_t)(hd * 64 + nt * 16 + fr) * 128 + ks * 32 + fq * 8);
          ag[nt] = MFMA16(f3, bg, ag[nt]);
        }
      }
#pragma unroll
      for (int nt = 0; nt < 4; nt++)
#pragma unroll
        for (int j = 0; j < 4; j++) p.G[(size_t)(gb + j) * 512 + hd * 64 + nt * 16 + fr] = f2bf(ag[nt][j]);
    }
  }
}

DI float red8(float v) {
  v += dppmov<0xB1>(v);
  v += dppmov<0x4E>(v);
  v += dppmov<0x141>(v);
  return v;
}
struct ScanOps { f32x4 r, d, k, n, b; float v; };
DI void scan_ld(ScanOps& o, const float* sb, int j0, int row) {
  o.r = *(const f32x4*)(sb + j0);
  o.d = *(const f32x4*)(sb + 64 + j0);
  o.k = *(const f32x4*)(sb + 128 + j0);
  o.n = *(const f32x4*)(sb + 192 + j0);
  o.b = *(const f32x4*)(sb + 320 + j0);
  o.v = sb[256 + row];
}
#define LO2(x) __builtin_shufflevector((x), (x), 0, 1)
#define HI2(x) __builtin_shufflevector((x), (x), 2, 3)
DI float scan_step(f32x2 (&S)[2], const ScanOps& o, f32x4& rprev) {
  const f32x2 vv = {o.v, o.v};
  const f32x2 tt = S[0] * LO2(o.n) + S[1] * HI2(o.n);
  const f32x2 yy = S[0] * LO2(rprev) + S[1] * HI2(rprev);
  const f32x2 m0 = S[0] * LO2(o.d) + vv * LO2(o.k);
  const f32x2 m1 = S[1] * HI2(o.d) + vv * HI2(o.k);
  float a = tt[0] + tt[1], y = yy[0] + yy[1];
  a += dppmov<0x128>(a); y += dppmov<0x128>(y);
  a += dppmov<0x124>(a); y += dppmov<0x124>(y);
  a += dppmov<0x122>(a); y += dppmov<0x122>(y);
  a += dppmov<0x121>(a); y += dppmov<0x121>(y);
  const float sa = -a;
  const f32x2 sv = {sa, sa};
  S[0] = m0 + sv * LO2(o.b);
  S[1] = m1 + sv * HI2(o.b);
  rprev = o.r;
  return y;
}

__device__ void ph_scan(const Params& p, int bid, int nb) {
  const int tid = otid(), lane = tid & 63, wv = tid >> 6;
  float* buf = (float*)dsm;
  const u16* SA = (const u16*)(p.out);
  const u16* SB = p.H;
  constexpr int CH = 32;
  for (int item = bid; item < 512; item += nb) {
    const int type = item >> 8, r_ = item & 255, half = r_ & 1, hb = r_ >> 1, h = hb & 7, b = hb >> 3;
    const int nch = type ? 64 / CH : 4096 / CH;
    const int gbase = type ? TP + b * 64 : b * 4096;
    const bool active = true;
    const int row = half * 32 + wv * 4 + (lane >> 4), j0 = (lane & 15) * 4;
    f32x2 S[2];
#pragma unroll
    for (int j = 0; j < 2; j++) S[j] = f32x2{0.f, 0.f};
    if (type && active) {
      const float* s0 = p.state_wkv + ((size_t)(b * 8 + h) * 64 + row) * 64 + j0;
#pragma unroll
      for (int j = 0; j < 2; j++) S[j] = f32x2{s0[2 * j], s0[2 * j + 1]};
    }
    f32x4 rprev = {0.f, 0.f, 0.f, 0.f};
    float ykeep = 0.f;
    u32x4 la[2], lb;
    auto gload = [&](int c) {
#pragma unroll
      for (int q = 0; q < 2; q++) {
        const int idx = tid + q * NTH, step = idx >> 5, u = idx & 31;
        la[q] = *(const u32x4*)(SA + ((size_t)(gbase + c * CH + step) * 8 + h) * 256 + u * 8);
      }
      {
        const int step = tid >> 4, u = tid & 15;
        lb = *(const u32x4*)(SB + ((size_t)(gbase + c * CH + step) * 8 + h) * 128 + u * 8);
      }
    };
    gload(0);
    for (int c = 0; c < nch; c++) {
      __syncthreads();
#pragma unroll
      for (int q = 0; q < 2; q++) {
        const int idx = tid + q * NTH, step = idx >> 5, u = idx & 31, arr = u >> 3, c0 = (u & 7) * 8;
        float* d = buf + step * 384 + arr * 64 + c0;
        float f[8];
#pragma unroll
        for (int e = 0; e < 4; e++) { f[2 * e] = bflo(la[q][e]); f[2 * e + 1] = bfhi(la[q][e]); }
        if (arr == 1) {
#pragma unroll
          for (int e = 0; e < 8; e++) f[e] = 1.f - f[e];
        }
        *(float4*)d = make_float4(f[0], f[1], f[2], f[3]);
        *(float4*)(d + 4) = make_float4(f[4], f[5], f[6], f[7]);
      }
      {
        const int step = tid >> 4, u = tid & 15, arr = u >> 3, c0 = (u & 7) * 8;
        float* d = buf + step * 384 + (4 + arr) * 64 + c0;
        *(float4*)d = make_float4(bflo(lb[0]), bfhi(lb[0]), bflo(lb[1]), bfhi(lb[1]));
        *(float4*)(d + 4) = make_float4(bflo(lb[2]), bfhi(lb[2]), bflo(lb[3]), bfhi(lb[3]));
      }
      __syncthreads();
      if (c + 1 < nch) gload(c + 1);
      if (active) {
        ScanOps A0, A1, B0, B1;
        scan_ld(A0, buf, j0, row);
        scan_ld(A1, buf + 384, j0, row);
#pragma unroll 1
        for (int s = 0; s < CH; s += 4) {
          scan_ld(B0, buf + (s + 2) * 384, j0, row);
          scan_ld(B1, buf + (s + 3) * 384, j0, row);
          SCHED;
          {
            const int g0 = c * CH + s;
            const float y0 = scan_step(S, A0, rprev);
            ykeep = ((lane & 15) == ((g0 - 1) & 15)) ? y0 : ykeep;
            if ((g0 & 15) == 0 && g0 > 0)
              p.Y[(size_t)(gbase + g0 - 16 + (lane & 15)) * 512 + h * 64 + row] = f2bf(ykeep);
            const float y1 = scan_step(S, A1, rprev);
            ykeep = ((lane & 15) == (g0 & 15)) ? y1 : ykeep;
          }
          SCHED;
          const int sn = (s + 4 < CH) ? s + 4 : s;
          scan_ld(A0, buf + sn * 384, j0, row);
          scan_ld(A1, buf + (sn + 1) * 384, j0, row);
          SCHED;
          {
            const int g0 = c * CH + s;
            const float y2 = scan_step(S, B0, rprev);
            ykeep = ((lane & 15) == ((g0 + 1) & 15)) ? y2 : ykeep;
            const float y3 = scan_step(S, B1, rprev);
            ykeep = ((lane & 15) == ((g0 + 2) & 15)) ? y3 : ykeep;
          }
          SCHED;
        }
      }
    }
    if (active) {
      const f32x2 yy = S[0] * LO2(rprev) + S[1] * HI2(rprev);
      const float yl = red16(yy[0] + yy[1]);
      ykeep = ((lane & 15) == 15) ? yl : ykeep;
      p.Y[(size_t)(gbase + nch * CH - 16 + (lane & 15)) * 512 + h * 64 + row] = f2bf(ykeep);
    }
    if (active) {
      float* so = p.out + (type ? OFF_WKV_S : OFF_WKV_P) + ((size_t)(b * 8 + h) * 64 + row) * 64 + j0;
      *(float4*)so = make_float4(S[0][0], S[0][1], S[1][0], S[1][1]);
    }
  }
}

__device__ void ph_attn(const Params& p, int bid, int nb, bool dry = false) {
  const int tid = otid(), lane = tid & 63, wv = tid >> 6, fr = lane & 15, fq = lane >> 4;
  u16* Ks = (u16*)dsm;
  u16* Vt = Ks + 192 * 72;
  for (int item = bid; item < 2080; item += nb) {
    const int kvh = item & 1, r = item >> 1;
    const bool samp = r >= 1024;
    const int b = samp ? r - 1024 : r >> 6, c = samp ? 0 : (r & 63);
    const int gq0 = samp ? TP + b * 64 : b * 4096 + c * 64;
    __syncthreads();
#pragma unroll
    for (int q = 0; q < 3; q++) {
      const int idx = tid + q * NTH, j = idx >> 3, d0 = (idx & 7) * 8;
      u32x4 kq = {0u, 0u, 0u, 0u}, vq = {0u, 0u, 0u, 0u};
      if (!samp) {
        const int tok = (c - 2) * 64 + j;
        if (tok >= 0) {
          const u16* src = p.P + (size_t)(b * 4096 + tok) * INC + 2304 + kvh * 64 + d0;
          kq = *(const u32x4*)src;
          vq = *(const u32x4*)(src + 128);
        }
      } else if (j < 128) {
        const float4* ck = (const float4*)(p.cache_k + ((size_t)(b * 128 + j) * 2 + kvh) * 64 + d0);
        const float4* cv = (const float4*)(p.cache_v + ((size_t)(b * 128 + j) * 2 + kvh) * 64 + d0);
        const float4 k0 = ck[0], k1 = ck[1], v0 = cv[0], v1 = cv[1];
        kq = u32x4{pack2(k0.x, k0.y), pack2(k0.z, k0.w), pack2(k1.x, k1.y), pack2(k1.z, k1.w)};
        vq = u32x4{pack2(v0.x, v0.y), pack2(v0.z, v0.w), pack2(v1.x, v1.y), pack2(v1.z, v1.w)};
      } else {
        const u16* src = p.P + (size_t)(TP + b * 64 + (j - 128)) * INC + 2304 + kvh * 64 + d0;
        kq = *(const u32x4*)src;
        vq = *(const u32x4*)(src + 128);
      }
      *(u32x4*)(Ks + j * 72 + d0) = kq;
#pragma unroll
      for (int e = 0; e < 4; e++) {
        Vt[(d0 + 2 * e) * 196 + j] = (u16)(vq[e] & 0xffffu);
        Vt[(d0 + 2 * e + 1) * 196 + j] = (u16)(vq[e] >> 16);
      }
    }
    __syncthreads();
    const int qh = kvh * 4 + (wv & 3);
    const float slope = exp2f(-(float)(qh + 1)), sink = p.sinks[qh];
#pragma unroll 1
    for (int ps = 0; ps < 2; ps++) {
      const int q0 = (wv >> 2) * 32 + ps * 16;
      const int tq = q0 + fr;
      const u16* qp = p.P + (size_t)(gq0 + tq) * INC + 1792 + qh * 64 + fq * 8;
      const bf16x8 qf0 = *(const bf16x8*)(qp), qf1 = *(const bf16x8*)(qp + 32);
      f32x4 sc[12];
#pragma unroll
      for (int kt = 0; kt < 12; kt++) {
        sc[kt] = f32x4{0.f, 0.f, 0.f, 0.f};
        const bf16x8 a0 = *(const bf16x8*)(Ks + (kt * 16 + fr) * 72 + fq * 8);
        const bf16x8 a1 = *(const bf16x8*)(Ks + (kt * 16 + fr) * 72 + 32 + fq * 8);
        sc[kt] = MFMA16(a0, qf0, sc[kt]);
        sc[kt] = MFMA16(a1, qf1, sc[kt]);
        if ((kt & 3) == 3) SCHED;
      }
      float mx = -3e38f;
#pragma unroll
      for (int kt = 0; kt < 12; kt++)
#pragma unroll
        for (int j = 0; j < 4; j++) {
          const int key = kt * 16 + fq * 4 + j;
          float s = sc[kt][j] * 0.125f - slope * fabsf((float)(128 + tq - key));
          if (!samp && (c - 2) * 64 + key < 0) s = -1e30f;
          sc[kt][j] = s;
          mx = fmaxf(mx, s);
        }
      mx = fmaxf(mx, __shfl_xor(mx, 16));
      mx = fmaxf(mx, __shfl_xor(mx, 32));
      mx = fmaxf(mx, sink);
      float sum = 0.f;
#pragma unroll
      for (int kt = 0; kt < 12; kt++)
#pragma unroll
        for (int j = 0; j < 4; j++) {
          const float e = __expf(sc[kt][j] - mx);
          sc[kt][j] = e;
          sum += e;
        }
      sum += __shfl_xor(sum, 16);
      sum += __shfl_xor(sum, 32);
      sum += __expf(sink - mx);
      const float inv = 1.f / sum;
      f32x4 o[4];
#pragma unroll
      for (int dt = 0; dt < 4; dt++) o[dt] = f32x4{0.f, 0.f, 0.f, 0.f};
#pragma unroll
      for (int t2 = 0; t2 < 6; t2++) {
        const u32x4 pw = {pack2(sc[2 * t2][0] * inv, sc[2 * t2][1] * inv), pack2(sc[2 * t2][2] * inv, sc[2 * t2][3] * inv),
                          pack2(sc[2 * t2 + 1][0] * inv, sc[2 * t2 + 1][1] * inv),
                          pack2(sc[2 * t2 + 1][2] * inv, sc[2 * t2 + 1][3] * inv)};
        const bf16x8 pa = __builtin_bit_cast(bf16x8, pw);
#pragma unroll
        for (int dt = 0; dt < 4; dt++) {
          const u16* vp = Vt + (dt * 16 + fr) * 196 + t2 * 32 + fq * 4;
          const uint2 v0 = *(const uint2*)vp, v1 = *(const uint2*)(vp + 16);
          const bf16x8 vb = __builtin_bit_cast(bf16x8, u32x4{v0.x, v0.y, v1.x, v1.y});
          o[dt] = MFMA16(pa, vb, o[dt]);
        }
        SCHED;
      }
#pragma unroll
      for (int dt = 0; dt < 4; dt++)
#pragma unroll
        for (int j = 0; j < 4; j++)
          p.OATT[(size_t)(gq0 + q0 + fq * 4 + j) * 512 + qh * 64 + dt * 16 + fr] = f2bf(o[dt][j]);
    }
  }
  const u16* SA = (const u16*)(p.out);
  const u16* SB = p.H;
  for (int it4 = bid * NW + wv; it4 < T * 2; it4 += nb * NW) {
    const int it = it4 * 4 + (lane >> 4), c0 = (lane & 15) * 4;
    const int g = it >> 3, h = it & 7, col = h * 64 + c0;
    const uint2 yw = *(const uint2*)(p.Y + (size_t)g * 512 + col);
    const uint2 rw = *(const uint2*)(SA + (size_t)it * 256 + c0), kw = *(const uint2*)(SA + (size_t)it * 256 + 128 + c0);
    const uint2 vw = *(const uint2*)(SB + (size_t)it * 128 + c0), gw = *(const uint2*)(p.G + (size_t)g * 512 + col);
    const float4 lw = *(const float4*)(p.lnx_w + col), lb = *(const float4*)(p.lnx_b + col), rk = *(const float4*)(p.r_k + col);
    const float y0 = bflo(yw.x), y1 = bfhi(yw.x), y2 = bflo(yw.y), y3 = bfhi(yw.y);
    const float mean = red16((y0 + y1) + (y2 + y3)) * (1.f / 64.f);
    const float e0 = y0 - mean, e1 = y1 - mean, e2 = y2 - mean, e3 = y3 - mean;
    const float var = red16((e0 * e0 + e1 * e1) + (e2 * e2 + e3 * e3)) * (1.f / 64.f);
    const float bonus = red16((bflo(rw.x) * bflo(kw.x) * rk.x + bfhi(rw.x) * bfhi(kw.x) * rk.y) +
                              (bflo(rw.y) * bflo(kw.y) * rk.z + bfhi(rw.y) * bfhi(kw.y) * rk.w));
    const float rsd = rsqrtf(var + 64e-5f);
    const float o0 = (e0 * rsd * lw.x + lb.x + bonus * bflo(vw.x)) * bflo(gw.x);
    const float o1 = (e1 * rsd * lw.y + lb.y + bonus * bfhi(vw.x)) * bfhi(gw.x);
    const float o2 = (e2 * rsd * lw.z + lb.z + bonus * bflo(vw.y)) * bflo(gw.y);
    const float o3 = (e3 * rsd * lw.w + lb.w + bonus * bfhi(vw.y)) * bfhi(gw.y);
    if (!dry || o0 == 123.456f) *(uint2*)(p.Y + (size_t)g * 512 + col) = make_uint2(pack2(o0, o1), pack2(o2, o3));
  }
}

__device__ void ph_gemm2(const Params& p, int bid, int nb) {
  const int tid_ = otid();
  u16* MG = p.H;
  const u16* Cs = (const u16*)dsm;
  const int nM = 260, nN = 4;
  for (int round = 0; round * nb < nM * nN; ++round) {
    int pm, pn;
    if (!tile_of(round, bid, nb, nM, nN, pm, pn)) break;
    f32x4 acc[2][2][4][2];
#pragma unroll 1
    for (int br = 0; br < 2; br++) {
      gemm256<512>(br ? p.OATT : p.Y, p.WbT + (size_t)br * 1024 * 512, pm * 256, pn * 256, acc);
      acc_to_lds(acc);
#pragma unroll 2
      for (int it = 0; it < 16; it++) {
        const int id = it * NTH + tid_, rl = id >> 5, c8 = (id & 31) * 8;
        const int row = pm * 256 + rl, col = pn * 256 + c8;
        const u32x4 v = *(const u32x4*)(Cs + rl * CS_LD + c8);
        const u32x4 gw = *(const u32x4*)(p.P + (size_t)row * INC + 2560 + br * 1024 + col);
        u32x4 prev = {0u, 0u, 0u, 0u};
        if (br) prev = *(const u32x4*)(MG + (size_t)row * 1024 + col);
        u32x4 o;
#pragma unroll
        for (int e = 0; e < 4; e++) {
          const float r0 = bflo(prev[e]) + sigmoidf_(bflo(gw[e])) * bflo(v[e]);
          const float r1 = bfhi(prev[e]) + sigmoidf_(bfhi(gw[e])) * bfhi(v[e]);
          o[e] = pack2(r0, r1);
        }
        *(u32x4*)(MG + (size_t)row * 1024 + col) = o;
      }
    }
  }
}

__device__ void ph_gemm3(const Params& p, int bid, int nb) {
  const int tid_ = otid();
  const u16* MG = p.H;
  const u16* Cs = (const u16*)dsm;
  const int nM = 260, nN = 4;
  for (int round = 0; round * nb < nM * nN; ++round) {
    int pm, pn;
    if (!tile_of(round, bid, nb, nM, nN, pm, pn)) break;
    f32x4 acc[2][2][4][2];
    gemm256<1024>(MG, p.WoutT, pm * 256, pn * 256, acc);
    acc_to_lds(acc);
#pragma unroll 2
    for (int it = 0; it < 16; it++) {
      const int id = it * NTH + tid_, rl = id >> 5, c8 = (id & 31) * 8;
      const int row = pm * 256 + rl, col = pn * 256 + c8;
      const u32x4 v = *(const u32x4*)(Cs + rl * CS_LD + c8);
      const float* xr = xrow(p, row) + col;
      const float4 x0 = *(const float4*)xr, x1 = *(const float4*)(xr + 4);
      float* dst = p.out + (size_t)row * 1024 + col;
      *(float4*)dst = make_float4(x0.x + bflo(v[0]), x0.y + bfhi(v[0]), x0.z + bflo(v[1]), x0.w + bfhi(v[1]));
      *(float4*)(dst + 4) = make_float4(x1.x + bflo(v[2]), x1.y + bfhi(v[2]), x1.z + bflo(v[3]), x1.w + bfhi(v[3]));
    }
  }
}

__device__ void ph_norm2(const Params& p, int bid, int nb) {
  const int tid = otid(), lane = tid & 63, wv = tid >> 6;
  for (int row = bid * NW + wv; row < T; row += nb * NW) {
    const float4* x = (const float4*)(p.out + (size_t)row * 1024);
    float4 v[4];
    float ss = 0.f;
#pragma unroll
    for (int i = 0; i < 4; i++) {
      v[i] = x[lane + i * 64];
      ss += v[i].x * v[i].x + v[i].y * v[i].y + v[i].z * v[i].z + v[i].w * v[i].w;
    }
    ss = wave_sum(ss);
    const float rs = rsqrtf(ss * (1.f / 1024.f) + 1e-6f);
    u16* hr = p.H + (size_t)row * 1024;
    float4 y[4];
    float am = 0.f;
#pragma unroll
    for (int i = 0; i < 4; i++) {
      const float4 g = ((const float4*)p.norm2_g)[lane + i * 64];
      y[i] = make_float4(v[i].x * rs * g.x, v[i].y * rs * g.y, v[i].z * rs * g.z, v[i].w * rs * g.w);
      ((uint2*)hr)[lane + i * 64] = make_uint2(pack2(y[i].x, y[i].y), pack2(y[i].z, y[i].w));
      am = fmaxf(am, fmaxf(fmaxf(fabsf(y[i].x), fabsf(y[i].y)), fmaxf(fabsf(y[i].z), fabsf(y[i].w))));
    }
    am = fmaxf(wave_max(am), 1e-30f);
    const float sc = 240.f / am;
    if (lane == 0) p.SH[row] = am * (1.f / 240.f);
    u32* h8 = (u32*)((unsigned char*)p.Y + (size_t)row * 1024);
#pragma unroll
    for (int i = 0; i < 4; i++) h8[lane + i * 64] = q4(y[i].x, y[i].y, y[i].z, y[i].w, sc);
  }
}

DI void ins16(float (&l)[16], float x) {
#pragma unroll
  for (int i = 0; i < 16; i++) {
    const float hi = fmaxf(l[i], x);
    x = fminf(l[i], x);
    l[i] = hi;
  }
}


DI void ce_desc(float& a, float& b) { const float hi = fmaxf(a, b), lo = fminf(a, b); a = hi; b = lo; }
DI void bitonic_sort16_desc(float (&a)[16]) {
#pragma unroll
  for (int k = 2; k <= 16; k <<= 1)
#pragma unroll
    for (int j = k >> 1; j > 0; j >>= 1)
#pragma unroll
      for (int i = 0; i < 16; i++) {
        const int l = i ^ j;
        if (l > i) {
          if ((i & k) == 0) ce_desc(a[i], a[l]);
          else ce_desc(a[l], a[i]);
        }
      }
}
DI void bitonic_merge16_desc(float (&a)[16]) {
#pragma unroll
  for (int j = 8; j > 0; j >>= 1)
#pragma unroll
    for (int i = 0; i < 16; i++) {
      const int l = i ^ j;
      if (l > i) ce_desc(a[i], a[l]);
    }
}
DI void top16_merge(float (&a)[16], const float (&b)[16]) {
#pragma unroll
  for (int i = 0; i < 16; i++) a[i] = fmaxf(a[i], b[15 - i]);
  bitonic_merge16_desc(a);
}

__device__ void ph_peerq(const Params& p, int bid, int nb) {
  GT_VARS
  const int l31 = lane & 31, kh = lane >> 5;
  u16* Qs = (u16*)dsm;
  unsigned char* lt = (unsigned char*)(dsm + 135168 + wid * 1024);
  int* IDX = (int*)p.G;
  float* GATE = (float*)p.OATT;
  const int nM = 260, nN = 4;
  for (int round = 0; round * nb < nM * nN; ++round) {
    int pm, pn;
    if (!tile_of(round, bid, nb, nM, nN, pm, pn)) break;
    {
      f32x4 acc[2][2][4][2];
      gemm256<1024>(p.H, p.WqT, pm * 256, pn * 256, acc);
      acc_to_lds(acc);
    }
#pragma unroll 1
    for (int hh = 0; hh < 2; hh++) {
      const int hp = pn * 2 + hh;
      float l1[16], l2[16];
#pragma unroll
      for (int i = 0; i < 16; i++) { l1[i] = 0.f; l2[i] = 0.f; }
#pragma unroll 1
      for (int pp = 0; pp < 2; pp++) {
        f32x16 sc[4];
#pragma unroll
        for (int m4 = 0; m4 < 4; m4++) {
#pragma unroll
          for (int i = 0; i < 16; i++) sc[m4][i] = 0.f;
#pragma unroll
          for (int kk = 0; kk < 4; kk++) {
            const bf16x8 a = *(const bf16x8*)(p.SK + (size_t)(pp * 128 + m4 * 32 + l31) * 64 + kk * 16 + kh * 8);
            const bf16x8 bq = *(const bf16x8*)(Qs + (wid * 32 + l31) * 264 + hh * 128 + pp * 64 + kk * 16 + kh * 8);
            sc[m4] = MFMA32(a, bq, sc[m4]);
          }
        }
        float l[16], q1[16], q2[16], q3[16];
#pragma unroll
        for (int i = 0; i < 16; i++) {
          const u32 nb_ = (i >> 2) * 8 + kh * 4 + (i & 3);
          l[i] = __uint_as_float((__float_as_uint(sc[0][i]) & ~0x7Fu) | nb_);
          q1[i] = __uint_as_float((__float_as_uint(sc[1][i]) & ~0x7Fu) | (32u + nb_));
          q2[i] = __uint_as_float((__float_as_uint(sc[2][i]) & ~0x7Fu) | (64u + nb_));
          q3[i] = __uint_as_float((__float_as_uint(sc[3][i]) & ~0x7Fu) | (96u + nb_));
        }
        bitonic_sort16_desc(l);
        bitonic_sort16_desc(q1);
        bitonic_sort16_desc(q2);
        bitonic_sort16_desc(q3);
        top16_merge(l, q1);
        top16_merge(q2, q3);
        top16_merge(l, q2);
        float o[16];
#pragma unroll
        for (int i = 0; i < 16; i++) o[i] = __shfl_xor(l[i], 32);
        top16_merge(l, o);
#pragma unroll
        for (int i = 0; i < 16; i++) {
          l1[i] = pp == 0 ? l[i] : l1[i];
          l2[i] = pp == 0 ? l2[i] : l[i];
        }
      }
      if (kh == 0) {
        u32 w[8];
#pragma unroll
        for (int q = 0; q < 4; q++) {
          w[q] = (__float_as_uint(l1[4 * q]) & 0x7F) | ((__float_as_uint(l1[4 * q + 1]) & 0x7F) << 8) |
                 ((__float_as_uint(l1[4 * q + 2]) & 0x7F) << 16) | ((__float_as_uint(l1[4 * q + 3]) & 0x7F) << 24);
          w[4 + q] = (__float_as_uint(l2[4 * q]) & 0x7F) | ((__float_as_uint(l2[4 * q + 1]) & 0x7F) << 8) |
                     ((__float_as_uint(l2[4 * q + 2]) & 0x7F) << 16) | ((__float_as_uint(l2[4 * q + 3]) & 0x7F) << 24);
        }
        *(uint4*)(lt + l31 * 32) = make_uint4(w[0], w[1], w[2], w[3]);
        *(uint4*)(lt + l31 * 32 + 16) = make_uint4(w[4], w[5], w[6], w[7]);
      }
      float v1[16], v2[16];
#pragma unroll
      for (int i = 0; i < 16; i++) {
        v1[i] = __uint_as_float(__float_as_uint(l1[i]) & ~0x7Fu);
        v2[i] = __uint_as_float(__float_as_uint(l2[i]) & ~0x7Fu);
      }
#define CAND(a, b) __uint_as_float((__float_as_uint(v1[a] + v2[b]) & ~0xFFu) | (u32)((a) * 16 + (b)))
      float l3[16], y1[16], y2[16];
#pragma unroll
      for (int b = 0; b < 16; b++) l3[b] = CAND(0, b);
#pragma unroll
      for (int b = 0; b < 8; b++) y1[b] = CAND(1, b);
#pragma unroll
      for (int b = 0; b < 5; b++) y1[8 + b] = CAND(2, b);
#pragma unroll
      for (int b = 0; b < 3; b++) y1[13 + b] = CAND(4, b);
#pragma unroll
      for (int b = 0; b < 4; b++) y2[b] = CAND(3, b);
      y2[4] = CAND(5, 0); y2[5] = CAND(5, 1); y2[6] = CAND(6, 0); y2[7] = CAND(6, 1); y2[8] = CAND(7, 0); y2[9] = CAND(7, 1);
      y2[10] = CAND(8, 0); y2[11] = CAND(9, 0); y2[12] = CAND(10, 0); y2[13] = CAND(11, 0); y2[14] = CAND(12, 0); y2[15] = CAND(13, 0);
      bitonic_sort16_desc(y1);
      bitonic_sort16_desc(y2);
      top16_merge(l3, y1);
      top16_merge(l3, y2);
      ins16(l3, CAND(14, 0));
      ins16(l3, CAND(15, 0));
#undef CAND
      __builtin_amdgcn_fence(__ATOMIC_RELEASE, "workgroup");
      __builtin_amdgcn_wave_barrier();
      if (kh == 0) {
        const int g = pm * 256 + wid * 32 + l31;
        float ev[16];
        int ei[16];
        float sum = 0.f;
        const float mxv = __uint_as_float(__float_as_uint(l3[0]) & ~0xFFu);
#pragma unroll
        for (int k = 0; k < 16; k++) {
          const u32 bits = __float_as_uint(l3[k]);
          const u32 pos = bits & 0xFF;
          ev[k] = __expf(__uint_as_float(bits & ~0xFFu) - mxv);
          sum += ev[k];
          ei[k] = (int)lt[l31 * 32 + (pos >> 4)] * 128 + (int)lt[l31 * 32 + 16 + (pos & 15)];
        }
        const float inv = 1.f / sum;
        int4* ip = (int4*)(IDX + (size_t)g * 128 + hp * 16);
        float4* gp = (float4*)(GATE + (size_t)g * 128 + hp * 16);
#pragma unroll
        for (int q = 0; q < 4; q++) {
          ip[q] = make_int4(ei[4 * q], ei[4 * q + 1], ei[4 * q + 2], ei[4 * q + 3]);
          gp[q] = make_float4(ev[4 * q] * inv, ev[4 * q + 1] * inv, ev[4 * q + 2] * inv, ev[4 * q + 3] * inv);
        }
      }
      __builtin_amdgcn_wave_barrier();
    }
  }
}

__device__ void ph_peer(const Params& p, int bid, int nb, bool dry = false) {
  const int tid = otid(), lane = tid & 63, wv = tid >> 6;
  constexpr int ST = 1104;
  char* wb = dsm + wv * (16 * ST + 2048);
  unsigned char* stg = (unsigned char*)wb;
  unsigned char* hs = stg + 16 * ST;
  float* acts = (float*)(hs + 1024);
  int* idxs = (int*)(hs + 1536);
  const int gr = lane >> 3, gc = lane & 7;
  const int* IDX = (const int*)p.G;
  const float* GATE = (const float*)p.OATT;
  const unsigned char* H8 = (const unsigned char*)p.Y;
  const int n = lane & 15, quad = lane >> 4;
  for (int g = bid * NW + wv; g < T; g += nb * NW) {
    *(u32x4*)(hs + lane * 16) = *(const u32x4*)(H8 + (size_t)g * 1024 + lane * 16);
    idxs[lane] = IDX[(size_t)g * 128 + lane];
    idxs[lane + 64] = IDX[(size_t)g * 128 + 64 + lane];
    const float shv = p.SH[g];
    __builtin_amdgcn_fence(__ATOMIC_RELEASE, "workgroup");
    __builtin_amdgcn_wave_barrier();
    {
      u32x4 ring[16];
      {
        const unsigned char* ua = p.U8 + (size_t)idxs[gr] * 1024 + gc * 16;
        const unsigned char* ub = p.U8 + (size_t)idxs[8 + gr] * 1024 + gc * 16;
#pragma unroll
        for (int i = 0; i < 8; i++) { ring[i] = *(const u32x4*)(ua + i * 128); ring[8 + i] = *(const u32x4*)(ub + i * 128); }
      }
#pragma unroll 1
      for (int grp = 0; grp < 8; grp++) {
        const int gn = grp < 7 ? grp + 1 : grp;
        const unsigned char* ua = p.U8 + (size_t)idxs[gn * 16 + gr] * 1024 + gc * 16;
        const unsigned char* ub = p.U8 + (size_t)idxs[gn * 16 + 8 + gr] * 1024 + gc * 16;
        const float4 gt = *(const float4*)(GATE + (size_t)g * 128 + grp * 16 + quad * 4);
        const int4 ee = *(const int4*)(idxs + grp * 16 + quad * 4);
        const float su0 = p.SU[ee.x], su1 = p.SU[ee.y], su2 = p.SU[ee.z], su3 = p.SU[ee.w];
        const float sv0 = p.SV[ee.x], sv1 = p.SV[ee.y], sv2 = p.SV[ee.z], sv3 = p.SV[ee.w];
#pragma unroll
        for (int i = 0; i < 8; i++) {
          *(u32x4*)(stg + gr * ST + i * 128 + gc * 16) = ring[i];
          *(u32x4*)(stg + (8 + gr) * ST + i * 128 + gc * 16) = ring[8 + i];
          if (grp < 7) { ring[i] = *(const u32x4*)(ua + i * 128); ring[8 + i] = *(const u32x4*)(ub + i * 128); }
        }
        __builtin_amdgcn_fence(__ATOMIC_RELEASE, "workgroup");
        __builtin_amdgcn_wave_barrier();
        f32x4 acc = {0.f, 0.f, 0.f, 0.f};
#pragma unroll
        for (int st = 0; st < 16; st++) {
          const u32x4 ua4 = *(const u32x4*)(stg + n * ST + st * 64 + quad * 16);
          const u32x4 hb = *(const u32x4*)(hs + st * 64 + quad * 16);
          const long a0 = (long)(((unsigned long)ua4[1] << 32) | ua4[0]);
          const long a1 = (long)(((unsigned long)ua4[3] << 32) | ua4[2]);
          const long b0 = (long)(((unsigned long)hb[1] << 32) | hb[0]);
          const long b1 = (long)(((unsigned long)hb[3] << 32) | hb[2]);
          acc = __builtin_amdgcn_mfma_f32_16x16x32_fp8_fp8(a0, b0, acc, 0, 0, 0);
          acc = __builtin_amdgcn_mfma_f32_16x16x32_fp8_fp8(a1, b1, acc, 0, 0, 0);
        }
        __builtin_amdgcn_wave_barrier();
        const float d0 = acc[0] * shv * su0, d1 = acc[1] * shv * su1, d2 = acc[2] * shv * su2, d3 = acc[3] * shv * su3;
        float4 av;
        av.x = 0.5f * d0 * (1.f + erff(d0 * 0.70710678118f)) * gt.x * sv0;
        av.y = 0.5f * d1 * (1.f + erff(d1 * 0.70710678118f)) * gt.y * sv1;
        av.z = 0.5f * d2 * (1.f + erff(d2 * 0.70710678118f)) * gt.z * sv2;
        av.w = 0.5f * d3 * (1.f + erff(d3 * 0.70710678118f)) * gt.w * sv3;
        if (n == 0) *(float4*)(acts + grp * 16 + quad * 4) = av;
      }
    }
    __builtin_amdgcn_fence(__ATOMIC_RELEASE, "workgroup");
    __builtin_amdgcn_wave_barrier();
    float o[16];
#pragma unroll
    for (int j = 0; j < 16; j++) o[j] = 0.f;
    {
      u32x4 ring[16];
#pragma unroll
      for (int k = 0; k < 16; k++) ring[k] = *(const u32x4*)(p.V8 + (size_t)idxs[k] * 1024 + lane * 16);
#pragma unroll 1
      for (int kb = 0; kb < 128; kb += 16) {
        const bool more = kb < 112;
        const int kn = more ? kb + 16 : kb;
#pragma unroll
        for (int j = 0; j < 16; j++) {
          const u32x4 vq = ring[j];
          if (more) ring[j] = *(const u32x4*)(p.V8 + (size_t)idxs[kn + j] * 1024 + lane * 16);
          const float a = acts[kb + j];
#pragma unroll
          for (int q = 0; q < 4; q++) {
            const f32x2 lo = __builtin_amdgcn_cvt_pk_f32_fp8((int)vq[q], false);
            const f32x2 hi = __builtin_amdgcn_cvt_pk_f32_fp8((int)vq[q], true);
            o[4 * q] += a * lo[0]; o[4 * q + 1] += a * lo[1]; o[4 * q + 2] += a * hi[0]; o[4 * q + 3] += a * hi[1];
          }
        }
      }
    }
    float* xr = p.out + (size_t)g * 1024 + lane * 16;
    float4 x[4];
#pragma unroll
    for (int q = 0; q < 4; q++) x[q] = *(const float4*)(xr + q * 4);
    float ss = 0.f;
#pragma unroll
    for (int q = 0; q < 4; q++) {
      x[q].x += o[4 * q]; x[q].y += o[4 * q + 1]; x[q].z += o[4 * q + 2]; x[q].w += o[4 * q + 3];
      ss += x[q].x * x[q].x + x[q].y * x[q].y + x[q].z * x[q].z + x[q].w * x[q].w;
    }
    ss = wave_sum(ss);
    if (dry && ss != 123.456f) continue;
    const float rs = rsqrtf(ss * (1.f / 1024.f) + 1e-6f);
#pragma unroll
    for (int q = 0; q < 4; q++) {
      const float4 gq = *(const float4*)(p.final_g + lane * 16 + q * 4);
      *(float4*)(xr + q * 4) = make_float4(x[q].x * rs * gq.x, x[q].y * rs * gq.y, x[q].z * rs * gq.z, x[q].w * rs * gq.w);
    }
  }
}

__global__ void __launch_bounds__(512) mega_kernel(Params p) {
  cg::grid_group grid = cg::this_grid();
  const int bid = blockIdx.x, nb = gridDim.x;
  if (ON(0)) ph_prep(p, bid, nb);
  grid.sync();
  if (ON(1)) ph_gemm1(p, bid, nb);
  grid.sync();
  if (REP == 1) { ph_gemm1(p, bid, nb); grid.sync(); }
  if (ON(2)) ph_rwprep(p, bid, nb);
  grid.sync();
  if (REP == 2) { ph_rwprep(p, bid, nb); grid.sync(); }
  if (ON(3)) ph_scan(p, bid, nb);
  grid.sync();
  if (REP == 3) { ph_scan(p, bid, nb); grid.sync(); }
  if (REP == 4) { ph_attn(p, bid, nb, true); grid.sync(); }
  if (ON(4)) ph_attn(p, bid, nb);
  grid.sync();
  if (ON(5)) ph_gemm2(p, bid, nb);
  grid.sync();
  if (REP == 5) { ph_gemm2(p, bid, nb); grid.sync(); }
  if (ON(6)) ph_gemm3(p, bid, nb);
  grid.sync();
  if (REP == 6) { ph_gemm3(p, bid, nb); grid.sync(); }
  if (ON(7)) ph_norm2(p, bid, nb);
  grid.sync();
  if (ON(8)) ph_peerq(p, bid, nb);
  grid.sync();
  if (REP == 8) { ph_peerq(p, bid, nb); grid.sync(); }
  if (REP == 9) { ph_peer(p, bid, nb, true); grid.sync(); }
  if (ON(9)) ph_peer(p, bid, nb);
}

extern "C" void kernel_launch(void* const* d_in, const int* in_sizes, int n_in, void* d_out, int out_size, void* d_ws,
                              size_t ws_size, hipStream_t stream) {
  Params p{};
  const float** f = (const float**)&p;
  for (int i = 0; i < 28; i++) f[i] = (const float*)d_in[i];
  p.out = (float*)d_out;
  char* w = (char*)d_ws;
  size_t off = 0;
  auto take = [&](size_t bytes) { char* r = w + off; off += (bytes + 255) & ~(size_t)255; return (u16*)r; };
  p.H = take((size_t)MP * 1024 * 2);
  p.P = take((size_t)MP * INC * 2);
  p.U8 = (unsigned char*)take((size_t)16384 * 1024);
  p.V8 = (unsigned char*)take((size_t)16384 * 1024);
  p.SU = (float*)take(16384 * 4);
  p.SV = (float*)take(16384 * 4);
  p.SH = (float*)take((size_t)T * 4);
  p.WinT = take((size_t)4608 * 1024 * 2);
  p.WbT = take((size_t)2 * 1024 * 512 * 2);
  p.WoutT = take((size_t)1024 * 1024 * 2);
  p.WqT = take((size_t)1024 * 1024 * 2);
  p.W2T = take((size_t)512 * 64 * 2);
  p.A2T = take((size_t)512 * 64 * 2);
  p.G2T = take((size_t)512 * 128 * 2);
  p.SK = take((size_t)2 * 128 * 64 * 2);
  p.Y = take((size_t)T * 512 * 2);
  p.G = take((size_t)T * 512 * 2);
  p.OATT = take((size_t)T * 512 * 2);
  static int grid_blocks = 0;
  if (!grid_blocks) {
    int dev = 0, cus = 0, per_cu = 0;
    (void)hipGetDevice(&dev);
    (void)hipDeviceGetAttribute(&cus, hipDeviceAttributeMultiprocessorCount, dev);
    (void)hipFuncSetAttribute((const void*)mega_kernel, hipFuncAttributeMaxDynamicSharedMemorySize, DYN_LDS);
    (void)hipOccupancyMaxActiveBlocksPerMultiprocessor(&per_cu, mega_kernel, NTH, DYN_LDS);
    if (per_cu > 1) per_cu = 1;
    grid_blocks = cus * per_cu;
  }
  void* args[] = {&p};
  hipError_t e = hipLaunchCooperativeKernel((void*)mega_kernel, dim3(grid_blocks), dim3(NTH), args, DYN_LDS, stream);
  if (e != hipSuccess) fprintf(stderr, "cooperative launch failed: %s (grid %d)\n", hipGetErrorString(e), grid_blocks);
}
```

```cpp
#include <hip/hip_runtime.h>
#include <hip/hip_cooperative_groups.h>
#include <cstdio>
namespace cg = cooperative_groups;

#ifndef REP
#define REP -1
#endif
#ifndef ONLY
#define ONLY -1
#endif
#define ON(k) (ONLY < 0 || ONLY == (k))

typedef unsigned short u16;
typedef unsigned int u32;
using bf16x8 = __attribute__((ext_vector_type(8))) short;
using f32x4 = __attribute__((ext_vector_type(4))) float;
using f32x16 = __attribute__((ext_vector_type(16))) float;
using u32x4 = __attribute__((ext_vector_type(4))) u32;
#define DI __device__ __forceinline__

constexpr int TP = 65536, TS = 1024, T = 66560, MP = 66816;
constexpr int INC = 4608;
constexpr int NW = 8;
constexpr int NTH = 512;
constexpr size_t OFF_Y = 0, OFF_SHIFT_P = 68157440, OFF_WKV_P = 68173824, OFF_KP = 68698112, OFF_VP = 68960256,
                 OFF_SHIFT_S = 69222400, OFF_WKV_S = 69238784, OFF_KS = 69763072, OFF_VS = 69894144;
constexpr int DYN_LDS = 163840;

extern __shared__ __attribute__((aligned(16))) char dsm[];

struct Params {
  const float *x_prompt, *x_sample, *state_shift, *state_wkv, *cache_k, *cache_v, *norm1_g, *w_in, *mu, *w0, *w2, *a0,
      *a2, *g2, *k_k, *k_a, *r_k, *lnx_w, *lnx_b, *sinks, *w_branch, *w_out, *norm2_g, *peer_wq, *sub_keys, *peer_u,
      *peer_v, *final_g;
  float* out;
  u16 *H, *P, *WinT, *WbT, *WoutT, *WqT, *W2T, *A2T, *G2T, *SK, *Y, *G, *OATT;
  unsigned char *U8, *V8;
  float *SU, *SV, *SH;
};

typedef __bf16 hbf2 __attribute__((ext_vector_type(2)));
typedef float hf2 __attribute__((ext_vector_type(2)));
DI u16 f2bf(float x) { const __bf16 r = (__bf16)x; return __builtin_bit_cast(unsigned short, r); }
DI float bf2f(u16 b) { return __uint_as_float(((u32)b) << 16); }
DI u32 pack2(float a, float b) { const hf2 v = {a, b}; const hbf2 r = __builtin_convertvector(v, hbf2); return __builtin_bit_cast(u32, r); }
DI float bflo(u32 w) { return __uint_as_float(w << 16); }
DI float bfhi(u32 w) { return __uint_as_float(w & 0xffff0000u); }
DI float wave_sum(float v) {
#pragma unroll
  for (int o = 32; o; o >>= 1) v += __shfl_xor(v, o);
  return v;
}
DI float sigmoidf_(float x) { return 1.f / (1.f + __expf(-x)); }
DI const float* xrow(const Params& p, int g) {
  return g < TP ? p.x_prompt + (size_t)g * 1024 : p.x_sample + (size_t)(g - TP) * 1024;
}
DI int otid() { int t = threadIdx.x; asm volatile("" : "+v"(t)); return t; }
#define MFMA32(a, b, c) __builtin_amdgcn_mfma_f32_32x32x16_bf16((a), (b), (c), 0, 0, 0)
#define MFMA16(a, b, c) __builtin_amdgcn_mfma_f32_16x16x32_bf16((a), (b), (c), 0, 0, 0)

template <int CTRL>
DI float dppmov(float v) {
  return __int_as_float(__builtin_amdgcn_update_dpp(0, __float_as_int(v), CTRL, 0xF, 0xF, false));
}
DI float red16(float v) {
  v += dppmov<0x128>(v);
  v += dppmov<0x124>(v);
  v += dppmov<0x122>(v);
  v += dppmov<0x121>(v);
  return v;
}


using f32x2 = __attribute__((ext_vector_type(2))) float;
DI float wave_max(float v) {
#pragma unroll
  for (int o = 32; o; o >>= 1) v = fmaxf(v, __shfl_xor(v, o));
  return v;
}
DI u32 q4(float a, float b, float c, float d, float sc) {
  int w = 0;
  w = __builtin_amdgcn_cvt_pk_fp8_f32(a * sc, b * sc, w, false);
  w = __builtin_amdgcn_cvt_pk_fp8_f32(c * sc, d * sc, w, true);
  return (u32)w;
}

DI void tcvt(const float* __restrict__ W, u16* __restrict__ Wt, int K, int N, int gt, int nt) {
  const int total = N * (K / 8);
  for (int i = gt; i < total; i += nt) {
    const int n = i % N, kg = i / N;
    u32 o[4];
#pragma unroll
    for (int j = 0; j < 4; j++)
      o[j] = pack2(W[(size_t)(kg * 8 + 2 * j) * N + n], W[(size_t)(kg * 8 + 2 * j + 1) * N + n]);
    *(uint4*)(Wt + (size_t)n * K + kg * 8) = make_uint4(o[0], o[1], o[2], o[3]);
  }
}
DI void scvt(const float* __restrict__ W, u16* __restrict__ O, int n8, int gt, int nt) {
  for (int i = gt; i < n8; i += nt) {
    const float4 a = ((const float4*)W)[2 * i], b = ((const float4*)W)[2 * i + 1];
    ((uint4*)O)[i] = make_uint4(pack2(a.x, a.y), pack2(a.z, a.w), pack2(b.x, b.y), pack2(b.z, b.w));
  }
}

__device__ void ph_prep(const Params& p, int bid, int nb) {
  const int tid = otid(), lane = tid & 63, wv = tid >> 6;
  for (int row = bid * NW + wv; row < MP; row += nb * NW) {
    u16* hr = p.H + (size_t)row * 1024;
    if (row < T) {
      const float4* x = (const float4*)xrow(p, row);
      float4 v[4];
      float ss = 0.f;
#pragma unroll
      for (int i = 0; i < 4; i++) {
        v[i] = x[lane + i * 64];
        ss += v[i].x * v[i].x + v[i].y * v[i].y + v[i].z * v[i].z + v[i].w * v[i].w;
      }
      ss = wave_sum(ss);
      const float rs = rsqrtf(ss * (1.f / 1024.f) + 1e-6f);
      float* so = nullptr;
      if (row < TP) {
        if ((row & 4095) == 4095) so = p.out + OFF_SHIFT_P + (size_t)(row >> 12) * 1024;
      } else {
        const int r2 = row - TP;
        if ((r2 & 63) == 63) so = p.out + OFF_SHIFT_S + (size_t)(r2 >> 6) * 1024;
      }
#pragma unroll
      for (int i = 0; i < 4; i++) {
        const float4 g = ((const float4*)p.norm1_g)[lane + i * 64];
        float4 y;
        y.x = v[i].x * rs * g.x; y.y = v[i].y * rs * g.y; y.z = v[i].z * rs * g.z; y.w = v[i].w * rs * g.w;
        ((uint2*)hr)[lane + i * 64] = make_uint2(pack2(y.x, y.y), pack2(y.z, y.w));
        if (so) ((float4*)so)[lane + i * 64] = y;
      }
    } else if (row < T + 16) {
      const float4* x = (const float4*)(p.state_shift + (size_t)(row - T) * 1024);
#pragma unroll
      for (int i = 0; i < 4; i++) {
        const float4 y = x[lane + i * 64];
        ((uint2*)hr)[lane + i * 64] = make_uint2(pack2(y.x, y.y), pack2(y.z, y.w));
      }
    } else {
#pragma unroll
      for (int i = 0; i < 4; i++) ((uint2*)hr)[lane + i * 64] = make_uint2(0u, 0u);
    }
  }
  const int gt = bid * NTH + tid, nt = nb * NTH;
  tcvt(p.w_in, p.WinT, 1024, 4608, gt, nt);
  tcvt(p.w_branch, p.WbT, 512, 1024, gt, nt);
  tcvt(p.w_branch + 512 * 1024, p.WbT + 1024 * 512, 512, 1024, gt, nt);
  tcvt(p.w_out, p.WoutT, 1024, 1024, gt, nt);
  tcvt(p.peer_wq, p.WqT, 1024, 1024, gt, nt);
  tcvt(p.w2, p.W2T, 64, 512, gt, nt);
  tcvt(p.a2, p.A2T, 64, 512, gt, nt);
  tcvt(p.g2, p.G2T, 128, 512, gt, nt);
  scvt(p.sub_keys, p.SK, 2 * 128 * 64 / 8, gt, nt);
  for (int r = bid * NW + wv; r < 32768; r += nb * NW) {
    const bool isv = r >= 16384;
    const int e = r & 16383;
    const float4* src = (const float4*)((isv ? p.peer_v : p.peer_u) + (size_t)e * 1024) + lane * 4;
    const float4 a = src[0], b = src[1], c = src[2], d = src[3];
    float am = fmaxf(fmaxf(fmaxf(fabsf(a.x), fabsf(a.y)), fmaxf(fabsf(a.z), fabsf(a.w))),
                     fmaxf(fmaxf(fabsf(b.x), fabsf(b.y)), fmaxf(fabsf(b.z), fabsf(b.w))));
    am = fmaxf(am, fmaxf(fmaxf(fmaxf(fabsf(c.x), fabsf(c.y)), fmaxf(fabsf(c.z), fabsf(c.w))),
                         fmaxf(fmaxf(fabsf(d.x), fabsf(d.y)), fmaxf(fabsf(d.z), fabsf(d.w)))));
    am = fmaxf(wave_max(am), 1e-30f);
    const float sc = 240.f / am;
    if (lane == 0) (isv ? p.SV : p.SU)[e] = am * (1.f / 240.f);
    *(u32x4*)((isv ? p.V8 : p.U8) + (size_t)e * 1024 + lane * 16) =
        u32x4{q4(a.x, a.y, a.z, a.w, sc), q4(b.x, b.y, b.z, b.w, sc), q4(c.x, c.y, c.z, c.w, sc), q4(d.x, d.y, d.z, d.w, sc)};
  }
}

constexpr int GBK = 64, GHALF = 128, GHT = GHALF * GBK;
DI int lds_byte(int r, int c) {
  const int st = (r >> 4) * 2 + (c >> 5), rr = r & 15, cc = c & 31, ob = rr * 64 + cc * 2;
  return st * 1024 + (ob ^ (((ob >> 9) & 1) << 5));
}
DI void stage_rc(int b, int& R, int& C) {
  const int st = b / 1024, sb = b % 1024, swz = sb ^ (((sb >> 9) & 1) << 5);
  R = (st >> 1) * 16 + swz / 64;
  C = (st & 1) * 32 + (swz % 64) / 2;
}
typedef __attribute__((address_space(3))) unsigned lds_u32;
#define G_SA(b, h) (shm + ((b) * 2 + (h)) * GHT)
#define G_SB(b, h) (shm + (4 + (b) * 2 + (h)) * GHT)
#define G_STAGE(P_, RS, br, kt)                                                                                   \
  do {                                                                                                            \
    const int _so = ((br) * K + (kt) * GBK) * 2;                                                                  \
    __builtin_amdgcn_raw_ptr_buffer_load_lds(RS, (lds_u32*)((char*)(P_) + tb0), 16, ob0, _so, 0, 0);              \
    __builtin_amdgcn_raw_ptr_buffer_load_lds(RS, (lds_u32*)((char*)(P_) + tb0 + 8192), 16, ob1, _so, 0, 0);       \
  } while (0)
#define G_LDA(dst, b, h)                                  \
  _Pragma("unroll") for (int m = 0; m < 4; ++m)           \
  _Pragma("unroll") for (int k = 0; k < 2; ++k)           \
    dst[m][k] = *reinterpret_cast<const bf16x8*>((const char*)G_SA(b, h) + lds_byte(wr * 64 + m * 16 + fr, k * 32 + fq * 8))
#define G_LDB(dst, b, h)                                  \
  _Pragma("unroll") for (int n = 0; n < 2; ++n)           \
  _Pragma("unroll") for (int k = 0; k < 2; ++k)           \
    dst[n][k] = *reinterpret_cast<const bf16x8*>((const char*)G_SB(b, h) + lds_byte(wc * 32 + n * 16 + fr, k * 32 + fq * 8))
#define G_MMA(ai, bj, At_, Bt_)                                                                         \
  do {                                                                                                  \
    __builtin_amdgcn_s_setprio(1);                                                                      \
    _Pragma("unroll") for (int m = 0; m < 4; ++m)                                                       \
    _Pragma("unroll") for (int n = 0; n < 2; ++n)                                                       \
    _Pragma("unroll") for (int k = 0; k < 2; ++k)                                                       \
      acc[ai][bj][m][n] = MFMA16(At_[m][k], Bt_[n][k], acc[ai][bj][m][n]);                              \
    __builtin_amdgcn_s_setprio(0);                                                                      \
  } while (0)
#define WAIT_V(n) asm volatile("s_waitcnt vmcnt(" #n ")" ::: "memory")
#define WAIT_L(n) asm volatile("s_waitcnt lgkmcnt(" #n ")" ::: "memory")
#define BAR __builtin_amdgcn_s_barrier()
#define SCHED __builtin_amdgcn_sched_barrier(0)

template <int K>
DI void gemm256(const u16* __restrict__ A, const u16* __restrict__ Bt, const int brow, const int bcol,
                f32x4 (&acc)[2][2][4][2]) {
  u16* shm = (u16*)dsm;
  const int tid_ = otid();
  const int wid = tid_ >> 6, lane = tid_ & 63, wr = wid >> 2, wc = wid & 3, fr = lane & 15, fq = lane >> 4;
#pragma unroll
  for (int a = 0; a < 2; a++)
#pragma unroll
    for (int b = 0; b < 2; b++)
#pragma unroll
      for (int m = 0; m < 4; m++)
#pragma unroll
        for (int n = 0; n < 2; n++) acc[a][b][m][n] = f32x4{0.f, 0.f, 0.f, 0.f};
  bf16x8 At[4][2], B0[2][2], B1[2][2];
  constexpr int nt = K / GBK;
  const __amdgpu_buffer_rsrc_t rsA = __builtin_amdgcn_make_buffer_rsrc((void*)A, 0, 0x7fffffff, 0x00020000);
  const __amdgpu_buffer_rsrc_t rsB = __builtin_amdgcn_make_buffer_rsrc((void*)Bt, 0, 0x7fffffff, 0x00020000);
  const unsigned tb0 = tid_ * 16;
  int ob0, ob1;
  {
    int r_, c_;
    stage_rc((int)tb0, r_, c_);
    ob0 = (r_ * K + c_) * 2;
    stage_rc((int)tb0 + 8192, r_, c_);
    ob1 = (r_ * K + c_) * 2;
  }
  WAIT_V(0);
  __syncthreads();
  G_STAGE(G_SB(0, 0), rsB, bcol, 0); G_STAGE(G_SA(0, 0), rsA, brow, 0);
  G_STAGE(G_SB(0, 1), rsB, bcol + GHALF, 0); G_STAGE(G_SA(0, 1), rsA, brow + GHALF, 0);
  if (wr == 1) BAR;
  WAIT_V(4); BAR;
  G_STAGE(G_SB(1, 0), rsB, bcol, 1); G_STAGE(G_SA(1, 0), rsA, brow, 1); G_STAGE(G_SB(1, 1), rsB, bcol + GHALF, 1);
  WAIT_V(6); BAR;
  for (int t = 0; t < nt - 2; t += 2) {
    G_LDB(B0, 0, 0); SCHED; G_LDA(At, 0, 0); G_STAGE(G_SA(1, 1), rsA, brow + GHALF, t + 1);
    WAIT_L(8); BAR; WAIT_L(0); G_MMA(0, 0, At, B0); BAR; SCHED;
    G_LDB(B1, 0, 1); G_STAGE(G_SB(0, 0), rsB, bcol, t + 2);
    BAR; WAIT_L(0); G_MMA(0, 1, At, B1); BAR;
    G_LDA(At, 0, 1); G_STAGE(G_SA(0, 0), rsA, brow, t + 2);
    BAR; WAIT_L(0); G_MMA(1, 0, At, B0); BAR; SCHED;
    G_STAGE(G_SB(0, 1), rsB, bcol + GHALF, t + 2);
    WAIT_V(6); BAR; G_MMA(1, 1, At, B1); BAR;
    G_LDB(B0, 1, 0); SCHED; G_LDA(At, 1, 0); G_STAGE(G_SA(0, 1), rsA, brow + GHALF, t + 2);
    WAIT_L(8); BAR; WAIT_L(0); G_MMA(0, 0, At, B0); BAR; SCHED;
    G_LDB(B1, 1, 1); G_STAGE(G_SB(1, 0), rsB, bcol, t + 3);
    BAR; WAIT_L(0); G_MMA(0, 1, At, B1); BAR;
    G_LDA(At, 1, 1); G_STAGE(G_SA(1, 0), rsA, brow, t + 3);
    BAR; WAIT_L(0); G_MMA(1, 0, At, B0); BAR; SCHED;
    G_STAGE(G_SB(1, 1), rsB, bcol + GHALF, t + 3);
    WAIT_V(6); BAR; G_MMA(1, 1, At, B1); BAR;
  }
  {
    G_LDB(B0, 0, 0); G_LDA(At, 0, 0); G_STAGE(G_SA(1, 1), rsA, brow + GHALF, nt - 1);
    BAR; WAIT_L(0); G_MMA(0, 0, At, B0); BAR;
    G_LDB(B1, 0, 1); BAR; WAIT_L(0); G_MMA(0, 1, At, B1); BAR;
    G_LDA(At, 0, 1); WAIT_V(4); BAR; WAIT_L(0); G_MMA(1, 0, At, B0); G_MMA(1, 1, At, B1); BAR;
  }
  {
    G_LDB(B0, 1, 0); G_LDA(At, 1, 0); WAIT_V(2); BAR; WAIT_L(0); G_MMA(0, 0, At, B0); BAR;
    G_LDB(B1, 1, 1); WAIT_V(0); BAR; WAIT_L(0); G_MMA(0, 1, At, B1); BAR;
    G_LDA(At, 1, 1); BAR; WAIT_L(0); G_MMA(1, 0, At, B0); G_MMA(1, 1, At, B1); BAR;
  }
  if (wr == 0) BAR;
}
#define GT_VARS \
  const int tid_ = otid(); const int wid = tid_ >> 6, lane = tid_ & 63, wr = wid >> 2, wc = wid & 3, fr = lane & 15, fq = lane >> 4;
#define GT_ROW(ai, m, j) ((ai) * 128 + wr * 64 + (m) * 16 + fq * 4 + (j))
#define GT_COL(bj, n) ((bj) * 128 + wc * 32 + (n) * 16 + fr)
#define GT_FOR                                       \
  _Pragma("unroll") for (int ai = 0; ai < 2; ++ai)   \
  _Pragma("unroll") for (int bj = 0; bj < 2; ++bj)   \
  _Pragma("unroll") for (int m = 0; m < 4; ++m)      \
  _Pragma("unroll") for (int n = 0; n < 2; ++n)      \
  _Pragma("unroll") for (int j = 0; j < 4; ++j)

DI bool tile_of(int round, int bid, int nb, int nM, int nN, int& pm, int& pn) {
  const int vt = round * nb + (bid & 7) * (nb >> 3) + (bid >> 3);
  if (vt >= nM * nN) return false;
  const int nig = 8 * nN, gid = vt / nig, fm = gid * 8, gsz = min(nM - fm, 8);
  pm = fm + (vt % nig) % gsz;
  pn = (vt % nig) / gsz;
  return true;
}


constexpr int CS_LD = 264;
DI void acc_to_lds(const f32x4 (&acc)[2][2][4][2]) {
  GT_VARS
  u16* Cs = (u16*)dsm;
  __syncthreads();
  GT_FOR { Cs[GT_ROW(ai, m, j) * CS_LD + GT_COL(bj, n)] = f2bf(acc[ai][bj][m][n][j]); }
  __syncthreads();
}

__device__ void ph_gemm1(const Params& p, int bid, int nb) {
  const int tid_ = otid();
  const int nM = 261, nN = 18;
  for (int round = 0; round * nb < nM * nN; ++round) {
    int pm, pn;
    if (!tile_of(round, bid, nb, nM, nN, pm, pn)) break;
    f32x4 acc[2][2][4][2];
    gemm256<1024>(p.H, p.WinT, pm * 256, pn * 256, acc);
    acc_to_lds(acc);
    const u16* Cs = (const u16*)dsm;
#pragma unroll 4
    for (int it = 0; it < 16; it++) {
      const int id = it * NTH + tid_, rl = id >> 5, c8 = (id & 31) * 8;
      const int row = pm * 256 + rl;
      const u32x4 v = *(const u32x4*)(Cs + rl * CS_LD + c8);
      *(u32x4*)(p.P + (size_t)row * INC + pn * 256 + c8) = v;
      if (pn == 9) {
        float* dst = nullptr;
        const int c2 = c8 & 127;
        if (row < TP) {
          const int tt = row & 4095;
          if (tt >= 3968) dst = p.out + (c8 < 128 ? OFF_KP : OFF_VP) + ((size_t)(row >> 12) * 128 + (tt - 3968)) * 128 + c2;
        } else if (row < T) {
          dst = p.out + (c8 < 128 ? OFF_KS : OFF_VS) + (size_t)(row - TP) * 128 + c2;
        }
        if (dst) {
          *(float4*)dst = make_float4(bflo(v[0]), bfhi(v[0]), bflo(v[1]), bfhi(v[1]));
          *(float4*)(dst + 4) = make_float4(bflo(v[2]), bfhi(v[2]), bflo(v[3]), bfhi(v[3]));
        }
      }
    }
  }
}

DI int prev_row(int g) {
  if (g < TP) return (g & 4095) ? g - 1 : -1;
  const int r2 = g - TP;
  return (r2 & 63) ? g - 1 : T + (r2 >> 6);
}

__device__ void ph_rwprep(const Params& p, int bid, int nb) {
  const int tid = otid(), lane = tid & 63, wv = tid >> 6, fr = lane & 15, fq = lane >> 4;
  u16* A1 = (u16*)dsm;
  u16* A2 = A1 + 64 * 80;
  u16* A3 = A2 + 64 * 80;
  u16* SA = (u16*)(p.out);
  u16* SB = p.H;
  const int hd = wv;
  u16* OT = (u16*)(dsm + 38912 + wv * 12288);
  u32x4 pin[7];
  for (int tile = bid; tile < T / 64; tile += nb) {
    const int g0 = tile * 64;
    auto issue_in = [&](int rg_) {
#pragma unroll
      for (int it = 0; it < 7; it++) {
        const int id = it * 64 + lane, ri = id / 24, rem = id - ri * 24, arr = rem >> 3, ch = rem & 7;
        int tok = g0 + rg_ * 16 - 1 + ri;
        if (rg_ == 0 && ri == 0) tok = prev_row(g0);
        pin[it] = u32x4{0u, 0u, 0u, 0u};
        if (id < 408 && tok >= 0) pin[it] = *(const u32x4*)(p.P + (size_t)tok * INC + arr * 512 + hd * 64 + ch * 8);
      }
    };
    __syncthreads();
    {
      const int row = tid >> 3, part8 = tid & 7, part = part8 >> 1, sub = part8 & 1;
      const int g = g0 + row, pr = prev_row(g);
      const int cb = 1536 + part * 64 + sub * 32;
      const u16* cur = p.P + (size_t)g * INC + cb;
      const u16* prv = p.P + (size_t)(pr < 0 ? 0 : pr) * INC + cb;
#pragma unroll
      for (int q = 0; q < 4; q++) {
        const u32x4 c4 = *(const u32x4*)(cur + q * 8);
        u32x4 p4 = {0u, 0u, 0u, 0u};
        if (pr >= 0) p4 = *(const u32x4*)(prv + q * 8);
        u32x4 ow;
#pragma unroll
        for (int e = 0; e < 4; e++) {
          const float c0 = bflo(c4[e]), c1 = bfhi(c4[e]), q0 = bflo(p4[e]), q1 = bfhi(p4[e]);
          float f0 = c0 + (q0 - c0) * p.mu[cb + q * 8 + 2 * e];
          float f1 = c1 + (q1 - c1) * p.mu[cb + q * 8 + 2 * e + 1];
          if (part == 0) { f0 = 1.f - 2.f / (1.f + __expf(2.f * f0)); f1 = 1.f - 2.f / (1.f + __expf(2.f * f1)); }
          else if (part >= 2) { f0 = sigmoidf_(f0); f1 = sigmoidf_(f1); }
          ow[e] = pack2(f0, f1);
        }
        u16* dst = part == 0 ? A1 + row * 80 + sub * 32 + q * 8
                 : part == 1 ? A2 + row * 80 + sub * 32 + q * 8
                             : A3 + row * 144 + (part - 2) * 64 + sub * 32 + q * 8;
        *(u32x4*)dst = ow;
      }
    }
    __syncthreads();
#pragma unroll 1
    for (int rg = 0; rg < 4; rg++) {
      issue_in(rg);
#pragma unroll
      for (int it = 0; it < 7; it++) {
        const int id = it * 64 + lane;
        if (id < 408) *(u32x4*)(OT + id * 8) = pin[it];
      }
      __builtin_amdgcn_fence(__ATOMIC_RELEASE, "workgroup");
      __builtin_amdgcn_wave_barrier();
      float inr[5][3][4];
#pragma unroll
      for (int jj = 0; jj < 5; jj++)
#pragma unroll
        for (int ar = 0; ar < 3; ar++)
#pragma unroll
          for (int nt = 0; nt < 4; nt++) inr[jj][ar][nt] = bf2f(OT[((fq * 4 + jj) * 3 + ar) * 64 + nt * 16 + fr]);
      __builtin_amdgcn_fence(__ATOMIC_RELEASE, "workgroup");
      __builtin_amdgcn_wave_barrier();
      SCHED;
      f32x4 aw[4], aa[4];
#pragma unroll
      for (int nt = 0; nt < 4; nt++) { aw[nt] = f32x4{0.f, 0.f, 0.f, 0.f}; aa[nt] = f32x4{0.f, 0.f, 0.f, 0.f}; }
#pragma unroll 1
      for (int ks = 0; ks < 2; ks++) {
        const bf16x8 f1 = *(const bf16x8*)(A1 + (rg * 16 + fr) * 80 + ks * 32 + fq * 8);
        const bf16x8 f2 = *(const bf16x8*)(A2 + (rg * 16 + fr) * 80 + ks * 32 + fq * 8);
#pragma unroll
        for (int nt = 0; nt < 4; nt++) {
          const bf16x8 bw = *(const bf16x8*)(p.W2T + (unsigned)((hd * 64 + nt * 16 + fr) * 64 + ks * 32 + fq * 8));
          const bf16x8 ba = *(const bf16x8*)(p.A2T + (unsigned)((hd * 64 + nt * 16 + fr) * 64 + ks * 32 + fq * 8));
          aw[nt] = MFMA16(f1, bw, aw[nt]);
          aa[nt] = MFMA16(f2, ba, aa[nt]);
        }
      }
      float ss[4] = {0.f, 0.f, 0.f, 0.f};
      const int rowb = rg * 16 + fq * 4;
      const int gb = g0 + rowb;
#pragma unroll
      for (int nt = 0; nt < 4; nt++) {
        const int c = nt * 16 + fr, col = hd * 64 + c;
        const float mu_r = p.mu[col], mu_k = p.mu[512 + col], mu_v = p.mu[1024 + col];
        const float w0c = p.w0[col], a0c = p.a0[col], kkc = p.k_k[col], kac = p.k_a[col];
        float qr = inr[0][0][nt], qk = inr[0][1][nt], qv = inr[0][2][nt];
#pragma unroll
        for (int j = 0; j < 4; j++) {
          const float cr = inr[j + 1][0][nt], ck = inr[j + 1][1][nt], cv = inr[j + 1][2][nt];
          const float r = cr + (qr - cr) * mu_r, k = ck + (qk - ck) * mu_k, v = cv + (qv - cv) * mu_v;
          qr = cr; qk = ck; qv = cv;
          const float ed = 0.6065306597126334f * sigmoidf_(w0c + aw[nt][j]);
          const float dm = 1.f - __expf(-ed);
          const float a = sigmoidf_(a0c + aa[nt][j]);
          const float kkv = k * kkc;
          ss[j] += kkv * kkv;
          const float k2 = k * (1.f + (a - 1.f) * kac);
          u16* ot = OT + (fq * 4 + j) * 384 + c;
          ot[0] = f2bf(r);
          ot[64] = f2bf(dm);
          ot[128] = f2bf(k2);
          ot[256] = f2bf(v);
          aw[nt][j] = kkv;
          aa[nt][j] = a;
        }
        SCHED;
      }
#pragma unroll
      for (int j = 0; j < 4; j++) ss[j] = 1.f / fmaxf(sqrtf(red16(ss[j])), 1e-12f);
#pragma unroll
      for (int nt = 0; nt < 4; nt++) {
        const int c = nt * 16 + fr;
#pragma unroll
        for (int j = 0; j < 4; j++) {
          const float kkn = aw[nt][j] * ss[j];
          u16* ot = OT + (fq * 4 + j) * 384 + c;
          ot[192] = f2bf(kkn);
          ot[320] = f2bf(kkn * aa[nt][j]);
        }
      }
      __builtin_amdgcn_fence(__ATOMIC_RELEASE, "workgroup");
      __builtin_amdgcn_wave_barrier();
      {
        const int gr0 = g0 + rg * 16;
#pragma unroll 4
        for (int it = 0; it < 12; it++) {
          const int id = it * 64 + lane, rowi = id / 48, pc = id % 48;
          const u32x4 v4 = *(const u32x4*)(OT + rowi * 384 + pc * 8);
          const size_t gh = (size_t)(gr0 + rowi) * 8 + hd;
          if (pc < 32) *(u32x4*)(SA + gh * 256 + pc * 8) = v4;
          else *(u32x4*)(SB + gh * 128 + (pc - 32) * 8) = v4;
        }
      }
      __builtin_amdgcn_wave_barrier();
      f32x4 ag[4];
#pragma unroll
      for (int nt = 0; nt < 4; nt++) ag[nt] = f32x4{0.f, 0.f, 0.f, 0.f};
#pragma unroll 1
      for (int ks = 0; ks < 4; ks++) {
        const bf16x8 f3 = *(const bf16x8*)(A3 + (rg * 16 + fr) * 144 + ks * 32 + fq * 8);
#pragma unroll
        for (int nt = 0; nt < 4; nt++) {
          const bf16x8 bg = *(const bf16x8*)(p.G2T + (unsigned)((hd * 64 + nt * 16 + fr) * 128 + ks * 32 + fq * 8));
          ag[nt] = MFMA16(f3, bg, ag[nt]);
        }
      }
#pragma unroll
      for (int nt = 0; nt < 4; nt++)
#pragma unroll
        for (int j = 0; j < 4; j++) p.G[(size_t)(gb + j) * 512 + hd * 64 + nt * 16 + fr] = f2bf(ag[nt][j]);
    }
  }
}

DI float red8(float v) {
  v += dppmov<0xB1>(v);
  v += dppmov<0x4E>(v);
  v += dppmov<0x141>(v);
  return v;
}
struct ScanOps { f32x4 r, d, k, n, b; float v; };
DI void scan_ld(ScanOps& o, const float* sb, int j0, int row) {
  o.r = *(const f32x4*)(sb + j0);
  o.d = *(const f32x4*)(sb + 64 + j0);
  o.k = *(const f32x4*)(sb + 128 + j0);
  o.n = *(const f32x4*)(sb + 192 + j0);
  o.b = *(const f32x4*)(sb + 320 + j0);
  o.v = sb[256 + row];
}
#define LO2(x) __builtin_shufflevector((x), (x), 0, 1)
#define HI2(x) __builtin_shufflevector((x), (x), 2, 3)
DI float scan_step(f32x2 (&S)[2], const ScanOps& o, f32x4& rprev) {
  const f32x2 vv = {o.v, o.v};
  const f32x2 tt = S[0] * LO2(o.n) + S[1] * HI2(o.n);
  const f32x2 yy = S[0] * LO2(rprev) + S[1] * HI2(rprev);
  const f32x2 m0 = S[0] * LO2(o.d) + vv * LO2(o.k);
  const f32x2 m1 = S[1] * HI2(o.d) + vv * HI2(o.k);
  float a = tt[0] + tt[1], y = yy[0] + yy[1];
  a += dppmov<0x128>(a); y += dppmov<0x128>(y);
  a += dppmov<0x124>(a); y += dppmov<0x124>(y);
  a += dppmov<0x122>(a); y += dppmov<0x122>(y);
  a += dppmov<0x121>(a); y += dppmov<0x121>(y);
  const float sa = -a;
  const f32x2 sv = {sa, sa};
  S[0] = m0 + sv * LO2(o.b);
  S[1] = m1 + sv * HI2(o.b);
  rprev = o.r;
  return y;
}

__device__ void ph_scan(const Params& p, int bid, int nb) {
  const int tid = otid(), lane = tid & 63, wv = tid >> 6;
  float* buf = (float*)dsm;
  const u16* SA = (const u16*)(p.out);
  const u16* SB = p.H;
  constexpr int CH = 32;
  for (int item = bid; item < 512; item += nb) {
    const int type = item >> 8, r_ = item & 255, half = r_ & 1, hb = r_ >> 1, h = hb & 7, b = hb >> 3;
    const int nch = type ? 64 / CH : 4096 / CH;
    const int gbase = type ? TP + b * 64 : b * 4096;
    const bool active = true;
    const int row = half * 32 + wv * 4 + (lane >> 4), j0 = (lane & 15) * 4;
    f32x2 S[2];
#pragma unroll
    for (int j = 0; j < 2; j++) S[j] = f32x2{0.f, 0.f};
    if (type && active) {
      const float* s0 = p.state_wkv + ((size_t)(b * 8 + h) * 64 + row) * 64 + j0;
#pragma unroll
      for (int j = 0; j < 2; j++) S[j] = f32x2{s0[2 * j], s0[2 * j + 1]};
    }
    f32x4 rprev = {0.f, 0.f, 0.f, 0.f};
    float ykeep = 0.f;
    u32x4 la[2], lb;
    auto gload = [&](int c) {
#pragma unroll
      for (int q = 0; q < 2; q++) {
        const int idx = tid + q * NTH, step = idx >> 5, u = idx & 31;
        la[q] = *(const u32x4*)(SA + ((size_t)(gbase + c * CH + step) * 8 + h) * 256 + u * 8);
      }
      {
        const int step = tid >> 4, u = tid & 15;
        lb = *(const u32x4*)(SB + ((size_t)(gbase + c * CH + step) * 8 + h) * 128 + u * 8);
      }
    };
    gload(0);
    for (int c = 0; c < nch; c++) {
      __syncthreads();
#pragma unroll
      for (int q = 0; q < 2; q++) {
        const int idx = tid + q * NTH, step = idx >> 5, u = idx & 31, arr = u >> 3, c0 = (u & 7) * 8;
        float* d = buf + step * 384 + arr * 64 + c0;
        float f[8];
#pragma unroll
        for (int e = 0; e < 4; e++) { f[2 * e] = bflo(la[q][e]); f[2 * e + 1] = bfhi(la[q][e]); }
        if (arr == 1) {
#pragma unroll
          for (int e = 0; e < 8; e++) f[e] = 1.f - f[e];
        }
        *(float4*)d = make_float4(f[0], f[1], f[2], f[3]);
        *(float4*)(d + 4) = make_float4(f[4], f[5], f[6], f[7]);
      }
      {
        const int step = tid >> 4, u = tid & 15, arr = u >> 3, c0 = (u & 7) * 8;
        float* d = buf + step * 384 + (4 + arr) * 64 + c0;
        *(float4*)d = make_float4(bflo(lb[0]), bfhi(lb[0]), bflo(lb[1]), bfhi(lb[1]));
        *(float4*)(d + 4) = make_float4(bflo(lb[2]), bfhi(lb[2]), bflo(lb[3]), bfhi(lb[3]));
      }
      __syncthreads();
      if (c + 1 < nch) gload(c + 1);
      if (active) {
        ScanOps A0, A1, B0, B1;
        scan_ld(A0, buf, j0, row);
        scan_ld(A1, buf + 384, j0, row);
#pragma unroll 1
        for (int s = 0; s < CH; s += 4) {
          scan_ld(B0, buf + (s + 2) * 384, j0, row);
          scan_ld(B1, buf + (s + 3) * 384, j0, row);
          SCHED;
          {
            const int g0 = c * CH + s;
            const float y0 = scan_step(S, A0, rprev);
            ykeep = ((lane & 15) == ((g0 - 1) & 15)) ? y0 : ykeep;
            if ((g0 & 15) == 0 && g0 > 0)
              p.Y[(size_t)(gbase + g0 - 16 + (lane & 15)) * 512 + h * 64 + row] = f2bf(ykeep);
            const float y1 = scan_step(S, A1, rprev);
            ykeep = ((lane & 15) == (g0 & 15)) ? y1 : ykeep;
          }
          SCHED;
          const int sn = (s + 4 < CH) ? s + 4 : s;
          scan_ld(A0, buf + sn * 384, j0, row);
          scan_ld(A1, buf + (sn + 1) * 384, j0, row);
          SCHED;
          {
            const int g0 = c * CH + s;
            const float y2 = scan_step(S, B0, rprev);
            ykeep = ((lane & 15) == ((g0 + 1) & 15)) ? y2 : ykeep;
            const float y3 = scan_step(S, B1, rprev);
            ykeep = ((lane & 15) == ((g0 + 2) & 15)) ? y3 : ykeep;
          }
          SCHED;
        }
      }
    }
    if (active) {
      const f32x2 yy = S[0] * LO2(rprev) + S[1] * HI2(rprev);
      const float yl = red16(yy[0] + yy[1]);
      ykeep = ((lane & 15) == 15) ? yl : ykeep;
      p.Y[(size_t)(gbase + nch * CH - 16 + (lane & 15)) * 512 + h * 64 + row] = f2bf(ykeep);
    }
    if (active) {
      float* so = p.out + (type ? OFF_WKV_S : OFF_WKV_P) + ((size_t)(b * 8 + h) * 64 + row) * 64 + j0;
      *(float4*)so = make_float4(S[0][0], S[0][1], S[1][0], S[1][1]);
    }
  }
}

__device__ void ph_attn(const Params& p, int bid, int nb, bool dry = false) {
  const int tid = otid(), lane = tid & 63, wv = tid >> 6, fr = lane & 15, fq = lane >> 4;
  u16* Ks = (u16*)dsm;
  u16* Vt = Ks + 192 * 72;
  for (int item = bid; item < 2080; item += nb) {
    const int kvh = item & 1, r = item >> 1;
    const bool samp = r >= 1024;
    const int b = samp ? r - 1024 : r >> 6, c = samp ? 0 : (r & 63);
    const int gq0 = samp ? TP + b * 64 : b * 4096 + c * 64;
    __syncthreads();
#pragma unroll
    for (int q = 0; q < 3; q++) {
      const int idx = tid + q * NTH, j = idx >> 3, d0 = (idx & 7) * 8;
      u32x4 kq = {0u, 0u, 0u, 0u}, vq = {0u, 0u, 0u, 0u};
      if (!samp) {
        const int tok = (c - 2) * 64 + j;
        if (tok >= 0) {
          const u16* src = p.P + (size_t)(b * 4096 + tok) * INC + 2304 + kvh * 64 + d0;
          kq = *(const u32x4*)src;
          vq = *(const u32x4*)(src + 128);
        }
      } else if (j < 128) {
        const float4* ck = (const float4*)(p.cache_k + ((size_t)(b * 128 + j) * 2 + kvh) * 64 + d0);
        const float4* cv = (const float4*)(p.cache_v + ((size_t)(b * 128 + j) * 2 + kvh) * 64 + d0);
        const float4 k0 = ck[0], k1 = ck[1], v0 = cv[0], v1 = cv[1];
        kq = u32x4{pack2(k0.x, k0.y), pack2(k0.z, k0.w), pack2(k1.x, k1.y), pack2(k1.z, k1.w)};
        vq = u32x4{pack2(v0.x, v0.y), pack2(v0.z, v0.w), pack2(v1.x, v1.y), pack2(v1.z, v1.w)};
      } else {
        const u16* src = p.P + (size_t)(TP + b * 64 + (j - 128)) * INC + 2304 + kvh * 64 + d0;
        kq = *(const u32x4*)src;
        vq = *(const u32x4*)(src + 128);
      }
      *(u32x4*)(Ks + j * 72 + d0) = kq;
#pragma unroll
      for (int e = 0; e < 4; e++) {
        Vt[(d0 + 2 * e) * 196 + j] = (u16)(vq[e] & 0xffffu);
        Vt[(d0 + 2 * e + 1) * 196 + j] = (u16)(vq[e] >> 16);
      }
    }
    __syncthreads();
    const int qh = kvh * 4 + (wv & 3);
    const float slope = exp2f(-(float)(qh + 1)), sink = p.sinks[qh];
#pragma unroll 1
    for (int ps = 0; ps < 2; ps++) {
      const int q0 = (wv >> 2) * 32 + ps * 16;
      const int tq = q0 + fr;
      const u16* qp = p.P + (size_t)(gq0 + tq) * INC + 1792 + qh * 64 + fq * 8;
      const bf16x8 qf0 = *(const bf16x8*)(qp), qf1 = *(const bf16x8*)(qp + 32);
      f32x4 sc[12];
#pragma unroll
      for (int kt = 0; kt < 12; kt++) {
        sc[kt] = f32x4{0.f, 0.f, 0.f, 0.f};
        const bf16x8 a0 = *(const bf16x8*)(Ks + (kt * 16 + fr) * 72 + fq * 8);
        const bf16x8 a1 = *(const bf16x8*)(Ks + (kt * 16 + fr) * 72 + 32 + fq * 8);
        sc[kt] = MFMA16(a0, qf0, sc[kt]);
        sc[kt] = MFMA16(a1, qf1, sc[kt]);
        if ((kt & 3) == 3) SCHED;
      }
      float mx = -3e38f;
#pragma unroll
      for (int kt = 0; kt < 12; kt++)
#pragma unroll
        for (int j = 0; j < 4; j++) {
          const int key = kt * 16 + fq * 4 + j;
          float s = sc[kt][j] * 0.125f - slope * fabsf((float)(128 + tq - key));
          if (!samp && (c - 2) * 64 + key < 0) s = -1e30f;
          sc[kt][j] = s;
          mx = fmaxf(mx, s);
        }
      mx = fmaxf(mx, __shfl_xor(mx, 16));
      mx = fmaxf(mx, __shfl_xor(mx, 32));
      mx = fmaxf(mx, sink);
      float sum = 0.f;
#pragma unroll
      for (int kt = 0; kt < 12; kt++)
#pragma unroll
        for (int j = 0; j < 4; j++) {
          const float e = __expf(sc[kt][j] - mx);
          sc[kt][j] = e;
          sum += e;
        }
      sum += __shfl_xor(sum, 16);
      sum += __shfl_xor(sum, 32);
      sum += __expf(sink - mx);
      const float inv = 1.f / sum;
      f32x4 o[4];
#pragma unroll
      for (int dt = 0; dt < 4; dt++) o[dt] = f32x4{0.f, 0.f, 0.f, 0.f};
#pragma unroll
      for (int t2 = 0; t2 < 6; t2++) {
        const u32x4 pw = {pack2(sc[2 * t2][0] * inv, sc[2 * t2][1] * inv), pack2(sc[2 * t2][2] * inv, sc[2 * t2][3] * inv),
                          pack2(sc[2 * t2 + 1][0] * inv, sc[2 * t2 + 1][1] * inv),
                          pack2(sc[2 * t2 + 1][2] * inv, sc[2 * t2 + 1][3] * inv)};
        const bf16x8 pa = __builtin_bit_cast(bf16x8, pw);
#pragma unroll
        for (int dt = 0; dt < 4; dt++) {
          const u16* vp = Vt + (dt * 16 + fr) * 196 + t2 * 32 + fq * 4;
          const uint2 v0 = *(const uint2*)vp, v1 = *(const uint2*)(vp + 16);
          const bf16x8 vb = __builtin_bit_cast(bf16x8, u32x4{v0.x, v0.y, v1.x, v1.y});
          o[dt] = MFMA16(pa, vb, o[dt]);
        }
        SCHED;
      }
#pragma unroll
      for (int dt = 0; dt < 4; dt++)
#pragma unroll
        for (int j = 0; j < 4; j++)
          p.OATT[(size_t)(gq0 + q0 + fq * 4 + j) * 512 + qh * 64 + dt * 16 + fr] = f2bf(o[dt][j]);
    }
  }
  const u16* SA = (const u16*)(p.out);
  const u16* SB = p.H;
  for (int it4 = bid * NW + wv; it4 < T * 2; it4 += nb * NW) {
    const int it = it4 * 4 + (lane >> 4), c0 = (lane & 15) * 4;
    const int g = it >> 3, h = it & 7, col = h * 64 + c0;
    const uint2 yw = *(const uint2*)(p.Y + (size_t)g * 512 + col);
    const uint2 rw = *(const uint2*)(SA + (size_t)it * 256 + c0), kw = *(const uint2*)(SA + (size_t)it * 256 + 128 + c0);
    const uint2 vw = *(const uint2*)(SB + (size_t)it * 128 + c0), gw = *(const uint2*)(p.G + (size_t)g * 512 + col);
    const float4 lw = *(const float4*)(p.lnx_w + col), lb = *(const float4*)(p.lnx_b + col), rk = *(const float4*)(p.r_k + col);
    const float y0 = bflo(yw.x), y1 = bfhi(yw.x), y2 = bflo(yw.y), y3 = bfhi(yw.y);
    const float mean = red16((y0 + y1) + (y2 + y3)) * (1.f / 64.f);
    const float e0 = y0 - mean, e1 = y1 - mean, e2 = y2 - mean, e3 = y3 - mean;
    const float var = red16((e0 * e0 + e1 * e1) + (e2 * e2 + e3 * e3)) * (1.f / 64.f);
    const float bonus = red16((bflo(rw.x) * bflo(kw.x) * rk.x + bfhi(rw.x) * bfhi(kw.x) * rk.y) +
                              (bflo(rw.y) * bflo(kw.y) * rk.z + bfhi(rw.y) * bfhi(kw.y) * rk.w));
    const float rsd = rsqrtf(var + 64e-5f);
    const float o0 = (e0 * rsd * lw.x + lb.x + bonus * bflo(vw.x)) * bflo(gw.x);
    const float o1 = (e1 * rsd * lw.y + lb.y + bonus * bfhi(vw.x)) * bfhi(gw.x);
    const float o2 = (e2 * rsd * lw.z + lb.z + bonus * bflo(vw.y)) * bflo(gw.y);
    const float o3 = (e3 * rsd * lw.w + lb.w + bonus * bfhi(vw.y)) * bfhi(gw.y);
    if (!dry || o0 == 123.456f) *(uint2*)(p.Y + (size_t)g * 512 + col) = make_uint2(pack2(o0, o1), pack2(o2, o3));
  }
}

__device__ void ph_gemm2(const Params& p, int bid, int nb) {
  const int tid_ = otid();
  u16* MG = p.H;
  const u16* Cs = (const u16*)dsm;
  const int nM = 260, nN = 4;
  for (int round = 0; round * nb < nM * nN; ++round) {
    int pm, pn;
    if (!tile_of(round, bid, nb, nM, nN, pm, pn)) break;
    f32x4 acc[2][2][4][2];
#pragma unroll 1
    for (int br = 0; br < 2; br++) {
      gemm256<512>(br ? p.OATT : p.Y, p.WbT + (size_t)br * 1024 * 512, pm * 256, pn * 256, acc);
      acc_to_lds(acc);
#pragma unroll 2
      for (int it = 0; it < 16; it++) {
        const int id = it * NTH + tid_, rl = id >> 5, c8 = (id & 31) * 8;
        const int row = pm * 256 + rl, col = pn * 256 + c8;
        const u32x4 v = *(const u32x4*)(Cs + rl * CS_LD + c8);
        const u32x4 gw = *(const u32x4*)(p.P + (size_t)row * INC + 2560 + br * 1024 + col);
        u32x4 prev = {0u, 0u, 0u, 0u};
        if (br) prev = *(const u32x4*)(MG + (size_t)row * 1024 + col);
        u32x4 o;
#pragma unroll
        for (int e = 0; e < 4; e++) {
          const float r0 = bflo(prev[e]) + sigmoidf_(bflo(gw[e])) * bflo(v[e]);
          const float r1 = bfhi(prev[e]) + sigmoidf_(bfhi(gw[e])) * bfhi(v[e]);
          o[e] = pack2(r0, r1);
        }
        *(u32x4*)(MG + (size_t)row * 1024 + col) = o;
      }
    }
  }
}

__device__ void ph_gemm3(const Params& p, int bid, int nb) {
  const int tid_ = otid();
  const u16* MG = p.H;
  const u16* Cs = (const u16*)dsm;
  const int nM = 260, nN = 4;
  for (int round = 0; round * nb < nM * nN; ++round) {
    int pm, pn;
    if (!tile_of(round, bid, nb, nM, nN, pm, pn)) break;
    f32x4 acc[2][2][4][2];
    gemm256<1024>(MG, p.WoutT, pm * 256, pn * 256, acc);
    acc_to_lds(acc);
#pragma unroll 2
    for (int it = 0; it < 16; it++) {
      const int id = it * NTH + tid_, rl = id >> 5, c8 = (id & 31) * 8;
      const int row = pm * 256 + rl, col = pn * 256 + c8;
      const u32x4 v = *(const u32x4*)(Cs + rl * CS_LD + c8);
      const float* xr = xrow(p, row) + col;
      const float4 x0 = *(const float4*)xr, x1 = *(const float4*)(xr + 4);
      float* dst = p.out + (size_t)row * 1024 + col;
      *(float4*)dst = make_float4(x0.x + bflo(v[0]), x0.y + bfhi(v[0]), x0.z + bflo(v[1]), x0.w + bfhi(v[1]));
      *(float4*)(dst + 4) = make_float4(x1.x + bflo(v[2]), x1.y + bfhi(v[2]), x1.z + bflo(v[3]), x1.w + bfhi(v[3]));
    }
  }
}

__device__ void ph_norm2(const Params& p, int bid, int nb) {
  const int tid = otid(), lane = tid & 63, wv = tid >> 6;
  for (int row = bid * NW + wv; row < T; row += nb * NW) {
    const float4* x = (const float4*)(p.out + (size_t)row * 1024);
    float4 v[4];
    float ss = 0.f;
#pragma unroll
    for (int i = 0; i < 4; i++) {
      v[i] = x[lane + i * 64];
      ss += v[i].x * v[i].x + v[i].y * v[i].y + v[i].z * v[i].z + v[i].w * v[i].w;
    }
    ss = wave_sum(ss);
    const float rs = rsqrtf(ss * (1.f / 1024.f) + 1e-6f);
    u16* hr = p.H + (size_t)row * 1024;
    float4 y[4];
    float am = 0.f;
#pragma unroll
    for (int i = 0; i < 4; i++) {
      const float4 g = ((const float4*)p.norm2_g)[lane + i * 64];
      y[i] = make_float4(v[i].x * rs * g.x, v[i].y * rs * g.y, v[i].z * rs * g.z, v[i].w * rs * g.w);
      ((uint2*)hr)[lane + i * 64] = make_uint2(pack2(y[i].x, y[i].y), pack2(y[i].z, y[i].w));
      am = fmaxf(am, fmaxf(fmaxf(fabsf(y[i].x), fabsf(y[i].y)), fmaxf(fabsf(y[i].z), fabsf(y[i].w))));
    }
    am = fmaxf(wave_max(am), 1e-30f);
    const float sc = 240.f / am;
    if (lane == 0) p.SH[row] = am * (1.f / 240.f);
    u32* h8 = (u32*)((unsigned char*)p.Y + (size_t)row * 1024);
#pragma unroll
    for (int i = 0; i < 4; i++) h8[lane + i * 64] = q4(y[i].x, y[i].y, y[i].z, y[i].w, sc);
  }
}

DI void ins16(float (&l)[16], float x) {
#pragma unroll
  for (int i = 0; i < 16; i++) {
    const float hi = fmaxf(l[i], x);
    x = fminf(l[i], x);
    l[i] = hi;
  }
}


DI void ce_desc(float& a, float& b) { const float hi = fmaxf(a, b), lo = fminf(a, b); a = hi; b = lo; }
DI void bitonic_sort16_desc(float (&a)[16]) {
#pragma unroll
  for (int k = 2; k <= 16; k <<= 1)
#pragma unroll
    for (int j = k >> 1; j > 0; j >>= 1)
#pragma unroll
      for (int i = 0; i < 16; i++) {
        const int l = i ^ j;
        if (l > i) {
          if ((i & k) == 0) ce_desc(a[i], a[l]);
          else ce_desc(a[l], a[i]);
        }
      }
}
DI void bitonic_merge16_desc(float (&a)[16]) {
#pragma unroll
  for (int j = 8; j > 0; j >>= 1)
#pragma unroll
    for (int i = 0; i < 16; i++) {
      const int l = i ^ j;
      if (l > i) ce_desc(a[i], a[l]);
    }
}
DI void top16_merge(float (&a)[16], const float (&b)[16]) {
#pragma unroll
  for (int i = 0; i < 16; i++) a[i] = fmaxf(a[i], b[15 - i]);
  bitonic_merge16_desc(a);
}

__device__ void ph_peerq(const Params& p, int bid, int nb) {
  GT_VARS
  const int l31 = lane & 31, kh = lane >> 5;
  u16* Qs = (u16*)dsm;
  unsigned char* lt = (unsigned char*)(dsm + 135168 + wid * 1024);
  int* IDX = (int*)p.G;
  float* GATE = (float*)p.OATT;
  const int nM = 260, nN = 4;
  for (int round = 0; round * nb < nM * nN; ++round) {
    int pm, pn;
    if (!tile_of(round, bid, nb, nM, nN, pm, pn)) break;
    {
      f32x4 acc[2][2][4][2];
      gemm256<1024>(p.H, p.WqT, pm * 256, pn * 256, acc);
      acc_to_lds(acc);
    }
#pragma unroll 1
    for (int hh = 0; hh < 2; hh++) {
      const int hp = pn * 2 + hh;
      float l1[16], l2[16];
#pragma unroll
      for (int i = 0; i < 16; i++) { l1[i] = 0.f; l2[i] = 0.f; }
#pragma unroll 1
      for (int pp = 0; pp < 2; pp++) {
        f32x16 sc[4];
#pragma unroll
        for (int m4 = 0; m4 < 4; m4++) {
#pragma unroll
          for (int i = 0; i < 16; i++) sc[m4][i] = 0.f;
#pragma unroll
          for (int kk = 0; kk < 4; kk++) {
            const bf16x8 a = *(const bf16x8*)(p.SK + (size_t)(pp * 128 + m4 * 32 + l31) * 64 + kk * 16 + kh * 8);
            const bf16x8 bq = *(const bf16x8*)(Qs + (wid * 32 + l31) * 264 + hh * 128 + pp * 64 + kk * 16 + kh * 8);
            sc[m4] = MFMA32(a, bq, sc[m4]);
          }
        }
        float l[16], q1[16], q2[16], q3[16];
#pragma unroll
        for (int i = 0; i < 16; i++) {
          const u32 nb_ = (i >> 2) * 8 + kh * 4 + (i & 3);
          l[i] = __uint_as_float((__float_as_uint(sc[0][i]) & ~0x7Fu) | nb_);
          q1[i] = __uint_as_float((__float_as_uint(sc[1][i]) & ~0x7Fu) | (32u + nb_));
          q2[i] = __uint_as_float((__float_as_uint(sc[2][i]) & ~0x7Fu) | (64u + nb_));
          q3[i] = __uint_as_float((__float_as_uint(sc[3][i]) & ~0x7Fu) | (96u + nb_));
        }
        bitonic_sort16_desc(l);
        bitonic_sort16_desc(q1);
        bitonic_sort16_desc(q2);
        bitonic_sort16_desc(q3);
        top16_merge(l, q1);
        top16_merge(q2, q3);
        top16_merge(l, q2);
        float o[16];
#pragma unroll
        for (int i = 0; i < 16; i++) o[i] = __shfl_xor(l[i], 32);
        top16_merge(l, o);
#pragma unroll
        for (int i = 0; i < 16; i++) {
          l1[i] = pp == 0 ? l[i] : l1[i];
          l2[i] = pp == 0 ? l2[i] : l[i];
        }
      }
      if (kh == 0) {
        u32 w[8];
#pragma unroll
        for (int q = 0; q < 4; q++) {
          w[q] = (__float_as_uint(l1[4 * q]) & 0x7F) | ((__float_as_uint(l1[4 * q + 1]) & 0x7F) << 8) |
                 ((__float_as_uint(l1[4 * q + 2]) & 0x7F) << 16) | ((__float_as_uint(l1[4 * q + 3]) & 0x7F) << 24);
          w[4 + q] = (__float_as_uint(l2[4 * q]) & 0x7F) | ((__float_as_uint(l2[4 * q + 1]) & 0x7F) << 8) |
                     ((__float_as_uint(l2[4 * q + 2]) & 0x7F) << 16) | ((__float_as_uint(l2[4 * q + 3]) & 0x7F) << 24);
        }
        *(uint4*)(lt + l31 * 32) = make_uint4(w[0], w[1], w[2], w[3]);
        *(uint4*)(lt + l31 * 32 + 16) = make_uint4(w[4], w[5], w[6], w[7]);
      }
      float v1[16], v2[16];
#pragma unroll
      for (int i = 0; i < 16; i++) {
        v1[i] = __uint_as_float(__float_as_uint(l1[i]) & ~0x7Fu);
        v2[i] = __uint_as_float(__float_as_uint(l2[i]) & ~0x7Fu);
      }
#define CAND(a, b) __uint_as_float((__float_as_uint(v1[a] + v2[b]) & ~0xFFu) | (u32)((a) * 16 + (b)))
      float l3[16], y1[16], y2[16];
#pragma unroll
      for (int b = 0; b < 16; b++) l3[b] = CAND(0, b);
#pragma unroll
      for (int b = 0; b < 8; b++) y1[b] = CAND(1, b);
#pragma unroll
      for (int b = 0; b < 5; b++) y1[8 + b] = CAND(2, b);
#pragma unroll
      for (int b = 0; b < 3; b++) y1[13 + b] = CAND(4, b);
#pragma unroll
      for (int b = 0; b < 4; b++) y2[b] = CAND(3, b);
      y2[4] = CAND(5, 0); y2[5] = CAND(5, 1); y2[6] = CAND(6, 0); y2[7] = CAND(6, 1); y2[8] = CAND(7, 0); y2[9] = CAND(7, 1);
      y2[10] = CAND(8, 0); y2[11] = CAND(9, 0); y2[12] = CAND(10, 0); y2[13] = CAND(11, 0); y2[14] = CAND(12, 0); y2[15] = CAND(13, 0);
      bitonic_sort16_desc(y1);
      bitonic_sort16_desc(y2);
      top16_merge(l3, y1);
      top16_merge(l3, y2);
      ins16(l3, CAND(14, 0));
      ins16(l3, CAND(15, 0));
#undef CAND
      __builtin_amdgcn_fence(__ATOMIC_RELEASE, "workgroup");
      __builtin_amdgcn_wave_barrier();
      if (kh == 0) {
        const int g = pm * 256 + wid * 32 + l31;
        float ev[16];
        int ei[16];
        float sum = 0.f;
        const float mxv = __uint_as_float(__float_as_uint(l3[0]) & ~0xFFu);
#pragma unroll
        for (int k = 0; k < 16; k++) {
          const u32 bits = __float_as_uint(l3[k]);
          const u32 pos = bits & 0xFF;
          ev[k] = __expf(__uint_as_float(bits & ~0xFFu) - mxv);
          sum += ev[k];
          ei[k] = (int)lt[l31 * 32 + (pos >> 4)] * 128 + (int)lt[l31 * 32 + 16 + (pos & 15)];
        }
        const float inv = 1.f / sum;
        int4* ip = (int4*)(IDX + (size_t)g * 128 + hp * 16);
        float4* gp = (float4*)(GATE + (size_t)g * 128 + hp * 16);
#pragma unroll
        for (int q = 0; q < 4; q++) {
          ip[q] = make_int4(ei[4 * q], ei[4 * q + 1], ei[4 * q + 2], ei[4 * q + 3]);
          gp[q] = make_float4(ev[4 * q] * inv, ev[4 * q + 1] * inv, ev[4 * q + 2] * inv, ev[4 * q + 3] * inv);
        }
      }
      __builtin_amdgcn_wave_barrier();
    }
  }
}

__device__ void ph_peer(const Params& p, int bid, int nb, bool dry = false) {
  const int tid = otid(), lane = tid & 63, wv = tid >> 6;
  constexpr int ST = 1104;
  char* wb = dsm + wv * (16 * ST + 2048);
  unsigned char* stg = (unsigned char*)wb;
  unsigned char* hs = stg + 16 * ST;
  float* acts = (float*)(hs + 1024);
  int* idxs = (int*)(hs + 1536);
  const int gr = lane >> 3, gc = lane & 7;
  const int* IDX = (const int*)p.G;
  const float* GATE = (const float*)p.OATT;
  const unsigned char* H8 = (const unsigned char*)p.Y;
  const int n = lane & 15, quad = lane >> 4;
  for (int g = bid * NW + wv; g < T; g += nb * NW) {
    *(u32x4*)(hs + lane * 16) = *(const u32x4*)(H8 + (size_t)g * 1024 + lane * 16);
    idxs[lane] = IDX[(size_t)g * 128 + lane];
    idxs[lane + 64] = IDX[(size_t)g * 128 + 64 + lane];
    const float shv = p.SH[g];
    __builtin_amdgcn_fence(__ATOMIC_RELEASE, "workgroup");
    __builtin_amdgcn_wave_barrier();
    {
      u32x4 ring[16];
      {
        const unsigned char* ua = p.U8 + (size_t)idxs[gr] * 1024 + gc * 16;
        const unsigned char* ub = p.U8 + (size_t)idxs[8 + gr] * 1024 + gc * 16;
#pragma unroll
        for (int i = 0; i < 8; i++) { ring[i] = *(const u32x4*)(ua + i * 128); ring[8 + i] = *(const u32x4*)(ub + i * 128); }
      }
#pragma unroll 1
      for (int grp = 0; grp < 8; grp++) {
        const int gn = grp < 7 ? grp + 1 : grp;
        const unsigned char* ua = p.U8 + (size_t)idxs[gn * 16 + gr] * 1024 + gc * 16;
        const unsigned char* ub = p.U8 + (size_t)idxs[gn * 16 + 8 + gr] * 1024 + gc * 16;
        const float4 gt = *(const float4*)(GATE + (size_t)g * 128 + grp * 16 + quad * 4);
        const int4 ee = *(const int4*)(idxs + grp * 16 + quad * 4);
        const float su0 = p.SU[ee.x], su1 = p.SU[ee.y], su2 = p.SU[ee.z], su3 = p.SU[ee.w];
        const float sv0 = p.SV[ee.x], sv1 = p.SV[ee.y], sv2 = p.SV[ee.z], sv3 = p.SV[ee.w];
#pragma unroll
        for (int i = 0; i < 8; i++) {
          *(u32x4*)(stg + gr * ST + i * 128 + gc * 16) = ring[i];
          *(u32x4*)(stg + (8 + gr) * ST + i * 128 + gc * 16) = ring[8 + i];
          if (grp < 7) { ring[i] = *(const u32x4*)(ua + i * 128); ring[8 + i] = *(const u32x4*)(ub + i * 128); }
        }
        __builtin_amdgcn_fence(__ATOMIC_RELEASE, "workgroup");
        __builtin_amdgcn_wave_barrier();
        f32x4 acc = {0.f, 0.f, 0.f, 0.f};
#pragma unroll
        for (int st = 0; st < 16; st++) {
          const u32x4 ua4 = *(const u32x4*)(stg + n * ST + st * 64 + quad * 16);
          const u32x4 hb = *(const u32x4*)(hs + st * 64 + quad * 16);
          const long a0 = (long)(((unsigned long)ua4[1] << 32) | ua4[0]);
          const long a1 = (long)(((unsigned long)ua4[3] << 32) | ua4[2]);
          const long b0 = (long)(((unsigned long)hb[1] << 32) | hb[0]);
          const long b1 = (long)(((unsigned long)hb[3] << 32) | hb[2]);
          acc = __builtin_amdgcn_mfma_f32_16x16x32_fp8_fp8(a0, b0, acc, 0, 0, 0);
          acc = __builtin_amdgcn_mfma_f32_16x16x32_fp8_fp8(a1, b1, acc, 0, 0, 0);
        }
        __builtin_amdgcn_wave_barrier();
        const float d0 = acc[0] * shv * su0, d1 = acc[1] * shv * su1, d2 = acc[2] * shv * su2, d3 = acc[3] * shv * su3;
        float4 av;
        av.x = 0.5f * d0 * (1.f + erff(d0 * 0.70710678118f)) * gt.x * sv0;
        av.y = 0.5f * d1 * (1.f + erff(d1 * 0.70710678118f)) * gt.y * sv1;
        av.z = 0.5f * d2 * (1.f + erff(d2 * 0.70710678118f)) * gt.z * sv2;
        av.w = 0.5f * d3 * (1.f + erff(d3 * 0.70710678118f)) * gt.w * sv3;
        if (n == 0) *(float4*)(acts + grp * 16 + quad * 4) = av;
      }
    }
    __builtin_amdgcn_fence(__ATOMIC_RELEASE, "workgroup");
    __builtin_amdgcn_wave_barrier();
    float o[16];
#pragma unroll
    for (int j = 0; j < 16; j++) o[j] = 0.f;
    {
      u32x4 ring[16];
#pragma unroll
      for (int k = 0; k < 16; k++) ring[k] = *(const u32x4*)(p.V8 + (size_t)idxs[k] * 1024 + lane * 16);
#pragma unroll 1
      for (int kb = 0; kb < 128; kb += 16) {
        const bool more = kb < 112;
        const int kn = more ? kb + 16 : kb;
#pragma unroll
        for (int j = 0; j < 16; j++) {
          const u32x4 vq = ring[j];
          if (more) ring[j] = *(const u32x4*)(p.V8 + (size_t)idxs[kn + j] * 1024 + lane * 16);
          const float a = acts[kb + j];
#pragma unroll
          for (int q = 0; q < 4; q++) {
            const f32x2 lo = __builtin_amdgcn_cvt_pk_f32_fp8((int)vq[q], false);
            const f32x2 hi = __builtin_amdgcn_cvt_pk_f32_fp8((int)vq[q], true);
            o[4 * q] += a * lo[0]; o[4 * q + 1] += a * lo[1]; o[4 * q + 2] += a * hi[0]; o[4 * q + 3] += a * hi[1];
          }
        }
      }
    }
    float* xr = p.out + (size_t)g * 1024 + lane * 16;
    float4 x[4];
#pragma unroll
    for (int q = 0; q < 4; q++) x[q] = *(const float4*)(xr + q * 4);
    float ss = 0.f;
#pragma unroll
    for (int q = 0; q < 4; q++) {
      x[q].x += o[4 * q]; x[q].y += o[4 * q + 1]; x[q].z += o[4 * q + 2]; x[q].w += o[4 * q + 3];
      ss += x[q].x * x[q].x + x[q].y * x[q].y + x[q].z * x[q].z + x[q].w * x[q].w;
    }
    ss = wave_sum(ss);
    if (dry && ss != 123.456f) continue;
    const float rs = rsqrtf(ss * (1.f / 1024.f) + 1e-6f);
#pragma unroll
    for (int q = 0; q < 4; q++) {
      const float4 gq = *(const float4*)(p.final_g + lane * 16 + q * 4);
      *(float4*)(xr + q * 4) = make_float4(x[q].x * rs * gq.x, x[q].y * rs * gq.y, x[q].z * rs * gq.z, x[q].w * rs * gq.w);
    }
  }
}

__global__ void __launch_bounds__(512) mega_kernel(Params p) {
  cg::grid_group grid = cg::this_grid();
  const int bid = blockIdx.x, nb = gridDim.x;
  if (ON(0)) ph_prep(p, bid, nb);
  grid.sync();
  if (ON(1)) ph_gemm1(p, bid, nb);
  grid.sync();
  if (REP == 1) { ph_gemm1(p, bid, nb); grid.sync(); }
  if (ON(2)) ph_rwprep(p, bid, nb);
  grid.sync();
  if (REP == 2) { ph_rwprep(p, bid, nb); grid.sync(); }
  if (ON(3)) ph_scan(p, bid, nb);
  grid.sync();
  if (REP == 3) { ph_scan(p, bid, nb); grid.sync(); }
  if (REP == 4) { ph_attn(p, bid, nb, true); grid.sync(); }
  if (ON(4)) ph_attn(p, bid, nb);
  grid.sync();
  if (ON(5)) ph_gemm2(p, bid, nb);
  grid.sync();
  if (REP == 5) { ph_gemm2(p, bid, nb); grid.sync(); }
  if (ON(6)) ph_gemm3(p, bid, nb);
  grid.sync();
  if (REP == 6) { ph_gemm3(p, bid, nb); grid.sync(); }
  if (ON(7)) ph_norm2(p, bid, nb);
  grid.sync();
  if (ON(8)) ph_peerq(p, bid, nb);
  grid.sync();
  if (REP == 8) { ph_peerq(p, bid, nb); grid.sync(); }
  if (REP == 9) { ph_peer(p, bid, nb, true); grid.sync(); }
  if (ON(9)) ph_peer(p, bid, nb);
}

extern "C" void kernel_launch(void* const* d_in, const int* in_sizes, int n_in, void* d_out, int out_size, void* d_ws,
                              size_t ws_size, hipStream_t stream) {
  Params p{};
  const float** f = (const float**)&p;
  for (int i = 0; i < 28; i++) f[i] = (const float*)d_in[i];
  p.out = (float*)d_out;
  char* w = (char*)d_ws;
  size_t off = 0;
  auto take = [&](size_t bytes) { char* r = w + off; off += (bytes + 255) & ~(size_t)255; return (u16*)r; };
  p.H = take((size_t)MP * 1024 * 2);
  p.P = take((size_t)MP * INC * 2);
  p.U8 = (unsigned char*)take((size_t)16384 * 1024);
  p.V8 = (unsigned char*)take((size_t)16384 * 1024);
  p.SU = (float*)take(16384 * 4);
  p.SV = (float*)take(16384 * 4);
  p.SH = (float*)take((size_t)T * 4);
  p.WinT = take((size_t)4608 * 1024 * 2);
  p.WbT = take((size_t)2 * 1024 * 512 * 2);
  p.WoutT = take((size_t)1024 * 1024 * 2);
  p.WqT = take((size_t)1024 * 1024 * 2);
  p.W2T = take((size_t)512 * 64 * 2);
  p.A2T = take((size_t)512 * 64 * 2);
  p.G2T = take((size_t)512 * 128 * 2);
  p.SK = take((size_t)2 * 128 * 64 * 2);
  p.Y = take((size_t)T * 512 * 2);
  p.G = take((size_t)T * 512 * 2);
  p.OATT = take((size_t)T * 512 * 2);
  static int grid_blocks = 0;
  if (!grid_blocks) {
    int dev = 0, cus = 0, per_cu = 0;
    (void)hipGetDevice(&dev);
    (void)hipDeviceGetAttribute(&cus, hipDeviceAttributeMultiprocessorCount, dev);
    (void)hipFuncSetAttribute((const void*)mega_kernel, hipFuncAttributeMaxDynamicSharedMemorySize, DYN_LDS);
    (void)hipOccupancyMaxActiveBlocksPerMultiprocessor(&per_cu, mega_kernel, NTH, DYN_LDS);
    if (per_cu > 1) per_cu = 1;
    grid_blocks = cus * per_cu;
  }
  void* args[] = {&p};
  hipError_t e = hipLaunchCooperativeKernel((void*)mega_kernel, dim3(grid_blocks), dim3(NTH), args, DYN_LDS, stream);
  if (e != hipSuccess) fprintf(stderr, "cooperative launch failed: %s (grid %d)\n", hipGetErrorString(e), grid_blocks);
}
```

```cpp
#include <hip/hip_runtime.h>
#include <hip/hip_cooperative_groups.h>
#include <cstdio>
namespace cg = cooperative_groups;

#ifndef REP
#define REP -1
#endif
#ifndef ONLY
#define ONLY -1
#endif
#define ON(k) (ONLY < 0 || ONLY == (k))

typedef unsigned short u16;
typedef unsigned int u32;
using bf16x8 = __attribute__((ext_vector_type(8))) short;
using f32x4 = __attribute__((ext_vector_type(4))) float;
using f32x16 = __attribute__((ext_vector_type(16))) float;
using u32x4 = __attribute__((ext_vector_type(4))) u32;
#define DI __device__ __forceinline__

constexpr int TP = 65536, TS = 1024, T = 66560, MP = 66816;
constexpr int INC = 4608;
constexpr int NW = 8;
constexpr int NTH = 512;
constexpr size_t OFF_Y = 0, OFF_SHIFT_P = 68157440, OFF_WKV_P = 68173824, OFF_KP = 68698112, OFF_VP = 68960256,
                 OFF_SHIFT_S = 69222400, OFF_WKV_S = 69238784, OFF_KS = 69763072, OFF_VS = 69894144;
constexpr int DYN_LDS = 163840;

extern __shared__ __attribute__((aligned(16))) char dsm[];

struct Params {
  const float *x_prompt, *x_sample, *state_shift, *state_wkv, *cache_k, *cache_v, *norm1_g, *w_in, *mu, *w0, *w2, *a0,
      *a2, *g2, *k_k, *k_a, *r_k, *lnx_w, *lnx_b, *sinks, *w_branch, *w_out, *norm2_g, *peer_wq, *sub_keys, *peer_u,
      *peer_v, *final_g;
  float* out;
  u16 *H, *P, *WinT, *WbT, *WoutT, *WqT, *W2T, *A2T, *G2T, *SK, *Y, *G, *OATT;
  unsigned char *U8, *V8;
  float *SU, *SV, *SH;
};

typedef __bf16 hbf2 __attribute__((ext_vector_type(2)));
typedef float hf2 __attribute__((ext_vector_type(2)));
DI u16 f2bf(float x) { const __bf16 r = (__bf16)x; return __builtin_bit_cast(unsigned short, r); }
DI float bf2f(u16 b) { return __uint_as_float(((u32)b) << 16); }
DI u32 pack2(float a, float b) { const hf2 v = {a, b}; const hbf2 r = __builtin_convertvector(v, hbf2); return __builtin_bit_cast(u32, r); }
DI float bflo(u32 w) { return __uint_as_float(w << 16); }
DI float bfhi(u32 w) { return __uint_as_float(w & 0xffff0000u); }
DI float wave_sum(float v) {
#pragma unroll
  for (int o = 32; o; o >>= 1) v += __shfl_xor(v, o);
  return v;
}
DI float sigmoidf_(float x) { return 1.f / (1.f + __expf(-x)); }
DI const float* xrow(const Params& p, int g) {
  return g < TP ? p.x_prompt + (size_t)g * 1024 : p.x_sample + (size_t)(g - TP) * 1024;
}
DI int otid() { int t = threadIdx.x; asm volatile("" : "+v"(t)); return t; }
#define MFMA32(a, b, c) __builtin_amdgcn_mfma_f32_32x32x16_bf16((a), (b), (c), 0, 0, 0)
#define MFMA16(a, b, c) __builtin_amdgcn_mfma_f32_16x16x32_bf16((a), (b), (c), 0, 0, 0)

template <int CTRL>
DI float dppmov(float v) {
  return __int_as_float(__builtin_amdgcn_update_dpp(0, __float_as_int(v), CTRL, 0xF, 0xF, false));
}
DI float red16(float v) {
  v += dppmov<0x128>(v);
  v += dppmov<0x124>(v);
  v += dppmov<0x122>(v);
  v += dppmov<0x121>(v);
  return v;
}


using f32x2 = __attribute__((ext_vector_type(2))) float;
DI float wave_max(float v) {
#pragma unroll
  for (int o = 32; o; o >>= 1) v = fmaxf(v, __shfl_xor(v, o));
  return v;
}
DI u32 q4(float a, float b, float c, float d, float sc) {
  int w = 0;
  w = __builtin_amdgcn_cvt_pk_fp8_f32(a * sc, b * sc, w, false);
  w = __builtin_amdgcn_cvt_pk_fp8_f32(c * sc, d * sc, w, true);
  return (u32)w;
}

DI void tcvt(const float* __restrict__ W, u16* __restrict__ Wt, int K, int N, int gt, int nt) {
  const int total = N * (K / 8);
  for (int i = gt; i < total; i += nt) {
    const int n = i % N, kg = i / N;
    u32 o[4];
#pragma unroll
    for (int j = 0; j < 4; j++)
      o[j] = pack2(W[(size_t)(kg * 8 + 2 * j) * N + n], W[(size_t)(kg * 8 + 2 * j + 1) * N + n]);
    *(uint4*)(Wt + (size_t)n * K + kg * 8) = make_uint4(o[0], o[1], o[2], o[3]);
  }
}
DI void scvt(const float* __restrict__ W, u16* __restrict__ O, int n8, int gt, int nt) {
  for (int i = gt; i < n8; i += nt) {
    const float4 a = ((const float4*)W)[2 * i], b = ((const float4*)W)[2 * i + 1];
    ((uint4*)O)[i] = make_uint4(pack2(a.x, a.y), pack2(a.z, a.w), pack2(b.x, b.y), pack2(b.z, b.w));
  }
}

__device__ void ph_prep(const Params& p, int bid, int nb) {
  const int tid = otid(), lane = tid & 63, wv = tid >> 6;
  for (int row = bid * NW + wv; row < MP; row += nb * NW) {
    u16* hr = p.H + (size_t)row * 1024;
    if (row < T) {
      const float4* x = (const float4*)xrow(p, row);
      float4 v[4];
      float ss = 0.f;
#pragma unroll
      for (int i = 0; i < 4; i++) {
        v[i] = x[lane + i * 64];
        ss += v[i].x * v[i].x + v[i].y * v[i].y + v[i].z * v[i].z + v[i].w * v[i].w;
      }
      ss = wave_sum(ss);
      const float rs = rsqrtf(ss * (1.f / 1024.f) + 1e-6f);
      float* so = nullptr;
      if (row < TP) {
        if ((row & 4095) == 4095) so = p.out + OFF_SHIFT_P + (size_t)(row >> 12) * 1024;
      } else {
        const int r2 = row - TP;
        if ((r2 & 63) == 63) so = p.out + OFF_SHIFT_S + (size_t)(r2 >> 6) * 1024;
      }
#pragma unroll
      for (int i = 0; i < 4; i++) {
        const float4 g = ((const float4*)p.norm1_g)[lane + i * 64];
        float4 y;
        y.x = v[i].x * rs * g.x; y.y = v[i].y * rs * g.y; y.z = v[i].z * rs * g.z; y.w = v[i].w * rs * g.w;
        ((uint2*)hr)[lane + i * 64] = make_uint2(pack2(y.x, y.y), pack2(y.z, y.w));
        if (so) ((float4*)so)[lane + i * 64] = y;
      }
    } else if (row < T + 16) {
      const float4* x = (const float4*)(p.state_shift + (size_t)(row - T) * 1024);
#pragma unroll
      for (int i = 0; i < 4; i++) {
        const float4 y = x[lane + i * 64];
        ((uint2*)hr)[lane + i * 64] = make_uint2(pack2(y.x, y.y), pack2(y.z, y.w));
      }
    } else {
#pragma unroll
      for (int i = 0; i < 4; i++) ((uint2*)hr)[lane + i * 64] = make_uint2(0u, 0u);
    }
  }
  const int gt = bid * NTH + tid, nt = nb * NTH;
  tcvt(p.w_in, p.WinT, 1024, 4608, gt, nt);
  tcvt(p.w_branch, p.WbT, 512, 1024, gt, nt);
  tcvt(p.w_branch + 512 * 1024, p.WbT + 1024 * 512, 512, 1024, gt, nt);
  tcvt(p.w_out, p.WoutT, 1024, 1024, gt, nt);
  tcvt(p.peer_wq, p.WqT, 1024, 1024, gt, nt);
  tcvt(p.w2, p.W2T, 64, 512, gt, nt);
  tcvt(p.a2, p.A2T, 64, 512, gt, nt);
  tcvt(p.g2, p.G2T, 128, 512, gt, nt);
  scvt(p.sub_keys, p.SK, 2 * 128 * 64 / 8, gt, nt);
  for (int r = bid * NW + wv; r < 32768; r += nb * NW) {
    const bool isv = r >= 16384;
    const int e = r & 16383;
    const float4* src = (const float4*)((isv ? p.peer_v : p.peer_u) + (size_t)e * 1024) + lane * 4;
    const float4 a = src[0], b = src[1], c = src[2], d = src[3];
    float am = fmaxf(fmaxf(fmaxf(fabsf(a.x), fabsf(a.y)), fmaxf(fabsf(a.z), fabsf(a.w))),
                     fmaxf(fmaxf(fabsf(b.x), fabsf(b.y)), fmaxf(fabsf(b.z), fabsf(b.w))));
    am = fmaxf(am, fmaxf(fmaxf(fmaxf(fabsf(c.x), fabsf(c.y)), fmaxf(fabsf(c.z), fabsf(c.w))),
                         fmaxf(fmaxf(fabsf(d.x), fabsf(d.y)), fmaxf(fabsf(d.z), fabsf(d.w)))));
    am = fmaxf(wave_max(am), 1e-30f);
    const float sc = 240.f / am;
    if (lane == 0) (isv ? p.SV : p.SU)[e] = am * (1.f / 240.f);
    *(u32x4*)((isv ? p.V8 : p.U8) + (size_t)e * 1024 + lane * 16) =
        u32x4{q4(a.x, a.y, a.z, a.w, sc), q4(b.x, b.y, b.z, b.w, sc), q4(c.x, c.y, c.z, c.w, sc), q4(d.x, d.y, d.z, d.w, sc)};
  }
}

constexpr int GBK = 64, GHALF = 128, GHT = GHALF * GBK;
DI int lds_byte(int r, int c) {
  const int st = (r >> 4) * 2 + (c >> 5), rr = r & 15, cc = c & 31, ob = rr * 64 + cc * 2;
  return st * 1024 + (ob ^ (((ob >> 9) & 1) << 5));
}
DI void stage_rc(int b, int& R, int& C) {
  const int st = b / 1024, sb = b % 1024, swz = sb ^ (((sb >> 9) & 1) << 5);
  R = (st >> 1) * 16 + swz / 64;
  C = (st & 1) * 32 + (swz % 64) / 2;
}
typedef __attribute__((address_space(3))) unsigned lds_u32;
#define G_SA(b, h) (shm + ((b) * 2 + (h)) * GHT)
#define G_SB(b, h) (shm + (4 + (b) * 2 + (h)) * GHT)
#define G_STAGE(P_, RS, br, kt)                                                                                   \
  do {                                                                                                            \
    const int _so = ((br) * K + (kt) * GBK) * 2;                                                                  \
    __builtin_amdgcn_raw_ptr_buffer_load_lds(RS, (lds_u32*)((char*)(P_) + tb0), 16, ob0, _so, 0, 0);              \
    __builtin_amdgcn_raw_ptr_buffer_load_lds(RS, (lds_u32*)((char*)(P_) + tb0 + 8192), 16, ob1, _so, 0, 0);       \
  } while (0)
#define G_LDA(dst, b, h)                                  \
  _Pragma("unroll") for (int m = 0; m < 4; ++m)           \
  _Pragma("unroll") for (int k = 0; k < 2; ++k)           \
    dst[m][k] = *reinterpret_cast<const bf16x8*>((const char*)G_SA(b, h) + lds_byte(wr * 64 + m * 16 + fr, k * 32 + fq * 8))
#define G_LDB(dst, b, h)                                  \
  _Pragma("unroll") for (int n = 0; n < 2; ++n)           \
  _Pragma("unroll") for (int k = 0; k < 2; ++k)           \
    dst[n][k] = *reinterpret_cast<const bf16x8*>((const char*)G_SB(b, h) + lds_byte(wc * 32 + n * 16 + fr, k * 32 + fq * 8))
#define G_MMA(ai, bj, At_, Bt_)                                                                         \
  do {                                                                                                  \
    __builtin_amdgcn_s_setprio(1);                                                                      \
    _Pragma("unroll") for (int m = 0; m < 4; ++m)                                                       \
    _Pragma("unroll") for (int n = 0; n < 2; ++n)                                                       \
    _Pragma("unroll") for (int k = 0; k < 2; ++k)                                                       \
      acc[ai][bj][m][n] = MFMA16(At_[m][k], Bt_[n][k], acc[ai][bj][m][n]);                              \
    __builtin_amdgcn_s_setprio(0);                                                                      \
  } while (0)
#define WAIT_V(n) asm volatile("s_waitcnt vmcnt(" #n ")" ::: "memory")
#define WAIT_L(n) asm volatile("s_waitcnt lgkmcnt(" #n ")" ::: "memory")
#define BAR __builtin_amdgcn_s_barrier()
#define SCHED __builtin_amdgcn_sched_barrier(0)

template <int K>
DI void gemm256(const u16* __restrict__ A, const u16* __restrict__ Bt, const int brow, const int bcol,
                f32x4 (&acc)[2][2][4][2]) {
  u16* shm = (u16*)dsm;
  const int tid_ = otid();
  const int wid = tid_ >> 6, lane = tid_ & 63, wr = wid >> 2, wc = wid & 3, fr = lane & 15, fq = lane >> 4;
#pragma unroll
  for (int a = 0; a < 2; a++)
#pragma unroll
    for (int b = 0; b < 2; b++)
#pragma unroll
      for (int m = 0; m < 4; m++)
#pragma unroll
        for (int n = 0; n < 2; n++) acc[a][b][m][n] = f32x4{0.f, 0.f, 0.f, 0.f};
  bf16x8 At[4][2], B0[2][2], B1[2][2];
  constexpr int nt = K / GBK;
  const __amdgpu_buffer_rsrc_t rsA = __builtin_amdgcn_make_buffer_rsrc((void*)A, 0, 0x7fffffff, 0x00020000);
  const __amdgpu_buffer_rsrc_t rsB = __builtin_amdgcn_make_buffer_rsrc((void*)Bt, 0, 0x7fffffff, 0x00020000);
  const unsigned tb0 = tid_ * 16;
  int ob0, ob1;
  {
    int r_, c_;
    stage_rc((int)tb0, r_, c_);
    ob0 = (r_ * K + c_) * 2;
    stage_rc((int)tb0 + 8192, r_, c_);
    ob1 = (r_ * K + c_) * 2;
  }
  WAIT_V(0);
  __syncthreads();
  G_STAGE(G_SB(0, 0), rsB, bcol, 0); G_STAGE(G_SA(0, 0), rsA, brow, 0);
  G_STAGE(G_SB(0, 1), rsB, bcol + GHALF, 0); G_STAGE(G_SA(0, 1), rsA, brow + GHALF, 0);
  if (wr == 1) BAR;
  WAIT_V(4); BAR;
  G_STAGE(G_SB(1, 0), rsB, bcol, 1); G_STAGE(G_SA(1, 0), rsA, brow, 1); G_STAGE(G_SB(1, 1), rsB, bcol + GHALF, 1);
  WAIT_V(6); BAR;
  for (int t = 0; t < nt - 2; t += 2) {
    G_LDB(B0, 0, 0); SCHED; G_LDA(At, 0, 0); G_STAGE(G_SA(1, 1), rsA, brow + GHALF, t + 1);
    WAIT_L(8); BAR; WAIT_L(0); G_MMA(0, 0, At, B0); BAR; SCHED;
    G_LDB(B1, 0, 1); G_STAGE(G_SB(0, 0), rsB, bcol, t + 2);
    BAR; WAIT_L(0); G_MMA(0, 1, At, B1); BAR;
    G_LDA(At, 0, 1); G_STAGE(G_SA(0, 0), rsA, brow, t + 2);
    BAR; WAIT_L(0); G_MMA(1, 0, At, B0); BAR; SCHED;
    G_STAGE(G_SB(0, 1), rsB, bcol + GHALF, t + 2);
    WAIT_V(6); BAR; G_MMA(1, 1, At, B1); BAR;
    G_LDB(B0, 1, 0); SCHED; G_LDA(At, 1, 0); G_STAGE(G_SA(0, 1), rsA, brow + GHALF, t + 2);
    WAIT_L(8); BAR; WAIT_L(0); G_MMA(0, 0, At, B0); BAR; SCHED;
    G_LDB(B1, 1, 1); G_STAGE(G_SB(1, 0), rsB, bcol, t + 3);
    BAR; WAIT_L(0); G_MMA(0, 1, At, B1); BAR;
    G_LDA(At, 1, 1); G_STAGE(G_SA(1, 0), rsA, brow, t + 3);
    BAR; WAIT_L(0); G_MMA(1, 0, At, B0); BAR; SCHED;
    G_STAGE(G_SB(1, 1), rsB, bcol + GHALF, t + 3);
    WAIT_V(6); BAR; G_MMA(1, 1, At, B1); BAR;
  }
  {
    G_LDB(B0, 0, 0); G_LDA(At, 0, 0); G_STAGE(G_SA(1, 1), rsA, brow + GHALF, nt - 1);
    BAR; WAIT_L(0); G_MMA(0, 0, At, B0); BAR;
    G_LDB(B1, 0, 1); BAR; WAIT_L(0); G_MMA(0, 1, At, B1); BAR;
    G_LDA(At, 0, 1); WAIT_V(4); BAR; WAIT_L(0); G_MMA(1, 0, At, B0); G_MMA(1, 1, At, B1); BAR;
  }
  {
    G_LDB(B0, 1, 0); G_LDA(At, 1, 0); WAIT_V(2); BAR; WAIT_L(0); G_MMA(0, 0, At, B0); BAR;
    G_LDB(B1, 1, 1); WAIT_V(0); BAR; WAIT_L(0); G_MMA(0, 1, At, B1); BAR;
    G_LDA(At, 1, 1); BAR; WAIT_L(0); G_MMA(1, 0, At, B0); G_MMA(1, 1, At, B1); BAR;
  }
  if (wr == 0) BAR;
}
#define GT_VARS \
  const int tid_ = otid(); const int wid = tid_ >> 6, lane = tid_ & 63, wr = wid >> 2, wc = wid & 3, fr = lane & 15, fq = lane >> 4;
#define GT_ROW(ai, m, j) ((ai) * 128 + wr * 64 + (m) * 16 + fq * 4 + (j))
#define GT_COL(bj, n) ((bj) * 128 + wc * 32 + (n) * 16 + fr)
#define GT_FOR                                       \
  _Pragma("unroll") for (int ai = 0; ai < 2; ++ai)   \
  _Pragma("unroll") for (int bj = 0; bj < 2; ++bj)   \
  _Pragma("unroll") for (int m = 0; m < 4; ++m)      \
  _Pragma("unroll") for (int n = 0; n < 2; ++n)      \
  _Pragma("unroll") for (int j = 0; j < 4; ++j)

DI bool tile_of(int round, int bid, int nb, int nM, int nN, int& pm, int& pn) {
  const int vt = round * nb + (bid & 7) * (nb >> 3) + (bid >> 3);
  if (vt >= nM * nN) return false;
  const int nig = 8 * nN, gid = vt / nig, fm = gid * 8, gsz = min(nM - fm, 8);
  pm = fm + (vt % nig) % gsz;
  pn = (vt % nig) / gsz;
  return true;
}


constexpr int CS_LD = 264;
DI void acc_to_lds(const f32x4 (&acc)[2][2][4][2]) {
  GT_VARS
  u16* Cs = (u16*)dsm;
  __syncthreads();
  GT_FOR { Cs[GT_ROW(ai, m, j) * CS_LD + GT_COL(bj, n)] = f2bf(acc[ai][bj][m][n][j]); }
  __syncthreads();
}

__device__ void ph_gemm1(const Params& p, int bid, int nb) {
  const int tid_ = otid();
  const int nM = 261, nN = 18;
  for (int round = 0; round * nb < nM * nN; ++round) {
    int pm, pn;
    if (!tile_of(round, bid, nb, nM, nN, pm, pn)) break;
    f32x4 acc[2][2][4][2];
    gemm256<1024>(p.H, p.WinT, pm * 256, pn * 256, acc);
    acc_to_lds(acc);
    const u16* Cs = (const u16*)dsm;
#pragma unroll 4
    for (int it = 0; it < 16; it++) {
      const int id = it * NTH + tid_, rl = id >> 5, c8 = (id & 31) * 8;
      const int row = pm * 256 + rl;
      const u32x4 v = *(const u32x4*)(Cs + rl * CS_LD + c8);
      *(u32x4*)(p.P + (size_t)row * INC + pn * 256 + c8) = v;
      if (pn == 9) {
        float* dst = nullptr;
        const int c2 = c8 & 127;
        if (row < TP) {
          const int tt = row & 4095;
          if (tt >= 3968) dst = p.out + (c8 < 128 ? OFF_KP : OFF_VP) + ((size_t)(row >> 12) * 128 + (tt - 3968)) * 128 + c2;
        } else if (row < T) {
          dst = p.out + (c8 < 128 ? OFF_KS : OFF_VS) + (size_t)(row - TP) * 128 + c2;
        }
        if (dst) {
          *(float4*)dst = make_float4(bflo(v[0]), bfhi(v[0]), bflo(v[1]), bfhi(v[1]));
          *(float4*)(dst + 4) = make_float4(bflo(v[2]), bfhi(v[2]), bflo(v[3]), bfhi(v[3]));
        }
      }
    }
  }
}

DI int prev_row(int g) {
  if (g < TP) return (g & 4095) ? g - 1 : -1;
  const int r2 = g - TP;
  return (r2 & 63) ? g - 1 : T + (r2 >> 6);
}

__device__ void ph_rwprep(const Params& p, int bid, int nb) {
  const int tid = otid(), lane = tid & 63, wv = tid >> 6, fr = lane & 15, fq = lane >> 4;
  u16* A1 = (u16*)dsm;
  u16* A2 = A1 + 64 * 80;
  u16* A3 = A2 + 64 * 80;
  u16* SA = (u16*)(p.out);
  u16* SB = p.H;
  const int hd = wv;
  u16* OT = (u16*)(dsm + 38912 + wv * 12288);
  u32x4 pin[7];
  for (int tile = bid; tile < T / 64; tile += nb) {
    const int g0 = tile * 64;
    auto issue_in = [&](int rg_) {
#pragma unroll
      for (int it = 0; it < 7; it++) {
        const int id = it * 64 + lane, ri = id / 24, rem = id - ri * 24, arr = rem >> 3, ch = rem & 7;
        int tok = g0 + rg_ * 16 - 1 + ri;
        if (rg_ == 0 && ri == 0) tok = prev_row(g0);
        pin[it] = u32x4{0u, 0u, 0u, 0u};
        if (id < 408 && tok >= 0) pin[it] = *(const u32x4*)(p.P + (size_t)tok * INC + arr * 512 + hd * 64 + ch * 8);
      }
    };
    __syncthreads();
    {
      const int row = tid >> 3, part8 = tid & 7, part = part8 >> 1, sub = part8 & 1;
      const int g = g0 + row, pr = prev_row(g);
      const int cb = 1536 + part * 64 + sub * 32;
      const u16* cur = p.P + (size_t)g * INC + cb;
      const u16* prv = p.P + (size_t)(pr < 0 ? 0 : pr) * INC + cb;
#pragma unroll
      for (int q = 0; q < 4; q++) {
        const u32x4 c4 = *(const u32x4*)(cur + q * 8);
        u32x4 p4 = {0u, 0u, 0u, 0u};
        if (pr >= 0) p4 = *(const u32x4*)(prv + q * 8);
        u32x4 ow;
#pragma unroll
        for (int e = 0; e < 4; e++) {
          const float c0 = bflo(c4[e]), c1 = bfhi(c4[e]), q0 = bflo(p4[e]), q1 = bfhi(p4[e]);
          float f0 = c0 + (q0 - c0) * p.mu[cb + q * 8 + 2 * e];
          float f1 = c1 + (q1 - c1) * p.mu[cb + q * 8 + 2 * e + 1];
          if (part == 0) { f0 = 1.f - 2.f / (1.f + __expf(2.f * f0)); f1 = 1.f - 2.f / (1.f + __expf(2.f * f1)); }
          else if (part >= 2) { f0 = sigmoidf_(f0); f1 = sigmoidf_(f1); }
          ow[e] = pack2(f0, f1);
        }
        u16* dst = part == 0 ? A1 + row * 80 + sub * 32 + q * 8
                 : part == 1 ? A2 + row * 80 + sub * 32 + q * 8
                             : A3 + row * 144 + (part - 2) * 64 + sub * 32 + q * 8;
        *(u32x4*)dst = ow;
      }
    }
    __syncthreads();
#pragma unroll 1
    for (int rg = 0; rg < 4; rg++) {
      issue_in(rg);
#pragma unroll
      for (int it = 0; it < 7; it++) {
        const int id = it * 64 + lane;
        if (id < 408) *(u32x4*)(OT + id * 8) = pin[it];
      }
      __builtin_amdgcn_fence(__ATOMIC_RELEASE, "workgroup");
      __builtin_amdgcn_wave_barrier();
      float inr[5][3][4];
#pragma unroll
      for (int jj = 0; jj < 5; jj++)
#pragma unroll
        for (int ar = 0; ar < 3; ar++)
#pragma unroll
          for (int nt = 0; nt < 4; nt++) inr[jj][ar][nt] = bf2f(OT[((fq * 4 + jj) * 3 + ar) * 64 + nt * 16 + fr]);
      __builtin_amdgcn_fence(__ATOMIC_RELEASE, "workgroup");
      __builtin_amdgcn_wave_barrier();
      SCHED;
      f32x4 aw[4], aa[4];
#pragma unroll
      for (int nt = 0; nt < 4; nt++) { aw[nt] = f32x4{0.f, 0.f, 0.f, 0.f}; aa[nt] = f32x4{0.f, 0.f, 0.f, 0.f}; }
#pragma unroll 1
      for (int ks = 0; ks < 2; ks++) {
        const bf16x8 f1 = *(const bf16x8*)(A1 + (rg * 16 + fr) * 80 + ks * 32 + fq * 8);
        const bf16x8 f2 = *(const bf16x8*)(A2 + (rg * 16 + fr) * 80 + ks * 32 + fq * 8);
#pragma unroll
        for (int nt = 0; nt < 4; nt++) {
          const bf16x8 bw = *(const bf16x8*)(p.W2T + (unsigned)((hd * 64 + nt * 16 + fr) * 64 + ks * 32 + fq * 8));
          const bf16x8 ba = *(const bf16x8*)(p.A2T + (unsigned)((hd * 64 + nt * 16 + fr) * 64 + ks * 32 + fq * 8));
          aw[nt] = MFMA16(f1, bw, aw[nt]);
          aa[nt] = MFMA16(f2, ba, aa[nt]);
        }
      }
      float ss[4] = {0.f, 0.f, 0.f, 0.f};
      const int rowb = rg * 16 + fq * 4;
      const int gb = g0 + rowb;
#pragma unroll
      for (int nt = 0; nt < 4; nt++) {
        const int c = nt * 16 + fr, col = hd * 64 + c;
        const float mu_r = p.mu[col], mu_k = p.mu[512 + col], mu_v = p.mu[1024 + col];
        const float w0c = p.w0[col], a0c = p.a0[col], kkc = p.k_k[col], kac = p.k_a[col];
        float qr = inr[0][0][nt], qk = inr[0][1][nt], qv = inr[0][2][nt];
#pragma unroll
        for (int j = 0; j < 4; j++) {
          const float cr = inr[j + 1][0][nt], ck = inr[j + 1][1][nt], cv = inr[j + 1][2][nt];
          const float r = cr + (qr - cr) * mu_r, k = ck + (qk - ck) * mu_k, v = cv + (qv - cv) * mu_v;
          qr = cr; qk = ck; qv = cv;
          const float ed = 0.6065306597126334f * sigmoidf_(w0c + aw[nt][j]);
          const float dm = 1.f - __expf(-ed);
          const float a = sigmoidf_(a0c + aa[nt][j]);
          const float kkv = k * kkc;
          ss[j] += kkv * kkv;
          const float k2 = k * (1.f + (a - 1.f) * kac);
          u16* ot = OT + (fq * 4 + j) * 384 + c;
          ot[0] = f2bf(r);
          ot[64] = f2bf(dm);
          ot[128] = f2bf(k2);
          ot[256] = f2bf(v);
          aw[nt][j] = kkv;
          aa[nt][j] = a;
        }
        SCHED;
      }
#pragma unroll
      for (int j = 0; j < 4; j++) ss[j] = 1.f / fmaxf(sqrtf(red16(ss[j])), 1e-12f);
#pragma unroll
      for (int nt = 0; nt < 4; nt++) {
        const int c = nt * 16 + fr;
#pragma unroll
        for (int j = 0; j < 4; j++) {
          const float kkn = aw[nt][j] * ss[j];
          u16* ot = OT + (fq * 4 + j) * 384 + c;
          ot[192] = f2bf(kkn);
          ot[320] = f2bf(kkn * aa[nt][j]);
        }
      }
      __builtin_amdgcn_fence(__ATOMIC_RELEASE, "workgroup");
      __builtin_amdgcn_wave_barrier();
      {
        const int gr0 = g0 + rg * 16;
#pragma unroll 4
        for (int it = 0; it < 12; it++) {
          const int id = it * 64 + lane, rowi = id / 48, pc = id % 48;
          const u32x4 v4 = *(const u32x4*)(OT + rowi * 384 + pc * 8);
          const size_t gh = (size_t)(gr0 + rowi) * 8 + hd;
          if (pc < 32) *(u32x4*)(SA + gh * 256 + pc * 8) = v4;
          else *(u32x4*)(SB + gh * 128 + (pc - 32) * 8) = v4;
        }
      }
      __builtin_amdgcn_wave_barrier();
      f32x4 ag[4];
#pragma unroll
      for (int nt = 0; nt < 4; nt++) ag[nt] = f32x4{0.f, 0.f, 0.f, 0.f};
#pragma unroll 1
      for (int ks = 0; ks < 4; ks++) {
        const bf16x8 f3 = *(const bf16x8*)(A3 + (rg * 16 + fr) * 144 + ks * 32 + fq * 8);
#pragma unroll
        for (int nt = 0; nt < 4; nt++) {
          const bf16x8 bg = *(const bf16x8*)(p.G2T + (unsigned)((hd * 64 + nt * 16 + fr) * 128 + ks * 32 + fq * 8));
          ag[nt] = MFMA16(f3, bg, ag[nt]);
        }
      }
#pragma unroll
      for (int nt = 0; nt < 4; nt++)
#pragma unroll
        for (int j = 0; j < 4; j++) p.G[(size_t)(gb + j) * 512 + hd * 64 + nt * 16 + fr] = f2bf(ag[nt][j]);
    }
  }
}

DI float red8(float v) {
  v += dppmov<0xB1>(v);
  v += dppmov<0x4E>(v);
  v += dppmov<0x141>(v);
  return v;
}
struct ScanOps { f32x4 r, d, k, n, b; float v; };
DI void scan_ld(ScanOps& o, const float* sb, int j0, int row) {
  o.r = *(const f32x4*)(sb + j0);
  o.d = *(const f32x4*)(sb + 64 + j0);
  o.k = *(const f32x4*)(sb + 128 + j0);
  o.n = *(const f32x4*)(sb + 192 + j0);
  o.b = *(const f32x4*)(sb + 320 + j0);
  o.v = sb[256 + row];
}
#define LO2(x) __builtin_shufflevector((x), (x), 0, 1)
#define HI2(x) __builtin_shufflevector((x), (x), 2, 3)
DI float scan_step(f32x2 (&S)[2], const ScanOps& o, f32x4& rprev) {
  const f32x2 vv = {o.v, o.v};
  const f32x2 tt = S[0] * LO2(o.n) + S[1] * HI2(o.n);
  const f32x2 yy = S[0] * LO2(rprev) + S[1] * HI2(rprev);
  const f32x2 m0 = S[0] * LO2(o.d) + vv * LO2(o.k);
  const f32x2 m1 = S[1] * HI2(o.d) + vv * HI2(o.k);
  float a = tt[0] + tt[1], y = yy[0] + yy[1];
  a += dppmov<0x128>(a); y += dppmov<0x128>(y);
  a += dppmov<0x124>(a); y += dppmov<0x124>(y);
  a += dppmov<0x122>(a); y += dppmov<0x122>(y);
  a += dppmov<0x121>(a); y += dppmov<0x121>(y);
  const float sa = -a;
  const f32x2 sv = {sa, sa};
  S[0] = m0 + sv * LO2(o.b);
  S[1] = m1 + sv * HI2(o.b);
  rprev = o.r;
  return y;
}

__device__ void ph_scan(const Params& p, int bid, int nb) {
  const int tid = otid(), lane = tid & 63, wv = tid >> 6;
  float* buf = (float*)dsm;
  const u16* SA = (const u16*)(p.out);
  const u16* SB = p.H;
  constexpr int CH = 32;
  for (int item = bid; item < 512; item += nb) {
    const int type = item >> 8, r_ = item & 255, half = r_ & 1, hb = r_ >> 1, h = hb & 7, b = hb >> 3;
    const int nch = type ? 64 / CH : 4096 / CH;
    const int gbase = type ? TP + b * 64 : b * 4096;
    const bool active = true;
    const int row = half * 32 + wv * 4 + (lane >> 4), j0 = (lane & 15) * 4;
    f32x2 S[2];
#pragma unroll
    for (int j = 0; j < 2; j++) S[j] = f32x2{0.f, 0.f};
    if (type && active) {
      const float* s0 = p.state_wkv + ((size_t)(b * 8 + h) * 64 + row) * 64 + j0;
#pragma unroll
      for (int j = 0; j < 2; j++) S[j] = f32x2{s0[2 * j], s0[2 * j + 1]};
    }
    f32x4 rprev = {0.f, 0.f, 0.f, 0.f};
    float ykeep = 0.f;
    u32x4 la[2], lb;
    auto gload = [&](int c) {
#pragma unroll
      for (int q = 0; q < 2; q++) {
        const int idx = tid + q * NTH, step = idx >> 5, u = idx & 31;
        la[q] = *(const u32x4*)(SA + ((size_t)(gbase + c * CH + step) * 8 + h) * 256 + u * 8);
      }
      {
        const int step = tid >> 4, u = tid & 15;
        lb = *(const u32x4*)(SB + ((size_t)(gbase + c * CH + step) * 8 + h) * 128 + u * 8);
      }
    };
    gload(0);
    for (int c = 0; c < nch; c++) {
      __syncthreads();
#pragma unroll
      for (int q = 0; q < 2; q++) {
        const int idx = tid + q * NTH, step = idx >> 5, u = idx & 31, arr = u >> 3, c0 = (u & 7) * 8;
        float* d = buf + step * 384 + arr * 64 + c0;
        float f[8];
#pragma unroll
        for (int e = 0; e < 4; e++) { f[2 * e] = bflo(la[q][e]); f[2 * e + 1] = bfhi(la[q][e]); }
        if (arr == 1) {
#pragma unroll
          for (int e = 0; e < 8; e++) f[e] = 1.f - f[e];
        }
        *(float4*)d = make_float4(f[0], f[1], f[2], f[3]);
        *(float4*)(d + 4) = make_float4(f[4], f[5], f[6], f[7]);
      }
      {
        const int step = tid >> 4, u = tid & 15, arr = u >> 3, c0 = (u & 7) * 8;
        float* d = buf + step * 384 + (4 + arr) * 64 + c0;
        *(float4*)d = make_float4(bflo(lb[0]), bfhi(lb[0]), bflo(lb[1]), bfhi(lb[1]));
        *(float4*)(d + 4) = make_float4(bflo(lb[2]), bfhi(lb[2]), bflo(lb[3]), bfhi(lb[3]));
      }
      __syncthreads();
      if (c + 1 < nch) gload(c + 1);
      if (active) {
        ScanOps A0, A1, B0, B1;
        scan_ld(A0, buf, j0, row);
        scan_ld(A1, buf + 384, j0, row);
#pragma unroll 1
        for (int s = 0; s < CH; s += 4) {
          scan_ld(B0, buf + (s + 2) * 384, j0, row);
          scan_ld(B1, buf + (s + 3) * 384, j0, row);
          SCHED;
          {
            const int g0 = c * CH + s;
            const float y0 = scan_step(S, A0, rprev);
            ykeep = ((lane & 15) == ((g0 - 1) & 15)) ? y0 : ykeep;
            if ((g0 & 15) == 0 && g0 > 0)
              p.Y[(size_t)(gbase + g0 - 16 + (lane & 15)) * 512 + h * 64 + row] = f2bf(ykeep);
            const float y1 = scan_step(S, A1, rprev);
            ykeep = ((lane & 15) == (g0 & 15)) ? y1 : ykeep;
          }
          SCHED;
          const int sn = (s + 4 < CH) ? s + 4 : s;
          scan_ld(A0, buf + sn * 384, j0, row);
          scan_ld(A1, buf + (sn + 1) * 384, j0, row);
          SCHED;
          {
            const int g0 = c * CH + s;
            const float y2 = scan_step(S, B0, rprev);
            ykeep = ((lane & 15) == ((g0 + 1) & 15)) ? y2 : ykeep;
            const float y3 = scan_step(S, B1, rprev);
            ykeep = ((lane & 15) == ((g0 + 2) & 15)) ? y3 : ykeep;
          }
          SCHED;
        }
      }
    }
    if (active) {
      const f32x2 yy = S[0] * LO2(rprev) + S[1] * HI2(rprev);
      const float yl = red16(yy[0] + yy[1]);
      ykeep = ((lane & 15) == 15) ? yl : ykeep;
      p.Y[(size_t)(gbase + nch * CH - 16 + (lane & 15)) * 512 + h * 64 + row] = f2bf(ykeep);
    }
    if (active) {
      float* so = p.out + (type ? OFF_WKV_S : OFF_WKV_P) + ((size_t)(b * 8 + h) * 64 + row) * 64 + j0;
      *(float4*)so = make_float4(S[0][0], S[0][1], S[1][0], S[1][1]);
    }
  }
}

__device__ void ph_attn(const Params& p, int bid, int nb, bool dry = false) {
  const int tid = otid(), lane = tid & 63, wv = tid >> 6, fr = lane & 15, fq = lane >> 4;
  u16* Ks = (u16*)dsm;
  u16* Vt = Ks + 192 * 72;
  for (int item = bid; item < 2080; item += nb) {
    const int kvh = item & 1, r = item >> 1;
    const bool samp = r >= 1024;
    const int b = samp ? r - 1024 : r >> 6, c = samp ? 0 : (r & 63);
    const int gq0 = samp ? TP + b * 64 : b * 4096 + c * 64;
    __syncthreads();
#pragma unroll
    for (int q = 0; q < 3; q++) {
      const int idx = tid + q * NTH, j = idx >> 3, d0 = (idx & 7) * 8;
      u32x4 kq = {0u, 0u, 0u, 0u}, vq = {0u, 0u, 0u, 0u};
      if (!samp) {
        const int tok = (c - 2) * 64 + j;
        if (tok >= 0) {
          const u16* src = p.P + (size_t)(b * 4096 + tok) * INC + 2304 + kvh * 64 + d0;
          kq = *(const u32x4*)src;
          vq = *(const u32x4*)(src + 128);
        }
      } else if (j < 128) {
        const float4* ck = (const float4*)(p.cache_k + ((size_t)(b * 128 + j) * 2 + kvh) * 64 + d0);
        const float4* cv = (const float4*)(p.cache_v + ((size_t)(b * 128 + j) * 2 + kvh) * 64 + d0);
        const float4 k0 = ck[0], k1 = ck[1], v0 = cv[0], v1 = cv[1];
        kq = u32x4{pack2(k0.x, k0.y), pack2(k0.z, k0.w), pack2(k1.x, k1.y), pack2(k1.z, k1.w)};
        vq = u32x4{pack2(v0.x, v0.y), pack2(v0.z, v0.w), pack2(v1.x, v1.y), pack2(v1.z, v1.w)};
      } else {
        const u16* src = p.P + (size_t)(TP + b * 64 + (j - 128)) * INC + 2304 + kvh * 64 + d0;
        kq = *(const u32x4*)src;
        vq = *(const u32x4*)(src + 128);
      }
      *(u32x4*)(Ks + j * 72 + d0) = kq;
#pragma unroll
      for (int e = 0; e < 4; e++) {
        Vt[(d0 + 2 * e) * 196 + j] = (u16)(vq[e] & 0xffffu);
        Vt[(d0 + 2 * e + 1) * 196 + j] = (u16)(vq[e] >> 16);
      }
    }
    __syncthreads();
    const int qh = kvh * 4 + (wv & 3);
    const float slope = exp2f(-(float)(qh + 1)), sink = p.sinks[qh];
#pragma unroll 1
    for (int ps = 0; ps < 2; ps++) {
      const int q0 = (wv >> 2) * 32 + ps * 16;
      const int tq = q0 + fr;
      const u16* qp = p.P + (size_t)(gq0 + tq) * INC + 1792 + qh * 64 + fq * 8;
      const bf16x8 qf0 = *(const bf16x8*)(qp), qf1 = *(const bf16x8*)(qp + 32);
      f32x4 sc[12];
#pragma unroll
      for (int kt = 0; kt < 12; kt++) {
        sc[kt] = f32x4{0.f, 0.f, 0.f, 0.f};
        const bf16x8 a0 = *(const bf16x8*)(Ks + (kt * 16 + fr) * 72 + fq * 8);
        const bf16x8 a1 = *(const bf16x8*)(Ks + (kt * 16 + fr) * 72 + 32 + fq * 8);
        sc[kt] = MFMA16(a0, qf0, sc[kt]);
        sc[kt] = MFMA16(a1, qf1, sc[kt]);
        if ((kt & 3) == 3) SCHED;
      }
      float mx = -3e38f;
#pragma unroll
      for (int kt = 0; kt < 12; kt++)
#pragma unroll
        for (int j = 0; j < 4; j++) {
          const int key = kt * 16 + fq * 4 + j;
          float s = sc[kt][j] * 0.125f - slope * fabsf((float)(128 + tq - key));
          if (!samp && (c - 2) * 64 + key < 0) s = -1e30f;
          sc[kt][j] = s;
          mx = fmaxf(mx, s);
        }
      mx = fmaxf(mx, __shfl_xor(mx, 16));
      mx = fmaxf(mx, __shfl_xor(mx, 32));
      mx = fmaxf(mx, sink);
      float sum = 0.f;
#pragma unroll
      for (int kt = 0; kt < 12; kt++)
#pragma unroll
        for (int j = 0; j < 4; j++) {
          const float e = __expf(sc[kt][j] - mx);
          sc[kt][j] = e;
          sum += e;
        }
      sum += __shfl_xor(sum, 16);
      sum += __shfl_xor(sum, 32);
      sum += __expf(sink - mx);
      const float inv = 1.f / sum;
      f32x4 o[4];
#pragma unroll
      for (int dt = 0; dt < 4; dt++) o[dt] = f32x4{0.f, 0.f, 0.f, 0.f};
#pragma unroll
      for (int t2 = 0; t2 < 6; t2++) {
        const u32x4 pw = {pack2(sc[2 * t2][0] * inv, sc[2 * t2][1] * inv), pack2(sc[2 * t2][2] * inv, sc[2 * t2][3] * inv),
                          pack2(sc[2 * t2 + 1][0] * inv, sc[2 * t2 + 1][1] * inv),
                          pack2(sc[2 * t2 + 1][2] * inv, sc[2 * t2 + 1][3] * inv)};
        const bf16x8 pa = __builtin_bit_cast(bf16x8, pw);
#pragma unroll
        for (int dt = 0; dt < 4; dt++) {
          const u16* vp = Vt + (dt * 16 + fr) * 196 + t2 * 32 + fq * 4;
          const uint2 v0 = *(const uint2*)vp, v1 = *(const uint2*)(vp + 16);
          const bf16x8 vb = __builtin_bit_cast(bf16x8, u32x4{v0.x, v0.y, v1.x, v1.y});
          o[dt] = MFMA16(pa, vb, o[dt]);
        }
        SCHED;
      }
#pragma unroll
      for (int dt = 0; dt < 4; dt++)
#pragma unroll
        for (int j = 0; j < 4; j++)
          p.OATT[(size_t)(gq0 + q0 + fq * 4 + j) * 512 + qh * 64 + dt * 16 + fr] = f2bf(o[dt][j]);
    }
  }
  const u16* SA = (const u16*)(p.out);
  const u16* SB = p.H;
  for (int it4 = bid * NW + wv; it4 < T * 2; it4 += nb * NW) {
    const int it = it4 * 4 + (lane >> 4), c0 = (lane & 15) * 4;
    const int g = it >> 3, h = it & 7, col = h * 64 + c0;
    const uint2 yw = *(const uint2*)(p.Y + (size_t)g * 512 + col);
    const uint2 rw = *(const uint2*)(SA + (size_t)it * 256 + c0), kw = *(const uint2*)(SA + (size_t)it * 256 + 128 + c0);
    const uint2 vw = *(const uint2*)(SB + (size_t)it * 128 + c0), gw = *(const uint2*)(p.G + (size_t)g * 512 + col);
    const float4 lw = *(const float4*)(p.lnx_w + col), lb = *(const float4*)(p.lnx_b + col), rk = *(const float4*)(p.r_k + col);
    const float y0 = bflo(yw.x), y1 = bfhi(yw.x), y2 = bflo(yw.y), y3 = bfhi(yw.y);
    const float mean = red16((y0 + y1) + (y2 + y3)) * (1.f / 64.f);
    const float e0 = y0 - mean, e1 = y1 - mean, e2 = y2 - mean, e3 = y3 - mean;
    const float var = red16((e0 * e0 + e1 * e1) + (e2 * e2 + e3 * e3)) * (1.f / 64.f);
    const float bonus = red16((bflo(rw.x) * bflo(kw.x) * rk.x + bfhi(rw.x) * bfhi(kw.x) * rk.y) +
                              (bflo(rw.y) * bflo(kw.y) * rk.z + bfhi(rw.y) * bfhi(kw.y) * rk.w));
    const float rsd = rsqrtf(var + 64e-5f);
    const float o0 = (e0 * rsd * lw.x + lb.x + bonus * bflo(vw.x)) * bflo(gw.x);
    const float o1 = (e1 * rsd * lw.y + lb.y + bonus * bfhi(vw.x)) * bfhi(gw.x);
    const float o2 = (e2 * rsd * lw.z + lb.z + bonus * bflo(vw.y)) * bflo(gw.y);
    const float o3 = (e3 * rsd * lw.w + lb.w + bonus * bfhi(vw.y)) * bfhi(gw.y);
    if (!dry || o0 == 123.456f) *(uint2*)(p.Y + (size_t)g * 512 + col) = make_uint2(pack2(o0, o1), pack2(o2, o3));
  }
}

__device__ void ph_gemm2(const Params& p, int bid, int nb) {
  const int tid_ = otid();
  u16* MG = p.H;
  const u16* Cs = (const u16*)dsm;
  const int nM = 260, nN = 4;
  for (int round = 0; round * nb < nM * nN; ++round) {
    int pm, pn;
    if (!tile_of(round, bid, nb, nM, nN, pm, pn)) break;
    f32x4 acc[2][2][4][2];
#pragma unroll 1
    for (int br = 0; br < 2; br++) {
      gemm256<512>(br ? p.OATT : p.Y, p.WbT + (size_t)br * 1024 * 512, pm * 256, pn * 256, acc);
      acc_to_lds(acc);
#pragma unroll 2
      for (int it = 0; it < 16; it++) {
        const int id = it * NTH + tid_, rl = id >> 5, c8 = (id & 31) * 8;
        const int row = pm * 256 + rl, col = pn * 256 + c8;
        const u32x4 v = *(const u32x4*)(Cs + rl * CS_LD + c8);
        const u32x4 gw = *(const u32x4*)(p.P + (size_t)row * INC + 2560 + br * 1024 + col);
        u32x4 prev = {0u, 0u, 0u, 0u};
        if (br) prev = *(const u32x4*)(MG + (size_t)row * 1024 + col);
        u32x4 o;
#pragma unroll
        for (int e = 0; e < 4; e++) {
          const float r0 = bflo(prev[e]) + sigmoidf_(bflo(gw[e])) * bflo(v[e]);
          const float r1 = bfhi(prev[e]) + sigmoidf_(bfhi(gw[e])) * bfhi(v[e]);
          o[e] = pack2(r0, r1);
        }
        *(u32x4*)(MG + (size_t)row * 1024 + col) = o;
      }
    }
  }
}

__device__ void ph_gemm3(const Params& p, int bid, int nb) {
  const int tid_ = otid();
  const u16* MG = p.H;
  const u16* Cs = (const u16*)dsm;
  const int nM = 260, nN = 4;
  for (int round = 0; round * nb < nM * nN; ++round) {
    int pm, pn;
    if (!tile_of(round, bid, nb, nM, nN, pm, pn)) break;
    f32x4 acc[2][2][4][2];
    gemm256<1024>(MG, p.WoutT, pm * 256, pn * 256, acc);
    acc_to_lds(acc);
#pragma unroll 2
    for (int it = 0; it < 16; it++) {
      const int id = it * NTH + tid_, rl = id >> 5, c8 = (id & 31) * 8;
      const int row = pm * 256 + rl, col = pn * 256 + c8;
      const u32x4 v = *(const u32x4*)(Cs + rl * CS_LD + c8);
      const float* xr = xrow(p, row) + col;
      const float4 x0 = *(const float4*)xr, x1 = *(const float4*)(xr + 4);
      *(u32x4*)(p.P + (size_t)row * 1024 + col) =
          u32x4{pack2(x0.x + bflo(v[0]), x0.y + bfhi(v[0])), pack2(x0.z + bflo(v[1]), x0.w + bfhi(v[1])),
                pack2(x1.x + bflo(v[2]), x1.y + bfhi(v[2])), pack2(x1.z + bflo(v[3]), x1.w + bfhi(v[3]))};
    }
  }
}

__device__ void ph_norm2(const Params& p, int bid, int nb) {
  const int tid = otid(), lane = tid & 63, wv = tid >> 6;
  for (int row = bid * NW + wv; row < T; row += nb * NW) {
    const uint2* x = (const uint2*)(p.P + (size_t)row * 1024);
    float4 v[4];
    float ss = 0.f;
#pragma unroll
    for (int i = 0; i < 4; i++) {
      const uint2 xw = x[lane + i * 64];
      v[i] = make_float4(bflo(xw.x), bfhi(xw.x), bflo(xw.y), bfhi(xw.y));
      ss += v[i].x * v[i].x + v[i].y * v[i].y + v[i].z * v[i].z + v[i].w * v[i].w;
    }
    ss = wave_sum(ss);
    const float rs = rsqrtf(ss * (1.f / 1024.f) + 1e-6f);
    u16* hr = p.H + (size_t)row * 1024;
    float4 y[4];
    float am = 0.f;
#pragma unroll
    for (int i = 0; i < 4; i++) {
      const float4 g = ((const float4*)p.norm2_g)[lane + i * 64];
      y[i] = make_float4(v[i].x * rs * g.x, v[i].y * rs * g.y, v[i].z * rs * g.z, v[i].w * rs * g.w);
      ((uint2*)hr)[lane + i * 64] = make_uint2(pack2(y[i].x, y[i].y), pack2(y[i].z, y[i].w));
      am = fmaxf(am, fmaxf(fmaxf(fabsf(y[i].x), fabsf(y[i].y)), fmaxf(fabsf(y[i].z), fabsf(y[i].w))));
    }
    am = fmaxf(wave_max(am), 1e-30f);
    const float sc = 240.f / am;
    if (lane == 0) p.SH[row] = am * (1.f / 240.f);
    u32* h8 = (u32*)((unsigned char*)p.Y + (size_t)row * 1024);
#pragma unroll
    for (int i = 0; i < 4; i++) h8[lane + i * 64] = q4(y[i].x, y[i].y, y[i].z, y[i].w, sc);
  }
}

DI void ins16(float (&l)[16], float x) {
#pragma unroll
  for (int i = 0; i < 16; i++) {
    const float hi = fmaxf(l[i], x);
    x = fminf(l[i], x);
    l[i] = hi;
  }
}


DI void ce_desc(float& a, float& b) { const float hi = fmaxf(a, b), lo = fminf(a, b); a = hi; b = lo; }
DI void bitonic_sort16_desc(float (&a)[16]) {
#pragma unroll
  for (int k = 2; k <= 16; k <<= 1)
#pragma unroll
    for (int j = k >> 1; j > 0; j >>= 1)
#pragma unroll
      for (int i = 0; i < 16; i++) {
        const int l = i ^ j;
        if (l > i) {
          if ((i & k) == 0) ce_desc(a[i], a[l]);
          else ce_desc(a[l], a[i]);
        }
      }
}
DI void bitonic_merge16_desc(float (&a)[16]) {
#pragma unroll
  for (int j = 8; j > 0; j >>= 1)
#pragma unroll
    for (int i = 0; i < 16; i++) {
      const int l = i ^ j;
      if (l > i) ce_desc(a[i], a[l]);
    }
}
DI void top16_merge(float (&a)[16], const float (&b)[16]) {
#pragma unroll
  for (int i = 0; i < 16; i++) a[i] = fmaxf(a[i], b[15 - i]);
  bitonic_merge16_desc(a);
}

__device__ void ph_peerq(const Params& p, int bid, int nb) {
  GT_VARS
  const int l31 = lane & 31, kh = lane >> 5;
  u16* Qs = (u16*)dsm;
  unsigned char* lt = (unsigned char*)(dsm + 135168 + wid * 1024);
  int* IDX = (int*)p.G;
  float* GATE = (float*)p.OATT;
  const int nM = 260, nN = 4;
  for (int round = 0; round * nb < nM * nN; ++round) {
    int pm, pn;
    if (!tile_of(round, bid, nb, nM, nN, pm, pn)) break;
    {
      f32x4 acc[2][2][4][2];
      gemm256<1024>(p.H, p.WqT, pm * 256, pn * 256, acc);
      acc_to_lds(acc);
    }
#pragma unroll 1
    for (int hh = 0; hh < 2; hh++) {
      const int hp = pn * 2 + hh;
      float l1[16], l2[16];
#pragma unroll
      for (int i = 0; i < 16; i++) { l1[i] = 0.f; l2[i] = 0.f; }
#pragma unroll 1
      for (int pp = 0; pp < 2; pp++) {
        f32x16 sc[4];
#pragma unroll
        for (int m4 = 0; m4 < 4; m4++) {
#pragma unroll
          for (int i = 0; i < 16; i++) sc[m4][i] = 0.f;
#pragma unroll
          for (int kk = 0; kk < 4; kk++) {
            const bf16x8 a = *(const bf16x8*)(p.SK + (size_t)(pp * 128 + m4 * 32 + l31) * 64 + kk * 16 + kh * 8);
            const bf16x8 bq = *(const bf16x8*)(Qs + (wid * 32 + l31) * 264 + hh * 128 + pp * 64 + kk * 16 + kh * 8);
            sc[m4] = MFMA32(a, bq, sc[m4]);
          }
        }
        float l[16], q1[16], q2[16], q3[16];
#pragma unroll
        for (int i = 0; i < 16; i++) {
          const u32 nb_ = (i >> 2) * 8 + kh * 4 + (i & 3);
          l[i] = __uint_as_float((__float_as_uint(sc[0][i]) & ~0x7Fu) | nb_);
          q1[i] = __uint_as_float((__float_as_uint(sc[1][i]) & ~0x7Fu) | (32u + nb_));
          q2[i] = __uint_as_float((__float_as_uint(sc[2][i]) & ~0x7Fu) | (64u + nb_));
          q3[i] = __uint_as_float((__float_as_uint(sc[3][i]) & ~0x7Fu) | (96u + nb_));
        }
        bitonic_sort16_desc(l);
        bitonic_sort16_desc(q1);
        bitonic_sort16_desc(q2);
        bitonic_sort16_desc(q3);
        top16_merge(l, q1);
        top16_merge(q2, q3);
        top16_merge(l, q2);
        float o[16];
#pragma unroll
        for (int i = 0; i < 16; i++) o[i] = __shfl_xor(l[i], 32);
        top16_merge(l, o);
#pragma unroll
        for (int i = 0; i < 16; i++) {
          l1[i] = pp == 0 ? l[i] : l1[i];
          l2[i] = pp == 0 ? l2[i] : l[i];
        }
      }
      if (kh == 0) {
        u32 w[8];
#pragma unroll
        for (int q = 0; q < 4; q++) {
          w[q] = (__float_as_uint(l1[4 * q]) & 0x7F) | ((__float_as_uint(l1[4 * q + 1]) & 0x7F) << 8) |
                 ((__float_as_uint(l1[4 * q + 2]) & 0x7F) << 16) | ((__float_as_uint(l1[4 * q + 3]) & 0x7F) << 24);
          w[4 + q] = (__float_as_uint(l2[4 * q]) & 0x7F) | ((__float_as_uint(l2[4 * q + 1]) & 0x7F) << 8) |
                     ((__float_as_uint(l2[4 * q + 2]) & 0x7F) << 16) | ((__float_as_uint(l2[4 * q + 3]) & 0x7F) << 24);
        }
        *(uint4*)(lt + l31 * 32) = make_uint4(w[0], w[1], w[2], w[3]);
        *(uint4*)(lt + l31 * 32 + 16) = make_uint4(w[4], w[5], w[6], w[7]);
      }
      float v1[16], v2[16];
#pragma unroll
      for (int i = 0; i < 16; i++) {
        v1[i] = __uint_as_float(__float_as_uint(l1[i]) & ~0x7Fu);
        v2[i] = __uint_as_float(__float_as_uint(l2[i]) & ~0x7Fu);
      }
#define CAND(a, b) __uint_as_float((__float_as_uint(v1[a] + v2[b]) & ~0xFFu) | (u32)((a) * 16 + (b)))
      float l3[16], y1[16], y2[16];
#pragma unroll
      for (int b = 0; b < 16; b++) l3[b] = CAND(0, b);
#pragma unroll
      for (int b = 0; b < 8; b++) y1[b] = CAND(1, b);
#pragma unroll
      for (int b = 0; b < 5; b++) y1[8 + b] = CAND(2, b);
#pragma unroll
      for (int b = 0; b < 3; b++) y1[13 + b] = CAND(4, b);
#pragma unroll
      for (int b = 0; b < 4; b++) y2[b] = CAND(3, b);
      y2[4] = CAND(5, 0); y2[5] = CAND(5, 1); y2[6] = CAND(6, 0); y2[7] = CAND(6, 1); y2[8] = CAND(7, 0); y2[9] = CAND(7, 1);
      y2[10] = CAND(8, 0); y2[11] = CAND(9, 0); y2[12] = CAND(10, 0); y2[13] = CAND(11, 0); y2[14] = CAND(12, 0); y2[15] = CAND(13, 0);
      bitonic_sort16_desc(y1);
      bitonic_sort16_desc(y2);
      top16_merge(l3, y1);
      top16_merge(l3, y2);
      ins16(l3, CAND(14, 0));
      ins16(l3, CAND(15, 0));
#undef CAND
      __builtin_amdgcn_fence(__ATOMIC_RELEASE, "workgroup");
      __builtin_amdgcn_wave_barrier();
      if (kh == 0) {
        const int g = pm * 256 + wid * 32 + l31;
        float ev[16];
        int ei[16];
        float sum = 0.f;
        const float mxv = __uint_as_float(__float_as_uint(l3[0]) & ~0xFFu);
#pragma unroll
        for (int k = 0; k < 16; k++) {
          const u32 bits = __float_as_uint(l3[k]);
          const u32 pos = bits & 0xFF;
          ev[k] = __expf(__uint_as_float(bits & ~0xFFu) - mxv);
          sum += ev[k];
          ei[k] = (int)lt[l31 * 32 + (pos >> 4)] * 128 + (int)lt[l31 * 32 + 16 + (pos & 15)];
        }
        const float inv = 1.f / sum;
        int4* ip = (int4*)(IDX + (size_t)g * 128 + hp * 16);
        float4* gp = (float4*)(GATE + (size_t)g * 128 + hp * 16);
#pragma unroll
        for (int q = 0; q < 4; q++) {
          ip[q] = make_int4(ei[4 * q], ei[4 * q + 1], ei[4 * q + 2], ei[4 * q + 3]);
          gp[q] = make_float4(ev[4 * q] * inv, ev[4 * q + 1] * inv, ev[4 * q + 2] * inv, ev[4 * q + 3] * inv);
        }
      }
      __builtin_amdgcn_wave_barrier();
    }
  }
}

__device__ void ph_peer(const Params& p, int bid, int nb, bool dry = false) {
  const int tid = otid(), lane = tid & 63, wv = tid >> 6;
  constexpr int ST = 1104;
  char* wb = dsm + wv * (16 * ST + 2048);
  unsigned char* stg = (unsigned char*)wb;
  unsigned char* hs = stg + 16 * ST;
  float* acts = (float*)(hs + 1024);
  int* idxs = (int*)(hs + 1536);
  const int gr = lane >> 3, gc = lane & 7;
  const int* IDX = (const int*)p.G;
  const float* GATE = (const float*)p.OATT;
  const unsigned char* H8 = (const unsigned char*)p.Y;
  const int n = lane & 15, quad = lane >> 4;
  for (int g = bid * NW + wv; g < T; g += nb * NW) {
    *(u32x4*)(hs + lane * 16) = *(const u32x4*)(H8 + (size_t)g * 1024 + lane * 16);
    idxs[lane] = IDX[(size_t)g * 128 + lane];
    idxs[lane + 64] = IDX[(size_t)g * 128 + 64 + lane];
    const float shv = p.SH[g];
    __builtin_amdgcn_fence(__ATOMIC_RELEASE, "workgroup");
    __builtin_amdgcn_wave_barrier();
    {
      u32x4 ring[16];
      {
        const unsigned char* ua = p.U8 + (size_t)idxs[gr] * 1024 + gc * 16;
        const unsigned char* ub = p.U8 + (size_t)idxs[8 + gr] * 1024 + gc * 16;
#pragma unroll
        for (int i = 0; i < 8; i++) { ring[i] = *(const u32x4*)(ua + i * 128); ring[8 + i] = *(const u32x4*)(ub + i * 128); }
      }
#pragma unroll 1
      for (int grp = 0; grp < 8; grp++) {
        const int gn = grp < 7 ? grp + 1 : grp;
        const unsigned char* ua = p.U8 + (size_t)idxs[gn * 16 + gr] * 1024 + gc * 16;
        const unsigned char* ub = p.U8 + (size_t)idxs[gn * 16 + 8 + gr] * 1024 + gc * 16;
        const float4 gt = *(const float4*)(GATE + (size_t)g * 128 + grp * 16 + quad * 4);
        const int4 ee = *(const int4*)(idxs + grp * 16 + quad * 4);
        const float su0 = p.SU[ee.x], su1 = p.SU[ee.y], su2 = p.SU[ee.z], su3 = p.SU[ee.w];
        const float sv0 = p.SV[ee.x], sv1 = p.SV[ee.y], sv2 = p.SV[ee.z], sv3 = p.SV[ee.w];
#pragma unroll
        for (int i = 0; i < 8; i++) {
          *(u32x4*)(stg + gr * ST + i * 128 + gc * 16) = ring[i];
          *(u32x4*)(stg + (8 + gr) * ST + i * 128 + gc * 16) = ring[8 + i];
          if (grp < 7) { ring[i] = *(const u32x4*)(ua + i * 128); ring[8 + i] = *(const u32x4*)(ub + i * 128); }
        }
        __builtin_amdgcn_fence(__ATOMIC_RELEASE, "workgroup");
        __builtin_amdgcn_wave_barrier();
        f32x4 acc = {0.f, 0.f, 0.f, 0.f};
#pragma unroll
        for (int st = 0; st < 16; st++) {
          const u32x4 ua4 = *(const u32x4*)(stg + n * ST + st * 64 + quad * 16);
          const u32x4 hb = *(const u32x4*)(hs + st * 64 + quad * 16);
          const long a0 = (long)(((unsigned long)ua4[1] << 32) | ua4[0]);
          const long a1 = (long)(((unsigned long)ua4[3] << 32) | ua4[2]);
          const long b0 = (long)(((unsigned long)hb[1] << 32) | hb[0]);
          const long b1 = (long)(((unsigned long)hb[3] << 32) | hb[2]);
          acc = __builtin_amdgcn_mfma_f32_16x16x32_fp8_fp8(a0, b0, acc, 0, 0, 0);
          acc = __builtin_amdgcn_mfma_f32_16x16x32_fp8_fp8(a1, b1, acc, 0, 0, 0);
        }
        __builtin_amdgcn_wave_barrier();
        const float d0 = acc[0] * shv * su0, d1 = acc[1] * shv * su1, d2 = acc[2] * shv * su2, d3 = acc[3] * shv * su3;
        float4 av;
        av.x = 0.5f * d0 * (1.f + erff(d0 * 0.70710678118f)) * gt.x * sv0;
        av.y = 0.5f * d1 * (1.f + erff(d1 * 0.70710678118f)) * gt.y * sv1;
        av.z = 0.5f * d2 * (1.f + erff(d2 * 0.70710678118f)) * gt.z * sv2;
        av.w = 0.5f * d3 * (1.f + erff(d3 * 0.70710678118f)) * gt.w * sv3;
        if (n == 0) *(float4*)(acts + grp * 16 + quad * 4) = av;
      }
    }
    __builtin_amdgcn_fence(__ATOMIC_RELEASE, "workgroup");
    __builtin_amdgcn_wave_barrier();
    float o[16];
#pragma unroll
    for (int j = 0; j < 16; j++) o[j] = 0.f;
    {
      u32x4 ring[16];
#pragma unroll
      for (int k = 0; k < 16; k++) ring[k] = *(const u32x4*)(p.V8 + (size_t)idxs[k] * 1024 + lane * 16);
#pragma unroll 1
      for (int kb = 0; kb < 128; kb += 16) {
        const bool more = kb < 112;
        const int kn = more ? kb + 16 : kb;
#pragma unroll
        for (int j = 0; j < 16; j++) {
          const u32x4 vq = ring[j];
          if (more) ring[j] = *(const u32x4*)(p.V8 + (size_t)idxs[kn + j] * 1024 + lane * 16);
          const float a = acts[kb + j];
#pragma unroll
          for (int q = 0; q < 4; q++) {
            const f32x2 lo = __builtin_amdgcn_cvt_pk_f32_fp8((int)vq[q], false);
            const f32x2 hi = __builtin_amdgcn_cvt_pk_f32_fp8((int)vq[q], true);
            o[4 * q] += a * lo[0]; o[4 * q + 1] += a * lo[1]; o[4 * q + 2] += a * hi[0]; o[4 * q + 3] += a * hi[1];
          }
        }
      }
    }
    float* xr = p.out + (size_t)g * 1024 + lane * 16;
    float4 x[4];
    {
      const u32x4 xa = *(const u32x4*)(p.P + (size_t)g * 1024 + lane * 16), xb = *(const u32x4*)(p.P + (size_t)g * 1024 + lane * 16 + 8);
      x[0] = make_float4(bflo(xa[0]), bfhi(xa[0]), bflo(xa[1]), bfhi(xa[1]));
      x[1] = make_float4(bflo(xa[2]), bfhi(xa[2]), bflo(xa[3]), bfhi(xa[3]));
      x[2] = make_float4(bflo(xb[0]), bfhi(xb[0]), bflo(xb[1]), bfhi(xb[1]));
      x[3] = make_float4(bflo(xb[2]), bfhi(xb[2]), bflo(xb[3]), bfhi(xb[3]));
    }
    float ss = 0.f;
#pragma unroll
    for (int q = 0; q < 4; q++) {
      x[q].x += o[4 * q]; x[q].y += o[4 * q + 1]; x[q].z += o[4 * q + 2]; x[q].w += o[4 * q + 3];
      ss += x[q].x * x[q].x + x[q].y * x[q].y + x[q].z * x[q].z + x[q].w * x[q].w;
    }
    ss = wave_sum(ss);
    if (dry && ss != 123.456f) continue;
    const float rs = rsqrtf(ss * (1.f / 1024.f) + 1e-6f);
#pragma unroll
    for (int q = 0; q < 4; q++) {
      const float4 gq = *(const float4*)(p.final_g + lane * 16 + q * 4);
      *(float4*)(xr + q * 4) = make_float4(x[q].x * rs * gq.x, x[q].y * rs * gq.y, x[q].z * rs * gq.z, x[q].w * rs * gq.w);
    }
  }
}

__global__ void __launch_bounds__(512) mega_kernel(Params p) {
  cg::grid_group grid = cg::this_grid();
  const int bid = blockIdx.x, nb = gridDim.x;
  if (ON(0)) ph_prep(p, bid, nb);
  grid.sync();
  if (ON(1)) ph_gemm1(p, bid, nb);
  grid.sync();
  if (REP == 1) { ph_gemm1(p, bid, nb); grid.sync(); }
  if (ON(2)) ph_rwprep(p, bid, nb);
  grid.sync();
  if (REP == 2) { ph_rwprep(p, bid, nb); grid.sync(); }
  if (ON(3)) ph_scan(p, bid, nb);
  grid.sync();
  if (REP == 3) { ph_scan(p, bid, nb); grid.sync(); }
  if (REP == 4) { ph_attn(p, bid, nb, true); grid.sync(); }
  if (ON(4)) ph_attn(p, bid, nb);
  grid.sync();
  if (ON(5)) ph_gemm2(p, bid, nb);
  grid.sync();
  if (REP == 5) { ph_gemm2(p, bid, nb); grid.sync(); }
  if (ON(6)) ph_gemm3(p, bid, nb);
  grid.sync();
  if (REP == 6) { ph_gemm3(p, bid, nb); grid.sync(); }
  if (ON(7)) ph_norm2(p, bid, nb);
  grid.sync();
  if (ON(8)) ph_peerq(p, bid, nb);
  grid.sync();
  if (REP == 8) { ph_peerq(p, bid, nb); grid.sync(); }
  if (REP == 9) { ph_peer(p, bid, nb, true); grid.sync(); }
  if (ON(9)) ph_peer(p, bid, nb);
}

extern "C" void kernel_launch(void* const* d_in, const int* in_sizes, int n_in, void* d_out, int out_size, void* d_ws,
                              size_t ws_size, hipStream_t stream) {
  Params p{};
  const float** f = (const float**)&p;
  for (int i = 0; i < 28; i++) f[i] = (const float*)d_in[i];
  p.out = (float*)d_out;
  char* w = (char*)d_ws;
  size_t off = 0;
  auto take = [&](size_t bytes) { char* r = w + off; off += (bytes + 255) & ~(size_t)255; return (u16*)r; };
  p.H = take((size_t)MP * 1024 * 2);
  p.P = take((size_t)MP * INC * 2);
  p.U8 = (unsigned char*)take((size_t)16384 * 1024);
  p.V8 = (unsigned char*)take((size_t)16384 * 1024);
  p.SU = (float*)take(16384 * 4);
  p.SV = (float*)take(16384 * 4);
  p.SH = (float*)take((size_t)T * 4);
  p.WinT = take((size_t)4608 * 1024 * 2);
  p.WbT = take((size_t)2 * 1024 * 512 * 2);
  p.WoutT = take((size_t)1024 * 1024 * 2);
  p.WqT = take((size_t)1024 * 1024 * 2);
  p.W2T = take((size_t)512 * 64 * 2);
  p.A2T = take((size_t)512 * 64 * 2);
  p.G2T = take((size_t)512 * 128 * 2);
  p.SK = take((size_t)2 * 128 * 64 * 2);
  p.Y = take((size_t)T * 512 * 2);
  p.G = take((size_t)T * 512 * 2);
  p.OATT = take((size_t)T * 512 * 2);
  static int grid_blocks = 0;
  if (!grid_blocks) {
    int dev = 0, cus = 0, per_cu = 0;
    (void)hipGetDevice(&dev);
    (void)hipDeviceGetAttribute(&cus, hipDeviceAttributeMultiprocessorCount, dev);
    (void)hipFuncSetAttribute((const void*)mega_kernel, hipFuncAttributeMaxDynamicSharedMemorySize, DYN_LDS);
    (void)hipOccupancyMaxActiveBlocksPerMultiprocessor(&per_cu, mega_kernel, NTH, DYN_LDS);
    if (per_cu > 1) per_cu = 1;
    grid_blocks = cus * per_cu;
  }
  void* args[] = {&p};
  hipError_t e = hipLaunchCooperativeKernel((void*)mega_kernel, dim3(grid_blocks), dim3(NTH), args, DYN_LDS, stream);
  if (e != hipSuccess) fprintf(stderr, "cooperative launch failed: %s (grid %d)\n", hipGetErrorString(e), grid_blocks);
}
```

```cpp
#include <hip/hip_runtime.h>
#include <hip/hip_cooperative_groups.h>
#include <cstdio>
namespace cg = cooperative_groups;

#ifndef REP
#define REP -1
#endif
#ifndef ONLY
#define ONLY -1
#endif
#define ON(k) (ONLY < 0 || ONLY == (k))

typedef unsigned short u16;
typedef unsigned int u32;
using bf16x8 = __attribute__((ext_vector_type(8))) short;
using f32x4 = __attribute__((ext_vector_type(4))) float;
using f32x16 = __attribute__((ext_vector_type(16))) float;
using u32x4 = __attribute__((ext_vector_type(4))) u32;
#define DI __device__ __forceinline__

constexpr int TP = 65536, TS = 1024, T = 66560, MP = 66816;
constexpr int INC = 4608;
constexpr int NW = 8;
constexpr int NTH = 512;
constexpr size_t OFF_Y = 0, OFF_SHIFT_P = 68157440, OFF_WKV_P = 68173824, OFF_KP = 68698112, OFF_VP = 68960256,
                 OFF_SHIFT_S = 69222400, OFF_WKV_S = 69238784, OFF_KS = 69763072, OFF_VS = 69894144;
constexpr int DYN_LDS = 159744;

extern __shared__ __attribute__((aligned(16))) char dsm[];

struct Params {
  const float *x_prompt, *x_sample, *state_shift, *state_wkv, *cache_k, *cache_v, *norm1_g, *w_in, *mu, *w0, *w2, *a0,
      *a2, *g2, *k_k, *k_a, *r_k, *lnx_w, *lnx_b, *sinks, *w_branch, *w_out, *norm2_g, *peer_wq, *sub_keys, *peer_u,
      *peer_v, *final_g;
  float* out;
  u16 *H, *P, *WinT, *WbT, *WoutT, *WqT, *W2T, *A2T, *G2T, *SK, *Y, *G, *OATT;
  unsigned char *U8, *V8;
  float *SU, *SV, *SH;
  unsigned* bar;
};

typedef __bf16 hbf2 __attribute__((ext_vector_type(2)));
typedef float hf2 __attribute__((ext_vector_type(2)));
DI u16 f2bf(float x) { const __bf16 r = (__bf16)x; return __builtin_bit_cast(unsigned short, r); }
DI float bf2f(u16 b) { return __uint_as_float(((u32)b) << 16); }
DI u32 pack2(float a, float b) { const hf2 v = {a, b}; const hbf2 r = __builtin_convertvector(v, hbf2); return __builtin_bit_cast(u32, r); }
DI float bflo(u32 w) { return __uint_as_float(w << 16); }
DI float bfhi(u32 w) { return __uint_as_float(w & 0xffff0000u); }
DI float wave_sum(float v) {
#pragma unroll
  for (int o = 32; o; o >>= 1) v += __shfl_xor(v, o);
  return v;
}
DI float sigmoidf_(float x) { return 1.f / (1.f + __expf(-x)); }
DI const float* xrow(const Params& p, int g) {
  return g < TP ? p.x_prompt + (size_t)g * 1024 : p.x_sample + (size_t)(g - TP) * 1024;
}
DI int otid() { int t = threadIdx.x; asm volatile("" : "+v"(t)); return t; }
#define MFMA32(a, b, c) __builtin_amdgcn_mfma_f32_32x32x16_bf16((a), (b), (c), 0, 0, 0)
#define MFMA16(a, b, c) __builtin_amdgcn_mfma_f32_16x16x32_bf16((a), (b), (c), 0, 0, 0)

template <int CTRL>
DI float dppmov(float v) {
  return __int_as_float(__builtin_amdgcn_update_dpp(0, __float_as_int(v), CTRL, 0xF, 0xF, false));
}
DI float red16(float v) {
  v += dppmov<0x128>(v);
  v += dppmov<0x124>(v);
  v += dppmov<0x122>(v);
  v += dppmov<0x121>(v);
  return v;
}


using f32x2 = __attribute__((ext_vector_type(2))) float;
DI float wave_max(float v) {
#pragma unroll
  for (int o = 32; o; o >>= 1) v = fmaxf(v, __shfl_xor(v, o));
  return v;
}
DI u32 q4(float a, float b, float c, float d, float sc) {
  int w = 0;
  w = __builtin_amdgcn_cvt_pk_fp8_f32(a * sc, b * sc, w, false);
  w = __builtin_amdgcn_cvt_pk_fp8_f32(c * sc, d * sc, w, true);
  return (u32)w;
}

DI void tcvt(const float* __restrict__ W, u16* __restrict__ Wt, int K, int N, int gt, int nt) {
  const int total = N * (K / 8);
  for (int i = gt; i < total; i += nt) {
    const int n = i % N, kg = i / N;
    u32 o[4];
#pragma unroll
    for (int j = 0; j < 4; j++)
      o[j] = pack2(W[(size_t)(kg * 8 + 2 * j) * N + n], W[(size_t)(kg * 8 + 2 * j + 1) * N + n]);
    *(uint4*)(Wt + (size_t)n * K + kg * 8) = make_uint4(o[0], o[1], o[2], o[3]);
  }
}
DI void scvt(const float* __restrict__ W, u16* __restrict__ O, int n8, int gt, int nt) {
  for (int i = gt; i < n8; i += nt) {
    const float4 a = ((const float4*)W)[2 * i], b = ((const float4*)W)[2 * i + 1];
    ((uint4*)O)[i] = make_uint4(pack2(a.x, a.y), pack2(a.z, a.w), pack2(b.x, b.y), pack2(b.z, b.w));
  }
}

__device__ void ph_prep(const Params& p, int bid, int nb) {
  const int tid = otid(), lane = tid & 63, wv = tid >> 6;
  for (int row = bid * NW + wv; row < MP; row += nb * NW) {
    u16* hr = p.H + (size_t)row * 1024;
    if (row < T) {
      const float4* x = (const float4*)xrow(p, row);
      float4 v[4];
      float ss = 0.f;
#pragma unroll
      for (int i = 0; i < 4; i++) {
        v[i] = x[lane + i * 64];
        ss += v[i].x * v[i].x + v[i].y * v[i].y + v[i].z * v[i].z + v[i].w * v[i].w;
      }
      ss = wave_sum(ss);
      const float rs = rsqrtf(ss * (1.f / 1024.f) + 1e-6f);
      float* so = nullptr;
      if (row < TP) {
        if ((row & 4095) == 4095) so = p.out + OFF_SHIFT_P + (size_t)(row >> 12) * 1024;
      } else {
        const int r2 = row - TP;
        if ((r2 & 63) == 63) so = p.out + OFF_SHIFT_S + (size_t)(r2 >> 6) * 1024;
      }
#pragma unroll
      for (int i = 0; i < 4; i++) {
        const float4 g = ((const float4*)p.norm1_g)[lane + i * 64];
        float4 y;
        y.x = v[i].x * rs * g.x; y.y = v[i].y * rs * g.y; y.z = v[i].z * rs * g.z; y.w = v[i].w * rs * g.w;
        ((uint2*)hr)[lane + i * 64] = make_uint2(pack2(y.x, y.y), pack2(y.z, y.w));
        if (so) ((float4*)so)[lane + i * 64] = y;
      }
    } else if (row < T + 16) {
      const float4* x = (const float4*)(p.state_shift + (size_t)(row - T) * 1024);
#pragma unroll
      for (int i = 0; i < 4; i++) {
        const float4 y = x[lane + i * 64];
        ((uint2*)hr)[lane + i * 64] = make_uint2(pack2(y.x, y.y), pack2(y.z, y.w));
      }
    } else {
#pragma unroll
      for (int i = 0; i < 4; i++) ((uint2*)hr)[lane + i * 64] = make_uint2(0u, 0u);
    }
  }
  const int gt = bid * NTH + tid, nt = nb * NTH;
  tcvt(p.w_in, p.WinT, 1024, 4608, gt, nt);
  tcvt(p.w_branch, p.WbT, 512, 1024, gt, nt);
  tcvt(p.w_branch + 512 * 1024, p.WbT + 1024 * 512, 512, 1024, gt, nt);
  tcvt(p.w_out, p.WoutT, 1024, 1024, gt, nt);
  tcvt(p.peer_wq, p.WqT, 1024, 1024, gt, nt);
  tcvt(p.w2, p.W2T, 64, 512, gt, nt);
  tcvt(p.a2, p.A2T, 64, 512, gt, nt);
  tcvt(p.g2, p.G2T, 128, 512, gt, nt);
  scvt(p.sub_keys, p.SK, 2 * 128 * 64 / 8, gt, nt);
  for (int r = bid * NW + wv; r < 32768; r += nb * NW) {
    const bool isv = r >= 16384;
    const int e = r & 16383;
    const float4* src = (const float4*)((isv ? p.peer_v : p.peer_u) + (size_t)e * 1024) + lane * 4;
    const float4 a = src[0], b = src[1], c = src[2], d = src[3];
    float am = fmaxf(fmaxf(fmaxf(fabsf(a.x), fabsf(a.y)), fmaxf(fabsf(a.z), fabsf(a.w))),
                     fmaxf(fmaxf(fabsf(b.x), fabsf(b.y)), fmaxf(fabsf(b.z), fabsf(b.w))));
    am = fmaxf(am, fmaxf(fmaxf(fmaxf(fabsf(c.x), fabsf(c.y)), fmaxf(fabsf(c.z), fabsf(c.w))),
                         fmaxf(fmaxf(fabsf(d.x), fabsf(d.y)), fmaxf(fabsf(d.z), fabsf(d.w)))));
    am = fmaxf(wave_max(am), 1e-30f);
    const float sc = 240.f / am;
    if (lane == 0) (isv ? p.SV : p.SU)[e] = am * (1.f / 240.f);
    *(u32x4*)((isv ? p.V8 : p.U8) + (size_t)e * 1024 + lane * 16) =
        u32x4{q4(a.x, a.y, a.z, a.w, sc), q4(b.x, b.y, b.z, b.w, sc), q4(c.x, c.y, c.z, c.w, sc), q4(d.x, d.y, d.z, d.w, sc)};
  }
}

constexpr int GBK = 64, GHALF = 128, GHT = GHALF * GBK;
DI int lds_byte(int r, int c) {
  const int st = (r >> 4) * 2 + (c >> 5), rr = r & 15, cc = c & 31, ob = rr * 64 + cc * 2;
  return st * 1024 + (ob ^ (((ob >> 9) & 1) << 5));
}
DI void stage_rc(int b, int& R, int& C) {
  const int st = b / 1024, sb = b % 1024, swz = sb ^ (((sb >> 9) & 1) << 5);
  R = (st >> 1) * 16 + swz / 64;
  C = (st & 1) * 32 + (swz % 64) / 2;
}
typedef __attribute__((address_space(3))) unsigned lds_u32;
#define G_SA(b, h) (shm + ((b) * 2 + (h)) * GHT)
#define G_SB(b, h) (shm + (4 + (b) * 2 + (h)) * GHT)
#define G_STAGE(P_, RS, br, kt)                                                                                   \
  do {                                                                                                            \
    const int _so = ((br) * K + (kt) * GBK) * 2;                                                                  \
    __builtin_amdgcn_raw_ptr_buffer_load_lds(RS, (lds_u32*)((char*)(P_) + tb0), 16, ob0, _so, 0, 0);              \
    __builtin_amdgcn_raw_ptr_buffer_load_lds(RS, (lds_u32*)((char*)(P_) + tb0 + 8192), 16, ob1, _so, 0, 0);       \
  } while (0)
#define G_LDA(dst, b, h)                                  \
  _Pragma("unroll") for (int m = 0; m < 4; ++m)           \
  _Pragma("unroll") for (int k = 0; k < 2; ++k)           \
    dst[m][k] = *reinterpret_cast<const bf16x8*>((const char*)G_SA(b, h) + lds_byte(wr * 64 + m * 16 + fr, k * 32 + fq * 8))
#define G_LDB(dst, b, h)                                  \
  _Pragma("unroll") for (int n = 0; n < 2; ++n)           \
  _Pragma("unroll") for (int k = 0; k < 2; ++k)           \
    dst[n][k] = *reinterpret_cast<const bf16x8*>((const char*)G_SB(b, h) + lds_byte(wc * 32 + n * 16 + fr, k * 32 + fq * 8))
#define G_MMA(ai, bj, At_, Bt_)                                                                         \
  do {                                                                                                  \
    __builtin_amdgcn_s_setprio(1);                                                                      \
    _Pragma("unroll") for (int m = 0; m < 4; ++m)                                                       \
    _Pragma("unroll") for (int n = 0; n < 2; ++n)                                                       \
    _Pragma("unroll") for (int k = 0; k < 2; ++k)                                                       \
      acc[ai][bj][m][n] = MFMA16(At_[m][k], Bt_[n][k], acc[ai][bj][m][n]);                              \
    __builtin_amdgcn_s_setprio(0);                                                                      \
  } while (0)
#define WAIT_V(n) asm volatile("s_waitcnt vmcnt(" #n ")" ::: "memory")
#define WAIT_L(n) asm volatile("s_waitcnt lgkmcnt(" #n ")" ::: "memory")
#define BAR __builtin_amdgcn_s_barrier()
#define SCHED __builtin_amdgcn_sched_barrier(0)

template <int K>
DI void gemm256(const u16* __restrict__ A, const u16* __restrict__ Bt, const int brow, const int bcol,
                f32x4 (&acc)[2][2][4][2]) {
  u16* shm = (u16*)dsm;
  const int tid_ = otid();
  const int wid = tid_ >> 6, lane = tid_ & 63, wr = wid >> 2, wc = wid & 3, fr = lane & 15, fq = lane >> 4;
#pragma unroll
  for (int a = 0; a < 2; a++)
#pragma unroll
    for (int b = 0; b < 2; b++)
#pragma unroll
      for (int m = 0; m < 4; m++)
#pragma unroll
        for (int n = 0; n < 2; n++) acc[a][b][m][n] = f32x4{0.f, 0.f, 0.f, 0.f};
  bf16x8 At[4][2], B0[2][2], B1[2][2];
  constexpr int nt = K / GBK;
  const __amdgpu_buffer_rsrc_t rsA = __builtin_amdgcn_make_buffer_rsrc((void*)A, 0, 0x7fffffff, 0x00020000);
  const __amdgpu_buffer_rsrc_t rsB = __builtin_amdgcn_make_buffer_rsrc((void*)Bt, 0, 0x7fffffff, 0x00020000);
  const unsigned tb0 = tid_ * 16;
  int ob0, ob1;
  {
    int r_, c_;
    stage_rc((int)tb0, r_, c_);
    ob0 = (r_ * K + c_) * 2;
    stage_rc((int)tb0 + 8192, r_, c_);
    ob1 = (r_ * K + c_) * 2;
  }
  WAIT_V(0);
  __syncthreads();
  G_STAGE(G_SB(0, 0), rsB, bcol, 0); G_STAGE(G_SA(0, 0), rsA, brow, 0);
  G_STAGE(G_SB(0, 1), rsB, bcol + GHALF, 0); G_STAGE(G_SA(0, 1), rsA, brow + GHALF, 0);
  if (wr == 1) BAR;
  WAIT_V(4); BAR;
  G_STAGE(G_SB(1, 0), rsB, bcol, 1); G_STAGE(G_SA(1, 0), rsA, brow, 1); G_STAGE(G_SB(1, 1), rsB, bcol + GHALF, 1);
  WAIT_V(6); BAR;
  for (int t = 0; t < nt - 2; t += 2) {
    G_LDB(B0, 0, 0); SCHED; G_LDA(At, 0, 0); G_STAGE(G_SA(1, 1), rsA, brow + GHALF, t + 1);
    WAIT_L(8); BAR; WAIT_L(0); G_MMA(0, 0, At, B0); BAR; SCHED;
    G_LDB(B1, 0, 1); G_STAGE(G_SB(0, 0), rsB, bcol, t + 2);
    BAR; WAIT_L(0); G_MMA(0, 1, At, B1); BAR;
    G_LDA(At, 0, 1); G_STAGE(G_SA(0, 0), rsA, brow, t + 2);
    BAR; WAIT_L(0); G_MMA(1, 0, At, B0); BAR; SCHED;
    G_STAGE(G_SB(0, 1), rsB, bcol + GHALF, t + 2);
    WAIT_V(6); BAR; G_MMA(1, 1, At, B1); BAR;
    G_LDB(B0, 1, 0); SCHED; G_LDA(At, 1, 0); G_STAGE(G_SA(0, 1), rsA, brow + GHALF, t + 2);
    WAIT_L(8); BAR; WAIT_L(0); G_MMA(0, 0, At, B0); BAR; SCHED;
    G_LDB(B1, 1, 1); G_STAGE(G_SB(1, 0), rsB, bcol, t + 3);
    BAR; WAIT_L(0); G_MMA(0, 1, At, B1); BAR;
    G_LDA(At, 1, 1); G_STAGE(G_SA(1, 0), rsA, brow, t + 3);
    BAR; WAIT_L(0); G_MMA(1, 0, At, B0); BAR; SCHED;
    G_STAGE(G_SB(1, 1), rsB, bcol + GHALF, t + 3);
    WAIT_V(6); BAR; G_MMA(1, 1, At, B1); BAR;
  }
  {
    G_LDB(B0, 0, 0); G_LDA(At, 0, 0); G_STAGE(G_SA(1, 1), rsA, brow + GHALF, nt - 1);
    BAR; WAIT_L(0); G_MMA(0, 0, At, B0); BAR;
    G_LDB(B1, 0, 1); BAR; WAIT_L(0); G_MMA(0, 1, At, B1); BAR;
    G_LDA(At, 0, 1); WAIT_V(4); BAR; WAIT_L(0); G_MMA(1, 0, At, B0); G_MMA(1, 1, At, B1); BAR;
  }
  {
    G_LDB(B0, 1, 0); G_LDA(At, 1, 0); WAIT_V(2); BAR; WAIT_L(0); G_MMA(0, 0, At, B0); BAR;
    G_LDB(B1, 1, 1); WAIT_V(0); BAR; WAIT_L(0); G_MMA(0, 1, At, B1); BAR;
    G_LDA(At, 1, 1); BAR; WAIT_L(0); G_MMA(1, 0, At, B0); G_MMA(1, 1, At, B1); BAR;
  }
  if (wr == 0) BAR;
}
#define GT_VARS \
  const int tid_ = otid(); const int wid = tid_ >> 6, lane = tid_ & 63, wr = wid >> 2, wc = wid & 3, fr = lane & 15, fq = lane >> 4;
#define GT_ROW(ai, m, j) ((ai) * 128 + wr * 64 + (m) * 16 + fq * 4 + (j))
#define GT_COL(bj, n) ((bj) * 128 + wc * 32 + (n) * 16 + fr)
#define GT_FOR                                       \
  _Pragma("unroll") for (int ai = 0; ai < 2; ++ai)   \
  _Pragma("unroll") for (int bj = 0; bj < 2; ++bj)   \
  _Pragma("unroll") for (int m = 0; m < 4; ++m)      \
  _Pragma("unroll") for (int n = 0; n < 2; ++n)      \
  _Pragma("unroll") for (int j = 0; j < 4; ++j)

DI bool tile_of(int round, int bid, int nb, int nM, int nN, int& pm, int& pn) {
  const int vt = round * nb + (bid & 7) * (nb >> 3) + (bid >> 3);
  if (vt >= nM * nN) return false;
  const int nig = 8 * nN, gid = vt / nig, fm = gid * 8, gsz = min(nM - fm, 8);
  pm = fm + (vt % nig) % gsz;
  pn = (vt % nig) / gsz;
  return true;
}


constexpr int CS_LD = 264;
DI void acc_to_lds(const f32x4 (&acc)[2][2][4][2]) {
  GT_VARS
  u16* Cs = (u16*)dsm;
  __syncthreads();
  GT_FOR { Cs[GT_ROW(ai, m, j) * CS_LD + GT_COL(bj, n)] = f2bf(acc[ai][bj][m][n][j]); }
  __syncthreads();
}

__device__ void ph_gemm1(const Params& p, int bid, int nb) {
  const int tid_ = otid();
  const int nM = 261, nN = 18;
  for (int round = 0; round * nb < nM * nN; ++round) {
    int pm, pn;
    if (!tile_of(round, bid, nb, nM, nN, pm, pn)) break;
    f32x4 acc[2][2][4][2];
    gemm256<1024>(p.H, p.WinT, pm * 256, pn * 256, acc);
    acc_to_lds(acc);
    const u16* Cs = (const u16*)dsm;
#pragma unroll 4
    for (int it = 0; it < 16; it++) {
      const int id = it * NTH + tid_, rl = id >> 5, c8 = (id & 31) * 8;
      const int row = pm * 256 + rl;
      const u32x4 v = *(const u32x4*)(Cs + rl * CS_LD + c8);
      *(u32x4*)(p.P + (size_t)row * INC + pn * 256 + c8) = v;
      if (pn == 9) {
        float* dst = nullptr;
        const int c2 = c8 & 127;
        if (row < TP) {
          const int tt = row & 4095;
          if (tt >= 3968) dst = p.out + (c8 < 128 ? OFF_KP : OFF_VP) + ((size_t)(row >> 12) * 128 + (tt - 3968)) * 128 + c2;
        } else if (row < T) {
          dst = p.out + (c8 < 128 ? OFF_KS : OFF_VS) + (size_t)(row - TP) * 128 + c2;
        }
        if (dst) {
          *(float4*)dst = make_float4(bflo(v[0]), bfhi(v[0]), bflo(v[1]), bfhi(v[1]));
          *(float4*)(dst + 4) = make_float4(bflo(v[2]), bfhi(v[2]), bflo(v[3]), bfhi(v[3]));
        }
      }
    }
  }
}

DI int prev_row(int g) {
  if (g < TP) return (g & 4095) ? g - 1 : -1;
  const int r2 = g - TP;
  return (r2 & 63) ? g - 1 : T + (r2 >> 6);
}

__device__ void ph_rwprep(const Params& p, int bid, int nb) {
  const int tid = otid(), lane = tid & 63, wv = tid >> 6, fr = lane & 15, fq = lane >> 4;
  u16* A1 = (u16*)dsm;
  u16* A2 = A1 + 64 * 80;
  u16* A3 = A2 + 64 * 80;
  u16* SA = (u16*)(p.out);
  u16* SB = p.H;
  const int hd = wv;
  u16* OT = (u16*)(dsm + 38912 + wv * 12288);
  u32x4 pin[7];
  for (int tile = bid; tile < T / 64; tile += nb) {
    const int g0 = tile * 64;
    auto issue_in = [&](int rg_) {
#pragma unroll
      for (int it = 0; it < 7; it++) {
        const int id = it * 64 + lane, ri = id / 24, rem = id - ri * 24, arr = rem >> 3, ch = rem & 7;
        int tok = g0 + rg_ * 16 - 1 + ri;
        if (rg_ == 0 && ri == 0) tok = prev_row(g0);
        pin[it] = u32x4{0u, 0u, 0u, 0u};
        if (id < 408 && tok >= 0) pin[it] = *(const u32x4*)(p.P + (size_t)tok * INC + arr * 512 + hd * 64 + ch * 8);
      }
    };
    __syncthreads();
    {
      const int row = tid >> 3, part8 = tid & 7, part = part8 >> 1, sub = part8 & 1;
      const int g = g0 + row, pr = prev_row(g);
      const int cb = 1536 + part * 64 + sub * 32;
      const u16* cur = p.P + (size_t)g * INC + cb;
      const u16* prv = p.P + (size_t)(pr < 0 ? 0 : pr) * INC + cb;
#pragma unroll
      for (int q = 0; q < 4; q++) {
        const u32x4 c4 = *(const u32x4*)(cur + q * 8);
        u32x4 p4 = {0u, 0u, 0u, 0u};
        if (pr >= 0) p4 = *(const u32x4*)(prv + q * 8);
        u32x4 ow;
#pragma unroll
        for (int e = 0; e < 4; e++) {
          const float c0 = bflo(c4[e]), c1 = bfhi(c4[e]), q0 = bflo(p4[e]), q1 = bfhi(p4[e]);
          float f0 = c0 + (q0 - c0) * p.mu[cb + q * 8 + 2 * e];
          float f1 = c1 + (q1 - c1) * p.mu[cb + q * 8 + 2 * e + 1];
          if (part == 0) { f0 = 1.f - 2.f / (1.f + __expf(2.f * f0)); f1 = 1.f - 2.f / (1.f + __expf(2.f * f1)); }
          else if (part >= 2) { f0 = sigmoidf_(f0); f1 = sigmoidf_(f1); }
          ow[e] = pack2(f0, f1);
        }
        u16* dst = part == 0 ? A1 + row * 80 + sub * 32 + q * 8
                 : part == 1 ? A2 + row * 80 + sub * 32 + q * 8
                             : A3 + row * 144 + (part - 2) * 64 + sub * 32 + q * 8;
        *(u32x4*)dst = ow;
      }
    }
    __syncthreads();
#pragma unroll 1
    for (int rg = 0; rg < 4; rg++) {
      issue_in(rg);
#pragma unroll
      for (int it = 0; it < 7; it++) {
        const int id = it * 64 + lane;
        if (id < 408) *(u32x4*)(OT + id * 8) = pin[it];
      }
      __builtin_amdgcn_fence(__ATOMIC_RELEASE, "workgroup");
      __builtin_amdgcn_wave_barrier();
      float inr[5][3][4];
#pragma unroll
      for (int jj = 0; jj < 5; jj++)
#pragma unroll
        for (int ar = 0; ar < 3; ar++)
#pragma unroll
          for (int nt = 0; nt < 4; nt++) inr[jj][ar][nt] = bf2f(OT[((fq * 4 + jj) * 3 + ar) * 64 + nt * 16 + fr]);
      __builtin_amdgcn_fence(__ATOMIC_RELEASE, "workgroup");
      __builtin_amdgcn_wave_barrier();
      SCHED;
      f32x4 aw[4], aa[4];
#pragma unroll
      for (int nt = 0; nt < 4; nt++) { aw[nt] = f32x4{0.f, 0.f, 0.f, 0.f}; aa[nt] = f32x4{0.f, 0.f, 0.f, 0.f}; }
#pragma unroll 1
      for (int ks = 0; ks < 2; ks++) {
        const bf16x8 f1 = *(const bf16x8*)(A1 + (rg * 16 + fr) * 80 + ks * 32 + fq * 8);
        const bf16x8 f2 = *(const bf16x8*)(A2 + (rg * 16 + fr) * 80 + ks * 32 + fq * 8);
#pragma unroll
        for (int nt = 0; nt < 4; nt++) {
          const bf16x8 bw = *(const bf16x8*)(p.W2T + (unsigned)((hd * 64 + nt * 16 + fr) * 64 + ks * 32 + fq * 8));
          const bf16x8 ba = *(const bf16x8*)(p.A2T + (unsigned)((hd * 64 + nt * 16 + fr) * 64 + ks * 32 + fq * 8));
          aw[nt] = MFMA16(f1, bw, aw[nt]);
          aa[nt] = MFMA16(f2, ba, aa[nt]);
        }
      }
      float ss[4] = {0.f, 0.f, 0.f, 0.f};
      const int rowb = rg * 16 + fq * 4;
      const int gb = g0 + rowb;
#pragma unroll
      for (int nt = 0; nt < 4; nt++) {
        const int c = nt * 16 + fr, col = hd * 64 + c;
        const float mu_r = p.mu[col], mu_k = p.mu[512 + col], mu_v = p.mu[1024 + col];
        const float w0c = p.w0[col], a0c = p.a0[col], kkc = p.k_k[col], kac = p.k_a[col];
        float qr = inr[0][0][nt], qk = inr[0][1][nt], qv = inr[0][2][nt];
#pragma unroll
        for (int j = 0; j < 4; j++) {
          const float cr = inr[j + 1][0][nt], ck = inr[j + 1][1][nt], cv = inr[j + 1][2][nt];
          const float r = cr + (qr - cr) * mu_r, k = ck + (qk - ck) * mu_k, v = cv + (qv - cv) * mu_v;
          qr = cr; qk = ck; qv = cv;
          const float ed = 0.6065306597126334f * sigmoidf_(w0c + aw[nt][j]);
          const float dm = 1.f - __expf(-ed);
          const float a = sigmoidf_(a0c + aa[nt][j]);
          const float kkv = k * kkc;
          ss[j] += kkv * kkv;
          const float k2 = k * (1.f + (a - 1.f) * kac);
          u16* ot = OT + (fq * 4 + j) * 384 + c;
          ot[0] = f2bf(r);
          ot[64] = f2bf(dm);
          ot[128] = f2bf(k2);
          ot[256] = f2bf(v);
          aw[nt][j] = kkv;
          aa[nt][j] = a;
        }
        SCHED;
      }
#pragma unroll
      for (int j = 0; j < 4; j++) ss[j] = 1.f / fmaxf(sqrtf(red16(ss[j])), 1e-12f);
#pragma unroll
      for (int nt = 0; nt < 4; nt++) {
        const int c = nt * 16 + fr;
#pragma unroll
        for (int j = 0; j < 4; j++) {
          const float kkn = aw[nt][j] * ss[j];
          u16* ot = OT + (fq * 4 + j) * 384 + c;
          ot[192] = f2bf(kkn);
          ot[320] = f2bf(kkn * aa[nt][j]);
        }
      }
      __builtin_amdgcn_fence(__ATOMIC_RELEASE, "workgroup");
      __builtin_amdgcn_wave_barrier();
      {
        const int gr0 = g0 + rg * 16;
#pragma unroll 4
        for (int it = 0; it < 12; it++) {
          const int id = it * 64 + lane, rowi = id / 48, pc = id % 48;
          const u32x4 v4 = *(const u32x4*)(OT + rowi * 384 + pc * 8);
          const size_t gh = (size_t)(gr0 + rowi) * 8 + hd;
          if (pc < 32) *(u32x4*)(SA + gh * 256 + pc * 8) = v4;
          else *(u32x4*)(SB + gh * 128 + (pc - 32) * 8) = v4;
        }
      }
      __builtin_amdgcn_wave_barrier();
      f32x4 ag[4];
#pragma unroll
      for (int nt = 0; nt < 4; nt++) ag[nt] = f32x4{0.f, 0.f, 0.f, 0.f};
#pragma unroll 1
      for (int ks = 0; ks < 4; ks++) {
        const bf16x8 f3 = *(const bf16x8*)(A3 + (rg * 16 + fr) * 144 + ks * 32 + fq * 8);
#pragma unroll
        for (int nt = 0; nt < 4; nt++) {
          const bf16x8 bg = *(const bf16x8*)(p.G2T + (unsigned)((hd * 64 + nt * 16 + fr) * 128 + ks * 32 + fq * 8));
          ag[nt] = MFMA16(f3, bg, ag[nt]);
        }
      }
#pragma unroll
      for (int nt = 0; nt < 4; nt++)
#pragma unroll
        for (int j = 0; j < 4; j++) p.G[(size_t)(gb + j) * 512 + hd * 64 + nt * 16 + fr] = f2bf(ag[nt][j]);
    }
  }
}

DI float red8(float v) {
  v += dppmov<0xB1>(v);
  v += dppmov<0x4E>(v);
  v += dppmov<0x141>(v);
  return v;
}
struct ScanOps { f32x4 r, d, k, n, b; float v; };
DI void scan_ld(ScanOps& o, const float* sb, int j0, int row) {
  o.r = *(const f32x4*)(sb + j0);
  o.d = *(const f32x4*)(sb + 64 + j0);
  o.k = *(const f32x4*)(sb + 128 + j0);
  o.n = *(const f32x4*)(sb + 192 + j0);
  o.b = *(const f32x4*)(sb + 320 + j0);
  o.v = sb[256 + row];
}
#define LO2(x) __builtin_shufflevector((x), (x), 0, 1)
#define HI2(x) __builtin_shufflevector((x), (x), 2, 3)
DI float scan_step(f32x2 (&S)[2], const ScanOps& o, f32x4& rprev) {
  const f32x2 vv = {o.v, o.v};
  const f32x2 tt = S[0] * LO2(o.n) + S[1] * HI2(o.n);
  const f32x2 yy = S[0] * LO2(rprev) + S[1] * HI2(rprev);
  const f32x2 m0 = S[0] * LO2(o.d) + vv * LO2(o.k);
  const f32x2 m1 = S[1] * HI2(o.d) + vv * HI2(o.k);
  float a = tt[0] + tt[1], y = yy[0] + yy[1];
  a += dppmov<0x128>(a); y += dppmov<0x128>(y);
  a += dppmov<0x124>(a); y += dppmov<0x124>(y);
  a += dppmov<0x122>(a); y += dppmov<0x122>(y);
  a += dppmov<0x121>(a); y += dppmov<0x121>(y);
  const float sa = -a;
  const f32x2 sv = {sa, sa};
  S[0] = m0 + sv * LO2(o.b);
  S[1] = m1 + sv * HI2(o.b);
  rprev = o.r;
  return y;
}

__device__ void ph_scan(const Params& p, int bid, int nb) {
  const int tid = otid(), lane = tid & 63, wv = tid >> 6;
  float* buf = (float*)dsm;
  const u16* SA = (const u16*)(p.out);
  const u16* SB = p.H;
  constexpr int CH = 32;
  for (int item = bid; item < 512; item += nb) {
    const int type = item >> 8, r_ = item & 255, half = r_ & 1, hb = r_ >> 1, h = hb & 7, b = hb >> 3;
    const int nch = type ? 64 / CH : 4096 / CH;
    const int gbase = type ? TP + b * 64 : b * 4096;
    const bool active = true;
    const int row = half * 32 + wv * 4 + (lane >> 4), j0 = (lane & 15) * 4;
    f32x2 S[2];
#pragma unroll
    for (int j = 0; j < 2; j++) S[j] = f32x2{0.f, 0.f};
    if (type && active) {
      const float* s0 = p.state_wkv + ((size_t)(b * 8 + h) * 64 + row) * 64 + j0;
#pragma unroll
      for (int j = 0; j < 2; j++) S[j] = f32x2{s0[2 * j], s0[2 * j + 1]};
    }
    f32x4 rprev = {0.f, 0.f, 0.f, 0.f};
    float ykeep = 0.f;
    u32x4 la[2], lb;
    auto gload = [&](int c) {
#pragma unroll
      for (int q = 0; q < 2; q++) {
        const int idx = tid + q * NTH, step = idx >> 5, u = idx & 31;
        la[q] = *(const u32x4*)(SA + ((size_t)(gbase + c * CH + step) * 8 + h) * 256 + u * 8);
      }
      {
        const int step = tid >> 4, u = tid & 15;
        lb = *(const u32x4*)(SB + ((size_t)(gbase + c * CH + step) * 8 + h) * 128 + u * 8);
      }
    };
    gload(0);
    for (int c = 0; c < nch; c++) {
      __syncthreads();
#pragma unroll
      for (int q = 0; q < 2; q++) {
        const int idx = tid + q * NTH, step = idx >> 5, u = idx & 31, arr = u >> 3, c0 = (u & 7) * 8;
        float* d = buf + step * 384 + arr * 64 + c0;
        float f[8];
#pragma unroll
        for (int e = 0; e < 4; e++) { f[2 * e] = bflo(la[q][e]); f[2 * e + 1] = bfhi(la[q][e]); }
        if (arr == 1) {
#pragma unroll
          for (int e = 0; e < 8; e++) f[e] = 1.f - f[e];
        }
        *(float4*)d = make_float4(f[0], f[1], f[2], f[3]);
        *(float4*)(d + 4) = make_float4(f[4], f[5], f[6], f[7]);
      }
      {
        const int step = tid >> 4, u = tid & 15, arr = u >> 3, c0 = (u & 7) * 8;
        float* d = buf + step * 384 + (4 + arr) * 64 + c0;
        *(float4*)d = make_float4(bflo(lb[0]), bfhi(lb[0]), bflo(lb[1]), bfhi(lb[1]));
        *(float4*)(d + 4) = make_float4(bflo(lb[2]), bfhi(lb[2]), bflo(lb[3]), bfhi(lb[3]));
      }
      __syncthreads();
      if (c + 1 < nch) gload(c + 1);
      if (active) {
        ScanOps A0, A1, B0, B1;
        scan_ld(A0, buf, j0, row);
        scan_ld(A1, buf + 384, j0, row);
#pragma unroll 1
        for (int s = 0; s < CH; s += 4) {
          scan_ld(B0, buf + (s + 2) * 384, j0, row);
          scan_ld(B1, buf + (s + 3) * 384, j0, row);
          SCHED;
          {
            const int g0 = c * CH + s;
            const float y0 = scan_step(S, A0, rprev);
            ykeep = ((lane & 15) == ((g0 - 1) & 15)) ? y0 : ykeep;
            if ((g0 & 15) == 0 && g0 > 0)
              p.Y[(size_t)(gbase + g0 - 16 + (lane & 15)) * 512 + h * 64 + row] = f2bf(ykeep);
            const float y1 = scan_step(S, A1, rprev);
            ykeep = ((lane & 15) == (g0 & 15)) ? y1 : ykeep;
          }
          SCHED;
          const int sn = (s + 4 < CH) ? s + 4 : s;
          scan_ld(A0, buf + sn * 384, j0, row);
          scan_ld(A1, buf + (sn + 1) * 384, j0, row);
          SCHED;
          {
            const int g0 = c * CH + s;
            const float y2 = scan_step(S, B0, rprev);
            ykeep = ((lane & 15) == ((g0 + 1) & 15)) ? y2 : ykeep;
            const float y3 = scan_step(S, B1, rprev);
            ykeep = ((lane & 15) == ((g0 + 2) & 15)) ? y3 : ykeep;
          }
          SCHED;
        }
      }
    }
    if (active) {
      const f32x2 yy = S[0] * LO2(rprev) + S[1] * HI2(rprev);
      const float yl = red16(yy[0] + yy[1]);
      ykeep = ((lane & 15) == 15) ? yl : ykeep;
      p.Y[(size_t)(gbase + nch * CH - 16 + (lane & 15)) * 512 + h * 64 + row] = f2bf(ykeep);
    }
    if (active) {
      float* so = p.out + (type ? OFF_WKV_S : OFF_WKV_P) + ((size_t)(b * 8 + h) * 64 + row) * 64 + j0;
      *(float4*)so = make_float4(S[0][0], S[0][1], S[1][0], S[1][1]);
    }
  }
}

__device__ void ph_attn(const Params& p, int bid, int nb, bool dry = false) {
  const int tid = otid(), lane = tid & 63, wv = tid >> 6, fr = lane & 15, fq = lane >> 4;
  u16* Ks = (u16*)dsm;
  u16* Vt = Ks + 192 * 72;
  for (int item = bid; item < 2080; item += nb) {
    const int kvh = item & 1, r = item >> 1;
    const bool samp = r >= 1024;
    const int b = samp ? r - 1024 : r >> 6, c = samp ? 0 : (r & 63);
    const int gq0 = samp ? TP + b * 64 : b * 4096 + c * 64;
    __syncthreads();
#pragma unroll
    for (int q = 0; q < 3; q++) {
      const int idx = tid + q * NTH, j = idx >> 3, d0 = (idx & 7) * 8;
      u32x4 kq = {0u, 0u, 0u, 0u}, vq = {0u, 0u, 0u, 0u};
      if (!samp) {
        const int tok = (c - 2) * 64 + j;
        if (tok >= 0) {
          const u16* src = p.P + (size_t)(b * 4096 + tok) * INC + 2304 + kvh * 64 + d0;
          kq = *(const u32x4*)src;
          vq = *(const u32x4*)(src + 128);
        }
      } else if (j < 128) {
        const float4* ck = (const float4*)(p.cache_k + ((size_t)(b * 128 + j) * 2 + kvh) * 64 + d0);
        const float4* cv = (const float4*)(p.cache_v + ((size_t)(b * 128 + j) * 2 + kvh) * 64 + d0);
        const float4 k0 = ck[0], k1 = ck[1], v0 = cv[0], v1 = cv[1];
        kq = u32x4{pack2(k0.x, k0.y), pack2(k0.z, k0.w), pack2(k1.x, k1.y), pack2(k1.z, k1.w)};
        vq = u32x4{pack2(v0.x, v0.y), pack2(v0.z, v0.w), pack2(v1.x, v1.y), pack2(v1.z, v1.w)};
      } else {
        const u16* src = p.P + (size_t)(TP + b * 64 + (j - 128)) * INC + 2304 + kvh * 64 + d0;
        kq = *(const u32x4*)src;
        vq = *(const u32x4*)(src + 128);
      }
      *(u32x4*)(Ks + j * 72 + d0) = kq;
#pragma unroll
      for (int e = 0; e < 4; e++) {
        Vt[(d0 + 2 * e) * 196 + j] = (u16)(vq[e] & 0xffffu);
        Vt[(d0 + 2 * e + 1) * 196 + j] = (u16)(vq[e] >> 16);
      }
    }
    __syncthreads();
    const int qh = kvh * 4 + (wv & 3);
    const float slope = exp2f(-(float)(qh + 1)), sink = p.sinks[qh];
#pragma unroll 1
    for (int ps = 0; ps < 2; ps++) {
      const int q0 = (wv >> 2) * 32 + ps * 16;
      const int tq = q0 + fr;
      const u16* qp = p.P + (size_t)(gq0 + tq) * INC + 1792 + qh * 64 + fq * 8;
      const bf16x8 qf0 = *(const bf16x8*)(qp), qf1 = *(const bf16x8*)(qp + 32);
      f32x4 sc[12];
#pragma unroll
      for (int kt = 0; kt < 12; kt++) {
        sc[kt] = f32x4{0.f, 0.f, 0.f, 0.f};
        const bf16x8 a0 = *(const bf16x8*)(Ks + (kt * 16 + fr) * 72 + fq * 8);
        const bf16x8 a1 = *(const bf16x8*)(Ks + (kt * 16 + fr) * 72 + 32 + fq * 8);
        sc[kt] = MFMA16(a0, qf0, sc[kt]);
        sc[kt] = MFMA16(a1, qf1, sc[kt]);
        if ((kt & 3) == 3) SCHED;
      }
      float mx = -3e38f;
#pragma unroll
      for (int kt = 0; kt < 12; kt++)
#pragma unroll
        for (int j = 0; j < 4; j++) {
          const int key = kt * 16 + fq * 4 + j;
          float s = sc[kt][j] * 0.125f - slope * fabsf((float)(128 + tq - key));
          if (!samp && (c - 2) * 64 + key < 0) s = -1e30f;
          sc[kt][j] = s;
          mx = fmaxf(mx, s);
        }
      mx = fmaxf(mx, __shfl_xor(mx, 16));
      mx = fmaxf(mx, __shfl_xor(mx, 32));
      mx = fmaxf(mx, sink);
      float sum = 0.f;
#pragma unroll
      for (int kt = 0; kt < 12; kt++)
#pragma unroll
        for (int j = 0; j < 4; j++) {
          const float e = __expf(sc[kt][j] - mx);
          sc[kt][j] = e;
          sum += e;
        }
      sum += __shfl_xor(sum, 16);
      sum += __shfl_xor(sum, 32);
      sum += __expf(sink - mx);
      const float inv = 1.f / sum;
      f32x4 o[4];
#pragma unroll
      for (int dt = 0; dt < 4; dt++) o[dt] = f32x4{0.f, 0.f, 0.f, 0.f};
#pragma unroll
      for (int t2 = 0; t2 < 6; t2++) {
        const u32x4 pw = {pack2(sc[2 * t2][0] * inv, sc[2 * t2][1] * inv), pack2(sc[2 * t2][2] * inv, sc[2 * t2][3] * inv),
                          pack2(sc[2 * t2 + 1][0] * inv, sc[2 * t2 + 1][1] * inv),
                          pack2(sc[2 * t2 + 1][2] * inv, sc[2 * t2 + 1][3] * inv)};
        const bf16x8 pa = __builtin_bit_cast(bf16x8, pw);
#pragma unroll
        for (int dt = 0; dt < 4; dt++) {
          const u16* vp = Vt + (dt * 16 + fr) * 196 + t2 * 32 + fq * 4;
          const uint2 v0 = *(const uint2*)vp, v1 = *(const uint2*)(vp + 16);
          const bf16x8 vb = __builtin_bit_cast(bf16x8, u32x4{v0.x, v0.y, v1.x, v1.y});
          o[dt] = MFMA16(pa, vb, o[dt]);
        }
        SCHED;
      }
#pragma unroll
      for (int dt = 0; dt < 4; dt++)
#pragma unroll
        for (int j = 0; j < 4; j++)
          p.OATT[(size_t)(gq0 + q0 + fq * 4 + j) * 512 + qh * 64 + dt * 16 + fr] = f2bf(o[dt][j]);
    }
  }
  const u16* SA = (const u16*)(p.out);
  const u16* SB = p.H;
  for (int it4 = bid * NW + wv; it4 < T * 2; it4 += nb * NW) {
    const int it = it4 * 4 + (lane >> 4), c0 = (lane & 15) * 4;
    const int g = it >> 3, h = it & 7, col = h * 64 + c0;
    const uint2 yw = *(const uint2*)(p.Y + (size_t)g * 512 + col);
    const uint2 rw = *(const uint2*)(SA + (size_t)it * 256 + c0), kw = *(const uint2*)(SA + (size_t)it * 256 + 128 + c0);
    const uint2 vw = *(const uint2*)(SB + (size_t)it * 128 + c0), gw = *(const uint2*)(p.G + (size_t)g * 512 + col);
    const float4 lw = *(const float4*)(p.lnx_w + col), lb = *(const float4*)(p.lnx_b + col), rk = *(const float4*)(p.r_k + col);
    const float y0 = bflo(yw.x), y1 = bfhi(yw.x), y2 = bflo(yw.y), y3 = bfhi(yw.y);
    const float mean = red16((y0 + y1) + (y2 + y3)) * (1.f / 64.f);
    const float e0 = y0 - mean, e1 = y1 - mean, e2 = y2 - mean, e3 = y3 - mean;
    const float var = red16((e0 * e0 + e1 * e1) + (e2 * e2 + e3 * e3)) * (1.f / 64.f);
    const float bonus = red16((bflo(rw.x) * bflo(kw.x) * rk.x + bfhi(rw.x) * bfhi(kw.x) * rk.y) +
                              (bflo(rw.y) * bflo(kw.y) * rk.z + bfhi(rw.y) * bfhi(kw.y) * rk.w));
    const float rsd = rsqrtf(var + 64e-5f);
    const float o0 = (e0 * rsd * lw.x + lb.x + bonus * bflo(vw.x)) * bflo(gw.x);
    const float o1 = (e1 * rsd * lw.y + lb.y + bonus * bfhi(vw.x)) * bfhi(gw.x);
    const float o2 = (e2 * rsd * lw.z + lb.z + bonus * bflo(vw.y)) * bflo(gw.y);
    const float o3 = (e3 * rsd * lw.w + lb.w + bonus * bfhi(vw.y)) * bfhi(gw.y);
    if (!dry || o0 == 123.456f) *(uint2*)(p.Y + (size_t)g * 512 + col) = make_uint2(pack2(o0, o1), pack2(o2, o3));
  }
}

__device__ void ph_gemm2(const Params& p, int bid, int nb) {
  const int tid_ = otid();
  u16* MG = p.H;
  const u16* Cs = (const u16*)dsm;
  const int nM = 260, nN = 4;
  for (int round = 0; round * nb < nM * nN; ++round) {
    int pm, pn;
    if (!tile_of(round, bid, nb, nM, nN, pm, pn)) break;
    f32x4 acc[2][2][4][2];
#pragma unroll 1
    for (int br = 0; br < 2; br++) {
      gemm256<512>(br ? p.OATT : p.Y, p.WbT + (size_t)br * 1024 * 512, pm * 256, pn * 256, acc);
      acc_to_lds(acc);
#pragma unroll 2
      for (int it = 0; it < 16; it++) {
        const int id = it * NTH + tid_, rl = id >> 5, c8 = (id & 31) * 8;
        const int row = pm * 256 + rl, col = pn * 256 + c8;
        const u32x4 v = *(const u32x4*)(Cs + rl * CS_LD + c8);
        const u32x4 gw = *(const u32x4*)(p.P + (size_t)row * INC + 2560 + br * 1024 + col);
        u32x4 prev = {0u, 0u, 0u, 0u};
        if (br) prev = *(const u32x4*)(MG + (size_t)row * 1024 + col);
        u32x4 o;
#pragma unroll
        for (int e = 0; e < 4; e++) {
          const float r0 = bflo(prev[e]) + sigmoidf_(bflo(gw[e])) * bflo(v[e]);
          const float r1 = bfhi(prev[e]) + sigmoidf_(bfhi(gw[e])) * bfhi(v[e]);
          o[e] = pack2(r0, r1);
        }
        *(u32x4*)(MG + (size_t)row * 1024 + col) = o;
      }
    }
  }
}

__device__ void ph_gemm3(const Params& p, int bid, int nb) {
  const int tid_ = otid();
  const u16* MG = p.H;
  const u16* Cs = (const u16*)dsm;
  const int nM = 260, nN = 4;
  for (int round = 0; round * nb < nM * nN; ++round) {
    int pm, pn;
    if (!tile_of(round, bid, nb, nM, nN, pm, pn)) break;
    f32x4 acc[2][2][4][2];
    gemm256<1024>(MG, p.WoutT, pm * 256, pn * 256, acc);
    acc_to_lds(acc);
#pragma unroll 2
    for (int it = 0; it < 16; it++) {
      const int id = it * NTH + tid_, rl = id >> 5, c8 = (id & 31) * 8;
      const int row = pm * 256 + rl, col = pn * 256 + c8;
      const u32x4 v = *(const u32x4*)(Cs + rl * CS_LD + c8);
      const float* xr = xrow(p, row) + col;
      const float4 x0 = *(const float4*)xr, x1 = *(const float4*)(xr + 4);
      *(u32x4*)(p.P + (size_t)row * 1024 + col) =
          u32x4{pack2(x0.x + bflo(v[0]), x0.y + bfhi(v[0])), pack2(x0.z + bflo(v[1]), x0.w + bfhi(v[1])),
                pack2(x1.x + bflo(v[2]), x1.y + bfhi(v[2])), pack2(x1.z + bflo(v[3]), x1.w + bfhi(v[3]))};
    }
  }
}

__device__ void ph_norm2(const Params& p, int bid, int nb) {
  const int tid = otid(), lane = tid & 63, wv = tid >> 6;
  for (int row = bid * NW + wv; row < T; row += nb * NW) {
    const uint2* x = (const uint2*)(p.P + (size_t)row * 1024);
    float4 v[4];
    float ss = 0.f;
#pragma unroll
    for (int i = 0; i < 4; i++) {
      const uint2 xw = x[lane + i * 64];
      v[i] = make_float4(bflo(xw.x), bfhi(xw.x), bflo(xw.y), bfhi(xw.y));
      ss += v[i].x * v[i].x + v[i].y * v[i].y + v[i].z * v[i].z + v[i].w * v[i].w;
    }
    ss = wave_sum(ss);
    const float rs = rsqrtf(ss * (1.f / 1024.f) + 1e-6f);
    u16* hr = p.H + (size_t)row * 1024;
    float4 y[4];
    float am = 0.f;
#pragma unroll
    for (int i = 0; i < 4; i++) {
      const float4 g = ((const float4*)p.norm2_g)[lane + i * 64];
      y[i] = make_float4(v[i].x * rs * g.x, v[i].y * rs * g.y, v[i].z * rs * g.z, v[i].w * rs * g.w);
      ((uint2*)hr)[lane + i * 64] = make_uint2(pack2(y[i].x, y[i].y), pack2(y[i].z, y[i].w));
      am = fmaxf(am, fmaxf(fmaxf(fabsf(y[i].x), fabsf(y[i].y)), fmaxf(fabsf(y[i].z), fabsf(y[i].w))));
    }
    am = fmaxf(wave_max(am), 1e-30f);
    const float sc = 240.f / am;
    if (lane == 0) p.SH[row] = am * (1.f / 240.f);
    u32* h8 = (u32*)((unsigned char*)p.Y + (size_t)row * 1024);
#pragma unroll
    for (int i = 0; i < 4; i++) h8[lane + i * 64] = q4(y[i].x, y[i].y, y[i].z, y[i].w, sc);
  }
}

DI void ins16(float (&l)[16], float x) {
#pragma unroll
  for (int i = 0; i < 16; i++) {
    const float hi = fmaxf(l[i], x);
    x = fminf(l[i], x);
    l[i] = hi;
  }
}


DI void ce_desc(float& a, float& b) { const float hi = fmaxf(a, b), lo = fminf(a, b); a = hi; b = lo; }
DI void bitonic_sort16_desc(float (&a)[16]) {
#pragma unroll
  for (int k = 2; k <= 16; k <<= 1)
#pragma unroll
    for (int j = k >> 1; j > 0; j >>= 1)
#pragma unroll
      for (int i = 0; i < 16; i++) {
        const int l = i ^ j;
        if (l > i) {
          if ((i & k) == 0) ce_desc(a[i], a[l]);
          else ce_desc(a[l], a[i]);
        }
      }
}
DI void bitonic_merge16_desc(float (&a)[16]) {
#pragma unroll
  for (int j = 8; j > 0; j >>= 1)
#pragma unroll
    for (int i = 0; i < 16; i++) {
      const int l = i ^ j;
      if (l > i) ce_desc(a[i], a[l]);
    }
}
DI void top16_merge(float (&a)[16], const float (&b)[16]) {
#pragma unroll
  for (int i = 0; i < 16; i++) a[i] = fmaxf(a[i], b[15 - i]);
  bitonic_merge16_desc(a);
}

__device__ void ph_peerq(const Params& p, int bid, int nb) {
  GT_VARS
  const int l31 = lane & 31, kh = lane >> 5;
  u16* Qs = (u16*)dsm;
  unsigned char* lt = (unsigned char*)(dsm + 135168 + wid * 1024);
  int* IDX = (int*)p.G;
  float* GATE = (float*)p.OATT;
  const int nM = 260, nN = 4;
  for (int round = 0; round * nb < nM * nN; ++round) {
    int pm, pn;
    if (!tile_of(round, bid, nb, nM, nN, pm, pn)) break;
    {
      f32x4 acc[2][2][4][2];
      gemm256<1024>(p.H, p.WqT, pm * 256, pn * 256, acc);
      acc_to_lds(acc);
    }
#pragma unroll 1
    for (int hh = 0; hh < 2; hh++) {
      const int hp = pn * 2 + hh;
      float l1[16], l2[16];
#pragma unroll
      for (int i = 0; i < 16; i++) { l1[i] = 0.f; l2[i] = 0.f; }
#pragma unroll 1
      for (int pp = 0; pp < 2; pp++) {
        f32x16 sc[4];
#pragma unroll
        for (int m4 = 0; m4 < 4; m4++) {
#pragma unroll
          for (int i = 0; i < 16; i++) sc[m4][i] = 0.f;
#pragma unroll
          for (int kk = 0; kk < 4; kk++) {
            const bf16x8 a = *(const bf16x8*)(p.SK + (size_t)(pp * 128 + m4 * 32 + l31) * 64 + kk * 16 + kh * 8);
            const bf16x8 bq = *(const bf16x8*)(Qs + (wid * 32 + l31) * 264 + hh * 128 + pp * 64 + kk * 16 + kh * 8);
            sc[m4] = MFMA32(a, bq, sc[m4]);
          }
        }
        float l[16], q1[16], q2[16], q3[16];
#pragma unroll
        for (int i = 0; i < 16; i++) {
          const u32 nb_ = (i >> 2) * 8 + kh * 4 + (i & 3);
          l[i] = __uint_as_float((__float_as_uint(sc[0][i]) & ~0x7Fu) | nb_);
          q1[i] = __uint_as_float((__float_as_uint(sc[1][i]) & ~0x7Fu) | (32u + nb_));
          q2[i] = __uint_as_float((__float_as_uint(sc[2][i]) & ~0x7Fu) | (64u + nb_));
          q3[i] = __uint_as_float((__float_as_uint(sc[3][i]) & ~0x7Fu) | (96u + nb_));
        }
        bitonic_sort16_desc(l);
        bitonic_sort16_desc(q1);
        bitonic_sort16_desc(q2);
        bitonic_sort16_desc(q3);
        top16_merge(l, q1);
        top16_merge(q2, q3);
        top16_merge(l, q2);
        float o[16];
#pragma unroll
        for (int i = 0; i < 16; i++) o[i] = __shfl_xor(l[i], 32);
        top16_merge(l, o);
#pragma unroll
        for (int i = 0; i < 16; i++) {
          l1[i] = pp == 0 ? l[i] : l1[i];
          l2[i] = pp == 0 ? l2[i] : l[i];
        }
      }
      if (kh == 0) {
        u32 w[8];
#pragma unroll
        for (int q = 0; q < 4; q++) {
          w[q] = (__float_as_uint(l1[4 * q]) & 0x7F) | ((__float_as_uint(l1[4 * q + 1]) & 0x7F) << 8) |
                 ((__float_as_uint(l1[4 * q + 2]) & 0x7F) << 16) | ((__float_as_uint(l1[4 * q + 3]) & 0x7F) << 24);
          w[4 + q] = (__float_as_uint(l2[4 * q]) & 0x7F) | ((__float_as_uint(l2[4 * q + 1]) & 0x7F) << 8) |
                     ((__float_as_uint(l2[4 * q + 2]) & 0x7F) << 16) | ((__float_as_uint(l2[4 * q + 3]) & 0x7F) << 24);
        }
        *(uint4*)(lt + l31 * 32) = make_uint4(w[0], w[1], w[2], w[3]);
        *(uint4*)(lt + l31 * 32 + 16) = make_uint4(w[4], w[5], w[6], w[7]);
      }
      float v1[16], v2[16];
#pragma unroll
      for (int i = 0; i < 16; i++) {
        v1[i] = __uint_as_float(__float_as_uint(l1[i]) & ~0x7Fu);
        v2[i] = __uint_as_float(__float_as_uint(l2[i]) & ~0x7Fu);
      }
#define CAND(a, b) __uint_as_float((__float_as_uint(v1[a] + v2[b]) & ~0xFFu) | (u32)((a) * 16 + (b)))
      float l3[16], y1[16], y2[16];
#pragma unroll
      for (int b = 0; b < 16; b++) l3[b] = CAND(0, b);
#pragma unroll
      for (int b = 0; b < 8; b++) y1[b] = CAND(1, b);
#pragma unroll
      for (int b = 0; b < 5; b++) y1[8 + b] = CAND(2, b);
#pragma unroll
      for (int b = 0; b < 3; b++) y1[13 + b] = CAND(4, b);
#pragma unroll
      for (int b = 0; b < 4; b++) y2[b] = CAND(3, b);
      y2[4] = CAND(5, 0); y2[5] = CAND(5, 1); y2[6] = CAND(6, 0); y2[7] = CAND(6, 1); y2[8] = CAND(7, 0); y2[9] = CAND(7, 1);
      y2[10] = CAND(8, 0); y2[11] = CAND(9, 0); y2[12] = CAND(10, 0); y2[13] = CAND(11, 0); y2[14] = CAND(12, 0); y2[15] = CAND(13, 0);
      bitonic_sort16_desc(y1);
      bitonic_sort16_desc(y2);
      top16_merge(l3, y1);
      top16_merge(l3, y2);
      ins16(l3, CAND(14, 0));
      ins16(l3, CAND(15, 0));
#undef CAND
      __builtin_amdgcn_fence(__ATOMIC_RELEASE, "workgroup");
      __builtin_amdgcn_wave_barrier();
      if (kh == 0) {
        const int g = pm * 256 + wid * 32 + l31;
        float ev[16];
        int ei[16];
        float sum = 0.f;
        const float mxv = __uint_as_float(__float_as_uint(l3[0]) & ~0xFFu);
#pragma unroll
        for (int k = 0; k < 16; k++) {
          const u32 bits = __float_as_uint(l3[k]);
          const u32 pos = bits & 0xFF;
          ev[k] = __expf(__uint_as_float(bits & ~0xFFu) - mxv);
          sum += ev[k];
          ei[k] = (int)lt[l31 * 32 + (pos >> 4)] * 128 + (int)lt[l31 * 32 + 16 + (pos & 15)];
        }
        const float inv = 1.f / sum;
        int4* ip = (int4*)(IDX + (size_t)g * 128 + hp * 16);
        float4* gp = (float4*)(GATE + (size_t)g * 128 + hp * 16);
#pragma unroll
        for (int q = 0; q < 4; q++) {
          ip[q] = make_int4(ei[4 * q], ei[4 * q + 1], ei[4 * q + 2], ei[4 * q + 3]);
          gp[q] = make_float4(ev[4 * q] * inv, ev[4 * q + 1] * inv, ev[4 * q + 2] * inv, ev[4 * q + 3] * inv);
        }
      }
      __builtin_amdgcn_wave_barrier();
    }
  }
}

__device__ void ph_peer(const Params& p, int bid, int nb, bool dry = false) {
  const int tid = otid(), lane = tid & 63, wv = tid >> 6;
  constexpr int ST = 1104;
  char* wb = dsm + wv * (16 * ST + 2048);
  unsigned char* stg = (unsigned char*)wb;
  unsigned char* hs = stg + 16 * ST;
  float* acts = (float*)(hs + 1024);
  int* idxs = (int*)(hs + 1536);
  const int gr = lane >> 3, gc = lane & 7;
  const int* IDX = (const int*)p.G;
  const float* GATE = (const float*)p.OATT;
  const unsigned char* H8 = (const unsigned char*)p.Y;
  const int n = lane & 15, quad = lane >> 4;
  for (int g = bid * NW + wv; g < T; g += nb * NW) {
    *(u32x4*)(hs + lane * 16) = *(const u32x4*)(H8 + (size_t)g * 1024 + lane * 16);
    idxs[lane] = IDX[(size_t)g * 128 + lane];
    idxs[lane + 64] = IDX[(size_t)g * 128 + 64 + lane];
    const float shv = p.SH[g];
    __builtin_amdgcn_fence(__ATOMIC_RELEASE, "workgroup");
    __builtin_amdgcn_wave_barrier();
    {
      u32x4 ring[16];
      {
        const unsigned char* ua = p.U8 + (size_t)idxs[gr] * 1024 + gc * 16;
        const unsigned char* ub = p.U8 + (size_t)idxs[8 + gr] * 1024 + gc * 16;
#pragma unroll
        for (int i = 0; i < 8; i++) { ring[i] = *(const u32x4*)(ua + i * 128); ring[8 + i] = *(const u32x4*)(ub + i * 128); }
      }
#pragma unroll 1
      for (int grp = 0; grp < 8; grp++) {
        const int gn = grp < 7 ? grp + 1 : grp;
        const unsigned char* ua = p.U8 + (size_t)idxs[gn * 16 + gr] * 1024 + gc * 16;
        const unsigned char* ub = p.U8 + (size_t)idxs[gn * 16 + 8 + gr] * 1024 + gc * 16;
        const float4 gt = *(const float4*)(GATE + (size_t)g * 128 + grp * 16 + quad * 4);
        const int4 ee = *(const int4*)(idxs + grp * 16 + quad * 4);
        const float su0 = p.SU[ee.x], su1 = p.SU[ee.y], su2 = p.SU[ee.z], su3 = p.SU[ee.w];
        const float sv0 = p.SV[ee.x], sv1 = p.SV[ee.y], sv2 = p.SV[ee.z], sv3 = p.SV[ee.w];
#pragma unroll
        for (int i = 0; i < 8; i++) {
          *(u32x4*)(stg + gr * ST + i * 128 + gc * 16) = ring[i];
          *(u32x4*)(stg + (8 + gr) * ST + i * 128 + gc * 16) = ring[8 + i];
          if (grp < 7) { ring[i] = *(const u32x4*)(ua + i * 128); ring[8 + i] = *(const u32x4*)(ub + i * 128); }
        }
        __builtin_amdgcn_fence(__ATOMIC_RELEASE, "workgroup");
        __builtin_amdgcn_wave_barrier();
        f32x4 acc = {0.f, 0.f, 0.f, 0.f};
#pragma unroll
        for (int st = 0; st < 16; st++) {
          const u32x4 ua4 = *(const u32x4*)(stg + n * ST + st * 64 + quad * 16);
          const u32x4 hb = *(const u32x4*)(hs + st * 64 + quad * 16);
          const long a0 = (long)(((unsigned long)ua4[1] << 32) | ua4[0]);
          const long a1 = (long)(((unsigned long)ua4[3] << 32) | ua4[2]);
          const long b0 = (long)(((unsigned long)hb[1] << 32) | hb[0]);
          const long b1 = (long)(((unsigned long)hb[3] << 32) | hb[2]);
          acc = __builtin_amdgcn_mfma_f32_16x16x32_fp8_fp8(a0, b0, acc, 0, 0, 0);
          acc = __builtin_amdgcn_mfma_f32_16x16x32_fp8_fp8(a1, b1, acc, 0, 0, 0);
        }
        __builtin_amdgcn_wave_barrier();
        const float d0 = acc[0] * shv * su0, d1 = acc[1] * shv * su1, d2 = acc[2] * shv * su2, d3 = acc[3] * shv * su3;
        float4 av;
        av.x = 0.5f * d0 * (1.f + erff(d0 * 0.70710678118f)) * gt.x * sv0;
        av.y = 0.5f * d1 * (1.f + erff(d1 * 0.70710678118f)) * gt.y * sv1;
        av.z = 0.5f * d2 * (1.f + erff(d2 * 0.70710678118f)) * gt.z * sv2;
        av.w = 0.5f * d3 * (1.f + erff(d3 * 0.70710678118f)) * gt.w * sv3;
        if (n == 0) *(float4*)(acts + grp * 16 + quad * 4) = av;
      }
    }
    __builtin_amdgcn_fence(__ATOMIC_RELEASE, "workgroup");
    __builtin_amdgcn_wave_barrier();
    float o[16];
#pragma unroll
    for (int j = 0; j < 16; j++) o[j] = 0.f;
    {
      u32x4 ring[16];
#pragma unroll
      for (int k = 0; k < 16; k++) ring[k] = *(const u32x4*)(p.V8 + (size_t)idxs[k] * 1024 + lane * 16);
#pragma unroll 1
      for (int kb = 0; kb < 128; kb += 16) {
        const bool more = kb < 112;
        const int kn = more ? kb + 16 : kb;
#pragma unroll
        for (int j = 0; j < 16; j++) {
          const u32x4 vq = ring[j];
          if (more) ring[j] = *(const u32x4*)(p.V8 + (size_t)idxs[kn + j] * 1024 + lane * 16);
          const float a = acts[kb + j];
#pragma unroll
          for (int q = 0; q < 4; q++) {
            const f32x2 lo = __builtin_amdgcn_cvt_pk_f32_fp8((int)vq[q], false);
            const f32x2 hi = __builtin_amdgcn_cvt_pk_f32_fp8((int)vq[q], true);
            o[4 * q] += a * lo[0]; o[4 * q + 1] += a * lo[1]; o[4 * q + 2] += a * hi[0]; o[4 * q + 3] += a * hi[1];
          }
        }
      }
    }
    float* xr = p.out + (size_t)g * 1024 + lane * 16;
    float4 x[4];
    {
      const u32x4 xa = *(const u32x4*)(p.P + (size_t)g * 1024 + lane * 16), xb = *(const u32x4*)(p.P + (size_t)g * 1024 + lane * 16 + 8);
      x[0] = make_float4(bflo(xa[0]), bfhi(xa[0]), bflo(xa[1]), bfhi(xa[1]));
      x[1] = make_float4(bflo(xa[2]), bfhi(xa[2]), bflo(xa[3]), bfhi(xa[3]));
      x[2] = make_float4(bflo(xb[0]), bfhi(xb[0]), bflo(xb[1]), bfhi(xb[1]));
      x[3] = make_float4(bflo(xb[2]), bfhi(xb[2]), bflo(xb[3]), bfhi(xb[3]));
    }
    float ss = 0.f;
#pragma unroll
    for (int q = 0; q < 4; q++) {
      x[q].x += o[4 * q]; x[q].y += o[4 * q + 1]; x[q].z += o[4 * q + 2]; x[q].w += o[4 * q + 3];
      ss += x[q].x * x[q].x + x[q].y * x[q].y + x[q].z * x[q].z + x[q].w * x[q].w;
    }
    ss = wave_sum(ss);
    if (dry && ss != 123.456f) continue;
    const float rs = rsqrtf(ss * (1.f / 1024.f) + 1e-6f);
#pragma unroll
    for (int q = 0; q < 4; q++) {
      const float4 gq = *(const float4*)(p.final_g + lane * 16 + q * 4);
      *(float4*)(xr + q * 4) = make_float4(x[q].x * rs * gq.x, x[q].y * rs * gq.y, x[q].z * rs * gq.z, x[q].w * rs * gq.w);
    }
  }
}

#define XB_TMO      128
#define XB_XCNT(j)  (256  + 64 * (j))
#define XB_XSUB(j)  (1280 + 64 * (j))
#define XB_XGEN(j)  (2304 + 64 * (j))
#define XB_TOP      3328
#define XB_TOPGEN   3392
#define XCD_BAR_WORDS 3456
#define XB_SPIN_CAP (1u << 18)
#define LAS __attribute__((address_space(3)))
DI unsigned xb_ld(unsigned* p) { return __hip_atomic_load(p, __ATOMIC_RELAXED, __HIP_MEMORY_SCOPE_AGENT); }
DI unsigned xb_add(unsigned* p, unsigned v) { return __hip_atomic_fetch_add(p, v, __ATOMIC_RELAXED, __HIP_MEMORY_SCOPE_AGENT); }
DI unsigned xb_xcc_id() { return (unsigned)__builtin_amdgcn_s_getreg((3 << 11) | 20) & 0xFu; }
#define XB_SPIN(cond, bar) do { unsigned _sp = 0; while (cond) { __builtin_amdgcn_s_sleep(1); \
    if ((++_sp & 255u) == 0u) { if (xb_ld(&(bar)[XB_TMO])) break; if (_sp > XB_SPIN_CAP) { atomicAdd(&(bar)[XB_TMO], 1u); break; } } } } while (0)
struct XcdBarrier { unsigned* bar; unsigned x; volatile LAS unsigned* st; };
DI XcdBarrier xcd_barrier_post(unsigned* bar, volatile LAS unsigned* st) {
  XcdBarrier b; b.bar = bar; b.x = xb_xcc_id(); b.st = st;
  if (threadIdx.x == 0) (void)xb_add(&bar[XB_XCNT(b.x)], 1u);
  return b;
}
DI void xcd_barrier_complete(unsigned* bar, unsigned x, unsigned& nloc, unsigned& nx) {
  const unsigned G = gridDim.x * gridDim.y * gridDim.z;
  unsigned sum, cnt, mine, sp = 0u;
  for (;;) {
    sum = 0u; cnt = 0u; mine = 0u;
#pragma unroll
    for (unsigned j = 0; j < 16; ++j) { const unsigned c = xb_ld(&bar[XB_XCNT(j)]); sum += c; cnt += (c > 0u) ? 1u : 0u; mine = (j == x) ? c : mine; }
    if (sum == G) break;
    __builtin_amdgcn_s_sleep(1);
    if ((++sp & 255u) == 0u) { if (xb_ld(&bar[XB_TMO])) break; if (sp > XB_SPIN_CAP) { atomicAdd(&bar[XB_TMO], 1u); break; } }
  }
  nloc = mine > 0u ? mine : 1u; nx = cnt > 0u ? cnt : 1u;
}
DI void xcd_barrier(const XcdBarrier& b) {
  asm volatile("s_waitcnt vmcnt(0)" ::: "memory");
  __syncthreads();
  if (threadIdx.x == 0) {
    unsigned* bar = b.bar;
    __builtin_amdgcn_s_waitcnt(0);
    unsigned nloc = b.st[0], nx = b.st[1];
    if (nloc == 0u) { xcd_barrier_complete(bar, b.x, nloc, nx); b.st[0] = nloc; b.st[1] = nx; }
    const unsigned old = xb_add(&bar[XB_XSUB(b.x)], 1u);
    const unsigned gen = old / nloc;
    if (old + 1u == (gen + 1u) * nloc) {
      __builtin_amdgcn_fence(__ATOMIC_RELEASE, "agent");
      asm volatile("s_waitcnt vmcnt(0)" ::: "memory");
      const unsigned og = xb_add(&bar[XB_TOP], 1u);
      const unsigned tg = og / nx;
      if (og + 1u == (tg + 1u) * nx) xb_add(&bar[XB_TOPGEN], 1u);
      else XB_SPIN(xb_ld(&bar[XB_TOPGEN]) == tg, bar);
      __builtin_amdgcn_fence(__ATOMIC_ACQUIRE, "agent");
      xb_add(&bar[XB_XGEN(b.x)], 1u);
      asm volatile("s_waitcnt vmcnt(0)" ::: "memory");
    } else {
      XB_SPIN(xb_ld(&bar[XB_XGEN(b.x)]) == gen, bar);
      __builtin_amdgcn_fence(__ATOMIC_ACQUIRE, "agent");
      asm volatile("s_waitcnt vmcnt(0)" ::: "memory");
    }
  }
  __syncthreads();
}

__global__ void __launch_bounds__(512) mega_kernel(Params p) {
  cg::grid_group grid = cg::this_grid();
  const int bid = blockIdx.x, nb = gridDim.x;
  __shared__ uint4 xb_words;
  if (threadIdx.x == 0) xb_words = make_uint4(0u, 0u, 0u, 0u);
  __syncthreads();
  const XcdBarrier xb = xcd_barrier_post(p.bar, (volatile LAS unsigned*)&xb_words);
  if (ON(0)) ph_prep(p, bid, nb);
  grid.sync();
  if (ON(1)) ph_gemm1(p, bid, nb);
  xcd_barrier(xb);
  if (REP == 1) { ph_gemm1(p, bid, nb); xcd_barrier(xb); }
  if (ON(2)) ph_rwprep(p, bid, nb);
  xcd_barrier(xb);
  if (REP == 2) { ph_rwprep(p, bid, nb); xcd_barrier(xb); }
  if (ON(3)) ph_scan(p, bid, nb);
  xcd_barrier(xb);
  if (REP == 3) { ph_scan(p, bid, nb); xcd_barrier(xb); }
  if (REP == 4) { ph_attn(p, bid, nb, true); xcd_barrier(xb); }
  if (ON(4)) ph_attn(p, bid, nb);
  xcd_barrier(xb);
  if (ON(5)) ph_gemm2(p, bid, nb);
  xcd_barrier(xb);
  if (REP == 5) { ph_gemm2(p, bid, nb); xcd_barrier(xb); }
  if (ON(6)) ph_gemm3(p, bid, nb);
  xcd_barrier(xb);
  if (REP == 6) { ph_gemm3(p, bid, nb); xcd_barrier(xb); }
  if (ON(7)) ph_norm2(p, bid, nb);
  xcd_barrier(xb);
  if (ON(8)) ph_peerq(p, bid, nb);
  xcd_barrier(xb);
  if (REP == 8) { ph_peerq(p, bid, nb); xcd_barrier(xb); }
  if (REP == 9) { ph_peer(p, bid, nb, true); xcd_barrier(xb); }
  if (ON(9)) ph_peer(p, bid, nb);
}

extern "C" void kernel_launch(void* const* d_in, const int* in_sizes, int n_in, void* d_out, int out_size, void* d_ws,
                              size_t ws_size, hipStream_t stream) {
  Params p{};
  const float** f = (const float**)&p;
  for (int i = 0; i < 28; i++) f[i] = (const float*)d_in[i];
  p.out = (float*)d_out;
  char* w = (char*)d_ws;
  size_t off = 0;
  auto take = [&](size_t bytes) { char* r = w + off; off += (bytes + 255) & ~(size_t)255; return (u16*)r; };
  p.H = take((size_t)MP * 1024 * 2);
  p.P = take((size_t)MP * INC * 2);
  p.U8 = (unsigned char*)take((size_t)16384 * 1024);
  p.V8 = (unsigned char*)take((size_t)16384 * 1024);
  p.SU = (float*)take(16384 * 4);
  p.SV = (float*)take(16384 * 4);
  p.SH = (float*)take((size_t)T * 4);
  p.bar = (unsigned*)take((size_t)XCD_BAR_WORDS * 4);
  p.WinT = take((size_t)4608 * 1024 * 2);
  p.WbT = take((size_t)2 * 1024 * 512 * 2);
  p.WoutT = take((size_t)1024 * 1024 * 2);
  p.WqT = take((size_t)1024 * 1024 * 2);
  p.W2T = take((size_t)512 * 64 * 2);
  p.A2T = take((size_t)512 * 64 * 2);
  p.G2T = take((size_t)512 * 128 * 2);
  p.SK = take((size_t)2 * 128 * 64 * 2);
  p.Y = take((size_t)T * 512 * 2);
  p.G = take((size_t)T * 512 * 2);
  p.OATT = take((size_t)T * 512 * 2);
  static int grid_blocks = 0;
  if (!grid_blocks) {
    int dev = 0, cus = 0, per_cu = 0;
    (void)hipGetDevice(&dev);
    (void)hipDeviceGetAttribute(&cus, hipDeviceAttributeMultiprocessorCount, dev);
    (void)hipFuncSetAttribute((const void*)mega_kernel, hipFuncAttributeMaxDynamicSharedMemorySize, DYN_LDS);
    (void)hipOccupancyMaxActiveBlocksPerMultiprocessor(&per_cu, mega_kernel, NTH, DYN_LDS);
    if (per_cu > 1) per_cu = 1;
    grid_blocks = cus * per_cu;
  }
  (void)hipMemsetAsync(p.bar, 0, (size_t)XCD_BAR_WORDS * 4, stream);
  void* args[] = {&p};
  hipError_t e = hipLaunchCooperativeKernel((void*)mega_kernel, dim3(grid_blocks), dim3(NTH), args, DYN_LDS, stream);
  if (e != hipSuccess) fprintf(stderr, "cooperative launch failed: %s (grid %d)\n", hipGetErrorString(e), grid_blocks);
}
```

```cpp
#include <hip/hip_runtime.h>
#include <hip/hip_cooperative_groups.h>
#include <cstdio>
namespace cg = cooperative_groups;

#ifndef REP
#define REP -1
#endif
#ifndef ONLY
#define ONLY -1
#endif
#define ON(k) (ONLY < 0 || ONLY == (k))

typedef unsigned short u16;
typedef unsigned int u32;
using bf16x8 = __attribute__((ext_vector_type(8))) short;
using f32x4 = __attribute__((ext_vector_type(4))) float;
using f32x16 = __attribute__((ext_vector_type(16))) float;
using u32x4 = __attribute__((ext_vector_type(4))) u32;
#define DI __device__ __forceinline__

constexpr int TP = 65536, TS = 1024, T = 66560, MP = 66816;
constexpr int INC = 4608;
constexpr int NW = 8;
constexpr int NTH = 512;
constexpr size_t OFF_Y = 0, OFF_SHIFT_P = 68157440, OFF_WKV_P = 68173824, OFF_KP = 68698112, OFF_VP = 68960256,
                 OFF_SHIFT_S = 69222400, OFF_WKV_S = 69238784, OFF_KS = 69763072, OFF_VS = 69894144;
constexpr int DYN_LDS = 159744;

extern __shared__ __attribute__((aligned(16))) char dsm[];

struct Params {
  const float *x_prompt, *x_sample, *state_shift, *state_wkv, *cache_k, *cache_v, *norm1_g, *w_in, *mu, *w0, *w2, *a0,
      *a2, *g2, *k_k, *k_a, *r_k, *lnx_w, *lnx_b, *sinks, *w_branch, *w_out, *norm2_g, *peer_wq, *sub_keys, *peer_u,
      *peer_v, *final_g;
  float* out;
  u16 *H, *P, *WinT, *WbT, *WoutT, *WqT, *W2T, *A2T, *G2T, *SK, *Y, *G, *OATT;
  unsigned char *U8, *V8;
  float *SU, *SV, *SH;
  unsigned* bar;
};

typedef __bf16 hbf2 __attribute__((ext_vector_type(2)));
typedef float hf2 __attribute__((ext_vector_type(2)));
DI u16 f2bf(float x) { const __bf16 r = (__bf16)x; return __builtin_bit_cast(unsigned short, r); }
DI float bf2f(u16 b) { return __uint_as_float(((u32)b) << 16); }
DI u32 pack2(float a, float b) { const hf2 v = {a, b}; const hbf2 r = __builtin_convertvector(v, hbf2); return __builtin_bit_cast(u32, r); }
DI float bflo(u32 w) { return __uint_as_float(w << 16); }
DI float bfhi(u32 w) { return __uint_as_float(w & 0xffff0000u); }
DI float wave_sum(float v) {
#pragma unroll
  for (int o = 32; o; o >>= 1) v += __shfl_xor(v, o);
  return v;
}
DI float sigmoidf_(float x) { return 1.f / (1.f + __expf(-x)); }
DI const float* xrow(const Params& p, int g) {
  return g < TP ? p.x_prompt + (size_t)g * 1024 : p.x_sample + (size_t)(g - TP) * 1024;
}
DI int otid() { int t = threadIdx.x; asm volatile("" : "+v"(t)); return t; }
#define MFMA32(a, b, c) __builtin_amdgcn_mfma_f32_32x32x16_bf16((a), (b), (c), 0, 0, 0)
#define MFMA16(a, b, c) __builtin_amdgcn_mfma_f32_16x16x32_bf16((a), (b), (c), 0, 0, 0)

template <int CTRL>
DI float dppmov(float v) {
  return __int_as_float(__builtin_amdgcn_update_dpp(0, __float_as_int(v), CTRL, 0xF, 0xF, false));
}
DI float red16(float v) {
  v += dppmov<0x128>(v);
  v += dppmov<0x124>(v);
  v += dppmov<0x122>(v);
  v += dppmov<0x121>(v);
  return v;
}


using f32x2 = __attribute__((ext_vector_type(2))) float;
DI float wave_max(float v) {
#pragma unroll
  for (int o = 32; o; o >>= 1) v = fmaxf(v, __shfl_xor(v, o));
  return v;
}
DI u32 q4(float a, float b, float c, float d, float sc) {
  int w = 0;
  w = __builtin_amdgcn_cvt_pk_fp8_f32(a * sc, b * sc, w, false);
  w = __builtin_amdgcn_cvt_pk_fp8_f32(c * sc, d * sc, w, true);
  return (u32)w;
}

DI void tcvt(const float* __restrict__ W, u16* __restrict__ Wt, int K, int N, int gt, int nt) {
  const int total = N * (K / 8);
  for (int i = gt; i < total; i += nt) {
    const int n = i % N, kg = i / N;
    u32 o[4];
#pragma unroll
    for (int j = 0; j < 4; j++)
      o[j] = pack2(W[(size_t)(kg * 8 + 2 * j) * N + n], W[(size_t)(kg * 8 + 2 * j + 1) * N + n]);
    *(uint4*)(Wt + (size_t)n * K + kg * 8) = make_uint4(o[0], o[1], o[2], o[3]);
  }
}
DI void scvt(const float* __restrict__ W, u16* __restrict__ O, int n8, int gt, int nt) {
  for (int i = gt; i < n8; i += nt) {
    const float4 a = ((const float4*)W)[2 * i], b = ((const float4*)W)[2 * i + 1];
    ((uint4*)O)[i] = make_uint4(pack2(a.x, a.y), pack2(a.z, a.w), pack2(b.x, b.y), pack2(b.z, b.w));
  }
}

__device__ void ph_prep(const Params& p, int bid, int nb) {
  const int tid = otid(), lane = tid & 63, wv = tid >> 6;
  for (int row = bid * NW + wv; row < MP; row += nb * NW) {
    u16* hr = p.H + (size_t)row * 1024;
    if (row < T) {
      const float4* x = (const float4*)xrow(p, row);
      float4 v[4];
      float ss = 0.f;
#pragma unroll
      for (int i = 0; i < 4; i++) {
        v[i] = x[lane + i * 64];
        ss += v[i].x * v[i].x + v[i].y * v[i].y + v[i].z * v[i].z + v[i].w * v[i].w;
      }
      ss = wave_sum(ss);
      const float rs = rsqrtf(ss * (1.f / 1024.f) + 1e-6f);
      float* so = nullptr;
      if (row < TP) {
        if ((row & 4095) == 4095) so = p.out + OFF_SHIFT_P + (size_t)(row >> 12) * 1024;
      } else {
        const int r2 = row - TP;
        if ((r2 & 63) == 63) so = p.out + OFF_SHIFT_S + (size_t)(r2 >> 6) * 1024;
      }
#pragma unroll
      for (int i = 0; i < 4; i++) {
        const float4 g = ((const float4*)p.norm1_g)[lane + i * 64];
        float4 y;
        y.x = v[i].x * rs * g.x; y.y = v[i].y * rs * g.y; y.z = v[i].z * rs * g.z; y.w = v[i].w * rs * g.w;
        ((uint2*)hr)[lane + i * 64] = make_uint2(pack2(y.x, y.y), pack2(y.z, y.w));
        if (so) ((float4*)so)[lane + i * 64] = y;
      }
    } else if (row < T + 16) {
      const float4* x = (const float4*)(p.state_shift + (size_t)(row - T) * 1024);
#pragma unroll
      for (int i = 0; i < 4; i++) {
        const float4 y = x[lane + i * 64];
        ((uint2*)hr)[lane + i * 64] = make_uint2(pack2(y.x, y.y), pack2(y.z, y.w));
      }
    } else {
#pragma unroll
      for (int i = 0; i < 4; i++) ((uint2*)hr)[lane + i * 64] = make_uint2(0u, 0u);
    }
  }
  const int gt = bid * NTH + tid, nt = nb * NTH;
  tcvt(p.w_in, p.WinT, 1024, 4608, gt, nt);
  tcvt(p.w_branch, p.WbT, 512, 1024, gt, nt);
  tcvt(p.w_branch + 512 * 1024, p.WbT + 1024 * 512, 512, 1024, gt, nt);
  tcvt(p.w_out, p.WoutT, 1024, 1024, gt, nt);
  tcvt(p.peer_wq, p.WqT, 1024, 1024, gt, nt);
  tcvt(p.w2, p.W2T, 64, 512, gt, nt);
  tcvt(p.a2, p.A2T, 64, 512, gt, nt);
  tcvt(p.g2, p.G2T, 128, 512, gt, nt);
  scvt(p.sub_keys, p.SK, 2 * 128 * 64 / 8, gt, nt);
  for (int r = bid * NW + wv; r < 32768; r += nb * NW) {
    const bool isv = r >= 16384;
    const int e = r & 16383;
    const float4* src = (const float4*)((isv ? p.peer_v : p.peer_u) + (size_t)e * 1024) + lane * 4;
    const float4 a = src[0], b = src[1], c = src[2], d = src[3];
    float am = fmaxf(fmaxf(fmaxf(fabsf(a.x), fabsf(a.y)), fmaxf(fabsf(a.z), fabsf(a.w))),
                     fmaxf(fmaxf(fabsf(b.x), fabsf(b.y)), fmaxf(fabsf(b.z), fabsf(b.w))));
    am = fmaxf(am, fmaxf(fmaxf(fmaxf(fabsf(c.x), fabsf(c.y)), fmaxf(fabsf(c.z), fabsf(c.w))),
                         fmaxf(fmaxf(fabsf(d.x), fabsf(d.y)), fmaxf(fabsf(d.z), fabsf(d.w)))));
    am = fmaxf(wave_max(am), 1e-30f);
    const float sc = 240.f / am;
    if (lane == 0) (isv ? p.SV : p.SU)[e] = am * (1.f / 240.f);
    *(u32x4*)((isv ? p.V8 : p.U8) + (size_t)e * 1024 + lane * 16) =
        u32x4{q4(a.x, a.y, a.z, a.w, sc), q4(b.x, b.y, b.z, b.w, sc), q4(c.x, c.y, c.z, c.w, sc), q4(d.x, d.y, d.z, d.w, sc)};
  }
}

constexpr int GBK = 64, GHALF = 128, GHT = GHALF * GBK;
DI int lds_byte(int r, int c) {
  const int st = (r >> 4) * 2 + (c >> 5), rr = r & 15, cc = c & 31, ob = rr * 64 + cc * 2;
  return st * 1024 + (ob ^ (((ob >> 9) & 1) << 5));
}
DI void stage_rc(int b, int& R, int& C) {
  const int st = b / 1024, sb = b % 1024, swz = sb ^ (((sb >> 9) & 1) << 5);
  R = (st >> 1) * 16 + swz / 64;
  C = (st & 1) * 32 + (swz % 64) / 2;
}
typedef __attribute__((address_space(3))) unsigned lds_u32;
#define G_SA(b, h) (shm + ((b) * 2 + (h)) * GHT)
#define G_SB(b, h) (shm + (4 + (b) * 2 + (h)) * GHT)
#define G_STAGE(P_, RS, br, kt)                                                                                   \
  do {                                                                                                            \
    const int _so = ((br) * K + (kt) * GBK) * 2;                                                                  \
    __builtin_amdgcn_raw_ptr_buffer_load_lds(RS, (lds_u32*)((char*)(P_) + tb0), 16, ob0, _so, 0, 0);              \
    __builtin_amdgcn_raw_ptr_buffer_load_lds(RS, (lds_u32*)((char*)(P_) + tb0 + 8192), 16, ob1, _so, 0, 0);       \
  } while (0)
#define G_LDA(dst, b, h)                                  \
  _Pragma("unroll") for (int m = 0; m < 4; ++m)           \
  _Pragma("unroll") for (int k = 0; k < 2; ++k)           \
    dst[m][k] = *reinterpret_cast<const bf16x8*>((const char*)G_SA(b, h) + lds_byte(wr * 64 + m * 16 + fr, k * 32 + fq * 8))
#define G_LDB(dst, b, h)                                  \
  _Pragma("unroll") for (int n = 0; n < 2; ++n)           \
  _Pragma("unroll") for (int k = 0; k < 2; ++k)           \
    dst[n][k] = *reinterpret_cast<const bf16x8*>((const char*)G_SB(b, h) + lds_byte(wc * 32 + n * 16 + fr, k * 32 + fq * 8))
#define G_MMA(ai, bj, At_, Bt_)                                                                         \
  do {                                                                                                  \
    __builtin_amdgcn_s_setprio(1);                                                                      \
    _Pragma("unroll") for (int m = 0; m < 4; ++m)                                                       \
    _Pragma("unroll") for (int n = 0; n < 2; ++n)                                                       \
    _Pragma("unroll") for (int k = 0; k < 2; ++k)                                                       \
      acc[ai][bj][m][n] = MFMA16(At_[m][k], Bt_[n][k], acc[ai][bj][m][n]);                              \
    __builtin_amdgcn_s_setprio(0);                                                                      \
  } while (0)
#define WAIT_V(n) asm volatile("s_waitcnt vmcnt(" #n ")" ::: "memory")
#define WAIT_L(n) asm volatile("s_waitcnt lgkmcnt(" #n ")" ::: "memory")
#define BAR __builtin_amdgcn_s_barrier()
#define SCHED __builtin_amdgcn_sched_barrier(0)

template <int K>
DI void gemm256(const u16* __restrict__ A, const u16* __restrict__ Bt, const int brow, const int bcol,
                f32x4 (&acc)[2][2][4][2]) {
  u16* shm = (u16*)dsm;
  const int tid_ = otid();
  const int wid = tid_ >> 6, lane = tid_ & 63, wr = wid >> 2, wc = wid & 3, fr = lane & 15, fq = lane >> 4;
#pragma unroll
  for (int a = 0; a < 2; a++)
#pragma unroll
    for (int b = 0; b < 2; b++)
#pragma unroll
      for (int m = 0; m < 4; m++)
#pragma unroll
        for (int n = 0; n < 2; n++) acc[a][b][m][n] = f32x4{0.f, 0.f, 0.f, 0.f};
  bf16x8 At[4][2], B0[2][2], B1[2][2];
  constexpr int nt = K / GBK;
  const __amdgpu_buffer_rsrc_t rsA = __builtin_amdgcn_make_buffer_rsrc((void*)A, 0, 0x7fffffff, 0x00020000);
  const __amdgpu_buffer_rsrc_t rsB = __builtin_amdgcn_make_buffer_rsrc((void*)Bt, 0, 0x7fffffff, 0x00020000);
  const unsigned tb0 = tid_ * 16;
  int ob0, ob1;
  {
    int r_, c_;
    stage_rc((int)tb0, r_, c_);
    ob0 = (r_ * K + c_) * 2;
    stage_rc((int)tb0 + 8192, r_, c_);
    ob1 = (r_ * K + c_) * 2;
  }
  WAIT_V(0);
  __syncthreads();
  G_STAGE(G_SB(0, 0), rsB, bcol, 0); G_STAGE(G_SA(0, 0), rsA, brow, 0);
  G_STAGE(G_SB(0, 1), rsB, bcol + GHALF, 0); G_STAGE(G_SA(0, 1), rsA, brow + GHALF, 0);
  if (wr == 1) BAR;
  WAIT_V(4); BAR;
  G_STAGE(G_SB(1, 0), rsB, bcol, 1); G_STAGE(G_SA(1, 0), rsA, brow, 1); G_STAGE(G_SB(1, 1), rsB, bcol + GHALF, 1);
  WAIT_V(6); BAR;
  for (int t = 0; t < nt - 2; t += 2) {
    G_LDB(B0, 0, 0); SCHED; G_LDA(At, 0, 0); G_STAGE(G_SA(1, 1), rsA, brow + GHALF, t + 1);
    WAIT_L(8); BAR; WAIT_L(0); G_MMA(0, 0, At, B0); BAR; SCHED;
    G_LDB(B1, 0, 1); G_STAGE(G_SB(0, 0), rsB, bcol, t + 2);
    BAR; WAIT_L(0); G_MMA(0, 1, At, B1); BAR;
    G_LDA(At, 0, 1); G_STAGE(G_SA(0, 0), rsA, brow, t + 2);
    BAR; WAIT_L(0); G_MMA(1, 0, At, B0); BAR; SCHED;
    G_STAGE(G_SB(0, 1), rsB, bcol + GHALF, t + 2);
    WAIT_V(6); BAR; G_MMA(1, 1, At, B1); BAR;
    G_LDB(B0, 1, 0); SCHED; G_LDA(At, 1, 0); G_STAGE(G_SA(0, 1), rsA, brow + GHALF, t + 2);
    WAIT_L(8); BAR; WAIT_L(0); G_MMA(0, 0, At, B0); BAR; SCHED;
    G_LDB(B1, 1, 1); G_STAGE(G_SB(1, 0), rsB, bcol, t + 3);
    BAR; WAIT_L(0); G_MMA(0, 1, At, B1); BAR;
    G_LDA(At, 1, 1); G_STAGE(G_SA(1, 0), rsA, brow, t + 3);
    BAR; WAIT_L(0); G_MMA(1, 0, At, B0); BAR; SCHED;
    G_STAGE(G_SB(1, 1), rsB, bcol + GHALF, t + 3);
    WAIT_V(6); BAR; G_MMA(1, 1, At, B1); BAR;
  }
  {
    G_LDB(B0, 0, 0); G_LDA(At, 0, 0); G_STAGE(G_SA(1, 1), rsA, brow + GHALF, nt - 1);
    BAR; WAIT_L(0); G_MMA(0, 0, At, B0); BAR;
    G_LDB(B1, 0, 1); BAR; WAIT_L(0); G_MMA(0, 1, At, B1); BAR;
    G_LDA(At, 0, 1); WAIT_V(4); BAR; WAIT_L(0); G_MMA(1, 0, At, B0); G_MMA(1, 1, At, B1); BAR;
  }
  {
    G_LDB(B0, 1, 0); G_LDA(At, 1, 0); WAIT_V(2); BAR; WAIT_L(0); G_MMA(0, 0, At, B0); BAR;
    G_LDB(B1, 1, 1); WAIT_V(0); BAR; WAIT_L(0); G_MMA(0, 1, At, B1); BAR;
    G_LDA(At, 1, 1); BAR; WAIT_L(0); G_MMA(1, 0, At, B0); G_MMA(1, 1, At, B1); BAR;
  }
  if (wr == 0) BAR;
}
#define GT_VARS \
  const int tid_ = otid(); const int wid = tid_ >> 6, lane = tid_ & 63, wr = wid >> 2, wc = wid & 3, fr = lane & 15, fq = lane >> 4;
#define GT_ROW(ai, m, j) ((ai) * 128 + wr * 64 + (m) * 16 + fq * 4 + (j))
#define GT_COL(bj, n) ((bj) * 128 + wc * 32 + (n) * 16 + fr)
#define GT_FOR                                       \
  _Pragma("unroll") for (int ai = 0; ai < 2; ++ai)   \
  _Pragma("unroll") for (int bj = 0; bj < 2; ++bj)   \
  _Pragma("unroll") for (int m = 0; m < 4; ++m)      \
  _Pragma("unroll") for (int n = 0; n < 2; ++n)      \
  _Pragma("unroll") for (int j = 0; j < 4; ++j)

DI bool tile_of(int round, int bid, int nb, int nM, int nN, int& pm, int& pn) {
  const int vt = round * nb + (bid & 7) * (nb >> 3) + (bid >> 3);
  if (vt >= nM * nN) return false;
  const int nig = 8 * nN, gid = vt / nig, fm = gid * 8, gsz = min(nM - fm, 8);
  pm = fm + (vt % nig) % gsz;
  pn = (vt % nig) / gsz;
  return true;
}


constexpr int CS_LD = 264;
DI void acc_to_lds(const f32x4 (&acc)[2][2][4][2]) {
  GT_VARS
  u16* Cs = (u16*)dsm;
  __syncthreads();
  GT_FOR { Cs[GT_ROW(ai, m, j) * CS_LD + GT_COL(bj, n)] = f2bf(acc[ai][bj][m][n][j]); }
  __syncthreads();
}

__device__ void ph_gemm1(const Params& p, int bid, int nb) {
  const int tid_ = otid();
  const int nM = 261, nN = 18;
  for (int round = 0; round * nb < nM * nN; ++round) {
    int pm, pn;
    if (!tile_of(round, bid, nb, nM, nN, pm, pn)) break;
    f32x4 acc[2][2][4][2];
    gemm256<1024>(p.H, p.WinT, pm * 256, pn * 256, acc);
    acc_to_lds(acc);
    const u16* Cs = (const u16*)dsm;
#pragma unroll 4
    for (int it = 0; it < 16; it++) {
      const int id = it * NTH + tid_, rl = id >> 5, c8 = (id & 31) * 8;
      const int row = pm * 256 + rl;
      const u32x4 v = *(const u32x4*)(Cs + rl * CS_LD + c8);
      *(u32x4*)(p.P + (size_t)row * INC + pn * 256 + c8) = v;
      if (pn == 9) {
        float* dst = nullptr;
        const int c2 = c8 & 127;
        if (row < TP) {
          const int tt = row & 4095;
          if (tt >= 3968) dst = p.out + (c8 < 128 ? OFF_KP : OFF_VP) + ((size_t)(row >> 12) * 128 + (tt - 3968)) * 128 + c2;
        } else if (row < T) {
          dst = p.out + (c8 < 128 ? OFF_KS : OFF_VS) + (size_t)(row - TP) * 128 + c2;
        }
        if (dst) {
          *(float4*)dst = make_float4(bflo(v[0]), bfhi(v[0]), bflo(v[1]), bfhi(v[1]));
          *(float4*)(dst + 4) = make_float4(bflo(v[2]), bfhi(v[2]), bflo(v[3]), bfhi(v[3]));
        }
      }
    }
  }
}

DI int prev_row(int g) {
  if (g < TP) return (g & 4095) ? g - 1 : -1;
  const int r2 = g - TP;
  return (r2 & 63) ? g - 1 : T + (r2 >> 6);
}

__device__ void ph_rwprep(const Params& p, int bid, int nb) {
  const int tid = otid(), lane = tid & 63, wv = tid >> 6, fr = lane & 15, fq = lane >> 4;
  u16* A1 = (u16*)dsm;
  u16* A2 = A1 + 64 * 80;
  u16* A3 = A2 + 64 * 80;
  u16* SA = (u16*)(p.out);
  u16* SB = p.H;
  const int hd = wv;
  u16* OT = (u16*)(dsm + 38912 + wv * 12288);
  u32x4 pin[7];
  for (int tile = bid; tile < T / 64; tile += nb) {
    const int g0 = tile * 64;
    auto issue_in = [&](int rg_) {
#pragma unroll
      for (int it = 0; it < 7; it++) {
        const int id = it * 64 + lane, ri = id / 24, rem = id - ri * 24, arr = rem >> 3, ch = rem & 7;
        int tok = g0 + rg_ * 16 - 1 + ri;
        if (rg_ == 0 && ri == 0) tok = prev_row(g0);
        pin[it] = u32x4{0u, 0u, 0u, 0u};
        if (id < 408 && tok >= 0) pin[it] = *(const u32x4*)(p.P + (size_t)tok * INC + arr * 512 + hd * 64 + ch * 8);
      }
    };
    __syncthreads();
    {
      const int row = tid >> 3, part8 = tid & 7, part = part8 >> 1, sub = part8 & 1;
      const int g = g0 + row, pr = prev_row(g);
      const int cb = 1536 + part * 64 + sub * 32;
      const u16* cur = p.P + (size_t)g * INC + cb;
      const u16* prv = p.P + (size_t)(pr < 0 ? 0 : pr) * INC + cb;
#pragma unroll
      for (int q = 0; q < 4; q++) {
        const u32x4 c4 = *(const u32x4*)(cur + q * 8);
        u32x4 p4 = {0u, 0u, 0u, 0u};
        if (pr >= 0) p4 = *(const u32x4*)(prv + q * 8);
        u32x4 ow;
#pragma unroll
        for (int e = 0; e < 4; e++) {
          const float c0 = bflo(c4[e]), c1 = bfhi(c4[e]), q0 = bflo(p4[e]), q1 = bfhi(p4[e]);
          float f0 = c0 + (q0 - c0) * p.mu[cb + q * 8 + 2 * e];
          float f1 = c1 + (q1 - c1) * p.mu[cb + q * 8 + 2 * e + 1];
          if (part == 0) { f0 = 1.f - 2.f / (1.f + __expf(2.f * f0)); f1 = 1.f - 2.f / (1.f + __expf(2.f * f1)); }
          else if (part >= 2) { f0 = sigmoidf_(f0); f1 = sigmoidf_(f1); }
          ow[e] = pack2(f0, f1);
        }
        u16* dst = part == 0 ? A1 + row * 80 + sub * 32 + q * 8
                 : part == 1 ? A2 + row * 80 + sub * 32 + q * 8
                             : A3 + row * 144 + (part - 2) * 64 + sub * 32 + q * 8;
        *(u32x4*)dst = ow;
      }
    }
    __syncthreads();
#pragma unroll 1
    for (int rg = 0; rg < 4; rg++) {
      issue_in(rg);
#pragma unroll
      for (int it = 0; it < 7; it++) {
        const int id = it * 64 + lane;
        if (id < 408) *(u32x4*)(OT + id * 8) = pin[it];
      }
      __builtin_amdgcn_fence(__ATOMIC_RELEASE, "workgroup");
      __builtin_amdgcn_wave_barrier();
      float inr[5][3][4];
#pragma unroll
      for (int jj = 0; jj < 5; jj++)
#pragma unroll
        for (int ar = 0; ar < 3; ar++)
#pragma unroll
          for (int nt = 0; nt < 4; nt++) inr[jj][ar][nt] = bf2f(OT[((fq * 4 + jj) * 3 + ar) * 64 + nt * 16 + fr]);
      __builtin_amdgcn_fence(__ATOMIC_RELEASE, "workgroup");
      __builtin_amdgcn_wave_barrier();
      SCHED;
      f32x4 aw[4], aa[4];
#pragma unroll
      for (int nt = 0; nt < 4; nt++) { aw[nt] = f32x4{0.f, 0.f, 0.f, 0.f}; aa[nt] = f32x4{0.f, 0.f, 0.f, 0.f}; }
#pragma unroll 1
      for (int ks = 0; ks < 2; ks++) {
        const bf16x8 f1 = *(const bf16x8*)(A1 + (rg * 16 + fr) * 80 + ks * 32 + fq * 8);
        const bf16x8 f2 = *(const bf16x8*)(A2 + (rg * 16 + fr) * 80 + ks * 32 + fq * 8);
#pragma unroll
        for (int nt = 0; nt < 4; nt++) {
          const bf16x8 bw = *(const bf16x8*)(p.W2T + (unsigned)((hd * 64 + nt * 16 + fr) * 64 + ks * 32 + fq * 8));
          const bf16x8 ba = *(const bf16x8*)(p.A2T + (unsigned)((hd * 64 + nt * 16 + fr) * 64 + ks * 32 + fq * 8));
          aw[nt] = MFMA16(f1, bw, aw[nt]);
          aa[nt] = MFMA16(f2, ba, aa[nt]);
        }
      }
      float ss[4] = {0.f, 0.f, 0.f, 0.f};
      const int rowb = rg * 16 + fq * 4;
      const int gb = g0 + rowb;
#pragma unroll
      for (int nt = 0; nt < 4; nt++) {
        const int c = nt * 16 + fr, col = hd * 64 + c;
        const float mu_r = p.mu[col], mu_k = p.mu[512 + col], mu_v = p.mu[1024 + col];
        const float w0c = p.w0[col], a0c = p.a0[col], kkc = p.k_k[col], kac = p.k_a[col];
        float qr = inr[0][0][nt], qk = inr[0][1][nt], qv = inr[0][2][nt];
#pragma unroll
        for (int j = 0; j < 4; j++) {
          const float cr = inr[j + 1][0][nt], ck = inr[j + 1][1][nt], cv = inr[j + 1][2][nt];
          const float r = cr + (qr - cr) * mu_r, k = ck + (qk - ck) * mu_k, v = cv + (qv - cv) * mu_v;
          qr = cr; qk = ck; qv = cv;
          const float ed = 0.6065306597126334f * sigmoidf_(w0c + aw[nt][j]);
          const float dm = 1.f - __expf(-ed);
          const float a = sigmoidf_(a0c + aa[nt][j]);
          const float kkv = k * kkc;
          ss[j] += kkv * kkv;
          const float k2 = k * (1.f + (a - 1.f) * kac);
          u16* ot = OT + (fq * 4 + j) * 384 + c;
          ot[0] = f2bf(r);
          ot[64] = f2bf(dm);
          ot[128] = f2bf(k2);
          ot[256] = f2bf(v);
          aw[nt][j] = kkv;
          aa[nt][j] = a;
        }
        SCHED;
      }
#pragma unroll
      for (int j = 0; j < 4; j++) ss[j] = 1.f / fmaxf(sqrtf(red16(ss[j])), 1e-12f);
#pragma unroll
      for (int nt = 0; nt < 4; nt++) {
        const int c = nt * 16 + fr;
#pragma unroll
        for (int j = 0; j < 4; j++) {
          const float kkn = aw[nt][j] * ss[j];
          u16* ot = OT + (fq * 4 + j) * 384 + c;
          ot[192] = f2bf(kkn);
          ot[320] = f2bf(kkn * aa[nt][j]);
        }
      }
      __builtin_amdgcn_fence(__ATOMIC_RELEASE, "workgroup");
      __builtin_amdgcn_wave_barrier();
      {
        const int gr0 = g0 + rg * 16;
#pragma unroll 4
        for (int it = 0; it < 12; it++) {
          const int id = it * 64 + lane, rowi = id / 48, pc = id % 48;
          const u32x4 v4 = *(const u32x4*)(OT + rowi * 384 + pc * 8);
          const size_t gh = (size_t)(gr0 + rowi) * 8 + hd;
          if (pc < 32) *(u32x4*)(SA + gh * 256 + pc * 8) = v4;
          else *(u32x4*)(SB + gh * 128 + (pc - 32) * 8) = v4;
        }
      }
      __builtin_amdgcn_wave_barrier();
      f32x4 ag[4];
#pragma unroll
      for (int nt = 0; nt < 4; nt++) ag[nt] = f32x4{0.f, 0.f, 0.f, 0.f};
#pragma unroll 1
      for (int ks = 0; ks < 4; ks++) {
        const bf16x8 f3 = *(const bf16x8*)(A3 + (rg * 16 + fr) * 144 + ks * 32 + fq * 8);
#pragma unroll
        for (int nt = 0; nt < 4; nt++) {
          const bf16x8 bg = *(const bf16x8*)(p.G2T + (unsigned)((hd * 64 + nt * 16 + fr) * 128 + ks * 32 + fq * 8));
          ag[nt] = MFMA16(f3, bg, ag[nt]);
        }
      }
#pragma unroll
      for (int nt = 0; nt < 4; nt++)
#pragma unroll
        for (int j = 0; j < 4; j++) p.G[(size_t)(gb + j) * 512 + hd * 64 + nt * 16 + fr] = f2bf(ag[nt][j]);
    }
  }
}

DI float red8(float v) {
  v += dppmov<0xB1>(v);
  v += dppmov<0x4E>(v);
  v += dppmov<0x141>(v);
  return v;
}
struct ScanOps { f32x4 r, d, k, n, b; float v; };
DI void scan_ld(ScanOps& o, const float* sb, int j0, int row) {
  o.r = *(const f32x4*)(sb + j0);
  o.d = *(const f32x4*)(sb + 64 + j0);
  o.k = *(const f32x4*)(sb + 128 + j0);
  o.n = *(const f32x4*)(sb + 192 + j0);
  o.b = *(const f32x4*)(sb + 320 + j0);
  o.v = sb[256 + row];
}
#define LO2(x) __builtin_shufflevector((x), (x), 0, 1)
#define HI2(x) __builtin_shufflevector((x), (x), 2, 3)
DI float scan_step(f32x2 (&S)[2], const ScanOps& o, f32x4& rprev) {
  const f32x2 vv = {o.v, o.v};
  const f32x2 tt = S[0] * LO2(o.n) + S[1] * HI2(o.n);
  const f32x2 yy = S[0] * LO2(rprev) + S[1] * HI2(rprev);
  const f32x2 m0 = S[0] * LO2(o.d) + vv * LO2(o.k);
  const f32x2 m1 = S[1] * HI2(o.d) + vv * HI2(o.k);
  float a = tt[0] + tt[1], y = yy[0] + yy[1];
  a += dppmov<0x128>(a); y += dppmov<0x128>(y);
  a += dppmov<0x124>(a); y += dppmov<0x124>(y);
  a += dppmov<0x122>(a); y += dppmov<0x122>(y);
  a += dppmov<0x121>(a); y += dppmov<0x121>(y);
  const float sa = -a;
  const f32x2 sv = {sa, sa};
  S[0] = m0 + sv * LO2(o.b);
  S[1] = m1 + sv * HI2(o.b);
  rprev = o.r;
  return y;
}

__device__ void ph_scan(const Params& p, int bid, int nb) {
  const int tid = otid(), lane = tid & 63, wv = tid >> 6;
  float* buf = (float*)dsm;
  const u16* SA = (const u16*)(p.out);
  const u16* SB = p.H;
  constexpr int CH = 32;
  for (int item = bid; item < 512; item += nb) {
    const int type = item >> 8, r_ = item & 255, half = r_ & 1, hb = r_ >> 1, h = hb & 7, b = hb >> 3;
    const int nch = type ? 64 / CH : 4096 / CH;
    const int gbase = type ? TP + b * 64 : b * 4096;
    const bool active = true;
    const int row = half * 32 + wv * 4 + (lane >> 4), j0 = (lane & 15) * 4;
    f32x2 S[2];
#pragma unroll
    for (int j = 0; j < 2; j++) S[j] = f32x2{0.f, 0.f};
    if (type && active) {
      const float* s0 = p.state_wkv + ((size_t)(b * 8 + h) * 64 + row) * 64 + j0;
#pragma unroll
      for (int j = 0; j < 2; j++) S[j] = f32x2{s0[2 * j], s0[2 * j + 1]};
    }
    f32x4 rprev = {0.f, 0.f, 0.f, 0.f};
    float ykeep = 0.f;
    u32x4 la[2], lb;
    auto gload = [&](int c) {
#pragma unroll
      for (int q = 0; q < 2; q++) {
        const int idx = tid + q * NTH, step = idx >> 5, u = idx & 31;
        la[q] = *(const u32x4*)(SA + ((size_t)(gbase + c * CH + step) * 8 + h) * 256 + u * 8);
      }
      {
        const int step = tid >> 4, u = tid & 15;
        lb = *(const u32x4*)(SB + ((size_t)(gbase + c * CH + step) * 8 + h) * 128 + u * 8);
      }
    };
    gload(0);
    for (int c = 0; c < nch; c++) {
      __syncthreads();
#pragma unroll
      for (int q = 0; q < 2; q++) {
        const int idx = tid + q * NTH, step = idx >> 5, u = idx & 31, arr = u >> 3, c0 = (u & 7) * 8;
        float* d = buf + step * 384 + arr * 64 + c0;
        float f[8];
#pragma unroll
        for (int e = 0; e < 4; e++) { f[2 * e] = bflo(la[q][e]); f[2 * e + 1] = bfhi(la[q][e]); }
        if (arr == 1) {
#pragma unroll
          for (int e = 0; e < 8; e++) f[e] = 1.f - f[e];
        }
        *(float4*)d = make_float4(f[0], f[1], f[2], f[3]);
        *(float4*)(d + 4) = make_float4(f[4], f[5], f[6], f[7]);
      }
      {
        const int step = tid >> 4, u = tid & 15, arr = u >> 3, c0 = (u & 7) * 8;
        float* d = buf + step * 384 + (4 + arr) * 64 + c0;
        *(float4*)d = make_float4(bflo(lb[0]), bfhi(lb[0]), bflo(lb[1]), bfhi(lb[1]));
        *(float4*)(d + 4) = make_float4(bflo(lb[2]), bfhi(lb[2]), bflo(lb[3]), bfhi(lb[3]));
      }
      __syncthreads();
      if (c + 1 < nch) gload(c + 1);
      if (active) {
        ScanOps A0, A1, B0, B1;
        scan_ld(A0, buf, j0, row);
        scan_ld(A1, buf + 384, j0, row);
#pragma unroll 1
        for (int s = 0; s < CH; s += 4) {
          scan_ld(B0, buf + (s + 2) * 384, j0, row);
          scan_ld(B1, buf + (s + 3) * 384, j0, row);
          SCHED;
          {
            const int g0 = c * CH + s;
            const float y0 = scan_step(S, A0, rprev);
            ykeep = ((lane & 15) == ((g0 - 1) & 15)) ? y0 : ykeep;
            if ((g0 & 15) == 0 && g0 > 0)
              p.Y[(size_t)(gbase + g0 - 16 + (lane & 15)) * 512 + h * 64 + row] = f2bf(ykeep);
            const float y1 = scan_step(S, A1, rprev);
            ykeep = ((lane & 15) == (g0 & 15)) ? y1 : ykeep;
          }
          SCHED;
          const int sn = (s + 4 < CH) ? s + 4 : s;
          scan_ld(A0, buf + sn * 384, j0, row);
          scan_ld(A1, buf + (sn + 1) * 384, j0, row);
          SCHED;
          {
            const int g0 = c * CH + s;
            const float y2 = scan_step(S, B0, rprev);
            ykeep = ((lane & 15) == ((g0 + 1) & 15)) ? y2 : ykeep;
            const float y3 = scan_step(S, B1, rprev);
            ykeep = ((lane & 15) == ((g0 + 2) & 15)) ? y3 : ykeep;
          }
          SCHED;
        }
      }
    }
    if (active) {
      const f32x2 yy = S[0] * LO2(rprev) + S[1] * HI2(rprev);
      const float yl = red16(yy[0] + yy[1]);
      ykeep = ((lane & 15) == 15) ? yl : ykeep;
      p.Y[(size_t)(gbase + nch * CH - 16 + (lane & 15)) * 512 + h * 64 + row] = f2bf(ykeep);
    }
    if (active) {
      float* so = p.out + (type ? OFF_WKV_S : OFF_WKV_P) + ((size_t)(b * 8 + h) * 64 + row) * 64 + j0;
      *(float4*)so = make_float4(S[0][0], S[0][1], S[1][0], S[1][1]);
    }
  }
}

__device__ void ph_attn(const Params& p, int bid, int nb, bool dry = false) {
  const int tid = otid(), lane = tid & 63, wv = tid >> 6, fr = lane & 15, fq = lane >> 4;
  u16* Ks = (u16*)dsm;
  u16* Vt = Ks + 192 * 72;
  for (int item = bid; item < 2080; item += nb) {
    const int kvh = item & 1, r = item >> 1;
    const bool samp = r >= 1024;
    const int b = samp ? r - 1024 : r >> 6, c = samp ? 0 : (r & 63);
    const int gq0 = samp ? TP + b * 64 : b * 4096 + c * 64;
    __syncthreads();
#pragma unroll
    for (int q = 0; q < 3; q++) {
      const int idx = tid + q * NTH, j = idx >> 3, d0 = (idx & 7) * 8;
      u32x4 kq = {0u, 0u, 0u, 0u}, vq = {0u, 0u, 0u, 0u};
      if (!samp) {
        const int tok = (c - 2) * 64 + j;
        if (tok >= 0) {
          const u16* src = p.P + (size_t)(b * 4096 + tok) * INC + 2304 + kvh * 64 + d0;
          kq = *(const u32x4*)src;
          vq = *(const u32x4*)(src + 128);
        }
      } else if (j < 128) {
        const float4* ck = (const float4*)(p.cache_k + ((size_t)(b * 128 + j) * 2 + kvh) * 64 + d0);
        const float4* cv = (const float4*)(p.cache_v + ((size_t)(b * 128 + j) * 2 + kvh) * 64 + d0);
        const float4 k0 = ck[0], k1 = ck[1], v0 = cv[0], v1 = cv[1];
        kq = u32x4{pack2(k0.x, k0.y), pack2(k0.z, k0.w), pack2(k1.x, k1.y), pack2(k1.z, k1.w)};
        vq = u32x4{pack2(v0.x, v0.y), pack2(v0.z, v0.w), pack2(v1.x, v1.y), pack2(v1.z, v1.w)};
      } else {
        const u16* src = p.P + (size_t)(TP + b * 64 + (j - 128)) * INC + 2304 + kvh * 64 + d0;
        kq = *(const u32x4*)src;
        vq = *(const u32x4*)(src + 128);
      }
      *(u32x4*)(Ks + j * 72 + d0) = kq;
#pragma unroll
      for (int e = 0; e < 4; e++) {
        Vt[(d0 + 2 * e) * 196 + j] = (u16)(vq[e] & 0xffffu);
        Vt[(d0 + 2 * e + 1) * 196 + j] = (u16)(vq[e] >> 16);
      }
    }
    __syncthreads();
    const int qh = kvh * 4 + (wv & 3);
    const float slope = exp2f(-(float)(qh + 1)), sink = p.sinks[qh];
#pragma unroll 1
    for (int ps = 0; ps < 2; ps++) {
      const int q0 = (wv >> 2) * 32 + ps * 16;
      const int tq = q0 + fr;
      const u16* qp = p.P + (size_t)(gq0 + tq) * INC + 1792 + qh * 64 + fq * 8;
      const bf16x8 qf0 = *(const bf16x8*)(qp), qf1 = *(const bf16x8*)(qp + 32);
      f32x4 sc[12];
#pragma unroll
      for (int kt = 0; kt < 12; kt++) {
        sc[kt] = f32x4{0.f, 0.f, 0.f, 0.f};
        const bf16x8 a0 = *(const bf16x8*)(Ks + (kt * 16 + fr) * 72 + fq * 8);
        const bf16x8 a1 = *(const bf16x8*)(Ks + (kt * 16 + fr) * 72 + 32 + fq * 8);
        sc[kt] = MFMA16(a0, qf0, sc[kt]);
        sc[kt] = MFMA16(a1, qf1, sc[kt]);
        if ((kt & 3) == 3) SCHED;
      }
      float mx = -3e38f;
#pragma unroll
      for (int kt = 0; kt < 12; kt++)
#pragma unroll
        for (int j = 0; j < 4; j++) {
          const int key = kt * 16 + fq * 4 + j;
          float s = sc[kt][j] * 0.125f - slope * fabsf((float)(128 + tq - key));
          if (!samp && (c - 2) * 64 + key < 0) s = -1e30f;
          sc[kt][j] = s;
          mx = fmaxf(mx, s);
        }
      mx = fmaxf(mx, __shfl_xor(mx, 16));
      mx = fmaxf(mx, __shfl_xor(mx, 32));
      mx = fmaxf(mx, sink);
      float sum = 0.f;
#pragma unroll
      for (int kt = 0; kt < 12; kt++)
#pragma unroll
        for (int j = 0; j < 4; j++) {
          const float e = __expf(sc[kt][j] - mx);
          sc[kt][j] = e;
          sum += e;
        }
      sum += __shfl_xor(sum, 16);
      sum += __shfl_xor(sum, 32);
      sum += __expf(sink - mx);
      const float inv = 1.f / sum;
      f32x4 o[4];
#pragma unroll
      for (int dt = 0; dt < 4; dt++) o[dt] = f32x4{0.f, 0.f, 0.f, 0.f};
#pragma unroll
      for (int t2 = 0; t2 < 6; t2++) {
        const u32x4 pw = {pack2(sc[2 * t2][0] * inv, sc[2 * t2][1] * inv), pack2(sc[2 * t2][2] * inv, sc[2 * t2][3] * inv),
                          pack2(sc[2 * t2 + 1][0] * inv, sc[2 * t2 + 1][1] * inv),
                          pack2(sc[2 * t2 + 1][2] * inv, sc[2 * t2 + 1][3] * inv)};
        const bf16x8 pa = __builtin_bit_cast(bf16x8, pw);
#pragma unroll
        for (int dt = 0; dt < 4; dt++) {
          const u16* vp = Vt + (dt * 16 + fr) * 196 + t2 * 32 + fq * 4;
          const uint2 v0 = *(const uint2*)vp, v1 = *(const uint2*)(vp + 16);
          const bf16x8 vb = __builtin_bit_cast(bf16x8, u32x4{v0.x, v0.y, v1.x, v1.y});
          o[dt] = MFMA16(pa, vb, o[dt]);
        }
        SCHED;
      }
#pragma unroll
      for (int dt = 0; dt < 4; dt++)
#pragma unroll
        for (int j = 0; j < 4; j++)
          p.OATT[(size_t)(gq0 + q0 + fq * 4 + j) * 512 + qh * 64 + dt * 16 + fr] = f2bf(o[dt][j]);
    }
  }
  const u16* SA = (const u16*)(p.out);
  const u16* SB = p.H;
  for (int it4 = bid * NW + wv; it4 < T * 2; it4 += nb * NW) {
    const int it = it4 * 4 + (lane >> 4), c0 = (lane & 15) * 4;
    const int g = it >> 3, h = it & 7, col = h * 64 + c0;
    const uint2 yw = *(const uint2*)(p.Y + (size_t)g * 512 + col);
    const uint2 rw = *(const uint2*)(SA + (size_t)it * 256 + c0), kw = *(const uint2*)(SA + (size_t)it * 256 + 128 + c0);
    const uint2 vw = *(const uint2*)(SB + (size_t)it * 128 + c0), gw = *(const uint2*)(p.G + (size_t)g * 512 + col);
    const float4 lw = *(const float4*)(p.lnx_w + col), lb = *(const float4*)(p.lnx_b + col), rk = *(const float4*)(p.r_k + col);
    const float y0 = bflo(yw.x), y1 = bfhi(yw.x), y2 = bflo(yw.y), y3 = bfhi(yw.y);
    const float mean = red16((y0 + y1) + (y2 + y3)) * (1.f / 64.f);
    const float e0 = y0 - mean, e1 = y1 - mean, e2 = y2 - mean, e3 = y3 - mean;
    const float var = red16((e0 * e0 + e1 * e1) + (e2 * e2 + e3 * e3)) * (1.f / 64.f);
    const float bonus = red16((bflo(rw.x) * bflo(kw.x) * rk.x + bfhi(rw.x) * bfhi(kw.x) * rk.y) +
                              (bflo(rw.y) * bflo(kw.y) * rk.z + bfhi(rw.y) * bfhi(kw.y) * rk.w));
    const float rsd = rsqrtf(var + 64e-5f);
    const float o0 = (e0 * rsd * lw.x + lb.x + bonus * bflo(vw.x)) * bflo(gw.x);
    const float o1 = (e1 * rsd * lw.y + lb.y + bonus * bfhi(vw.x)) * bfhi(gw.x);
    const float o2 = (e2 * rsd * lw.z + lb.z + bonus * bflo(vw.y)) * bflo(gw.y);
    const float o3 = (e3 * rsd * lw.w + lb.w + bonus * bfhi(vw.y)) * bfhi(gw.y);
    if (!dry || o0 == 123.456f) *(uint2*)(p.Y + (size_t)g * 512 + col) = make_uint2(pack2(o0, o1), pack2(o2, o3));
  }
}

__device__ void ph_gemm2(const Params& p, int bid, int nb) {
  const int tid_ = otid();
  u16* MG = p.H;
  const u16* Cs = (const u16*)dsm;
  const int nM = 260, nN = 4;
  for (int round = 0; round * nb < nM * nN; ++round) {
    int pm, pn;
    if (!tile_of(round, bid, nb, nM, nN, pm, pn)) break;
    f32x4 acc[2][2][4][2];
#pragma unroll 1
    for (int br = 0; br < 2; br++) {
      gemm256<512>(br ? p.OATT : p.Y, p.WbT + (size_t)br * 1024 * 512, pm * 256, pn * 256, acc);
      acc_to_lds(acc);
#pragma unroll 2
      for (int it = 0; it < 16; it++) {
        const int id = it * NTH + tid_, rl = id >> 5, c8 = (id & 31) * 8;
        const int row = pm * 256 + rl, col = pn * 256 + c8;
        const u32x4 v = *(const u32x4*)(Cs + rl * CS_LD + c8);
        const u32x4 gw = *(const u32x4*)(p.P + (size_t)row * INC + 2560 + br * 1024 + col);
        u32x4 prev = {0u, 0u, 0u, 0u};
        if (br) prev = *(const u32x4*)(MG + (size_t)row * 1024 + col);
        u32x4 o;
#pragma unroll
        for (int e = 0; e < 4; e++) {
          const float r0 = bflo(prev[e]) + sigmoidf_(bflo(gw[e])) * bflo(v[e]);
          const float r1 = bfhi(prev[e]) + sigmoidf_(bfhi(gw[e])) * bfhi(v[e]);
          o[e] = pack2(r0, r1);
        }
        *(u32x4*)(MG + (size_t)row * 1024 + col) = o;
      }
    }
  }
}

__device__ void ph_gemm3(const Params& p, int bid, int nb) {
  const int tid_ = otid();
  const u16* MG = p.H;
  const u16* Cs = (const u16*)dsm;
  const int nM = 260, nN = 4;
  for (int round = 0; round * nb < nM * nN; ++round) {
    int pm, pn;
    if (!tile_of(round, bid, nb, nM, nN, pm, pn)) break;
    f32x4 acc[2][2][4][2];
    gemm256<1024>(MG, p.WoutT, pm * 256, pn * 256, acc);
    acc_to_lds(acc);
#pragma unroll 2
    for (int it = 0; it < 16; it++) {
      const int id = it * NTH + tid_, rl = id >> 5, c8 = (id & 31) * 8;
      const int row = pm * 256 + rl, col = pn * 256 + c8;
      const u32x4 v = *(const u32x4*)(Cs + rl * CS_LD + c8);
      const float* xr = xrow(p, row) + col;
      const float4 x0 = *(const float4*)xr, x1 = *(const float4*)(xr + 4);
      *(u32x4*)(p.P + (size_t)row * 1024 + col) =
          u32x4{pack2(x0.x + bflo(v[0]), x0.y + bfhi(v[0])), pack2(x0.z + bflo(v[1]), x0.w + bfhi(v[1])),
                pack2(x1.x + bflo(v[2]), x1.y + bfhi(v[2])), pack2(x1.z + bflo(v[3]), x1.w + bfhi(v[3]))};
    }
  }
}

__device__ void ph_norm2(const Params& p, int bid, int nb) {
  const int tid = otid(), lane = tid & 63, wv = tid >> 6;
  for (int row = bid * NW + wv; row < T; row += nb * NW) {
    const uint2* x = (const uint2*)(p.P + (size_t)row * 1024);
    float4 v[4];
    float ss = 0.f;
#pragma unroll
    for (int i = 0; i < 4; i++) {
      const uint2 xw = x[lane + i * 64];
      v[i] = make_float4(bflo(xw.x), bfhi(xw.x), bflo(xw.y), bfhi(xw.y));
      ss += v[i].x * v[i].x + v[i].y * v[i].y + v[i].z * v[i].z + v[i].w * v[i].w;
    }
    ss = wave_sum(ss);
    const float rs = rsqrtf(ss * (1.f / 1024.f) + 1e-6f);
    u16* hr = p.H + (size_t)row * 1024;
    float4 y[4];
    float am = 0.f;
#pragma unroll
    for (int i = 0; i < 4; i++) {
      const float4 g = ((const float4*)p.norm2_g)[lane + i * 64];
      y[i] = make_float4(v[i].x * rs * g.x, v[i].y * rs * g.y, v[i].z * rs * g.z, v[i].w * rs * g.w);
      ((uint2*)hr)[lane + i * 64] = make_uint2(pack2(y[i].x, y[i].y), pack2(y[i].z, y[i].w));
      am = fmaxf(am, fmaxf(fmaxf(fabsf(y[i].x), fabsf(y[i].y)), fmaxf(fabsf(y[i].z), fabsf(y[i].w))));
    }
    am = fmaxf(wave_max(am), 1e-30f);
    const float sc = 240.f / am;
    if (lane == 0) p.SH[row] = am * (1.f / 240.f);
    u32* h8 = (u32*)((unsigned char*)p.Y + (size_t)row * 1024);
#pragma unroll
    for (int i = 0; i < 4; i++) h8[lane + i * 64] = q4(y[i].x, y[i].y, y[i].z, y[i].w, sc);
  }
}

DI void ins16(float (&l)[16], float x) {
#pragma unroll
  for (int i = 0; i < 16; i++) {
    const float hi = fmaxf(l[i], x);
    x = fminf(l[i], x);
    l[i] = hi;
  }
}


DI void ce_desc(float& a, float& b) { const float hi = fmaxf(a, b), lo = fminf(a, b); a = hi; b = lo; }
DI void bitonic_sort16_desc(float (&a)[16]) {
#pragma unroll
  for (int k = 2; k <= 16; k <<= 1)
#pragma unroll
    for (int j = k >> 1; j > 0; j >>= 1)
#pragma unroll
      for (int i = 0; i < 16; i++) {
        const int l = i ^ j;
        if (l > i) {
          if ((i & k) == 0) ce_desc(a[i], a[l]);
          else ce_desc(a[l], a[i]);
        }
      }
}
DI void bitonic_merge16_desc(float (&a)[16]) {
#pragma unroll
  for (int j = 8; j > 0; j >>= 1)
#pragma unroll
    for (int i = 0; i < 16; i++) {
      const int l = i ^ j;
      if (l > i) ce_desc(a[i], a[l]);
    }
}
DI void top16_merge(float (&a)[16], const float (&b)[16]) {
#pragma unroll
  for (int i = 0; i < 16; i++) a[i] = fmaxf(a[i], b[15 - i]);
  bitonic_merge16_desc(a);
}

__device__ void ph_peerq(const Params& p, int bid, int nb) {
  GT_VARS
  const int l31 = lane & 31, kh = lane >> 5;
  u16* Qs = (u16*)dsm;
  unsigned char* lt = (unsigned char*)(dsm + 135168 + wid * 1024);
  int* IDX = (int*)p.G;
  float* GATE = (float*)p.OATT;
  const int nM = 260, nN = 4;
  for (int round = 0; round * nb < nM * nN; ++round) {
    int pm, pn;
    if (!tile_of(round, bid, nb, nM, nN, pm, pn)) break;
    {
      f32x4 acc[2][2][4][2];
      gemm256<1024>(p.H, p.WqT, pm * 256, pn * 256, acc);
      acc_to_lds(acc);
    }
#pragma unroll 1
    for (int hh = 0; hh < 2; hh++) {
      const int hp = pn * 2 + hh;
      float l1[16], l2[16];
#pragma unroll
      for (int i = 0; i < 16; i++) { l1[i] = 0.f; l2[i] = 0.f; }
#pragma unroll 1
      for (int pp = 0; pp < 2; pp++) {
        f32x16 sc[4];
#pragma unroll
        for (int m4 = 0; m4 < 4; m4++) {
#pragma unroll
          for (int i = 0; i < 16; i++) sc[m4][i] = 0.f;
#pragma unroll
          for (int kk = 0; kk < 4; kk++) {
            const bf16x8 a = *(const bf16x8*)(p.SK + (size_t)(pp * 128 + m4 * 32 + l31) * 64 + kk * 16 + kh * 8);
            const bf16x8 bq = *(const bf16x8*)(Qs + (wid * 32 + l31) * 264 + hh * 128 + pp * 64 + kk * 16 + kh * 8);
            sc[m4] = MFMA32(a, bq, sc[m4]);
          }
        }
        float l[16], q1[16], q2[16], q3[16];
#pragma unroll
        for (int i = 0; i < 16; i++) {
          const u32 nb_ = (i >> 2) * 8 + kh * 4 + (i & 3);
          l[i] = __uint_as_float((__float_as_uint(sc[0][i]) & ~0x7Fu) | nb_);
          q1[i] = __uint_as_float((__float_as_uint(sc[1][i]) & ~0x7Fu) | (32u + nb_));
          q2[i] = __uint_as_float((__float_as_uint(sc[2][i]) & ~0x7Fu) | (64u + nb_));
          q3[i] = __uint_as_float((__float_as_uint(sc[3][i]) & ~0x7Fu) | (96u + nb_));
        }
        bitonic_sort16_desc(l);
        bitonic_sort16_desc(q1);
        bitonic_sort16_desc(q2);
        bitonic_sort16_desc(q3);
        top16_merge(l, q1);
        top16_merge(q2, q3);
        top16_merge(l, q2);
        float o[16];
#pragma unroll
        for (int i = 0; i < 16; i++) o[i] = __shfl_xor(l[i], 32);
        top16_merge(l, o);
#pragma unroll
        for (int i = 0; i < 16; i++) {
          l1[i] = pp == 0 ? l[i] : l1[i];
          l2[i] = pp == 0 ? l2[i] : l[i];
        }
      }
      if (kh == 0) {
        u32 w[8];
#pragma unroll
        for (int q = 0; q < 4; q++) {
          w[q] = (__float_as_uint(l1[4 * q]) & 0x7F) | ((__float_as_uint(l1[4 * q + 1]) & 0x7F) << 8) |
                 ((__float_as_uint(l1[4 * q + 2]) & 0x7F) << 16) | ((__float_as_uint(l1[4 * q + 3]) & 0x7F) << 24);
          w[4 + q] = (__float_as_uint(l2[4 * q]) & 0x7F) | ((__float_as_uint(l2[4 * q + 1]) & 0x7F) << 8) |
                     ((__float_as_uint(l2[4 * q + 2]) & 0x7F) << 16) | ((__float_as_uint(l2[4 * q + 3]) & 0x7F) << 24);
        }
        *(uint4*)(lt + l31 * 32) = make_uint4(w[0], w[1], w[2], w[3]);
        *(uint4*)(lt + l31 * 32 + 16) = make_uint4(w[4], w[5], w[6], w[7]);
      }
      float v1[16], v2[16];
#pragma unroll
      for (int i = 0; i < 16; i++) {
        v1[i] = __uint_as_float(__float_as_uint(l1[i]) & ~0x7Fu);
        v2[i] = __uint_as_float(__float_as_uint(l2[i]) & ~0x7Fu);
      }
#define CAND(a, b) __uint_as_float((__float_as_uint(v1[a] + v2[b]) & ~0xFFu) | (u32)((a) * 16 + (b)))
      float l3[16], y1[16], y2[16];
#pragma unroll
      for (int b = 0; b < 16; b++) l3[b] = CAND(0, b);
#pragma unroll
      for (int b = 0; b < 8; b++) y1[b] = CAND(1, b);
#pragma unroll
      for (int b = 0; b < 5; b++) y1[8 + b] = CAND(2, b);
#pragma unroll
      for (int b = 0; b < 3; b++) y1[13 + b] = CAND(4, b);
#pragma unroll
      for (int b = 0; b < 4; b++) y2[b] = CAND(3, b);
      y2[4] = CAND(5, 0); y2[5] = CAND(5, 1); y2[6] = CAND(6, 0); y2[7] = CAND(6, 1); y2[8] = CAND(7, 0); y2[9] = CAND(7, 1);
      y2[10] = CAND(8, 0); y2[11] = CAND(9, 0); y2[12] = CAND(10, 0); y2[13] = CAND(11, 0); y2[14] = CAND(12, 0); y2[15] = CAND(13, 0);
      bitonic_sort16_desc(y1);
      bitonic_sort16_desc(y2);
      top16_merge(l3, y1);
      top16_merge(l3, y2);
      ins16(l3, CAND(14, 0));
      ins16(l3, CAND(15, 0));
#undef CAND
      __builtin_amdgcn_fence(__ATOMIC_RELEASE, "workgroup");
      __builtin_amdgcn_wave_barrier();
      if (kh == 0) {
        const int g = pm * 256 + wid * 32 + l31;
        float ev[16];
        int ei[16];
        float sum = 0.f;
        const float mxv = __uint_as_float(__float_as_uint(l3[0]) & ~0xFFu);
#pragma unroll
        for (int k = 0; k < 16; k++) {
          const u32 bits = __float_as_uint(l3[k]);
          const u32 pos = bits & 0xFF;
          ev[k] = __expf(__uint_as_float(bits & ~0xFFu) - mxv);
          sum += ev[k];
          ei[k] = (int)lt[l31 * 32 + (pos >> 4)] * 128 + (int)lt[l31 * 32 + 16 + (pos & 15)];
        }
        const float inv = 1.f / sum;
        int4* ip = (int4*)(IDX + (size_t)g * 128 + hp * 16);
        float4* gp = (float4*)(GATE + (size_t)g * 128 + hp * 16);
#pragma unroll
        for (int q = 0; q < 4; q++) {
          ip[q] = make_int4(ei[4 * q], ei[4 * q + 1], ei[4 * q + 2], ei[4 * q + 3]);
          gp[q] = make_float4(ev[4 * q] * inv, ev[4 * q + 1] * inv, ev[4 * q + 2] * inv, ev[4 * q + 3] * inv);
        }
      }
      __builtin_amdgcn_wave_barrier();
    }
  }
}

__device__ void ph_peer(const Params& p, int bid, int nb, bool dry = false) {
  const int tid = otid(), lane = tid & 63, wv = tid >> 6;
  constexpr int ST = 1104;
  char* wb = dsm + wv * (16 * ST + 2048);
  unsigned char* stg = (unsigned char*)wb;
  unsigned char* hs = stg + 16 * ST;
  float* acts = (float*)(hs + 1024);
  int* idxs = (int*)(hs + 1536);
  const int gr = lane >> 3, gc = lane & 7;
  const int* IDX = (const int*)p.G;
  const float* GATE = (const float*)p.OATT;
  const unsigned char* H8 = (const unsigned char*)p.Y;
  const int n = lane & 15, quad = lane >> 4;
  for (int g = bid * NW + wv; g < T; g += nb * NW) {
    *(u32x4*)(hs + lane * 16) = *(const u32x4*)(H8 + (size_t)g * 1024 + lane * 16);
    idxs[lane] = IDX[(size_t)g * 128 + lane];
    idxs[lane + 64] = IDX[(size_t)g * 128 + 64 + lane];
    const float shv = p.SH[g];
    __builtin_amdgcn_fence(__ATOMIC_RELEASE, "workgroup");
    __builtin_amdgcn_wave_barrier();
    {
      u32x4 ring[16];
      {
        const unsigned char* ua = p.U8 + (size_t)idxs[gr] * 1024 + gc * 16;
        const unsigned char* ub = p.U8 + (size_t)idxs[8 + gr] * 1024 + gc * 16;
#pragma unroll
        for (int i = 0; i < 8; i++) { ring[i] = *(const u32x4*)(ua + i * 128); ring[8 + i] = *(const u32x4*)(ub + i * 128); }
      }
#pragma unroll 1
      for (int grp = 0; grp < 8; grp++) {
        const int gn = grp < 7 ? grp + 1 : grp;
        const unsigned char* ua = p.U8 + (size_t)idxs[gn * 16 + gr] * 1024 + gc * 16;
        const unsigned char* ub = p.U8 + (size_t)idxs[gn * 16 + 8 + gr] * 1024 + gc * 16;
        const float4 gt = *(const float4*)(GATE + (size_t)g * 128 + grp * 16 + quad * 4);
        const int4 ee = *(const int4*)(idxs + grp * 16 + quad * 4);
        const float su0 = p.SU[ee.x], su1 = p.SU[ee.y], su2 = p.SU[ee.z], su3 = p.SU[ee.w];
        const float sv0 = p.SV[ee.x], sv1 = p.SV[ee.y], sv2 = p.SV[ee.z], sv3 = p.SV[ee.w];
#pragma unroll
        for (int i = 0; i < 8; i++) {
          *(u32x4*)(stg + gr * ST + i * 128 + gc * 16) = ring[i];
          *(u32x4*)(stg + (8 + gr) * ST + i * 128 + gc * 16) = ring[8 + i];
          if (grp < 7) { ring[i] = *(const u32x4*)(ua + i * 128); ring[8 + i] = *(const u32x4*)(ub + i * 128); }
        }
        __builtin_amdgcn_fence(__ATOMIC_RELEASE, "workgroup");
        __builtin_amdgcn_wave_barrier();
        f32x4 acc = {0.f, 0.f, 0.f, 0.f};
#pragma unroll
        for (int st = 0; st < 16; st++) {
          const u32x4 ua4 = *(const u32x4*)(stg + n * ST + st * 64 + quad * 16);
          const u32x4 hb = *(const u32x4*)(hs + st * 64 + quad * 16);
          const long a0 = (long)(((unsigned long)ua4[1] << 32) | ua4[0]);
          const long a1 = (long)(((unsigned long)ua4[3] << 32) | ua4[2]);
          const long b0 = (long)(((unsigned long)hb[1] << 32) | hb[0]);
          const long b1 = (long)(((unsigned long)hb[3] << 32) | hb[2]);
          acc = __builtin_amdgcn_mfma_f32_16x16x32_fp8_fp8(a0, b0, acc, 0, 0, 0);
          acc = __builtin_amdgcn_mfma_f32_16x16x32_fp8_fp8(a1, b1, acc, 0, 0, 0);
        }
        __builtin_amdgcn_wave_barrier();
        const float d0 = acc[0] * shv * su0, d1 = acc[1] * shv * su1, d2 = acc[2] * shv * su2, d3 = acc[3] * shv * su3;
        float4 av;
        av.x = 0.5f * d0 * (1.f + erff(d0 * 0.70710678118f)) * gt.x * sv0;
        av.y = 0.5f * d1 * (1.f + erff(d1 * 0.70710678118f)) * gt.y * sv1;
        av.z = 0.5f * d2 * (1.f + erff(d2 * 0.70710678118f)) * gt.z * sv2;
        av.w = 0.5f * d3 * (1.f + erff(d3 * 0.70710678118f)) * gt.w * sv3;
        if (n == 0) *(float4*)(acts + grp * 16 + quad * 4) = av;
      }
    }
    __builtin_amdgcn_fence(__ATOMIC_RELEASE, "workgroup");
    __builtin_amdgcn_wave_barrier();
    float o[16];
#pragma unroll
    for (int j = 0; j < 16; j++) o[j] = 0.f;
    {
      u32x4 ring[16];
#pragma unroll
      for (int k = 0; k < 16; k++) ring[k] = *(const u32x4*)(p.V8 + (size_t)idxs[k] * 1024 + lane * 16);
#pragma unroll 1
      for (int kb = 0; kb < 128; kb += 16) {
        const bool more = kb < 112;
        const int kn = more ? kb + 16 : kb;
#pragma unroll
        for (int j = 0; j < 16; j++) {
          const u32x4 vq = ring[j];
          if (more) ring[j] = *(const u32x4*)(p.V8 + (size_t)idxs[kn + j] * 1024 + lane * 16);
          const float a = acts[kb + j];
#pragma unroll
          for (int q = 0; q < 4; q++) {
            const f32x2 lo = __builtin_amdgcn_cvt_pk_f32_fp8((int)vq[q], false);
            const f32x2 hi = __builtin_amdgcn_cvt_pk_f32_fp8((int)vq[q], true);
            o[4 * q] += a * lo[0]; o[4 * q + 1] += a * lo[1]; o[4 * q + 2] += a * hi[0]; o[4 * q + 3] += a * hi[1];
          }
        }
      }
    }
    float* xr = p.out + (size_t)g * 1024 + lane * 16;
    float4 x[4];
    {
      const u32x4 xa = *(const u32x4*)(p.P + (size_t)g * 1024 + lane * 16), xb = *(const u32x4*)(p.P + (size_t)g * 1024 + lane * 16 + 8);
      x[0] = make_float4(bflo(xa[0]), bfhi(xa[0]), bflo(xa[1]), bfhi(xa[1]));
      x[1] = make_float4(bflo(xa[2]), bfhi(xa[2]), bflo(xa[3]), bfhi(xa[3]));
      x[2] = make_float4(bflo(xb[0]), bfhi(xb[0]), bflo(xb[1]), bfhi(xb[1]));
      x[3] = make_float4(bflo(xb[2]), bfhi(xb[2]), bflo(xb[3]), bfhi(xb[3]));
    }
    float ss = 0.f;
#pragma unroll
    for (int q = 0; q < 4; q++) {
      x[q].x += o[4 * q]; x[q].y += o[4 * q + 1]; x[q].z += o[4 * q + 2]; x[q].w += o[4 * q + 3];
      ss += x[q].x * x[q].x + x[q].y * x[q].y + x[q].z * x[q].z + x[q].w * x[q].w;
    }
    ss = wave_sum(ss);
    if (dry && ss != 123.456f) continue;
    const float rs = rsqrtf(ss * (1.f / 1024.f) + 1e-6f);
#pragma unroll
    for (int q = 0; q < 4; q++) {
      const float4 gq = *(const float4*)(p.final_g + lane * 16 + q * 4);
      *(float4*)(xr + q * 4) = make_float4(x[q].x * rs * gq.x, x[q].y * rs * gq.y, x[q].z * rs * gq.z, x[q].w * rs * gq.w);
    }
  }
}

#define XB_TMO      128
#define XB_XCNT(j)  (256  + 64 * (j))
#define XB_XSUB(j)  (1280 + 64 * (j))
#define XB_XGEN(j)  (2304 + 64 * (j))
#define XB_TOP      3328
#define XB_TOPGEN   3392
#define XCD_BAR_WORDS 3456
#define XB_SPIN_CAP (1u << 18)
#define LAS __attribute__((address_space(3)))
DI unsigned xb_ld(unsigned* p) { return __hip_atomic_load(p, __ATOMIC_RELAXED, __HIP_MEMORY_SCOPE_AGENT); }
DI unsigned xb_add(unsigned* p, unsigned v) { return __hip_atomic_fetch_add(p, v, __ATOMIC_RELAXED, __HIP_MEMORY_SCOPE_AGENT); }
DI unsigned xb_xcc_id() { return (unsigned)__builtin_amdgcn_s_getreg((3 << 11) | 20) & 0xFu; }
#define XB_SPIN(cond, bar) do { unsigned _sp = 0; while (cond) { __builtin_amdgcn_s_sleep(1); \
    if ((++_sp & 255u) == 0u) { if (xb_ld(&(bar)[XB_TMO])) break; if (_sp > XB_SPIN_CAP) { atomicAdd(&(bar)[XB_TMO], 1u); break; } } } } while (0)
struct XcdBarrier { unsigned* bar; unsigned x; volatile LAS unsigned* st; };
DI XcdBarrier xcd_barrier_post(unsigned* bar, volatile LAS unsigned* st) {
  XcdBarrier b; b.bar = bar; b.x = xb_xcc_id(); b.st = st;
  if (threadIdx.x == 0) (void)xb_add(&bar[XB_XCNT(b.x)], 1u);
  return b;
}
DI void xcd_barrier_complete(unsigned* bar, unsigned x, unsigned& nloc, unsigned& nx) {
  const unsigned G = gridDim.x * gridDim.y * gridDim.z;
  unsigned sum, cnt, mine, sp = 0u;
  for (;;) {
    sum = 0u; cnt = 0u; mine = 0u;
#pragma unroll
    for (unsigned j = 0; j < 16; ++j) { const unsigned c = xb_ld(&bar[XB_XCNT(j)]); sum += c; cnt += (c > 0u) ? 1u : 0u; mine = (j == x) ? c : mine; }
    if (sum == G) break;
    __builtin_amdgcn_s_sleep(1);
    if ((++sp & 255u) == 0u) { if (xb_ld(&bar[XB_TMO])) break; if (sp > XB_SPIN_CAP) { atomicAdd(&bar[XB_TMO], 1u); break; } }
  }
  nloc = mine > 0u ? mine : 1u; nx = cnt > 0u ? cnt : 1u;
}
DI void xcd_barrier(const XcdBarrier& b) {
  asm volatile("s_waitcnt vmcnt(0)" ::: "memory");
  __syncthreads();
  if (threadIdx.x == 0) {
    unsigned* bar = b.bar;
    __builtin_amdgcn_s_waitcnt(0);
    unsigned nloc = b.st[0], nx = b.st[1];
    if (nloc == 0u) { xcd_barrier_complete(bar, b.x, nloc, nx); b.st[0] = nloc; b.st[1] = nx; }
    const unsigned old = xb_add(&bar[XB_XSUB(b.x)], 1u);
    const unsigned gen = old / nloc;
    if (old + 1u == (gen + 1u) * nloc) {
      __builtin_amdgcn_fence(__ATOMIC_RELEASE, "agent");
      asm volatile("s_waitcnt vmcnt(0)" ::: "memory");
      const unsigned og = xb_add(&bar[XB_TOP], 1u);
      const unsigned tg = og / nx;
      if (og + 1u == (tg + 1u) * nx) xb_add(&bar[XB_TOPGEN], 1u);
      else XB_SPIN(xb_ld(&bar[XB_TOPGEN]) == tg, bar);
      __builtin_amdgcn_fence(__ATOMIC_ACQUIRE, "agent");
      xb_add(&bar[XB_XGEN(b.x)], 1u);
      asm volatile("s_waitcnt vmcnt(0)" ::: "memory");
    } else {
      XB_SPIN(xb_ld(&bar[XB_XGEN(b.x)]) == gen, bar);
      __builtin_amdgcn_fence(__ATOMIC_ACQUIRE, "agent");
      asm volatile("s_waitcnt vmcnt(0)" ::: "memory");
    }
  }
  __syncthreads();
}

__global__ void __launch_bounds__(512) mega_kernel(Params p) {
  cg::grid_group grid = cg::this_grid();
  const int bid = blockIdx.x, nb = gridDim.x;
  __shared__ uint4 xb_words;
  if (threadIdx.x == 0) xb_words = make_uint4(0u, 0u, 0u, 0u);
  __syncthreads();
  const XcdBarrier xb = xcd_barrier_post(p.bar, (volatile LAS unsigned*)&xb_words);
  if (ON(0)) ph_prep(p, bid, nb);
  xcd_barrier(xb);
  if (nb == 0x7fffffff) grid.sync();
  if (ON(1)) ph_gemm1(p, bid, nb);
  xcd_barrier(xb);
  if (REP == 1) { ph_gemm1(p, bid, nb); xcd_barrier(xb); }
  if (ON(2)) ph_rwprep(p, bid, nb);
  xcd_barrier(xb);
  if (REP == 2) { ph_rwprep(p, bid, nb); xcd_barrier(xb); }
  if (ON(3)) ph_scan(p, bid, nb);
  xcd_barrier(xb);
  if (REP == 3) { ph_scan(p, bid, nb); xcd_barrier(xb); }
  if (REP == 4) { ph_attn(p, bid, nb, true); xcd_barrier(xb); }
  if (ON(4)) ph_attn(p, bid, nb);
  xcd_barrier(xb);
  if (ON(5)) ph_gemm2(p, bid, nb);
  xcd_barrier(xb);
  if (REP == 5) { ph_gemm2(p, bid, nb); xcd_barrier(xb); }
  if (ON(6)) ph_gemm3(p, bid, nb);
  xcd_barrier(xb);
  if (REP == 6) { ph_gemm3(p, bid, nb); xcd_barrier(xb); }
  if (ON(7)) ph_norm2(p, bid, nb);
  xcd_barrier(xb);
  if (ON(8)) ph_peerq(p, bid, nb);
  xcd_barrier(xb);
  if (REP == 8) { ph_peerq(p, bid, nb); xcd_barrier(xb); }
  if (REP == 9) { ph_peer(p, bid, nb, true); xcd_barrier(xb); }
  if (ON(9)) ph_peer(p, bid, nb);
}

extern "C" void kernel_launch(void* const* d_in, const int* in_sizes, int n_in, void* d_out, int out_size, void* d_ws,
                              size_t ws_size, hipStream_t stream) {
  Params p{};
  const float** f = (const float**)&p;
  for (int i = 0; i < 28; i++) f[i] = (const float*)d_in[i];
  p.out = (float*)d_out;
  char* w = (char*)d_ws;
  size_t off = 0;
  auto take = [&](size_t bytes) { char* r = w + off; off += (bytes + 255) & ~(size_t)255; return (u16*)r; };
  p.H = take((size_t)MP * 1024 * 2);
  p.P = take((size_t)MP * INC * 2);
  p.U8 = (unsigned char*)take((size_t)16384 * 1024);
  p.V8 = (unsigned char*)take((size_t)16384 * 1024);
  p.SU = (float*)take(16384 * 4);
  p.SV = (float*)take(16384 * 4);
  p.SH = (float*)take((size_t)T * 4);
  p.bar = (unsigned*)take((size_t)XCD_BAR_WORDS * 4);
  p.WinT = take((size_t)4608 * 1024 * 2);
  p.WbT = take((size_t)2 * 1024 * 512 * 2);
  p.WoutT = take((size_t)1024 * 1024 * 2);
  p.WqT = take((size_t)1024 * 1024 * 2);
  p.W2T = take((size_t)512 * 64 * 2);
  p.A2T = take((size_t)512 * 64 * 2);
  p.G2T = take((size_t)512 * 128 * 2);
  p.SK = take((size_t)2 * 128 * 64 * 2);
  p.Y = take((size_t)T * 512 * 2);
  p.G = take((size_t)T * 512 * 2);
  p.OATT = take((size_t)T * 512 * 2);
  static int grid_blocks = 0;
  if (!grid_blocks) {
    int dev = 0, cus = 0, per_cu = 0;
    (void)hipGetDevice(&dev);
    (void)hipDeviceGetAttribute(&cus, hipDeviceAttributeMultiprocessorCount, dev);
    (void)hipFuncSetAttribute((const void*)mega_kernel, hipFuncAttributeMaxDynamicSharedMemorySize, DYN_LDS);
    (void)hipOccupancyMaxActiveBlocksPerMultiprocessor(&per_cu, mega_kernel, NTH, DYN_LDS);
    if (per_cu > 1) per_cu = 1;
    grid_blocks = cus * per_cu;
  }
  (void)hipMemsetAsync(p.bar, 0, (size_t)XCD_BAR_WORDS * 4, stream);
  void* args[] = {&p};
  hipError_t e = hipLaunchCooperativeKernel((void*)mega_kernel, dim3(grid_blocks), dim3(NTH), args, DYN_LDS, stream);
  if (e != hipSuccess) fprintf(stderr, "cooperative launch failed: %s (grid %d)\n", hipGetErrorString(e), grid_blocks);
}
```

```cpp
#include <hip/hip_runtime.h>
#include <hip/hip_cooperative_groups.h>
#include <cstdio>
namespace cg = cooperative_groups;

#ifndef REP
#define REP -1
#endif
#ifndef ONLY
#define ONLY -1
#endif
#define ON(k) (ONLY < 0 || ONLY == (k))

typedef unsigned short u16;
typedef unsigned int u32;
using bf16x8 = __attribute__((ext_vector_type(8))) short;
using f32x4 = __attribute__((ext_vector_type(4))) float;
using f32x16 = __attribute__((ext_vector_type(16))) float;
using u32x4 = __attribute__((ext_vector_type(4))) u32;
#define DI __device__ __forceinline__

constexpr int TP = 65536, TS = 1024, T = 66560, MP = 66816;
constexpr int INC = 4608;
constexpr int NW = 8;
constexpr int NTH = 512;
constexpr size_t OFF_Y = 0, OFF_SHIFT_P = 68157440, OFF_WKV_P = 68173824, OFF_KP = 68698112, OFF_VP = 68960256,
                 OFF_SHIFT_S = 69222400, OFF_WKV_S = 69238784, OFF_KS = 69763072, OFF_VS = 69894144;
constexpr int DYN_LDS = 159744;

extern __shared__ __attribute__((aligned(16))) char dsm[];

struct Params {
  const float *x_prompt, *x_sample, *state_shift, *state_wkv, *cache_k, *cache_v, *norm1_g, *w_in, *mu, *w0, *w2, *a0,
      *a2, *g2, *k_k, *k_a, *r_k, *lnx_w, *lnx_b, *sinks, *w_branch, *w_out, *norm2_g, *peer_wq, *sub_keys, *peer_u,
      *peer_v, *final_g;
  float* out;
  u16 *H, *P, *WinT, *WbT, *WoutT, *WqT, *W2T, *A2T, *G2T, *SK, *Y, *G, *OATT;
  unsigned char *U8, *V8;
  float *SU, *SV, *SH;
  unsigned* bar;
};

typedef __bf16 hbf2 __attribute__((ext_vector_type(2)));
typedef float hf2 __attribute__((ext_vector_type(2)));
DI u16 f2bf(float x) { const __bf16 r = (__bf16)x; return __builtin_bit_cast(unsigned short, r); }
DI float bf2f(u16 b) { return __uint_as_float(((u32)b) << 16); }
DI u32 pack2(float a, float b) { const hf2 v = {a, b}; const hbf2 r = __builtin_convertvector(v, hbf2); return __builtin_bit_cast(u32, r); }
DI float bflo(u32 w) { return __uint_as_float(w << 16); }
DI float bfhi(u32 w) { return __uint_as_float(w & 0xffff0000u); }
DI float wave_sum(float v) {
#pragma unroll
  for (int o = 32; o; o >>= 1) v += __shfl_xor(v, o);
  return v;
}
DI float sigmoidf_(float x) { return 1.f / (1.f + __expf(-x)); }
DI const float* xrow(const Params& p, int g) {
  return g < TP ? p.x_prompt + (size_t)g * 1024 : p.x_sample + (size_t)(g - TP) * 1024;
}
DI int otid() { int t = threadIdx.x; asm volatile("" : "+v"(t)); return t; }
#define MFMA32(a, b, c) __builtin_amdgcn_mfma_f32_32x32x16_bf16((a), (b), (c), 0, 0, 0)
#define MFMA16(a, b, c) __builtin_amdgcn_mfma_f32_16x16x32_bf16((a), (b), (c), 0, 0, 0)

template <int CTRL>
DI float dppmov(float v) {
  return __int_as_float(__builtin_amdgcn_update_dpp(0, __float_as_int(v), CTRL, 0xF, 0xF, false));
}
DI float red16(float v) {
  v += dppmov<0x128>(v);
  v += dppmov<0x124>(v);
  v += dppmov<0x122>(v);
  v += dppmov<0x121>(v);
  return v;
}


using f32x2 = __attribute__((ext_vector_type(2))) float;
DI float wave_max(float v) {
#pragma unroll
  for (int o = 32; o; o >>= 1) v = fmaxf(v, __shfl_xor(v, o));
  return v;
}
DI u32 q4(float a, float b, float c, float d, float sc) {
  int w = 0;
  w = __builtin_amdgcn_cvt_pk_fp8_f32(a * sc, b * sc, w, false);
  w = __builtin_amdgcn_cvt_pk_fp8_f32(c * sc, d * sc, w, true);
  return (u32)w;
}

DI void tcvt(const float* __restrict__ W, u16* __restrict__ Wt, int K, int N, int gt, int nt) {
  const int total = N * (K / 8);
  for (int i = gt; i < total; i += nt) {
    const int n = i % N, kg = i / N;
    u32 o[4];
#pragma unroll
    for (int j = 0; j < 4; j++)
      o[j] = pack2(W[(size_t)(kg * 8 + 2 * j) * N + n], W[(size_t)(kg * 8 + 2 * j + 1) * N + n]);
    *(uint4*)(Wt + (size_t)n * K + kg * 8) = make_uint4(o[0], o[1], o[2], o[3]);
  }
}
DI void scvt(const float* __restrict__ W, u16* __restrict__ O, int n8, int gt, int nt) {
  for (int i = gt; i < n8; i += nt) {
    const float4 a = ((const float4*)W)[2 * i], b = ((const float4*)W)[2 * i + 1];
    ((uint4*)O)[i] = make_uint4(pack2(a.x, a.y), pack2(a.z, a.w), pack2(b.x, b.y), pack2(b.z, b.w));
  }
}

__device__ void ph_prep(const Params& p, int bid, int nb) {
  const int tid = otid(), lane = tid & 63, wv = tid >> 6;
  for (int row = bid * NW + wv; row < MP; row += nb * NW) {
    u16* hr = p.H + (size_t)row * 1024;
    if (row < T) {
      const float4* x = (const float4*)xrow(p, row);
      float4 v[4];
      float ss = 0.f;
#pragma unroll
      for (int i = 0; i < 4; i++) {
        v[i] = x[lane + i * 64];
        ss += v[i].x * v[i].x + v[i].y * v[i].y + v[i].z * v[i].z + v[i].w * v[i].w;
      }
      ss = wave_sum(ss);
      const float rs = rsqrtf(ss * (1.f / 1024.f) + 1e-6f);
      float* so = nullptr;
      if (row < TP) {
        if ((row & 4095) == 4095) so = p.out + OFF_SHIFT_P + (size_t)(row >> 12) * 1024;
      } else {
        const int r2 = row - TP;
        if ((r2 & 63) == 63) so = p.out + OFF_SHIFT_S + (size_t)(r2 >> 6) * 1024;
      }
#pragma unroll
      for (int i = 0; i < 4; i++) {
        const float4 g = ((const float4*)p.norm1_g)[lane + i * 64];
        float4 y;
        y.x = v[i].x * rs * g.x; y.y = v[i].y * rs * g.y; y.z = v[i].z * rs * g.z; y.w = v[i].w * rs * g.w;
        ((uint2*)hr)[lane + i * 64] = make_uint2(pack2(y.x, y.y), pack2(y.z, y.w));
        if (so) ((float4*)so)[lane + i * 64] = y;
      }
    } else if (row < T + 16) {
      const float4* x = (const float4*)(p.state_shift + (size_t)(row - T) * 1024);
#pragma unroll
      for (int i = 0; i < 4; i++) {
        const float4 y = x[lane + i * 64];
        ((uint2*)hr)[lane + i * 64] = make_uint2(pack2(y.x, y.y), pack2(y.z, y.w));
      }
    } else {
#pragma unroll
      for (int i = 0; i < 4; i++) ((uint2*)hr)[lane + i * 64] = make_uint2(0u, 0u);
    }
  }
  const int gt = bid * NTH + tid, nt = nb * NTH;
  tcvt(p.w_in, p.WinT, 1024, 4608, gt, nt);
  tcvt(p.w_branch, p.WbT, 512, 1024, gt, nt);
  tcvt(p.w_branch + 512 * 1024, p.WbT + 1024 * 512, 512, 1024, gt, nt);
  tcvt(p.w_out, p.WoutT, 1024, 1024, gt, nt);
  tcvt(p.peer_wq, p.WqT, 1024, 1024, gt, nt);
  tcvt(p.w2, p.W2T, 64, 512, gt, nt);
  tcvt(p.a2, p.A2T, 64, 512, gt, nt);
  tcvt(p.g2, p.G2T, 128, 512, gt, nt);
  scvt(p.sub_keys, p.SK, 2 * 128 * 64 / 8, gt, nt);
  for (int r = bid * NW + wv; r < 32768; r += nb * NW) {
    const bool isv = r >= 16384;
    const int e = r & 16383;
    const float4* src = (const float4*)((isv ? p.peer_v : p.peer_u) + (size_t)e * 1024) + lane * 4;
    const float4 a = src[0], b = src[1], c = src[2], d = src[3];
    float am = fmaxf(fmaxf(fmaxf(fabsf(a.x), fabsf(a.y)), fmaxf(fabsf(a.z), fabsf(a.w))),
                     fmaxf(fmaxf(fabsf(b.x), fabsf(b.y)), fmaxf(fabsf(b.z), fabsf(b.w))));
    am = fmaxf(am, fmaxf(fmaxf(fmaxf(fabsf(c.x), fabsf(c.y)), fmaxf(fabsf(c.z), fabsf(c.w))),
                         fmaxf(fmaxf(fabsf(d.x), fabsf(d.y)), fmaxf(fabsf(d.z), fabsf(d.w)))));
    am = fmaxf(wave_max(am), 1e-30f);
    const float sc = 240.f / am;
    if (lane == 0) (isv ? p.SV : p.SU)[e] = am * (1.f / 240.f);
    *(u32x4*)((isv ? p.V8 : p.U8) + (size_t)e * 1024 + lane * 16) =
        u32x4{q4(a.x, a.y, a.z, a.w, sc), q4(b.x, b.y, b.z, b.w, sc), q4(c.x, c.y, c.z, c.w, sc), q4(d.x, d.y, d.z, d.w, sc)};
  }
}

constexpr int GBK = 64, GHALF = 128, GHT = GHALF * GBK;
DI int lds_byte(int r, int c) {
  const int st = (r >> 4) * 2 + (c >> 5), rr = r & 15, cc = c & 31, ob = rr * 64 + cc * 2;
  return st * 1024 + (ob ^ (((ob >> 9) & 1) << 5));
}
DI void stage_rc(int b, int& R, int& C) {
  const int st = b / 1024, sb = b % 1024, swz = sb ^ (((sb >> 9) & 1) << 5);
  R = (st >> 1) * 16 + swz / 64;
  C = (st & 1) * 32 + (swz % 64) / 2;
}
typedef __attribute__((address_space(3))) unsigned lds_u32;
#define G_SA(b, h) (shm + ((b) * 2 + (h)) * GHT)
#define G_SB(b, h) (shm + (4 + (b) * 2 + (h)) * GHT)
#define G_STAGE(P_, RS, br, kt)                                                                                   \
  do {                                                                                                            \
    const int _so = ((br) * K + (kt) * GBK) * 2;                                                                  \
    __builtin_amdgcn_raw_ptr_buffer_load_lds(RS, (lds_u32*)((char*)(P_) + tb0), 16, ob0, _so, 0, 0);              \
    __builtin_amdgcn_raw_ptr_buffer_load_lds(RS, (lds_u32*)((char*)(P_) + tb0 + 8192), 16, ob1, _so, 0, 0);       \
  } while (0)
#define G_LDA(dst, b, h)                                  \
  _Pragma("unroll") for (int m = 0; m < 4; ++m)           \
  _Pragma("unroll") for (int k = 0; k < 2; ++k)           \
    dst[m][k] = *reinterpret_cast<const bf16x8*>((const char*)G_SA(b, h) + lds_byte(wr * 64 + m * 16 + fr, k * 32 + fq * 8))
#define G_LDB(dst, b, h)                                  \
  _Pragma("unroll") for (int n = 0; n < 2; ++n)           \
  _Pragma("unroll") for (int k = 0; k < 2; ++k)           \
    dst[n][k] = *reinterpret_cast<const bf16x8*>((const char*)G_SB(b, h) + lds_byte(wc * 32 + n * 16 + fr, k * 32 + fq * 8))
#define G_MMA(ai, bj, At_, Bt_)                                                                         \
  do {                                                                                                  \
    __builtin_amdgcn_s_setprio(1);                                                                      \
    _Pragma("unroll") for (int m = 0; m < 4; ++m)                                                       \
    _Pragma("unroll") for (int n = 0; n < 2; ++n)                                                       \
    _Pragma("unroll") for (int k = 0; k < 2; ++k)                                                       \
      acc[ai][bj][m][n] = MFMA16(At_[m][k], Bt_[n][k], acc[ai][bj][m][n]);                              \
    __builtin_amdgcn_s_setprio(0);                                                                      \
  } while (0)
#define WAIT_V(n) asm volatile("s_waitcnt vmcnt(" #n ")" ::: "memory")
#define WAIT_L(n) asm volatile("s_waitcnt lgkmcnt(" #n ")" ::: "memory")
#define BAR __builtin_amdgcn_s_barrier()
#define SCHED __builtin_amdgcn_sched_barrier(0)

template <int K>
DI void gemm256(const u16* __restrict__ A, const u16* __restrict__ Bt, const int brow, const int bcol,
                f32x4 (&acc)[2][2][4][2]) {
  u16* shm = (u16*)dsm;
  const int tid_ = otid();
  const int wid = tid_ >> 6, lane = tid_ & 63, wr = wid >> 2, wc = wid & 3, fr = lane & 15, fq = lane >> 4;
#pragma unroll
  for (int a = 0; a < 2; a++)
#pragma unroll
    for (int b = 0; b < 2; b++)
#pragma unroll
      for (int m = 0; m < 4; m++)
#pragma unroll
        for (int n = 0; n < 2; n++) acc[a][b][m][n] = f32x4{0.f, 0.f, 0.f, 0.f};
  bf16x8 At[4][2], B0[2][2], B1[2][2];
  constexpr int nt = K / GBK;
  const __amdgpu_buffer_rsrc_t rsA = __builtin_amdgcn_make_buffer_rsrc((void*)A, 0, 0x7fffffff, 0x00020000);
  const __amdgpu_buffer_rsrc_t rsB = __builtin_amdgcn_make_buffer_rsrc((void*)Bt, 0, 0x7fffffff, 0x00020000);
  const unsigned tb0 = tid_ * 16;
  int ob0, ob1;
  {
    int r_, c_;
    stage_rc((int)tb0, r_, c_);
    ob0 = (r_ * K + c_) * 2;
    stage_rc((int)tb0 + 8192, r_, c_);
    ob1 = (r_ * K + c_) * 2;
  }
  WAIT_V(0);
  __syncthreads();
  G_STAGE(G_SB(0, 0), rsB, bcol, 0); G_STAGE(G_SA(0, 0), rsA, brow, 0);
  G_STAGE(G_SB(0, 1), rsB, bcol + GHALF, 0); G_STAGE(G_SA(0, 1), rsA, brow + GHALF, 0);
  if (wr == 1) BAR;
  WAIT_V(4); BAR;
  G_STAGE(G_SB(1, 0), rsB, bcol, 1); G_STAGE(G_SA(1, 0), rsA, brow, 1); G_STAGE(G_SB(1, 1), rsB, bcol + GHALF, 1);
  WAIT_V(6); BAR;
  for (int t = 0; t < nt - 2; t += 2) {
    G_LDB(B0, 0, 0); SCHED; G_LDA(At, 0, 0); G_STAGE(G_SA(1, 1), rsA, brow + GHALF, t + 1);
    WAIT_L(8); BAR; WAIT_L(0); G_MMA(0, 0, At, B0); BAR; SCHED;
    G_LDB(B1, 0, 1); G_STAGE(G_SB(0, 0), rsB, bcol, t + 2);
    BAR; WAIT_L(0); G_MMA(0, 1, At, B1); BAR;
    G_LDA(At, 0, 1); G_STAGE(G_SA(0, 0), rsA, brow, t + 2);
    BAR; WAIT_L(0); G_MMA(1, 0, At, B0); BAR; SCHED;
    G_STAGE(G_SB(0, 1), rsB, bcol + GHALF, t + 2);
    WAIT_V(6); BAR; G_MMA(1, 1, At, B1); BAR;
    G_LDB(B0, 1, 0); SCHED; G_LDA(At, 1, 0); G_STAGE(G_SA(0, 1), rsA, brow + GHALF, t + 2);
    WAIT_L(8); BAR; WAIT_L(0); G_MMA(0, 0, At, B0); BAR; SCHED;
    G_LDB(B1, 1, 1); G_STAGE(G_SB(1, 0), rsB, bcol, t + 3);
    BAR; WAIT_L(0); G_MMA(0, 1, At, B1); BAR;
    G_LDA(At, 1, 1); G_STAGE(G_SA(1, 0), rsA, brow, t + 3);
    BAR; WAIT_L(0); G_MMA(1, 0, At, B0); BAR; SCHED;
    G_STAGE(G_SB(1, 1), rsB, bcol + GHALF, t + 3);
    WAIT_V(6); BAR; G_MMA(1, 1, At, B1); BAR;
  }
  {
    G_LDB(B0, 0, 0); G_LDA(At, 0, 0); G_STAGE(G_SA(1, 1), rsA, brow + GHALF, nt - 1);
    BAR; WAIT_L(0); G_MMA(0, 0, At, B0); BAR;
    G_LDB(B1, 0, 1); BAR; WAIT_L(0); G_MMA(0, 1, At, B1); BAR;
    G_LDA(At, 0, 1); WAIT_V(4); BAR; WAIT_L(0); G_MMA(1, 0, At, B0); G_MMA(1, 1, At, B1); BAR;
  }
  {
    G_LDB(B0, 1, 0); G_LDA(At, 1, 0); WAIT_V(2); BAR; WAIT_L(0); G_MMA(0, 0, At, B0); BAR;
    G_LDB(B1, 1, 1); WAIT_V(0); BAR; WAIT_L(0); G_MMA(0, 1, At, B1); BAR;
    G_LDA(At, 1, 1); BAR; WAIT_L(0); G_MMA(1, 0, At, B0); G_MMA(1, 1, At, B1); BAR;
  }
  if (wr == 0) BAR;
}
#define GT_VARS \
  const int tid_ = otid(); const int wid = tid_ >> 6, lane = tid_ & 63, wr = wid >> 2, wc = wid & 3, fr = lane & 15, fq = lane >> 4;
#define GT_ROW(ai, m, j) ((ai) * 128 + wr * 64 + (m) * 16 + fq * 4 + (j))
#define GT_COL(bj, n) ((bj) * 128 + wc * 32 + (n) * 16 + fr)
#define GT_FOR                                       \
  _Pragma("unroll") for (int ai = 0; ai < 2; ++ai)   \
  _Pragma("unroll") for (int bj = 0; bj < 2; ++bj)   \
  _Pragma("unroll") for (int m = 0; m < 4; ++m)      \
  _Pragma("unroll") for (int n = 0; n < 2; ++n)      \
  _Pragma("unroll") for (int j = 0; j < 4; ++j)

DI bool tile_of(int round, int bid, int nb, int nM, int nN, int& pm, int& pn) {
  const int vt = round * nb + (bid & 7) * (nb >> 3) + (bid >> 3);
  if (vt >= nM * nN) return false;
  const int nig = 8 * nN, gid = vt / nig, fm = gid * 8, gsz = min(nM - fm, 8);
  pm = fm + (vt % nig) % gsz;
  pn = (vt % nig) / gsz;
  return true;
}


constexpr int CS_LD = 264;
DI void acc_to_lds(const f32x4 (&acc)[2][2][4][2]) {
  GT_VARS
  u16* Cs = (u16*)dsm;
  __syncthreads();
  GT_FOR { Cs[GT_ROW(ai, m, j) * CS_LD + GT_COL(bj, n)] = f2bf(acc[ai][bj][m][n][j]); }
  __syncthreads();
}

__device__ void ph_gemm1(const Params& p, int bid, int nb) {
  const int tid_ = otid();
  const int nM = 261, nN = 18;
  for (int round = 0; round * nb < nM * nN; ++round) {
    int pm, pn;
    if (!tile_of(round, bid, nb, nM, nN, pm, pn)) break;
    f32x4 acc[2][2][4][2];
    gemm256<1024>(p.H, p.WinT, pm * 256, pn * 256, acc);
    acc_to_lds(acc);
    const u16* Cs = (const u16*)dsm;
#pragma unroll 4
    for (int it = 0; it < 16; it++) {
      const int id = it * NTH + tid_, rl = id >> 5, c8 = (id & 31) * 8;
      const int row = pm * 256 + rl;
      const u32x4 v = *(const u32x4*)(Cs + rl * CS_LD + c8);
      *(u32x4*)(p.P + (size_t)row * INC + pn * 256 + c8) = v;
      if (pn == 9) {
        float* dst = nullptr;
        const int c2 = c8 & 127;
        if (row < TP) {
          const int tt = row & 4095;
          if (tt >= 3968) dst = p.out + (c8 < 128 ? OFF_KP : OFF_VP) + ((size_t)(row >> 12) * 128 + (tt - 3968)) * 128 + c2;
        } else if (row < T) {
          dst = p.out + (c8 < 128 ? OFF_KS : OFF_VS) + (size_t)(row - TP) * 128 + c2;
        }
        if (dst) {
          *(float4*)dst = make_float4(bflo(v[0]), bfhi(v[0]), bflo(v[1]), bfhi(v[1]));
          *(float4*)(dst + 4) = make_float4(bflo(v[2]), bfhi(v[2]), bflo(v[3]), bfhi(v[3]));
        }
      }
    }
  }
}

DI int prev_row(int g) {
  if (g < TP) return (g & 4095) ? g - 1 : -1;
  const int r2 = g - TP;
  return (r2 & 63) ? g - 1 : T + (r2 >> 6);
}

__device__ void ph_rwprep(const Params& p, int bid, int nb) {
  const int tid = otid(), lane = tid & 63, wv = tid >> 6, fr = lane & 15, fq = lane >> 4;
  u16* A1 = (u16*)dsm;
  u16* A2 = A1 + 64 * 80;
  u16* A3 = A2 + 64 * 80;
  u16* SA = (u16*)(p.out);
  u16* SB = p.H;
  const int hd = wv;
  u16* OT = (u16*)(dsm + 38912 + wv * 12288);
  u32x4 pin[7];
  for (int tile = bid; tile < T / 64; tile += nb) {
    const int g0 = tile * 64;
    auto issue_in = [&](int rg_) {
#pragma unroll
      for (int it = 0; it < 7; it++) {
        const int id = it * 64 + lane, ri = id / 24, rem = id - ri * 24, arr = rem >> 3, ch = rem & 7;
        int tok = g0 + rg_ * 16 - 1 + ri;
        if (rg_ == 0 && ri == 0) tok = prev_row(g0);
        pin[it] = u32x4{0u, 0u, 0u, 0u};
        if (id < 408 && tok >= 0) pin[it] = *(const u32x4*)(p.P + (size_t)tok * INC + arr * 512 + hd * 64 + ch * 8);
      }
    };
    __syncthreads();
    {
      const int row = tid >> 3, part8 = tid & 7, part = part8 >> 1, sub = part8 & 1;
      const int g = g0 + row, pr = prev_row(g);
      const int cb = 1536 + part * 64 + sub * 32;
      const u16* cur = p.P + (size_t)g * INC + cb;
      const u16* prv = p.P + (size_t)(pr < 0 ? 0 : pr) * INC + cb;
#pragma unroll
      for (int q = 0; q < 4; q++) {
        const u32x4 c4 = *(const u32x4*)(cur + q * 8);
        u32x4 p4 = {0u, 0u, 0u, 0u};
        if (pr >= 0) p4 = *(const u32x4*)(prv + q * 8);
        u32x4 ow;
#pragma unroll
        for (int e = 0; e < 4; e++) {
          const float c0 = bflo(c4[e]), c1 = bfhi(c4[e]), q0 = bflo(p4[e]), q1 = bfhi(p4[e]);
          float f0 = c0 + (q0 - c0) * p.mu[cb + q * 8 + 2 * e];
          float f1 = c1 + (q1 - c1) * p.mu[cb + q * 8 + 2 * e + 1];
          if (part == 0) { f0 = 1.f - 2.f / (1.f + __expf(2.f * f0)); f1 = 1.f - 2.f / (1.f + __expf(2.f * f1)); }
          else if (part >= 2) { f0 = sigmoidf_(f0); f1 = sigmoidf_(f1); }
          ow[e] = pack2(f0, f1);
        }
        u16* dst = part == 0 ? A1 + row * 80 + sub * 32 + q * 8
                 : part == 1 ? A2 + row * 80 + sub * 32 + q * 8
                             : A3 + row * 144 + (part - 2) * 64 + sub * 32 + q * 8;
        *(u32x4*)dst = ow;
      }
    }
    __syncthreads();
#pragma unroll 1
    for (int rg = 0; rg < 4; rg++) {
      issue_in(rg);
#pragma unroll
      for (int it = 0; it < 7; it++) {
        const int id = it * 64 + lane;
        if (id < 408) *(u32x4*)(OT + id * 8) = pin[it];
      }
      __builtin_amdgcn_fence(__ATOMIC_RELEASE, "workgroup");
      __builtin_amdgcn_wave_barrier();
      float inr[5][3][4];
#pragma unroll
      for (int jj = 0; jj < 5; jj++)
#pragma unroll
        for (int ar = 0; ar < 3; ar++)
#pragma unroll
          for (int nt = 0; nt < 4; nt++) inr[jj][ar][nt] = bf2f(OT[((fq * 4 + jj) * 3 + ar) * 64 + nt * 16 + fr]);
      __builtin_amdgcn_fence(__ATOMIC_RELEASE, "workgroup");
      __builtin_amdgcn_wave_barrier();
      SCHED;
      f32x4 aw[4], aa[4];
#pragma unroll
      for (int nt = 0; nt < 4; nt++) { aw[nt] = f32x4{0.f, 0.f, 0.f, 0.f}; aa[nt] = f32x4{0.f, 0.f, 0.f, 0.f}; }
#pragma unroll 1
      for (int ks = 0; ks < 2; ks++) {
        const bf16x8 f1 = *(const bf16x8*)(A1 + (rg * 16 + fr) * 80 + ks * 32 + fq * 8);
        const bf16x8 f2 = *(const bf16x8*)(A2 + (rg * 16 + fr) * 80 + ks * 32 + fq * 8);
#pragma unroll
        for (int nt = 0; nt < 4; nt++) {
          const bf16x8 bw = *(const bf16x8*)(p.W2T + (unsigned)((hd * 64 + nt * 16 + fr) * 64 + ks * 32 + fq * 8));
          const bf16x8 ba = *(const bf16x8*)(p.A2T + (unsigned)((hd * 64 + nt * 16 + fr) * 64 + ks * 32 + fq * 8));
          aw[nt] = MFMA16(f1, bw, aw[nt]);
          aa[nt] = MFMA16(f2, ba, aa[nt]);
        }
      }
      float ss[4] = {0.f, 0.f, 0.f, 0.f};
      const int rowb = rg * 16 + fq * 4;
      const int gb = g0 + rowb;
#pragma unroll
      for (int nt = 0; nt < 4; nt++) {
        const int c = nt * 16 + fr, col = hd * 64 + c;
        const float mu_r = p.mu[col], mu_k = p.mu[512 + col], mu_v = p.mu[1024 + col];
        const float w0c = p.w0[col], a0c = p.a0[col], kkc = p.k_k[col], kac = p.k_a[col];
        float qr = inr[0][0][nt], qk = inr[0][1][nt], qv = inr[0][2][nt];
#pragma unroll
        for (int j = 0; j < 4; j++) {
          const float cr = inr[j + 1][0][nt], ck = inr[j + 1][1][nt], cv = inr[j + 1][2][nt];
          const float r = cr + (qr - cr) * mu_r, k = ck + (qk - ck) * mu_k, v = cv + (qv - cv) * mu_v;
          qr = cr; qk = ck; qv = cv;
          const float ed = 0.6065306597126334f * sigmoidf_(w0c + aw[nt][j]);
          const float dm = 1.f - __expf(-ed);
          const float a = sigmoidf_(a0c + aa[nt][j]);
          const float kkv = k * kkc;
          ss[j] += kkv * kkv;
          const float k2 = k * (1.f + (a - 1.f) * kac);
          u16* ot = OT + (fq * 4 + j) * 384 + c;
          ot[0] = f2bf(r);
          ot[64] = f2bf(dm);
          ot[128] = f2bf(k2);
          ot[256] = f2bf(v);
          aw[nt][j] = kkv;
          aa[nt][j] = a;
        }
        SCHED;
      }
#pragma unroll
      for (int j = 0; j < 4; j++) ss[j] = 1.f / fmaxf(sqrtf(red16(ss[j])), 1e-12f);
#pragma unroll
      for (int nt = 0; nt < 4; nt++) {
        const int c = nt * 16 + fr;
#pragma unroll
        for (int j = 0; j < 4; j++) {
          const float kkn = aw[nt][j] * ss[j];
          u16* ot = OT + (fq * 4 + j) * 384 + c;
          ot[192] = f2bf(kkn);
          ot[320] = f2bf(kkn * aa[nt][j]);
        }
      }
      __builtin_amdgcn_fence(__ATOMIC_RELEASE, "workgroup");
      __builtin_amdgcn_wave_barrier();
      {
        const int gr0 = g0 + rg * 16;
#pragma unroll 4
        for (int it = 0; it < 12; it++) {
          const int id = it * 64 + lane, rowi = id / 48, pc = id % 48;
          const u32x4 v4 = *(const u32x4*)(OT + rowi * 384 + pc * 8);
          const size_t gh = (size_t)(gr0 + rowi) * 8 + hd;
          if (pc < 32) *(u32x4*)(SA + gh * 256 + pc * 8) = v4;
          else *(u32x4*)(SB + gh * 128 + (pc - 32) * 8) = v4;
        }
      }
      __builtin_amdgcn_wave_barrier();
      f32x4 ag[4];
#pragma unroll
      for (int nt = 0; nt < 4; nt++) ag[nt] = f32x4{0.f, 0.f, 0.f, 0.f};
#pragma unroll 1
      for (int ks = 0; ks < 4; ks++) {
        const bf16x8 f3 = *(const bf16x8*)(A3 + (rg * 16 + fr) * 144 + ks * 32 + fq * 8);
#pragma unroll
        for (int nt = 0; nt < 4; nt++) {
          const bf16x8 bg = *(const bf16x8*)(p.G2T + (unsigned)((hd * 64 + nt * 16 + fr) * 128 + ks * 32 + fq * 8));
          ag[nt] = MFMA16(f3, bg, ag[nt]);
        }
      }
#pragma unroll
      for (int nt = 0; nt < 4; nt++)
#pragma unroll
        for (int j = 0; j < 4; j++) p.G[(size_t)(gb + j) * 512 + hd * 64 + nt * 16 + fr] = f2bf(ag[nt][j]);
    }
  }
}

DI float red8(float v) {
  v += dppmov<0xB1>(v);
  v += dppmov<0x4E>(v);
  v += dppmov<0x141>(v);
  return v;
}
struct ScanOps { f32x4 r, d, k, n, b; float v; };
DI void scan_ld(ScanOps& o, const float* sb, int j0, int row) {
  o.r = *(const f32x4*)(sb + j0);
  o.d = *(const f32x4*)(sb + 64 + j0);
  o.k = *(const f32x4*)(sb + 128 + j0);
  o.n = *(const f32x4*)(sb + 192 + j0);
  o.b = *(const f32x4*)(sb + 320 + j0);
  o.v = sb[256 + row];
}
#define LO2(x) __builtin_shufflevector((x), (x), 0, 1)
#define HI2(x) __builtin_shufflevector((x), (x), 2, 3)
DI float scan_step(f32x2 (&S)[2], const ScanOps& o, f32x4& rprev) {
  const f32x2 vv = {o.v, o.v};
  const f32x2 tt = S[0] * LO2(o.n) + S[1] * HI2(o.n);
  const f32x2 yy = S[0] * LO2(rprev) + S[1] * HI2(rprev);
  const f32x2 m0 = S[0] * LO2(o.d) + vv * LO2(o.k);
  const f32x2 m1 = S[1] * HI2(o.d) + vv * HI2(o.k);
  float a = tt[0] + tt[1], y = yy[0] + yy[1];
  a += dppmov<0x128>(a); y += dppmov<0x128>(y);
  a += dppmov<0x124>(a); y += dppmov<0x124>(y);
  a += dppmov<0x122>(a); y += dppmov<0x122>(y);
  a += dppmov<0x121>(a); y += dppmov<0x121>(y);
  const float sa = -a;
  const f32x2 sv = {sa, sa};
  S[0] = m0 + sv * LO2(o.b);
  S[1] = m1 + sv * HI2(o.b);
  rprev = o.r;
  return y;
}

__device__ void ph_scan(const Params& p, int bid, int nb) {
  const int tid = otid(), lane = tid & 63, wv = tid >> 6;
  float* buf = (float*)dsm;
  const u16* SA = (const u16*)(p.out);
  const u16* SB = p.H;
  constexpr int CH = 32;
  for (int item = bid; item < 512; item += nb) {
    const int type = item >> 8, r_ = item & 255, half = r_ & 1, hb = r_ >> 1, h = hb & 7, b = hb >> 3;
    const int nch = type ? 64 / CH : 4096 / CH;
    const int gbase = type ? TP + b * 64 : b * 4096;
    const bool active = true;
    const int row = half * 32 + wv * 4 + (lane >> 4), j0 = (lane & 15) * 4;
    f32x2 S[2];
#pragma unroll
    for (int j = 0; j < 2; j++) S[j] = f32x2{0.f, 0.f};
    if (type && active) {
      const float* s0 = p.state_wkv + ((size_t)(b * 8 + h) * 64 + row) * 64 + j0;
#pragma unroll
      for (int j = 0; j < 2; j++) S[j] = f32x2{s0[2 * j], s0[2 * j + 1]};
    }
    f32x4 rprev = {0.f, 0.f, 0.f, 0.f};
    float ykeep = 0.f;
    u32x4 la[2], lb;
    auto gload = [&](int c) {
#pragma unroll
      for (int q = 0; q < 2; q++) {
        const int idx = tid + q * NTH, step = idx >> 5, u = idx & 31;
        la[q] = *(const u32x4*)(SA + ((size_t)(gbase + c * CH + step) * 8 + h) * 256 + u * 8);
      }
      {
        const int step = tid >> 4, u = tid & 15;
        lb = *(const u32x4*)(SB + ((size_t)(gbase + c * CH + step) * 8 + h) * 128 + u * 8);
      }
    };
    gload(0);
    for (int c = 0; c < nch; c++) {
      __syncthreads();
#pragma unroll
      for (int q = 0; q < 2; q++) {
        const int idx = tid + q * NTH, step = idx >> 5, u = idx & 31, arr = u >> 3, c0 = (u & 7) * 8;
        float* d = buf + step * 384 + arr * 64 + c0;
        float f[8];
#pragma unroll
        for (int e = 0; e < 4; e++) { f[2 * e] = bflo(la[q][e]); f[2 * e + 1] = bfhi(la[q][e]); }
        if (arr == 1) {
#pragma unroll
          for (int e = 0; e < 8; e++) f[e] = 1.f - f[e];
        }
        *(float4*)d = make_float4(f[0], f[1], f[2], f[3]);
        *(float4*)(d + 4) = make_float4(f[4], f[5], f[6], f[7]);
      }
      {
        const int step = tid >> 4, u = tid & 15, arr = u >> 3, c0 = (u & 7) * 8;
        float* d = buf + step * 384 + (4 + arr) * 64 + c0;
        *(float4*)d = make_float4(bflo(lb[0]), bfhi(lb[0]), bflo(lb[1]), bfhi(lb[1]));
        *(float4*)(d + 4) = make_float4(bflo(lb[2]), bfhi(lb[2]), bflo(lb[3]), bfhi(lb[3]));
      }
      __syncthreads();
      if (c + 1 < nch) gload(c + 1);
      if (active) {
        ScanOps A0, A1, B0, B1;
        scan_ld(A0, buf, j0, row);
        scan_ld(A1, buf + 384, j0, row);
#pragma unroll 1
        for (int s = 0; s < CH; s += 4) {
          scan_ld(B0, buf + (s + 2) * 384, j0, row);
          scan_ld(B1, buf + (s + 3) * 384, j0, row);
          SCHED;
          {
            const int g0 = c * CH + s;
            const float y0 = scan_step(S, A0, rprev);
            ykeep = ((lane & 15) == ((g0 - 1) & 15)) ? y0 : ykeep;
            if ((g0 & 15) == 0 && g0 > 0)
              p.Y[(size_t)(gbase + g0 - 16 + (lane & 15)) * 512 + h * 64 + row] = f2bf(ykeep);
            const float y1 = scan_step(S, A1, rprev);
            ykeep = ((lane & 15) == (g0 & 15)) ? y1 : ykeep;
          }
          SCHED;
          const int sn = (s + 4 < CH) ? s + 4 : s;
          scan_ld(A0, buf + sn * 384, j0, row);
          scan_ld(A1, buf + (sn + 1) * 384, j0, row);
          SCHED;
          {
            const int g0 = c * CH + s;
            const float y2 = scan_step(S, B0, rprev);
            ykeep = ((lane & 15) == ((g0 + 1) & 15)) ? y2 : ykeep;
            const float y3 = scan_step(S, B1, rprev);
            ykeep = ((lane & 15) == ((g0 + 2) & 15)) ? y3 : ykeep;
          }
          SCHED;
        }
      }
    }
    if (active) {
      const f32x2 yy = S[0] * LO2(rprev) + S[1] * HI2(rprev);
      const float yl = red16(yy[0] + yy[1]);
      ykeep = ((lane & 15) == 15) ? yl : ykeep;
      p.Y[(size_t)(gbase + nch * CH - 16 + (lane & 15)) * 512 + h * 64 + row] = f2bf(ykeep);
    }
    if (active) {
      float* so = p.out + (type ? OFF_WKV_S : OFF_WKV_P) + ((size_t)(b * 8 + h) * 64 + row) * 64 + j0;
      *(float4*)so = make_float4(S[0][0], S[0][1], S[1][0], S[1][1]);
    }
  }
}

__device__ void ph_attn(const Params& p, int bid, int nb, bool dry = false) {
  const int tid = otid(), lane = tid & 63, wv = tid >> 6, fr = lane & 15, fq = lane >> 4;
  u16* Ks = (u16*)dsm;
  u16* Vt = Ks + 192 * 72;
  for (int item = bid; item < 2080; item += nb) {
    const int kvh = item & 1, r = item >> 1;
    const bool samp = r >= 1024;
    const int b = samp ? r - 1024 : r >> 6, c = samp ? 0 : (r & 63);
    const int gq0 = samp ? TP + b * 64 : b * 4096 + c * 64;
    __syncthreads();
#pragma unroll
    for (int q = 0; q < 3; q++) {
      const int idx = tid + q * NTH, j = idx >> 3, d0 = (idx & 7) * 8;
      u32x4 kq = {0u, 0u, 0u, 0u}, vq = {0u, 0u, 0u, 0u};
      if (!samp) {
        const int tok = (c - 2) * 64 + j;
        if (tok >= 0) {
          const u16* src = p.P + (size_t)(b * 4096 + tok) * INC + 2304 + kvh * 64 + d0;
          kq = *(const u32x4*)src;
          vq = *(const u32x4*)(src + 128);
        }
      } else if (j < 128) {
        const float4* ck = (const float4*)(p.cache_k + ((size_t)(b * 128 + j) * 2 + kvh) * 64 + d0);
        const float4* cv = (const float4*)(p.cache_v + ((size_t)(b * 128 + j) * 2 + kvh) * 64 + d0);
        const float4 k0 = ck[0], k1 = ck[1], v0 = cv[0], v1 = cv[1];
        kq = u32x4{pack2(k0.x, k0.y), pack2(k0.z, k0.w), pack2(k1.x, k1.y), pack2(k1.z, k1.w)};
        vq = u32x4{pack2(v0.x, v0.y), pack2(v0.z, v0.w), pack2(v1.x, v1.y), pack2(v1.z, v1.w)};
      } else {
        const u16* src = p.P + (size_t)(TP + b * 64 + (j - 128)) * INC + 2304 + kvh * 64 + d0;
        kq = *(const u32x4*)src;
        vq = *(const u32x4*)(src + 128);
      }
      *(u32x4*)(Ks + j * 72 + d0) = kq;
#pragma unroll
      for (int e = 0; e < 4; e++) {
        Vt[(d0 + 2 * e) * 196 + j] = (u16)(vq[e] & 0xffffu);
        Vt[(d0 + 2 * e + 1) * 196 + j] = (u16)(vq[e] >> 16);
      }
    }
    __syncthreads();
    const int qh = kvh * 4 + (wv & 3);
    const float slope = exp2f(-(float)(qh + 1)), sink = p.sinks[qh];
#pragma unroll 1
    for (int ps = 0; ps < 2; ps++) {
      const int q0 = (wv >> 2) * 32 + ps * 16;
      const int tq = q0 + fr;
      const u16* qp = p.P + (size_t)(gq0 + tq) * INC + 1792 + qh * 64 + fq * 8;
      const bf16x8 qf0 = *(const bf16x8*)(qp), qf1 = *(const bf16x8*)(qp + 32);
      f32x4 sc[12];
#pragma unroll
      for (int kt = 0; kt < 12; kt++) {
        sc[kt] = f32x4{0.f, 0.f, 0.f, 0.f};
        const bf16x8 a0 = *(const bf16x8*)(Ks + (kt * 16 + fr) * 72 + fq * 8);
        const bf16x8 a1 = *(const bf16x8*)(Ks + (kt * 16 + fr) * 72 + 32 + fq * 8);
        sc[kt] = MFMA16(a0, qf0, sc[kt]);
        sc[kt] = MFMA16(a1, qf1, sc[kt]);
        if ((kt & 3) == 3) SCHED;
      }
      float mx = -3e38f;
#pragma unroll
      for (int kt = 0; kt < 12; kt++)
#pragma unroll
        for (int j = 0; j < 4; j++) {
          const int key = kt * 16 + fq * 4 + j;
          float s = sc[kt][j] * 0.125f - slope * fabsf((float)(128 + tq - key));
          if (!samp && (c - 2) * 64 + key < 0) s = -1e30f;
          sc[kt][j] = s;
          mx = fmaxf(mx, s);
        }
      mx = fmaxf(mx, __shfl_xor(mx, 16));
      mx = fmaxf(mx, __shfl_xor(mx, 32));
      mx = fmaxf(mx, sink);
      float sum = 0.f;
#pragma unroll
      for (int kt = 0; kt < 12; kt++)
#pragma unroll
        for (int j = 0; j < 4; j++) {
          const float e = __expf(sc[kt][j] - mx);
          sc[kt][j] = e;
          sum += e;
        }
      sum += __shfl_xor(sum, 16);
      sum += __shfl_xor(sum, 32);
      sum += __expf(sink - mx);
      const float inv = 1.f / sum;
      f32x4 o[4];
#pragma unroll
      for (int dt = 0; dt < 4; dt++) o[dt] = f32x4{0.f, 0.f, 0.f, 0.f};
#pragma unroll
      for (int t2 = 0; t2 < 6; t2++) {
        const u32x4 pw = {pack2(sc[2 * t2][0] * inv, sc[2 * t2][1] * inv), pack2(sc[2 * t2][2] * inv, sc[2 * t2][3] * inv),
                          pack2(sc[2 * t2 + 1][0] * inv, sc[2 * t2 + 1][1] * inv),
                          pack2(sc[2 * t2 + 1][2] * inv, sc[2 * t2 + 1][3] * inv)};
        const bf16x8 pa = __builtin_bit_cast(bf16x8, pw);
#pragma unroll
        for (int dt = 0; dt < 4; dt++) {
          const u16* vp = Vt + (dt * 16 + fr) * 196 + t2 * 32 + fq * 4;
          const uint2 v0 = *(const uint2*)vp, v1 = *(const uint2*)(vp + 16);
          const bf16x8 vb = __builtin_bit_cast(bf16x8, u32x4{v0.x, v0.y, v1.x, v1.y});
          o[dt] = MFMA16(pa, vb, o[dt]);
        }
        SCHED;
      }
#pragma unroll
      for (int dt = 0; dt < 4; dt++)
#pragma unroll
        for (int j = 0; j < 4; j++)
          p.OATT[(size_t)(gq0 + q0 + fq * 4 + j) * 512 + qh * 64 + dt * 16 + fr] = f2bf(o[dt][j]);
    }
  }
  const u16* SA = (const u16*)(p.out);
  const u16* SB = p.H;
  for (int it4 = bid * NW + wv; it4 < T * 2; it4 += nb * NW) {
    const int it = it4 * 4 + (lane >> 4), c0 = (lane & 15) * 4;
    const int g = it >> 3, h = it & 7, col = h * 64 + c0;
    const uint2 yw = *(const uint2*)(p.Y + (size_t)g * 512 + col);
    const uint2 rw = *(const uint2*)(SA + (size_t)it * 256 + c0), kw = *(const uint2*)(SA + (size_t)it * 256 + 128 + c0);
    const uint2 vw = *(const uint2*)(SB + (size_t)it * 128 + c0), gw = *(const uint2*)(p.G + (size_t)g * 512 + col);
    const float4 lw = *(const float4*)(p.lnx_w + col), lb = *(const float4*)(p.lnx_b + col), rk = *(const float4*)(p.r_k + col);
    const float y0 = bflo(yw.x), y1 = bfhi(yw.x), y2 = bflo(yw.y), y3 = bfhi(yw.y);
    const float mean = red16((y0 + y1) + (y2 + y3)) * (1.f / 64.f);
    const float e0 = y0 - mean, e1 = y1 - mean, e2 = y2 - mean, e3 = y3 - mean;
    const float var = red16((e0 * e0 + e1 * e1) + (e2 * e2 + e3 * e3)) * (1.f / 64.f);
    const float bonus = red16((bflo(rw.x) * bflo(kw.x) * rk.x + bfhi(rw.x) * bfhi(kw.x) * rk.y) +
                              (bflo(rw.y) * bflo(kw.y) * rk.z + bfhi(rw.y) * bfhi(kw.y) * rk.w));
    const float rsd = rsqrtf(var + 64e-5f);
    const float o0 = (e0 * rsd * lw.x + lb.x + bonus * bflo(vw.x)) * bflo(gw.x);
    const float o1 = (e1 * rsd * lw.y + lb.y + bonus * bfhi(vw.x)) * bfhi(gw.x);
    const float o2 = (e2 * rsd * lw.z + lb.z + bonus * bflo(vw.y)) * bflo(gw.y);
    const float o3 = (e3 * rsd * lw.w + lb.w + bonus * bfhi(vw.y)) * bfhi(gw.y);
    if (!dry || o0 == 123.456f) *(uint2*)(p.Y + (size_t)g * 512 + col) = make_uint2(pack2(o0, o1), pack2(o2, o3));
  }
}

DI void ph_gemm2(const Params& p, int bid, int nb, int sm = -1) {
  const int tid_ = otid();
  u16* MG = p.H;
  const u16* Cs = (const u16*)dsm;
  const int nM = 256, nN = 4;
  for (int round = 0;; ++round) {
    int pm, pn;
    if (sm >= 0) { if (round >= 4) break; pm = 256 + sm; pn = round; }
    else if (!tile_of(round, bid, nb, nM, nN, pm, pn)) break;
    f32x4 acc[2][2][4][2];
#pragma unroll 1
    for (int br = 0; br < 2; br++) {
      gemm256<512>(br ? p.OATT : p.Y, p.WbT + (size_t)br * 1024 * 512, pm * 256, pn * 256, acc);
      acc_to_lds(acc);
#pragma unroll 2
      for (int it = 0; it < 16; it++) {
        const int id = it * NTH + tid_, rl = id >> 5, c8 = (id & 31) * 8;
        const int row = pm * 256 + rl, col = pn * 256 + c8;
        const u32x4 v = *(const u32x4*)(Cs + rl * CS_LD + c8);
        const u32x4 gw = *(const u32x4*)(p.P + (size_t)row * INC + 2560 + br * 1024 + col);
        u32x4 prev = {0u, 0u, 0u, 0u};
        if (br) prev = *(const u32x4*)(MG + (size_t)row * 1024 + col);
        u32x4 o;
#pragma unroll
        for (int e = 0; e < 4; e++) {
          const float r0 = bflo(prev[e]) + sigmoidf_(bflo(gw[e])) * bflo(v[e]);
          const float r1 = bfhi(prev[e]) + sigmoidf_(bfhi(gw[e])) * bfhi(v[e]);
          o[e] = pack2(r0, r1);
        }
        *(u32x4*)(MG + (size_t)row * 1024 + col) = o;
      }
    }
  }
}

DI void ph_gemm3(const Params& p, int bid, int nb, int sm = -1) {
  const int tid_ = otid();
  const u16* MG = p.H;
  const u16* Cs = (const u16*)dsm;
  const int nM = 256, nN = 4;
  for (int round = 0;; ++round) {
    int pm, pn;
    if (sm >= 0) { if (round >= 4) break; pm = 256 + sm; pn = round; }
    else if (!tile_of(round, bid, nb, nM, nN, pm, pn)) break;
    f32x4 acc[2][2][4][2];
    gemm256<1024>(MG, p.WoutT, pm * 256, pn * 256, acc);
    acc_to_lds(acc);
#pragma unroll 2
    for (int it = 0; it < 16; it++) {
      const int id = it * NTH + tid_, rl = id >> 5, c8 = (id & 31) * 8;
      const int row = pm * 256 + rl, col = pn * 256 + c8;
      const u32x4 v = *(const u32x4*)(Cs + rl * CS_LD + c8);
      const float* xr = xrow(p, row) + col;
      const float4 x0 = *(const float4*)xr, x1 = *(const float4*)(xr + 4);
      *(u32x4*)(p.P + (size_t)row * 1024 + col) =
          u32x4{pack2(x0.x + bflo(v[0]), x0.y + bfhi(v[0])), pack2(x0.z + bflo(v[1]), x0.w + bfhi(v[1])),
                pack2(x1.x + bflo(v[2]), x1.y + bfhi(v[2])), pack2(x1.z + bflo(v[3]), x1.w + bfhi(v[3]))};
    }
  }
}

DI void ph_norm2(const Params& p, int row0, int row1, int wstride) {
  const int tid = otid(), lane = tid & 63;
  for (int row = row0; row < row1; row += wstride) {
    const uint2* x = (const uint2*)(p.P + (size_t)row * 1024);
    float4 v[4];
    float ss = 0.f;
#pragma unroll
    for (int i = 0; i < 4; i++) {
      const uint2 xw = x[lane + i * 64];
      v[i] = make_float4(bflo(xw.x), bfhi(xw.x), bflo(xw.y), bfhi(xw.y));
      ss += v[i].x * v[i].x + v[i].y * v[i].y + v[i].z * v[i].z + v[i].w * v[i].w;
    }
    ss = wave_sum(ss);
    const float rs = rsqrtf(ss * (1.f / 1024.f) + 1e-6f);
    u16* hr = p.H + (size_t)row * 1024;
    float4 y[4];
    float am = 0.f;
#pragma unroll
    for (int i = 0; i < 4; i++) {
      const float4 g = ((const float4*)p.norm2_g)[lane + i * 64];
      y[i] = make_float4(v[i].x * rs * g.x, v[i].y * rs * g.y, v[i].z * rs * g.z, v[i].w * rs * g.w);
      ((uint2*)hr)[lane + i * 64] = make_uint2(pack2(y[i].x, y[i].y), pack2(y[i].z, y[i].w));
      am = fmaxf(am, fmaxf(fmaxf(fabsf(y[i].x), fabsf(y[i].y)), fmaxf(fabsf(y[i].z), fabsf(y[i].w))));
    }
    am = fmaxf(wave_max(am), 1e-30f);
    const float sc = 240.f / am;
    if (lane == 0) p.SH[row] = am * (1.f / 240.f);
    u32* h8 = (u32*)((unsigned char*)p.Y + (size_t)row * 1024);
#pragma unroll
    for (int i = 0; i < 4; i++) h8[lane + i * 64] = q4(y[i].x, y[i].y, y[i].z, y[i].w, sc);
  }
}

DI void ins16(float (&l)[16], float x) {
#pragma unroll
  for (int i = 0; i < 16; i++) {
    const float hi = fmaxf(l[i], x);
    x = fminf(l[i], x);
    l[i] = hi;
  }
}


DI void ce_desc(float& a, float& b) { const float hi = fmaxf(a, b), lo = fminf(a, b); a = hi; b = lo; }
DI void bitonic_sort16_desc(float (&a)[16]) {
#pragma unroll
  for (int k = 2; k <= 16; k <<= 1)
#pragma unroll
    for (int j = k >> 1; j > 0; j >>= 1)
#pragma unroll
      for (int i = 0; i < 16; i++) {
        const int l = i ^ j;
        if (l > i) {
          if ((i & k) == 0) ce_desc(a[i], a[l]);
          else ce_desc(a[l], a[i]);
        }
      }
}
DI void bitonic_merge16_desc(float (&a)[16]) {
#pragma unroll
  for (int j = 8; j > 0; j >>= 1)
#pragma unroll
    for (int i = 0; i < 16; i++) {
      const int l = i ^ j;
      if (l > i) ce_desc(a[i], a[l]);
    }
}
DI void top16_merge(float (&a)[16], const float (&b)[16]) {
#pragma unroll
  for (int i = 0; i < 16; i++) a[i] = fmaxf(a[i], b[15 - i]);
  bitonic_merge16_desc(a);
}

DI void ph_peerq(const Params& p, int bid, int nb, int sm = -1) {
  GT_VARS
  const int l31 = lane & 31, kh = lane >> 5;
  u16* Qs = (u16*)dsm;
  unsigned char* lt = (unsigned char*)(dsm + 135168 + wid * 1024);
  int* IDX = (int*)p.G;
  float* GATE = (float*)p.OATT;
  const int nM = 256, nN = 4;
  for (int round = 0;; ++round) {
    int pm, pn;
    if (sm >= 0) { if (round >= 4) break; pm = 256 + sm; pn = round; }
    else if (!tile_of(round, bid, nb, nM, nN, pm, pn)) break;
    {
      f32x4 acc[2][2][4][2];
      gemm256<1024>(p.H, p.WqT, pm * 256, pn * 256, acc);
      acc_to_lds(acc);
    }
#pragma unroll 1
    for (int hh = 0; hh < 2; hh++) {
      const int hp = pn * 2 + hh;
      float l1[16], l2[16];
#pragma unroll
      for (int i = 0; i < 16; i++) { l1[i] = 0.f; l2[i] = 0.f; }
#pragma unroll 1
      for (int pp = 0; pp < 2; pp++) {
        f32x16 sc[4];
#pragma unroll
        for (int m4 = 0; m4 < 4; m4++) {
#pragma unroll
          for (int i = 0; i < 16; i++) sc[m4][i] = 0.f;
#pragma unroll
          for (int kk = 0; kk < 4; kk++) {
            const bf16x8 a = *(const bf16x8*)(p.SK + (size_t)(pp * 128 + m4 * 32 + l31) * 64 + kk * 16 + kh * 8);
            const bf16x8 bq = *(const bf16x8*)(Qs + (wid * 32 + l31) * 264 + hh * 128 + pp * 64 + kk * 16 + kh * 8);
            sc[m4] = MFMA32(a, bq, sc[m4]);
          }
        }
        float l[16], q1[16], q2[16], q3[16];
#pragma unroll
        for (int i = 0; i < 16; i++) {
          const u32 nb_ = (i >> 2) * 8 + kh * 4 + (i & 3);
          l[i] = __uint_as_float((__float_as_uint(sc[0][i]) & ~0x7Fu) | nb_);
          q1[i] = __uint_as_float((__float_as_uint(sc[1][i]) & ~0x7Fu) | (32u + nb_));
          q2[i] = __uint_as_float((__float_as_uint(sc[2][i]) & ~0x7Fu) | (64u + nb_));
          q3[i] = __uint_as_float((__float_as_uint(sc[3][i]) & ~0x7Fu) | (96u + nb_));
        }
        bitonic_sort16_desc(l);
        bitonic_sort16_desc(q1);
        bitonic_sort16_desc(q2);
        bitonic_sort16_desc(q3);
        top16_merge(l, q1);
        top16_merge(q2, q3);
        top16_merge(l, q2);
        float o[16];
#pragma unroll
        for (int i = 0; i < 16; i++) o[i] = __shfl_xor(l[i], 32);
        top16_merge(l, o);
#pragma unroll
        for (int i = 0; i < 16; i++) {
          l1[i] = pp == 0 ? l[i] : l1[i];
          l2[i] = pp == 0 ? l2[i] : l[i];
        }
      }
      if (kh == 0) {
        u32 w[8];
#pragma unroll
        for (int q = 0; q < 4; q++) {
          w[q] = (__float_as_uint(l1[4 * q]) & 0x7F) | ((__float_as_uint(l1[4 * q + 1]) & 0x7F) << 8) |
                 ((__float_as_uint(l1[4 * q + 2]) & 0x7F) << 16) | ((__float_as_uint(l1[4 * q + 3]) & 0x7F) << 24);
          w[4 + q] = (__float_as_uint(l2[4 * q]) & 0x7F) | ((__float_as_uint(l2[4 * q + 1]) & 0x7F) << 8) |
                     ((__float_as_uint(l2[4 * q + 2]) & 0x7F) << 16) | ((__float_as_uint(l2[4 * q + 3]) & 0x7F) << 24);
        }
        *(uint4*)(lt + l31 * 32) = make_uint4(w[0], w[1], w[2], w[3]);
        *(uint4*)(lt + l31 * 32 + 16) = make_uint4(w[4], w[5], w[6], w[7]);
      }
      float v1[16], v2[16];
#pragma unroll
      for (int i = 0; i < 16; i++) {
        v1[i] = __uint_as_float(__float_as_uint(l1[i]) & ~0x7Fu);
        v2[i] = __uint_as_float(__float_as_uint(l2[i]) & ~0x7Fu);
      }
#define CAND(a, b) __uint_as_float((__float_as_uint(v1[a] + v2[b]) & ~0xFFu) | (u32)((a) * 16 + (b)))
      float l3[16], y1[16], y2[16];
#pragma unroll
      for (int b = 0; b < 16; b++) l3[b] = CAND(0, b);
#pragma unroll
      for (int b = 0; b < 8; b++) y1[b] = CAND(1, b);
#pragma unroll
      for (int b = 0; b < 5; b++) y1[8 + b] = CAND(2, b);
#pragma unroll
      for (int b = 0; b < 3; b++) y1[13 + b] = CAND(4, b);
#pragma unroll
      for (int b = 0; b < 4; b++) y2[b] = CAND(3, b);
      y2[4] = CAND(5, 0); y2[5] = CAND(5, 1); y2[6] = CAND(6, 0); y2[7] = CAND(6, 1); y2[8] = CAND(7, 0); y2[9] = CAND(7, 1);
      y2[10] = CAND(8, 0); y2[11] = CAND(9, 0); y2[12] = CAND(10, 0); y2[13] = CAND(11, 0); y2[14] = CAND(12, 0); y2[15] = CAND(13, 0);
      bitonic_sort16_desc(y1);
      bitonic_sort16_desc(y2);
      top16_merge(l3, y1);
      top16_merge(l3, y2);
      ins16(l3, CAND(14, 0));
      ins16(l3, CAND(15, 0));
#undef CAND
      __builtin_amdgcn_fence(__ATOMIC_RELEASE, "workgroup");
      __builtin_amdgcn_wave_barrier();
      if (kh == 0) {
        const int g = pm * 256 + wid * 32 + l31;
        float ev[16];
        int ei[16];
        float sum = 0.f;
        const float mxv = __uint_as_float(__float_as_uint(l3[0]) & ~0xFFu);
#pragma unroll
        for (int k = 0; k < 16; k++) {
          const u32 bits = __float_as_uint(l3[k]);
          const u32 pos = bits & 0xFF;
          ev[k] = __expf(__uint_as_float(bits & ~0xFFu) - mxv);
          sum += ev[k];
          ei[k] = (int)lt[l31 * 32 + (pos >> 4)] * 128 + (int)lt[l31 * 32 + 16 + (pos & 15)];
        }
        const float inv = 1.f / sum;
        int4* ip = (int4*)(IDX + (size_t)g * 128 + hp * 16);
        float4* gp = (float4*)(GATE + (size_t)g * 128 + hp * 16);
#pragma unroll
        for (int q = 0; q < 4; q++) {
          ip[q] = make_int4(ei[4 * q], ei[4 * q + 1], ei[4 * q + 2], ei[4 * q + 3]);
          gp[q] = make_float4(ev[4 * q] * inv, ev[4 * q + 1] * inv, ev[4 * q + 2] * inv, ev[4 * q + 3] * inv);
        }
      }
      __builtin_amdgcn_wave_barrier();
    }
  }
}

DI void ph_peer(const Params& p, int g0_, int g1_, int gstride, bool dry = false) {
  const int tid = otid(), lane = tid & 63, wv = tid >> 6;
  constexpr int ST = 1104;
  char* wb = dsm + wv * (16 * ST + 2048);
  unsigned char* stg = (unsigned char*)wb;
  unsigned char* hs = stg + 16 * ST;
  float* acts = (float*)(hs + 1024);
  int* idxs = (int*)(hs + 1536);
  const int gr = lane >> 3, gc = lane & 7;
  const int* IDX = (const int*)p.G;
  const float* GATE = (const float*)p.OATT;
  const unsigned char* H8 = (const unsigned char*)p.Y;
  const int n = lane & 15, quad = lane >> 4;
  for (int g = g0_; g < g1_; g += gstride) {
    *(u32x4*)(hs + lane * 16) = *(const u32x4*)(H8 + (size_t)g * 1024 + lane * 16);
    idxs[lane] = IDX[(size_t)g * 128 + lane];
    idxs[lane + 64] = IDX[(size_t)g * 128 + 64 + lane];
    const float shv = p.SH[g];
    __builtin_amdgcn_fence(__ATOMIC_RELEASE, "workgroup");
    __builtin_amdgcn_wave_barrier();
    {
      u32x4 ring[16];
      {
        const unsigned char* ua = p.U8 + (size_t)idxs[gr] * 1024 + gc * 16;
        const unsigned char* ub = p.U8 + (size_t)idxs[8 + gr] * 1024 + gc * 16;
#pragma unroll
        for (int i = 0; i < 8; i++) { ring[i] = *(const u32x4*)(ua + i * 128); ring[8 + i] = *(const u32x4*)(ub + i * 128); }
      }
#pragma unroll 1
      for (int grp = 0; grp < 8; grp++) {
        const int gn = grp < 7 ? grp + 1 : grp;
        const unsigned char* ua = p.U8 + (size_t)idxs[gn * 16 + gr] * 1024 + gc * 16;
        const unsigned char* ub = p.U8 + (size_t)idxs[gn * 16 + 8 + gr] * 1024 + gc * 16;
        const float4 gt = *(const float4*)(GATE + (size_t)g * 128 + grp * 16 + quad * 4);
        const int4 ee = *(const int4*)(idxs + grp * 16 + quad * 4);
        const float su0 = p.SU[ee.x], su1 = p.SU[ee.y], su2 = p.SU[ee.z], su3 = p.SU[ee.w];
        const float sv0 = p.SV[ee.x], sv1 = p.SV[ee.y], sv2 = p.SV[ee.z], sv3 = p.SV[ee.w];
#pragma unroll
        for (int i = 0; i < 8; i++) {
          *(u32x4*)(stg + gr * ST + i * 128 + gc * 16) = ring[i];
          *(u32x4*)(stg + (8 + gr) * ST + i * 128 + gc * 16) = ring[8 + i];
          if (grp < 7) { ring[i] = *(const u32x4*)(ua + i * 128); ring[8 + i] = *(const u32x4*)(ub + i * 128); }
        }
        __builtin_amdgcn_fence(__ATOMIC_RELEASE, "workgroup");
        __builtin_amdgcn_wave_barrier();
        f32x4 acc = {0.f, 0.f, 0.f, 0.f};
#pragma unroll
        for (int st = 0; st < 16; st++) {
          const u32x4 ua4 = *(const u32x4*)(stg + n * ST + st * 64 + quad * 16);
          const u32x4 hb = *(const u32x4*)(hs + st * 64 + quad * 16);
          const long a0 = (long)(((unsigned long)ua4[1] << 32) | ua4[0]);
          const long a1 = (long)(((unsigned long)ua4[3] << 32) | ua4[2]);
          const long b0 = (long)(((unsigned long)hb[1] << 32) | hb[0]);
          const long b1 = (long)(((unsigned long)hb[3] << 32) | hb[2]);
          acc = __builtin_amdgcn_mfma_f32_16x16x32_fp8_fp8(a0, b0, acc, 0, 0, 0);
          acc = __builtin_amdgcn_mfma_f32_16x16x32_fp8_fp8(a1, b1, acc, 0, 0, 0);
        }
        __builtin_amdgcn_wave_barrier();
        const float d0 = acc[0] * shv * su0, d1 = acc[1] * shv * su1, d2 = acc[2] * shv * su2, d3 = acc[3] * shv * su3;
        float4 av;
        av.x = 0.5f * d0 * (1.f + erff(d0 * 0.70710678118f)) * gt.x * sv0;
        av.y = 0.5f * d1 * (1.f + erff(d1 * 0.70710678118f)) * gt.y * sv1;
        av.z = 0.5f * d2 * (1.f + erff(d2 * 0.70710678118f)) * gt.z * sv2;
        av.w = 0.5f * d3 * (1.f + erff(d3 * 0.70710678118f)) * gt.w * sv3;
        if (n == 0) *(float4*)(acts + grp * 16 + quad * 4) = av;
      }
    }
    __builtin_amdgcn_fence(__ATOMIC_RELEASE, "workgroup");
    __builtin_amdgcn_wave_barrier();
    float o[16];
#pragma unroll
    for (int j = 0; j < 16; j++) o[j] = 0.f;
    {
      u32x4 ring[16];
#pragma unroll
      for (int k = 0; k < 16; k++) ring[k] = *(const u32x4*)(p.V8 + (size_t)idxs[k] * 1024 + lane * 16);
#pragma unroll 1
      for (int kb = 0; kb < 128; kb += 16) {
        const bool more = kb < 112;
        const int kn = more ? kb + 16 : kb;
#pragma unroll
        for (int j = 0; j < 16; j++) {
          const u32x4 vq = ring[j];
          if (more) ring[j] = *(const u32x4*)(p.V8 + (size_t)idxs[kn + j] * 1024 + lane * 16);
          const float a = acts[kb + j];
#pragma unroll
          for (int q = 0; q < 4; q++) {
            const f32x2 lo = __builtin_amdgcn_cvt_pk_f32_fp8((int)vq[q], false);
            const f32x2 hi = __builtin_amdgcn_cvt_pk_f32_fp8((int)vq[q], true);
            o[4 * q] += a * lo[0]; o[4 * q + 1] += a * lo[1]; o[4 * q + 2] += a * hi[0]; o[4 * q + 3] += a * hi[1];
          }
        }
      }
    }
    float* xr = p.out + (size_t)g * 1024 + lane * 16;
    float4 x[4];
    {
      const u32x4 xa = *(const u32x4*)(p.P + (size_t)g * 1024 + lane * 16), xb = *(const u32x4*)(p.P + (size_t)g * 1024 + lane * 16 + 8);
      x[0] = make_float4(bflo(xa[0]), bfhi(xa[0]), bflo(xa[1]), bfhi(xa[1]));
      x[1] = make_float4(bflo(xa[2]), bfhi(xa[2]), bflo(xa[3]), bfhi(xa[3]));
      x[2] = make_float4(bflo(xb[0]), bfhi(xb[0]), bflo(xb[1]), bfhi(xb[1]));
      x[3] = make_float4(bflo(xb[2]), bfhi(xb[2]), bflo(xb[3]), bfhi(xb[3]));
    }
    float ss = 0.f;
#pragma unroll
    for (int q = 0; q < 4; q++) {
      x[q].x += o[4 * q]; x[q].y += o[4 * q + 1]; x[q].z += o[4 * q + 2]; x[q].w += o[4 * q + 3];
      ss += x[q].x * x[q].x + x[q].y * x[q].y + x[q].z * x[q].z + x[q].w * x[q].w;
    }
    ss = wave_sum(ss);
    if (dry && ss != 123.456f) continue;
    const float rs = rsqrtf(ss * (1.f / 1024.f) + 1e-6f);
#pragma unroll
    for (int q = 0; q < 4; q++) {
      const float4 gq = *(const float4*)(p.final_g + lane * 16 + q * 4);
      *(float4*)(xr + q * 4) = make_float4(x[q].x * rs * gq.x, x[q].y * rs * gq.y, x[q].z * rs * gq.z, x[q].w * rs * gq.w);
    }
  }
}

#define XB_TMO      128
#define XB_XCNT(j)  (256  + 64 * (j))
#define XB_XSUB(j)  (1280 + 64 * (j))
#define XB_XGEN(j)  (2304 + 64 * (j))
#define XB_TOP      3328
#define XB_TOPGEN   3392
#define XCD_BAR_WORDS 3456
#define XB_SPIN_CAP (1u << 18)
#define LAS __attribute__((address_space(3)))
DI unsigned xb_ld(unsigned* p) { return __hip_atomic_load(p, __ATOMIC_RELAXED, __HIP_MEMORY_SCOPE_AGENT); }
DI unsigned xb_add(unsigned* p, unsigned v) { return __hip_atomic_fetch_add(p, v, __ATOMIC_RELAXED, __HIP_MEMORY_SCOPE_AGENT); }
DI unsigned xb_xcc_id() { return (unsigned)__builtin_amdgcn_s_getreg((3 << 11) | 20) & 0xFu; }
#define XB_SPIN(cond, bar) do { unsigned _sp = 0; while (cond) { __builtin_amdgcn_s_sleep(1); \
    if ((++_sp & 255u) == 0u) { if (xb_ld(&(bar)[XB_TMO])) break; if (_sp > XB_SPIN_CAP) { atomicAdd(&(bar)[XB_TMO], 1u); break; } } } } while (0)
struct XcdBarrier { unsigned* bar; unsigned x; volatile LAS unsigned* st; };
DI XcdBarrier xcd_barrier_post(unsigned* bar, volatile LAS unsigned* st) {
  XcdBarrier b; b.bar = bar; b.x = xb_xcc_id(); b.st = st;
  if (threadIdx.x == 0) (void)xb_add(&bar[XB_XCNT(b.x)], 1u);
  return b;
}
DI void xcd_barrier_complete(unsigned* bar, unsigned x, unsigned& nloc, unsigned& nx) {
  const unsigned G = gridDim.x * gridDim.y * gridDim.z;
  unsigned sum, cnt, mine, sp = 0u;
  for (;;) {
    sum = 0u; cnt = 0u; mine = 0u;
#pragma unroll
    for (unsigned j = 0; j < 16; ++j) { const unsigned c = xb_ld(&bar[XB_XCNT(j)]); sum += c; cnt += (c > 0u) ? 1u : 0u; mine = (j == x) ? c : mine; }
    if (sum == G) break;
    __builtin_amdgcn_s_sleep(1);
    if ((++sp & 255u) == 0u) { if (xb_ld(&bar[XB_TMO])) break; if (sp > XB_SPIN_CAP) { atomicAdd(&bar[XB_TMO], 1u); break; } }
  }
  nloc = mine > 0u ? mine : 1u; nx = cnt > 0u ? cnt : 1u;
}
DI void xcd_barrier(const XcdBarrier& b) {
  asm volatile("s_waitcnt vmcnt(0)" ::: "memory");
  __syncthreads();
  if (threadIdx.x == 0) {
    unsigned* bar = b.bar;
    __builtin_amdgcn_s_waitcnt(0);
    unsigned nloc = b.st[0], nx = b.st[1];
    if (nloc == 0u) { xcd_barrier_complete(bar, b.x, nloc, nx); b.st[0] = nloc; b.st[1] = nx; }
    const unsigned old = xb_add(&bar[XB_XSUB(b.x)], 1u);
    const unsigned gen = old / nloc;
    if (old + 1u == (gen + 1u) * nloc) {
      __builtin_amdgcn_fence(__ATOMIC_RELEASE, "agent");
      asm volatile("s_waitcnt vmcnt(0)" ::: "memory");
      const unsigned og = xb_add(&bar[XB_TOP], 1u);
      const unsigned tg = og / nx;
      if (og + 1u == (tg + 1u) * nx) xb_add(&bar[XB_TOPGEN], 1u);
      else XB_SPIN(xb_ld(&bar[XB_TOPGEN]) == tg, bar);
      __builtin_amdgcn_fence(__ATOMIC_ACQUIRE, "agent");
      xb_add(&bar[XB_XGEN(b.x)], 1u);
      asm volatile("s_waitcnt vmcnt(0)" ::: "memory");
    } else {
      XB_SPIN(xb_ld(&bar[XB_XGEN(b.x)]) == gen, bar);
      __builtin_amdgcn_fence(__ATOMIC_ACQUIRE, "agent");
      asm volatile("s_waitcnt vmcnt(0)" ::: "memory");
    }
  }
  __syncthreads();
}

__global__ void __launch_bounds__(512) mega_kernel(Params p) {
  cg::grid_group grid = cg::this_grid();
  const int bid = blockIdx.x, nb = gridDim.x;
  __shared__ uint4 xb_words;
  if (threadIdx.x == 0) xb_words = make_uint4(0u, 0u, 0u, 0u);
  __syncthreads();
  const XcdBarrier xb = xcd_barrier_post(p.bar, (volatile LAS unsigned*)&xb_words);
  if (ON(0)) ph_prep(p, bid, nb);
  xcd_barrier(xb);
  if (nb == 0x7fffffff) grid.sync();
  if (ON(1)) ph_gemm1(p, bid, nb);
  xcd_barrier(xb);
  if (REP == 1) { ph_gemm1(p, bid, nb); xcd_barrier(xb); }
  if (ON(2)) ph_rwprep(p, bid, nb);
  xcd_barrier(xb);
  if (REP == 2) { ph_rwprep(p, bid, nb); xcd_barrier(xb); }
  if (ON(3)) ph_scan(p, bid, nb);
  xcd_barrier(xb);
  if (REP == 3) { ph_scan(p, bid, nb); xcd_barrier(xb); }
  if (REP == 4) { ph_attn(p, bid, nb, true); xcd_barrier(xb); }
  if (ON(4)) ph_attn(p, bid, nb);
  xcd_barrier(xb);
  if (ON(5)) ph_gemm2(p, bid, nb);
  xcd_barrier(xb);
  if (ON(6)) ph_gemm3(p, bid, nb);
  xcd_barrier(xb);
  if (ON(7)) ph_norm2(p, bid * NW + (otid() >> 6), TP, nb * NW);
  xcd_barrier(xb);
  if (ON(8)) ph_peerq(p, bid, nb);
  xcd_barrier(xb);
  if (ON(9)) {
    if (bid < 4) {
      const int wv_ = otid() >> 6;
      ph_gemm2(p, bid, nb, bid);
      __builtin_amdgcn_fence(__ATOMIC_RELEASE, "agent"); __syncthreads(); __builtin_amdgcn_fence(__ATOMIC_ACQUIRE, "agent");
      ph_gemm3(p, bid, nb, bid);
      __builtin_amdgcn_fence(__ATOMIC_RELEASE, "agent"); __syncthreads(); __builtin_amdgcn_fence(__ATOMIC_ACQUIRE, "agent");
      ph_norm2(p, (256 + bid) * 256 + wv_, (256 + bid) * 256 + 256, NW);
      __builtin_amdgcn_fence(__ATOMIC_RELEASE, "agent"); __syncthreads(); __builtin_amdgcn_fence(__ATOMIC_ACQUIRE, "agent");
      ph_peerq(p, bid, nb, bid);
    } else {
      ph_peer(p, (bid - 4) * NW + (otid() >> 6), TP, (nb - 4) * NW);
    }
  }
  xcd_barrier(xb);
  if (ON(9)) ph_peer(p, TP + bid * NW + (otid() >> 6), T, nb * NW);
}

extern "C" void kernel_launch(void* const* d_in, const int* in_sizes, int n_in, void* d_out, int out_size, void* d_ws,
                              size_t ws_size, hipStream_t stream) {
  Params p{};
  const float** f = (const float**)&p;
  for (int i = 0; i < 28; i++) f[i] = (const float*)d_in[i];
  p.out = (float*)d_out;
  char* w = (char*)d_ws;
  size_t off = 0;
  auto take = [&](size_t bytes) { char* r = w + off; off += (bytes + 255) & ~(size_t)255; return (u16*)r; };
  p.H = take((size_t)MP * 1024 * 2);
  p.P = take((size_t)MP * INC * 2);
  p.U8 = (unsigned char*)take((size_t)16384 * 1024);
  p.V8 = (unsigned char*)take((size_t)16384 * 1024);
  p.SU = (float*)take(16384 * 4);
  p.SV = (float*)take(16384 * 4);
  p.SH = (float*)take((size_t)T * 4);
  p.bar = (unsigned*)take((size_t)XCD_BAR_WORDS * 4);
  p.WinT = take((size_t)4608 * 1024 * 2);
  p.WbT = take((size_t)2 * 1024 * 512 * 2);
  p.WoutT = take((size_t)1024 * 1024 * 2);
  p.WqT = take((size_t)1024 * 1024 * 2);
  p.W2T = take((size_t)512 * 64 * 2);
  p.A2T = take((size_t)512 * 64 * 2);
  p.G2T = take((size_t)512 * 128 * 2);
  p.SK = take((size_t)2 * 128 * 64 * 2);
  p.Y = take((size_t)T * 512 * 2);
  p.G = take((size_t)T * 512 * 2);
  p.OATT = take((size_t)T * 512 * 2);
  static int grid_blocks = 0;
  if (!grid_blocks) {
    int dev = 0, cus = 0, per_cu = 0;
    (void)hipGetDevice(&dev);
    (void)hipDeviceGetAttribute(&cus, hipDeviceAttributeMultiprocessorCount, dev);
    (void)hipFuncSetAttribute((const void*)mega_kernel, hipFuncAttributeMaxDynamicSharedMemorySize, DYN_LDS);
    (void)hipOccupancyMaxActiveBlocksPerMultiprocessor(&per_cu, mega_kernel, NTH, DYN_LDS);
    if (per_cu > 1) per_cu = 1;
    grid_blocks = cus * per_cu;
  }
  (void)hipMemsetAsync(p.bar, 0, (size_t)XCD_BAR_WORDS * 4, stream);
  void* args[] = {&p};
  hipError_t e = hipLaunchCooperativeKernel((void*)mega_kernel, dim3(grid_blocks), dim3(NTH), args, DYN_LDS, stream);
  if (e != hipSuccess) fprintf(stderr, "cooperative launch failed: %s (grid %d)\n", hipGetErrorString(e), grid_blocks);
}
```

```cpp
#include <hip/hip_runtime.h>
#include <hip/hip_cooperative_groups.h>
#include <cstdio>
namespace cg = cooperative_groups;

#ifndef REP
#define REP -1
#endif
#ifndef ONLY
#define ONLY -1
#endif
#define ON(k) (ONLY < 0 || ONLY == (k))

typedef unsigned short u16;
typedef unsigned int u32;
using bf16x8 = __attribute__((ext_vector_type(8))) short;
using f32x4 = __attribute__((ext_vector_type(4))) float;
using f32x16 = __attribute__((ext_vector_type(16))) float;
using u32x4 = __attribute__((ext_vector_type(4))) u32;
#define DI __device__ __forceinline__

constexpr int TP = 65536, TS = 1024, T = 66560, MP = 66816;
constexpr int INC = 4608;
constexpr int NW = 8;
constexpr int NTH = 512;
constexpr size_t OFF_Y = 0, OFF_SHIFT_P = 68157440, OFF_WKV_P = 68173824, OFF_KP = 68698112, OFF_VP = 68960256,
                 OFF_SHIFT_S = 69222400, OFF_WKV_S = 69238784, OFF_KS = 69763072, OFF_VS = 69894144;
constexpr int DYN_LDS = 159744;

extern __shared__ __attribute__((aligned(16))) char dsm[];

struct Params {
  const float *x_prompt, *x_sample, *state_shift, *state_wkv, *cache_k, *cache_v, *norm1_g, *w_in, *mu, *w0, *w2, *a0,
      *a2, *g2, *k_k, *k_a, *r_k, *lnx_w, *lnx_b, *sinks, *w_branch, *w_out, *norm2_g, *peer_wq, *sub_keys, *peer_u,
      *peer_v, *final_g;
  float* out;
  u16 *H, *P, *WinT, *WbT, *WoutT, *WqT, *W2T, *A2T, *G2T, *SK, *Y, *G, *OATT;
  unsigned char *U8, *V8;
  float *SU, *SV, *SH;
  unsigned* bar;
};

typedef __bf16 hbf2 __attribute__((ext_vector_type(2)));
typedef float hf2 __attribute__((ext_vector_type(2)));
DI u16 f2bf(float x) { const __bf16 r = (__bf16)x; return __builtin_bit_cast(unsigned short, r); }
DI float bf2f(u16 b) { return __uint_as_float(((u32)b) << 16); }
DI u32 pack2(float a, float b) { const hf2 v = {a, b}; const hbf2 r = __builtin_convertvector(v, hbf2); return __builtin_bit_cast(u32, r); }
DI float bflo(u32 w) { return __uint_as_float(w << 16); }
DI float bfhi(u32 w) { return __uint_as_float(w & 0xffff0000u); }
DI float wave_sum(float v) {
#pragma unroll
  for (int o = 32; o; o >>= 1) v += __shfl_xor(v, o);
  return v;
}
DI float sigmoidf_(float x) { return 1.f / (1.f + __expf(-x)); }
DI const float* xrow(const Params& p, int g) {
  return g < TP ? p.x_prompt + (size_t)g * 1024 : p.x_sample + (size_t)(g - TP) * 1024;
}
DI int otid() { int t = threadIdx.x; asm volatile("" : "+v"(t)); return t; }
#define MFMA32(a, b, c) __builtin_amdgcn_mfma_f32_32x32x16_bf16((a), (b), (c), 0, 0, 0)
#define MFMA16(a, b, c) __builtin_amdgcn_mfma_f32_16x16x32_bf16((a), (b), (c), 0, 0, 0)

template <int CTRL>
DI float dppmov(float v) {
  return __int_as_float(__builtin_amdgcn_update_dpp(0, __float_as_int(v), CTRL, 0xF, 0xF, false));
}
DI float red16(float v) {
  v += dppmov<0x128>(v);
  v += dppmov<0x124>(v);
  v += dppmov<0x122>(v);
  v += dppmov<0x121>(v);
  return v;
}


using f32x2 = __attribute__((ext_vector_type(2))) float;
DI float wave_max(float v) {
#pragma unroll
  for (int o = 32; o; o >>= 1) v = fmaxf(v, __shfl_xor(v, o));
  return v;
}
DI u32 q4(float a, float b, float c, float d, float sc) {
  int w = 0;
  w = __builtin_amdgcn_cvt_pk_fp8_f32(a * sc, b * sc, w, false);
  w = __builtin_amdgcn_cvt_pk_fp8_f32(c * sc, d * sc, w, true);
  return (u32)w;
}

DI void tcvt(const float* __restrict__ W, u16* __restrict__ Wt, int K, int N, int gt, int nt) {
  const int total = N * (K / 8);
  for (int i = gt; i < total; i += nt) {
    const int n = i % N, kg = i / N;
    u32 o[4];
#pragma unroll
    for (int j = 0; j < 4; j++)
      o[j] = pack2(W[(size_t)(kg * 8 + 2 * j) * N + n], W[(size_t)(kg * 8 + 2 * j + 1) * N + n]);
    *(uint4*)(Wt + (size_t)n * K + kg * 8) = make_uint4(o[0], o[1], o[2], o[3]);
  }
}
DI void scvt(const float* __restrict__ W, u16* __restrict__ O, int n8, int gt, int nt) {
  for (int i = gt; i < n8; i += nt) {
    const float4 a = ((const float4*)W)[2 * i], b = ((const float4*)W)[2 * i + 1];
    ((uint4*)O)[i] = make_uint4(pack2(a.x, a.y), pack2(a.z, a.w), pack2(b.x, b.y), pack2(b.z, b.w));
  }
}

__device__ void ph_prep(const Params& p, int bid, int nb) {
  const int tid = otid(), lane = tid & 63, wv = tid >> 6;
  for (int row = bid * NW + wv; row < MP; row += nb * NW) {
    u16* hr = p.H + (size_t)row * 1024;
    if (row < T) {
      const float4* x = (const float4*)xrow(p, row);
      float4 v[4];
      float ss = 0.f;
#pragma unroll
      for (int i = 0; i < 4; i++) {
        v[i] = x[lane + i * 64];
        ss += v[i].x * v[i].x + v[i].y * v[i].y + v[i].z * v[i].z + v[i].w * v[i].w;
      }
      ss = wave_sum(ss);
      const float rs = rsqrtf(ss * (1.f / 1024.f) + 1e-6f);
      float* so = nullptr;
      if (row < TP) {
        if ((row & 4095) == 4095) so = p.out + OFF_SHIFT_P + (size_t)(row >> 12) * 1024;
      } else {
        const int r2 = row - TP;
        if ((r2 & 63) == 63) so = p.out + OFF_SHIFT_S + (size_t)(r2 >> 6) * 1024;
      }
#pragma unroll
      for (int i = 0; i < 4; i++) {
        const float4 g = ((const float4*)p.norm1_g)[lane + i * 64];
        float4 y;
        y.x = v[i].x * rs * g.x; y.y = v[i].y * rs * g.y; y.z = v[i].z * rs * g.z; y.w = v[i].w * rs * g.w;
        ((uint2*)hr)[lane + i * 64] = make_uint2(pack2(y.x, y.y), pack2(y.z, y.w));
        if (so) ((float4*)so)[lane + i * 64] = y;
      }
    } else if (row < T + 16) {
      const float4* x = (const float4*)(p.state_shift + (size_t)(row - T) * 1024);
#pragma unroll
      for (int i = 0; i < 4; i++) {
        const float4 y = x[lane + i * 64];
        ((uint2*)hr)[lane + i * 64] = make_uint2(pack2(y.x, y.y), pack2(y.z, y.w));
      }
    } else {
#pragma unroll
      for (int i = 0; i < 4; i++) ((uint2*)hr)[lane + i * 64] = make_uint2(0u, 0u);
    }
  }
  const int gt = bid * NTH + tid, nt = nb * NTH;
  tcvt(p.w_in, p.WinT, 1024, 4608, gt, nt);
  tcvt(p.w_branch, p.WbT, 512, 1024, gt, nt);
  tcvt(p.w_branch + 512 * 1024, p.WbT + 1024 * 512, 512, 1024, gt, nt);
  tcvt(p.w_out, p.WoutT, 1024, 1024, gt, nt);
  tcvt(p.peer_wq, p.WqT, 1024, 1024, gt, nt);
  tcvt(p.w2, p.W2T, 64, 512, gt, nt);
  tcvt(p.a2, p.A2T, 64, 512, gt, nt);
  tcvt(p.g2, p.G2T, 128, 512, gt, nt);
  scvt(p.sub_keys, p.SK, 2 * 128 * 64 / 8, gt, nt);
  for (int r = bid * NW + wv; r < 32768; r += nb * NW) {
    const bool isv = r >= 16384;
    const int e = r & 16383;
    const float4* src = (const float4*)((isv ? p.peer_v : p.peer_u) + (size_t)e * 1024) + lane * 4;
    const float4 a = src[0], b = src[1], c = src[2], d = src[3];
    float am = fmaxf(fmaxf(fmaxf(fabsf(a.x), fabsf(a.y)), fmaxf(fabsf(a.z), fabsf(a.w))),
                     fmaxf(fmaxf(fabsf(b.x), fabsf(b.y)), fmaxf(fabsf(b.z), fabsf(b.w))));
    am = fmaxf(am, fmaxf(fmaxf(fmaxf(fabsf(c.x), fabsf(c.y)), fmaxf(fabsf(c.z), fabsf(c.w))),
                         fmaxf(fmaxf(fabsf(d.x), fabsf(d.y)), fmaxf(fabsf(d.z), fabsf(d.w)))));
    am = fmaxf(wave_max(am), 1e-30f);
    const float sc = 240.f / am;
    if (lane == 0) (isv ? p.SV : p.SU)[e] = am * (1.f / 240.f);
    *(u32x4*)((isv ? p.V8 : p.U8) + (size_t)e * 1024 + lane * 16) =
        u32x4{q4(a.x, a.y, a.z, a.w, sc), q4(b.x, b.y, b.z, b.w, sc), q4(c.x, c.y, c.z, c.w, sc), q4(d.x, d.y, d.z, d.w, sc)};
  }
}

constexpr int GBK = 64, GHALF = 128, GHT = GHALF * GBK;
DI int lds_byte(int r, int c) {
  const int st = (r >> 4) * 2 + (c >> 5), rr = r & 15, cc = c & 31, ob = rr * 64 + cc * 2;
  return st * 1024 + (ob ^ (((ob >> 9) & 1) << 5));
}
DI void stage_rc(int b, int& R, int& C) {
  const int st = b / 1024, sb = b % 1024, swz = sb ^ (((sb >> 9) & 1) << 5);
  R = (st >> 1) * 16 + swz / 64;
  C = (st & 1) * 32 + (swz % 64) / 2;
}
typedef __attribute__((address_space(3))) unsigned lds_u32;
#define G_SA(b, h) (shm + ((b) * 2 + (h)) * GHT)
#define G_SB(b, h) (shm + (4 + (b) * 2 + (h)) * GHT)
#define G_STAGE(P_, RS, br, kt)                                                                                   \
  do {                                                                                                            \
    const int _so = ((br) * K + (kt) * GBK) * 2;                                                                  \
    __builtin_amdgcn_raw_ptr_buffer_load_lds(RS, (lds_u32*)((char*)(P_) + tb0), 16, ob0, _so, 0, 0);              \
    __builtin_amdgcn_raw_ptr_buffer_load_lds(RS, (lds_u32*)((char*)(P_) + tb0 + 8192), 16, ob1, _so, 0, 0);       \
  } while (0)
#define G_LDA(dst, b, h)                                  \
  _Pragma("unroll") for (int m = 0; m < 4; ++m)           \
  _Pragma("unroll") for (int k = 0; k < 2; ++k)           \
    dst[m][k] = *reinterpret_cast<const bf16x8*>((const char*)G_SA(b, h) + lds_byte(wr * 64 + m * 16 + fr, k * 32 + fq * 8))
#define G_LDB(dst, b, h)                                  \
  _Pragma("unroll") for (int n = 0; n < 2; ++n)           \
  _Pragma("unroll") for (int k = 0; k < 2; ++k)           \
    dst[n][k] = *reinterpret_cast<const bf16x8*>((const char*)G_SB(b, h) + lds_byte(wc * 32 + n * 16 + fr, k * 32 + fq * 8))
#define G_MMA(ai, bj, At_, Bt_)                                                                         \
  do {                                                                                                  \
    __builtin_amdgcn_s_setprio(1);                                                                      \
    _Pragma("unroll") for (int m = 0; m < 4; ++m)                                                       \
    _Pragma("unroll") for (int n = 0; n < 2; ++n)                                                       \
    _Pragma("unroll") for (int k = 0; k < 2; ++k)                                                       \
      acc[ai][bj][m][n] = MFMA16(At_[m][k], Bt_[n][k], acc[ai][bj][m][n]);                              \
    __builtin_amdgcn_s_setprio(0);                                                                      \
  } while (0)
#define WAIT_V(n) asm volatile("s_waitcnt vmcnt(" #n ")" ::: "memory")
#define WAIT_L(n) asm volatile("s_waitcnt lgkmcnt(" #n ")" ::: "memory")
#define BAR __builtin_amdgcn_s_barrier()
#define SCHED __builtin_amdgcn_sched_barrier(0)

template <int K>
DI void gemm256(const u16* __restrict__ A, const u16* __restrict__ Bt, const int brow, const int bcol,
                f32x4 (&acc)[2][2][4][2]) {
  u16* shm = (u16*)dsm;
  const int tid_ = otid();
  const int wid = tid_ >> 6, lane = tid_ & 63, wr = wid >> 2, wc = wid & 3, fr = lane & 15, fq = lane >> 4;
#pragma unroll
  for (int a = 0; a < 2; a++)
#pragma unroll
    for (int b = 0; b < 2; b++)
#pragma unroll
      for (int m = 0; m < 4; m++)
#pragma unroll
        for (int n = 0; n < 2; n++) acc[a][b][m][n] = f32x4{0.f, 0.f, 0.f, 0.f};
  bf16x8 At[4][2], B0[2][2], B1[2][2];
  constexpr int nt = K / GBK;
  const __amdgpu_buffer_rsrc_t rsA = __builtin_amdgcn_make_buffer_rsrc((void*)A, 0, 0x7fffffff, 0x00020000);
  const __amdgpu_buffer_rsrc_t rsB = __builtin_amdgcn_make_buffer_rsrc((void*)Bt, 0, 0x7fffffff, 0x00020000);
  const unsigned tb0 = tid_ * 16;
  int ob0, ob1;
  {
    int r_, c_;
    stage_rc((int)tb0, r_, c_);
    ob0 = (r_ * K + c_) * 2;
    stage_rc((int)tb0 + 8192, r_, c_);
    ob1 = (r_ * K + c_) * 2;
  }
  WAIT_V(0);
  __syncthreads();
  G_STAGE(G_SB(0, 0), rsB, bcol, 0); G_STAGE(G_SA(0, 0), rsA, brow, 0);
  G_STAGE(G_SB(0, 1), rsB, bcol + GHALF, 0); G_STAGE(G_SA(0, 1), rsA, brow + GHALF, 0);
  if (wr == 1) BAR;
  WAIT_V(4); BAR;
  G_STAGE(G_SB(1, 0), rsB, bcol, 1); G_STAGE(G_SA(1, 0), rsA, brow, 1); G_STAGE(G_SB(1, 1), rsB, bcol + GHALF, 1);
  WAIT_V(6); BAR;
  for (int t = 0; t < nt - 2; t += 2) {
    G_LDB(B0, 0, 0); SCHED; G_LDA(At, 0, 0); G_STAGE(G_SA(1, 1), rsA, brow + GHALF, t + 1);
    WAIT_L(8); BAR; WAIT_L(0); G_MMA(0, 0, At, B0); BAR; SCHED;
    G_LDB(B1, 0, 1); G_STAGE(G_SB(0, 0), rsB, bcol, t + 2);
    BAR; WAIT_L(0); G_MMA(0, 1, At, B1); BAR;
    G_LDA(At, 0, 1); G_STAGE(G_SA(0, 0), rsA, brow, t + 2);
    BAR; WAIT_L(0); G_MMA(1, 0, At, B0); BAR; SCHED;
    G_STAGE(G_SB(0, 1), rsB, bcol + GHALF, t + 2);
    WAIT_V(6); BAR; G_MMA(1, 1, At, B1); BAR;
    G_LDB(B0, 1, 0); SCHED; G_LDA(At, 1, 0); G_STAGE(G_SA(0, 1), rsA, brow + GHALF, t + 2);
    WAIT_L(8); BAR; WAIT_L(0); G_MMA(0, 0, At, B0); BAR; SCHED;
    G_LDB(B1, 1, 1); G_STAGE(G_SB(1, 0), rsB, bcol, t + 3);
    BAR; WAIT_L(0); G_MMA(0, 1, At, B1); BAR;
    G_LDA(At, 1, 1); G_STAGE(G_SA(1, 0), rsA, brow, t + 3);
    BAR; WAIT_L(0); G_MMA(1, 0, At, B0); BAR; SCHED;
    G_STAGE(G_SB(1, 1), rsB, bcol + GHALF, t + 3);
    WAIT_V(6); BAR; G_MMA(1, 1, At, B1); BAR;
  }
  {
    G_LDB(B0, 0, 0); G_LDA(At, 0, 0); G_STAGE(G_SA(1, 1), rsA, brow + GHALF, nt - 1);
    BAR; WAIT_L(0); G_MMA(0, 0, At, B0); BAR;
    G_LDB(B1, 0, 1); BAR; WAIT_L(0); G_MMA(0, 1, At, B1); BAR;
    G_LDA(At, 0, 1); WAIT_V(4); BAR; WAIT_L(0); G_MMA(1, 0, At, B0); G_MMA(1, 1, At, B1); BAR;
  }
  {
    G_LDB(B0, 1, 0); G_LDA(At, 1, 0); WAIT_V(2); BAR; WAIT_L(0); G_MMA(0, 0, At, B0); BAR;
    G_LDB(B1, 1, 1); WAIT_V(0); BAR; WAIT_L(0); G_MMA(0, 1, At, B1); BAR;
    G_LDA(At, 1, 1); BAR; WAIT_L(0); G_MMA(1, 0, At, B0); G_MMA(1, 1, At, B1); BAR;
  }
  if (wr == 0) BAR;
}
#define GT_VARS \
  const int tid_ = otid(); const int wid = tid_ >> 6, lane = tid_ & 63, wr = wid >> 2, wc = wid & 3, fr = lane & 15, fq = lane >> 4;
#define GT_ROW(ai, m, j) ((ai) * 128 + wr * 64 + (m) * 16 + fq * 4 + (j))
#define GT_COL(bj, n) ((bj) * 128 + wc * 32 + (n) * 16 + fr)
#define GT_FOR                                       \
  _Pragma("unroll") for (int ai = 0; ai < 2; ++ai)   \
  _Pragma("unroll") for (int bj = 0; bj < 2; ++bj)   \
  _Pragma("unroll") for (int m = 0; m < 4; ++m)      \
  _Pragma("unroll") for (int n = 0; n < 2; ++n)      \
  _Pragma("unroll") for (int j = 0; j < 4; ++j)

DI bool tile_of(int round, int bid, int nb, int nM, int nN, int& pm, int& pn) {
  const int vt = round * nb + (bid & 7) * (nb >> 3) + (bid >> 3);
  if (vt >= nM * nN) return false;
  const int nig = 8 * nN, gid = vt / nig, fm = gid * 8, gsz = min(nM - fm, 8);
  pm = fm + (vt % nig) % gsz;
  pn = (vt % nig) / gsz;
  return true;
}


constexpr int CS_LD = 264;
DI void acc_to_lds(const f32x4 (&acc)[2][2][4][2]) {
  GT_VARS
  u16* Cs = (u16*)dsm;
  __syncthreads();
  GT_FOR { Cs[GT_ROW(ai, m, j) * CS_LD + GT_COL(bj, n)] = f2bf(acc[ai][bj][m][n][j]); }
  __syncthreads();
}

__device__ void ph_gemm1(const Params& p, int bid, int nb) {
  const int tid_ = otid();
  const int nM = 261, nN = 18;
  for (int round = 0; round * nb < nM * nN; ++round) {
    int pm, pn;
    if (!tile_of(round, bid, nb, nM, nN, pm, pn)) break;
    f32x4 acc[2][2][4][2];
    gemm256<1024>(p.H, p.WinT, pm * 256, pn * 256, acc);
    acc_to_lds(acc);
    const u16* Cs = (const u16*)dsm;
#pragma unroll 4
    for (int it = 0; it < 16; it++) {
      const int id = it * NTH + tid_, rl = id >> 5, c8 = (id & 31) * 8;
      const int row = pm * 256 + rl;
      const u32x4 v = *(const u32x4*)(Cs + rl * CS_LD + c8);
      *(u32x4*)(p.P + (size_t)row * INC + pn * 256 + c8) = v;
      if (pn == 9) {
        float* dst = nullptr;
        const int c2 = c8 & 127;
        if (row < TP) {
          const int tt = row & 4095;
          if (tt >= 3968) dst = p.out + (c8 < 128 ? OFF_KP : OFF_VP) + ((size_t)(row >> 12) * 128 + (tt - 3968)) * 128 + c2;
        } else if (row < T) {
          dst = p.out + (c8 < 128 ? OFF_KS : OFF_VS) + (size_t)(row - TP) * 128 + c2;
        }
        if (dst) {
          *(float4*)dst = make_float4(bflo(v[0]), bfhi(v[0]), bflo(v[1]), bfhi(v[1]));
          *(float4*)(dst + 4) = make_float4(bflo(v[2]), bfhi(v[2]), bflo(v[3]), bfhi(v[3]));
        }
      }
    }
  }
}

DI int prev_row(int g) {
  if (g < TP) return (g & 4095) ? g - 1 : -1;
  const int r2 = g - TP;
  return (r2 & 63) ? g - 1 : T + (r2 >> 6);
}

__device__ void ph_rwprep(const Params& p, int bid, int nb) {
  const int tid = otid(), lane = tid & 63, wv = tid >> 6, fr = lane & 15, fq = lane >> 4;
  u16* A1 = (u16*)dsm;
  u16* A2 = A1 + 64 * 80;
  u16* A3 = A2 + 64 * 80;
  u16* SA = (u16*)(p.out);
  u16* SB = p.H;
  const int hd = wv;
  u16* OT = (u16*)(dsm + 38912 + wv * 12288);
  u32x4 pin[7];
  for (int unit = bid; unit < 1024 + 64; unit += nb) {
    const int g0 = unit < 1024 ? unit * 64 : TP + (unit - 1024) * 16;
    const int nrg = unit < 1024 ? 4 : 1;
    auto issue_in = [&](int rg_) {
#pragma unroll
      for (int it = 0; it < 7; it++) {
        const int id = it * 64 + lane, ri = id / 24, rem = id - ri * 24, arr = rem >> 3, ch = rem & 7;
        int tok = g0 + rg_ * 16 - 1 + ri;
        if (rg_ == 0 && ri == 0) tok = prev_row(g0);
        pin[it] = u32x4{0u, 0u, 0u, 0u};
        if (id < 408 && tok >= 0) pin[it] = *(const u32x4*)(p.P + (size_t)tok * INC + arr * 512 + hd * 64 + ch * 8);
      }
    };
    __syncthreads();
    if ((tid >> 3) < nrg * 16) {
      const int row = tid >> 3, part8 = tid & 7, part = part8 >> 1, sub = part8 & 1;
      const int g = g0 + row, pr = prev_row(g);
      const int cb = 1536 + part * 64 + sub * 32;
      const u16* cur = p.P + (size_t)g * INC + cb;
      const u16* prv = p.P + (size_t)(pr < 0 ? 0 : pr) * INC + cb;
#pragma unroll
      for (int q = 0; q < 4; q++) {
        const u32x4 c4 = *(const u32x4*)(cur + q * 8);
        u32x4 p4 = {0u, 0u, 0u, 0u};
        if (pr >= 0) p4 = *(const u32x4*)(prv + q * 8);
        u32x4 ow;
#pragma unroll
        for (int e = 0; e < 4; e++) {
          const float c0 = bflo(c4[e]), c1 = bfhi(c4[e]), q0 = bflo(p4[e]), q1 = bfhi(p4[e]);
          float f0 = c0 + (q0 - c0) * p.mu[cb + q * 8 + 2 * e];
          float f1 = c1 + (q1 - c1) * p.mu[cb + q * 8 + 2 * e + 1];
          if (part == 0) { f0 = 1.f - 2.f / (1.f + __expf(2.f * f0)); f1 = 1.f - 2.f / (1.f + __expf(2.f * f1)); }
          else if (part >= 2) { f0 = sigmoidf_(f0); f1 = sigmoidf_(f1); }
          ow[e] = pack2(f0, f1);
        }
        u16* dst = part == 0 ? A1 + row * 80 + sub * 32 + q * 8
                 : part == 1 ? A2 + row * 80 + sub * 32 + q * 8
                             : A3 + row * 144 + (part - 2) * 64 + sub * 32 + q * 8;
        *(u32x4*)dst = ow;
      }
    }
    __syncthreads();
#pragma unroll 1
    for (int rg = 0; rg < nrg; rg++) {
      issue_in(rg);
#pragma unroll
      for (int it = 0; it < 7; it++) {
        const int id = it * 64 + lane;
        if (id < 408) *(u32x4*)(OT + id * 8) = pin[it];
      }
      __builtin_amdgcn_fence(__ATOMIC_RELEASE, "workgroup");
      __builtin_amdgcn_wave_barrier();
      float inr[5][3][4];
#pragma unroll
      for (int jj = 0; jj < 5; jj++)
#pragma unroll
        for (int ar = 0; ar < 3; ar++)
#pragma unroll
          for (int nt = 0; nt < 4; nt++) inr[jj][ar][nt] = bf2f(OT[((fq * 4 + jj) * 3 + ar) * 64 + nt * 16 + fr]);
      __builtin_amdgcn_fence(__ATOMIC_RELEASE, "workgroup");
      __builtin_amdgcn_wave_barrier();
      SCHED;
      f32x4 aw[4], aa[4];
#pragma unroll
      for (int nt = 0; nt < 4; nt++) { aw[nt] = f32x4{0.f, 0.f, 0.f, 0.f}; aa[nt] = f32x4{0.f, 0.f, 0.f, 0.f}; }
#pragma unroll 1
      for (int ks = 0; ks < 2; ks++) {
        const bf16x8 f1 = *(const bf16x8*)(A1 + (rg * 16 + fr) * 80 + ks * 32 + fq * 8);
        const bf16x8 f2 = *(const bf16x8*)(A2 + (rg * 16 + fr) * 80 + ks * 32 + fq * 8);
#pragma unroll
        for (int nt = 0; nt < 4; nt++) {
          const bf16x8 bw = *(const bf16x8*)(p.W2T + (unsigned)((hd * 64 + nt * 16 + fr) * 64 + ks * 32 + fq * 8));
          const bf16x8 ba = *(const bf16x8*)(p.A2T + (unsigned)((hd * 64 + nt * 16 + fr) * 64 + ks * 32 + fq * 8));
          aw[nt] = MFMA16(f1, bw, aw[nt]);
          aa[nt] = MFMA16(f2, ba, aa[nt]);
        }
      }
      float ss[4] = {0.f, 0.f, 0.f, 0.f};
      const int rowb = rg * 16 + fq * 4;
      const int gb = g0 + rowb;
#pragma unroll
      for (int nt = 0; nt < 4; nt++) {
        const int c = nt * 16 + fr, col = hd * 64 + c;
        const float mu_r = p.mu[col], mu_k = p.mu[512 + col], mu_v = p.mu[1024 + col];
        const float w0c = p.w0[col], a0c = p.a0[col], kkc = p.k_k[col], kac = p.k_a[col];
        float qr = inr[0][0][nt], qk = inr[0][1][nt], qv = inr[0][2][nt];
#pragma unroll
        for (int j = 0; j < 4; j++) {
          const float cr = inr[j + 1][0][nt], ck = inr[j + 1][1][nt], cv = inr[j + 1][2][nt];
          const float r = cr + (qr - cr) * mu_r, k = ck + (qk - ck) * mu_k, v = cv + (qv - cv) * mu_v;
          qr = cr; qk = ck; qv = cv;
          const float ed = 0.6065306597126334f * sigmoidf_(w0c + aw[nt][j]);
          const float dm = 1.f - __expf(-ed);
          const float a = sigmoidf_(a0c + aa[nt][j]);
          const float kkv = k * kkc;
          ss[j] += kkv * kkv;
          const float k2 = k * (1.f + (a - 1.f) * kac);
          u16* ot = OT + (fq * 4 + j) * 384 + c;
          ot[0] = f2bf(r);
          ot[64] = f2bf(dm);
          ot[128] = f2bf(k2);
          ot[256] = f2bf(v);
          aw[nt][j] = kkv;
          aa[nt][j] = a;
        }
        SCHED;
      }
#pragma unroll
      for (int j = 0; j < 4; j++) ss[j] = 1.f / fmaxf(sqrtf(red16(ss[j])), 1e-12f);
#pragma unroll
      for (int nt = 0; nt < 4; nt++) {
        const int c = nt * 16 + fr;
#pragma unroll
        for (int j = 0; j < 4; j++) {
          const float kkn = aw[nt][j] * ss[j];
          u16* ot = OT + (fq * 4 + j) * 384 + c;
          ot[192] = f2bf(kkn);
          ot[320] = f2bf(kkn * aa[nt][j]);
        }
      }
      __builtin_amdgcn_fence(__ATOMIC_RELEASE, "workgroup");
      __builtin_amdgcn_wave_barrier();
      {
        const int gr0 = g0 + rg * 16;
#pragma unroll 4
        for (int it = 0; it < 12; it++) {
          const int id = it * 64 + lane, rowi = id / 48, pc = id % 48;
          const u32x4 v4 = *(const u32x4*)(OT + rowi * 384 + pc * 8);
          const size_t gh = (size_t)(gr0 + rowi) * 8 + hd;
          if (pc < 32) *(u32x4*)(SA + gh * 256 + pc * 8) = v4;
          else *(u32x4*)(SB + gh * 128 + (pc - 32) * 8) = v4;
        }
      }
      __builtin_amdgcn_wave_barrier();
      f32x4 ag[4];
#pragma unroll
      for (int nt = 0; nt < 4; nt++) ag[nt] = f32x4{0.f, 0.f, 0.f, 0.f};
#pragma unroll 1
      for (int ks = 0; ks < 4; ks++) {
        const bf16x8 f3 = *(const bf16x8*)(A3 + (rg * 16 + fr) * 144 + ks * 32 + fq * 8);
#pragma unroll
        for (int nt = 0; nt < 4; nt++) {
          const bf16x8 bg = *(const bf16x8*)(p.G2T + (unsigned)((hd * 64 + nt * 16 + fr) * 128 + ks * 32 + fq * 8));
          ag[nt] = MFMA16(f3, bg, ag[nt]);
        }
      }
#pragma unroll
      for (int nt = 0; nt < 4; nt++)
#pragma unroll
        for (int j = 0; j < 4; j++) p.G[(size_t)(gb + j) * 512 + hd * 64 + nt * 16 + fr] = f2bf(ag[nt][j]);
    }
  }
}

DI float red8(float v) {
  v += dppmov<0xB1>(v);
  v += dppmov<0x4E>(v);
  v += dppmov<0x141>(v);
  return v;
}
struct ScanOps { f32x4 r, d, k, n, b; float v; };
DI void scan_ld(ScanOps& o, const float* sb, int j0, int row) {
  o.r = *(const f32x4*)(sb + j0);
  o.d = *(const f32x4*)(sb + 64 + j0);
  o.k = *(const f32x4*)(sb + 128 + j0);
  o.n = *(const f32x4*)(sb + 192 + j0);
  o.b = *(const f32x4*)(sb + 320 + j0);
  o.v = sb[256 + row];
}
#define LO2(x) __builtin_shufflevector((x), (x), 0, 1)
#define HI2(x) __builtin_shufflevector((x), (x), 2, 3)
DI float scan_step(f32x2 (&S)[2], const ScanOps& o, f32x4& rprev) {
  const f32x2 vv = {o.v, o.v};
  const f32x2 tt = S[0] * LO2(o.n) + S[1] * HI2(o.n);
  const f32x2 yy = S[0] * LO2(rprev) + S[1] * HI2(rprev);
  const f32x2 m0 = S[0] * LO2(o.d) + vv * LO2(o.k);
  const f32x2 m1 = S[1] * HI2(o.d) + vv * HI2(o.k);
  float a = tt[0] + tt[1], y = yy[0] + yy[1];
  a += dppmov<0x128>(a); y += dppmov<0x128>(y);
  a += dppmov<0x124>(a); y += dppmov<0x124>(y);
  a += dppmov<0x122>(a); y += dppmov<0x122>(y);
  a += dppmov<0x121>(a); y += dppmov<0x121>(y);
  const float sa = -a;
  const f32x2 sv = {sa, sa};
  S[0] = m0 + sv * LO2(o.b);
  S[1] = m1 + sv * HI2(o.b);
  rprev = o.r;
  return y;
}

__device__ void ph_scan(const Params& p, int bid, int nb) {
  const int tid = otid(), lane = tid & 63, wv = tid >> 6;
  float* buf = (float*)dsm;
  const u16* SA = (const u16*)(p.out);
  const u16* SB = p.H;
  constexpr int CH = 32;
  for (int item = bid; item < 512; item += nb) {
    const int type = item >> 8, r_ = item & 255, half = r_ & 1, hb = r_ >> 1, h = hb & 7, b = hb >> 3;
    const int nch = type ? 64 / CH : 4096 / CH;
    const int gbase = type ? TP + b * 64 : b * 4096;
    const bool active = true;
    const int row = half * 32 + wv * 4 + (lane >> 4), j0 = (lane & 15) * 4;
    f32x2 S[2];
#pragma unroll
    for (int j = 0; j < 2; j++) S[j] = f32x2{0.f, 0.f};
    if (type && active) {
      const float* s0 = p.state_wkv + ((size_t)(b * 8 + h) * 64 + row) * 64 + j0;
#pragma unroll
      for (int j = 0; j < 2; j++) S[j] = f32x2{s0[2 * j], s0[2 * j + 1]};
    }
    f32x4 rprev = {0.f, 0.f, 0.f, 0.f};
    float ykeep = 0.f;
    u32x4 la[2], lb;
    auto gload = [&](int c) {
#pragma unroll
      for (int q = 0; q < 2; q++) {
        const int idx = tid + q * NTH, step = idx >> 5, u = idx & 31;
        la[q] = *(const u32x4*)(SA + ((size_t)(gbase + c * CH + step) * 8 + h) * 256 + u * 8);
      }
      {
        const int step = tid >> 4, u = tid & 15;
        lb = *(const u32x4*)(SB + ((size_t)(gbase + c * CH + step) * 8 + h) * 128 + u * 8);
      }
    };
    gload(0);
    for (int c = 0; c < nch; c++) {
      __syncthreads();
#pragma unroll
      for (int q = 0; q < 2; q++) {
        const int idx = tid + q * NTH, step = idx >> 5, u = idx & 31, arr = u >> 3, c0 = (u & 7) * 8;
        float* d = buf + step * 384 + arr * 64 + c0;
        float f[8];
#pragma unroll
        for (int e = 0; e < 4; e++) { f[2 * e] = bflo(la[q][e]); f[2 * e + 1] = bfhi(la[q][e]); }
        if (arr == 1) {
#pragma unroll
          for (int e = 0; e < 8; e++) f[e] = 1.f - f[e];
        }
        *(float4*)d = make_float4(f[0], f[1], f[2], f[3]);
        *(float4*)(d + 4) = make_float4(f[4], f[5], f[6], f[7]);
      }
      {
        const int step = tid >> 4, u = tid & 15, arr = u >> 3, c0 = (u & 7) * 8;
        float* d = buf + step * 384 + (4 + arr) * 64 + c0;
        *(float4*)d = make_float4(bflo(lb[0]), bfhi(lb[0]), bflo(lb[1]), bfhi(lb[1]));
        *(float4*)(d + 4) = make_float4(bflo(lb[2]), bfhi(lb[2]), bflo(lb[3]), bfhi(lb[3]));
      }
      __syncthreads();
      if (c + 1 < nch) gload(c + 1);
      if (active) {
        ScanOps A0, A1, B0, B1;
        scan_ld(A0, buf, j0, row);
        scan_ld(A1, buf + 384, j0, row);
#pragma unroll 1
        for (int s = 0; s < CH; s += 4) {
          scan_ld(B0, buf + (s + 2) * 384, j0, row);
          scan_ld(B1, buf + (s + 3) * 384, j0, row);
          SCHED;
          {
            const int g0 = c * CH + s;
            const float y0 = scan_step(S, A0, rprev);
            ykeep = ((lane & 15) == ((g0 - 1) & 15)) ? y0 : ykeep;
            if ((g0 & 15) == 0 && g0 > 0)
              p.Y[(size_t)(gbase + g0 - 16 + (lane & 15)) * 512 + h * 64 + row] = f2bf(ykeep);
            const float y1 = scan_step(S, A1, rprev);
            ykeep = ((lane & 15) == (g0 & 15)) ? y1 : ykeep;
          }
          SCHED;
          const int sn = (s + 4 < CH) ? s + 4 : s;
          scan_ld(A0, buf + sn * 384, j0, row);
          scan_ld(A1, buf + (sn + 1) * 384, j0, row);
          SCHED;
          {
            const int g0 = c * CH + s;
            const float y2 = scan_step(S, B0, rprev);
            ykeep = ((lane & 15) == ((g0 + 1) & 15)) ? y2 : ykeep;
            const float y3 = scan_step(S, B1, rprev);
            ykeep = ((lane & 15) == ((g0 + 2) & 15)) ? y3 : ykeep;
          }
          SCHED;
        }
      }
    }
    if (active) {
      const f32x2 yy = S[0] * LO2(rprev) + S[1] * HI2(rprev);
      const float yl = red16(yy[0] + yy[1]);
      ykeep = ((lane & 15) == 15) ? yl : ykeep;
      p.Y[(size_t)(gbase + nch * CH - 16 + (lane & 15)) * 512 + h * 64 + row] = f2bf(ykeep);
    }
    if (active) {
      float* so = p.out + (type ? OFF_WKV_S : OFF_WKV_P) + ((size_t)(b * 8 + h) * 64 + row) * 64 + j0;
      *(float4*)so = make_float4(S[0][0], S[0][1], S[1][0], S[1][1]);
    }
  }
}

__device__ void ph_attn(const Params& p, int bid, int nb, bool dry = false) {
  const int tid = otid(), lane = tid & 63, wv = tid >> 6, fr = lane & 15, fq = lane >> 4;
  u16* Ks = (u16*)dsm;
  u16* Vt = Ks + 192 * 72;
  for (int item = bid; item < 2080; item += nb) {
    const int kvh = item & 1, r = item >> 1;
    const bool samp = r >= 1024;
    const int b = samp ? r - 1024 : r >> 6, c = samp ? 0 : (r & 63);
    const int gq0 = samp ? TP + b * 64 : b * 4096 + c * 64;
    __syncthreads();
#pragma unroll
    for (int q = 0; q < 3; q++) {
      const int idx = tid + q * NTH, j = idx >> 3, d0 = (idx & 7) * 8;
      u32x4 kq = {0u, 0u, 0u, 0u}, vq = {0u, 0u, 0u, 0u};
      if (!samp) {
        const int tok = (c - 2) * 64 + j;
        if (tok >= 0) {
          const u16* src = p.P + (size_t)(b * 4096 + tok) * INC + 2304 + kvh * 64 + d0;
          kq = *(const u32x4*)src;
          vq = *(const u32x4*)(src + 128);
        }
      } else if (j < 128) {
        const float4* ck = (const float4*)(p.cache_k + ((size_t)(b * 128 + j) * 2 + kvh) * 64 + d0);
        const float4* cv = (const float4*)(p.cache_v + ((size_t)(b * 128 + j) * 2 + kvh) * 64 + d0);
        const float4 k0 = ck[0], k1 = ck[1], v0 = cv[0], v1 = cv[1];
        kq = u32x4{pack2(k0.x, k0.y), pack2(k0.z, k0.w), pack2(k1.x, k1.y), pack2(k1.z, k1.w)};
        vq = u32x4{pack2(v0.x, v0.y), pack2(v0.z, v0.w), pack2(v1.x, v1.y), pack2(v1.z, v1.w)};
      } else {
        const u16* src = p.P + (size_t)(TP + b * 64 + (j - 128)) * INC + 2304 + kvh * 64 + d0;
        kq = *(const u32x4*)src;
        vq = *(const u32x4*)(src + 128);
      }
      *(u32x4*)(Ks + j * 72 + d0) = kq;
#pragma unroll
      for (int e = 0; e < 4; e++) {
        Vt[(d0 + 2 * e) * 196 + j] = (u16)(vq[e] & 0xffffu);
        Vt[(d0 + 2 * e + 1) * 196 + j] = (u16)(vq[e] >> 16);
      }
    }
    __syncthreads();
    const int qh = kvh * 4 + (wv & 3);
    const float slope = exp2f(-(float)(qh + 1)), sink = p.sinks[qh];
#pragma unroll 1
    for (int ps = 0; ps < 2; ps++) {
      const int q0 = (wv >> 2) * 32 + ps * 16;
      const int tq = q0 + fr;
      const u16* qp = p.P + (size_t)(gq0 + tq) * INC + 1792 + qh * 64 + fq * 8;
      const bf16x8 qf0 = *(const bf16x8*)(qp), qf1 = *(const bf16x8*)(qp + 32);
      f32x4 sc[12];
#pragma unroll
      for (int kt = 0; kt < 12; kt++) {
        sc[kt] = f32x4{0.f, 0.f, 0.f, 0.f};
        const bf16x8 a0 = *(const bf16x8*)(Ks + (kt * 16 + fr) * 72 + fq * 8);
        const bf16x8 a1 = *(const bf16x8*)(Ks + (kt * 16 + fr) * 72 + 32 + fq * 8);
        sc[kt] = MFMA16(a0, qf0, sc[kt]);
        sc[kt] = MFMA16(a1, qf1, sc[kt]);
        if ((kt & 3) == 3) SCHED;
      }
      float mx = -3e38f;
#pragma unroll
      for (int kt = 0; kt < 12; kt++)
#pragma unroll
        for (int j = 0; j < 4; j++) {
          const int key = kt * 16 + fq * 4 + j;
          float s = sc[kt][j] * 0.125f - slope * fabsf((float)(128 + tq - key));
          if (!samp && (c - 2) * 64 + key < 0) s = -1e30f;
          sc[kt][j] = s;
          mx = fmaxf(mx, s);
        }
      mx = fmaxf(mx, __shfl_xor(mx, 16));
      mx = fmaxf(mx, __shfl_xor(mx, 32));
      mx = fmaxf(mx, sink);
      float sum = 0.f;
#pragma unroll
      for (int kt = 0; kt < 12; kt++)
#pragma unroll
        for (int j = 0; j < 4; j++) {
          const float e = __expf(sc[kt][j] - mx);
          sc[kt][j] = e;
          sum += e;
        }
      sum += __shfl_xor(sum, 16);
      sum += __shfl_xor(sum, 32);
      sum += __expf(sink - mx);
      const float inv = 1.f / sum;
      f32x4 o[4];
#pragma unroll
      for (int dt = 0; dt < 4; dt++) o[dt] = f32x4{0.f, 0.f, 0.f, 0.f};
#pragma unroll
      for (int t2 = 0; t2 < 6; t2++) {
        const u32x4 pw = {pack2(sc[2 * t2][0] * inv, sc[2 * t2][1] * inv), pack2(sc[2 * t2][2] * inv, sc[2 * t2][3] * inv),
                          pack2(sc[2 * t2 + 1][0] * inv, sc[2 * t2 + 1][1] * inv),
                          pack2(sc[2 * t2 + 1][2] * inv, sc[2 * t2 + 1][3] * inv)};
        const bf16x8 pa = __builtin_bit_cast(bf16x8, pw);
#pragma unroll
        for (int dt = 0; dt < 4; dt++) {
          const u16* vp = Vt + (dt * 16 + fr) * 196 + t2 * 32 + fq * 4;
          const uint2 v0 = *(const uint2*)vp, v1 = *(const uint2*)(vp + 16);
          const bf16x8 vb = __builtin_bit_cast(bf16x8, u32x4{v0.x, v0.y, v1.x, v1.y});
          o[dt] = MFMA16(pa, vb, o[dt]);
        }
        SCHED;
      }
#pragma unroll
      for (int dt = 0; dt < 4; dt++)
#pragma unroll
        for (int j = 0; j < 4; j++)
          p.OATT[(size_t)(gq0 + q0 + fq * 4 + j) * 512 + qh * 64 + dt * 16 + fr] = f2bf(o[dt][j]);
    }
  }
  const u16* SA = (const u16*)(p.out);
  const u16* SB = p.H;
  for (int it4 = bid * NW + wv; it4 < T * 2; it4 += nb * NW) {
    const int it = it4 * 4 + (lane >> 4), c0 = (lane & 15) * 4;
    const int g = it >> 3, h = it & 7, col = h * 64 + c0;
    const uint2 yw = *(const uint2*)(p.Y + (size_t)g * 512 + col);
    const uint2 rw = *(const uint2*)(SA + (size_t)it * 256 + c0), kw = *(const uint2*)(SA + (size_t)it * 256 + 128 + c0);
    const uint2 vw = *(const uint2*)(SB + (size_t)it * 128 + c0), gw = *(const uint2*)(p.G + (size_t)g * 512 + col);
    const float4 lw = *(const float4*)(p.lnx_w + col), lb = *(const float4*)(p.lnx_b + col), rk = *(const float4*)(p.r_k + col);
    const float y0 = bflo(yw.x), y1 = bfhi(yw.x), y2 = bflo(yw.y), y3 = bfhi(yw.y);
    const float mean = red16((y0 + y1) + (y2 + y3)) * (1.f / 64.f);
    const float e0 = y0 - mean, e1 = y1 - mean, e2 = y2 - mean, e3 = y3 - mean;
    const float var = red16((e0 * e0 + e1 * e1) + (e2 * e2 + e3 * e3)) * (1.f / 64.f);
    const float bonus = red16((bflo(rw.x) * bflo(kw.x) * rk.x + bfhi(rw.x) * bfhi(kw.x) * rk.y) +
                              (bflo(rw.y) * bflo(kw.y) * rk.z + bfhi(rw.y) * bfhi(kw.y) * rk.w));
    const float rsd = rsqrtf(var + 64e-5f);
    const float o0 = (e0 * rsd * lw.x + lb.x + bonus * bflo(vw.x)) * bflo(gw.x);
    const float o1 = (e1 * rsd * lw.y + lb.y + bonus * bfhi(vw.x)) * bfhi(gw.x);
    const float o2 = (e2 * rsd * lw.z + lb.z + bonus * bflo(vw.y)) * bflo(gw.y);
    const float o3 = (e3 * rsd * lw.w + lb.w + bonus * bfhi(vw.y)) * bfhi(gw.y);
    if (!dry || o0 == 123.456f) *(uint2*)(p.Y + (size_t)g * 512 + col) = make_uint2(pack2(o0, o1), pack2(o2, o3));
  }
}

DI void ph_gemm2(const Params& p, int bid, int nb, int sm = -1) {
  const int tid_ = otid();
  u16* MG = p.H;
  const u16* Cs = (const u16*)dsm;
  const int nM = 256, nN = 4;
  for (int round = 0;; ++round) {
    int pm, pn;
    if (sm >= 0) { if (round >= 4) break; pm = 256 + sm; pn = round; }
    else if (!tile_of(round, bid, nb, nM, nN, pm, pn)) break;
    f32x4 acc[2][2][4][2];
#pragma unroll 1
    for (int br = 0; br < 2; br++) {
      gemm256<512>(br ? p.OATT : p.Y, p.WbT + (size_t)br * 1024 * 512, pm * 256, pn * 256, acc);
      acc_to_lds(acc);
#pragma unroll 2
      for (int it = 0; it < 16; it++) {
        const int id = it * NTH + tid_, rl = id >> 5, c8 = (id & 31) * 8;
        const int row = pm * 256 + rl, col = pn * 256 + c8;
        const u32x4 v = *(const u32x4*)(Cs + rl * CS_LD + c8);
        const u32x4 gw = *(const u32x4*)(p.P + (size_t)row * INC + 2560 + br * 1024 + col);
        u32x4 prev = {0u, 0u, 0u, 0u};
        if (br) prev = *(const u32x4*)(MG + (size_t)row * 1024 + col);
        u32x4 o;
#pragma unroll
        for (int e = 0; e < 4; e++) {
          const float r0 = bflo(prev[e]) + sigmoidf_(bflo(gw[e])) * bflo(v[e]);
          const float r1 = bfhi(prev[e]) + sigmoidf_(bfhi(gw[e])) * bfhi(v[e]);
          o[e] = pack2(r0, r1);
        }
        *(u32x4*)(MG + (size_t)row * 1024 + col) = o;
      }
    }
  }
}

DI void ph_gemm3(const Params& p, int bid, int nb, int sm = -1) {
  const int tid_ = otid();
  const u16* MG = p.H;
  const u16* Cs = (const u16*)dsm;
  const int nM = 256, nN = 4;
  for (int round = 0;; ++round) {
    int pm, pn;
    if (sm >= 0) { if (round >= 4) break; pm = 256 + sm; pn = round; }
    else if (!tile_of(round, bid, nb, nM, nN, pm, pn)) break;
    f32x4 acc[2][2][4][2];
    gemm256<1024>(MG, p.WoutT, pm * 256, pn * 256, acc);
    acc_to_lds(acc);
#pragma unroll 2
    for (int it = 0; it < 16; it++) {
      const int id = it * NTH + tid_, rl = id >> 5, c8 = (id & 31) * 8;
      const int row = pm * 256 + rl, col = pn * 256 + c8;
      const u32x4 v = *(const u32x4*)(Cs + rl * CS_LD + c8);
      const float* xr = xrow(p, row) + col;
      const float4 x0 = *(const float4*)xr, x1 = *(const float4*)(xr + 4);
      *(u32x4*)(p.P + (size_t)row * 1024 + col) =
          u32x4{pack2(x0.x + bflo(v[0]), x0.y + bfhi(v[0])), pack2(x0.z + bflo(v[1]), x0.w + bfhi(v[1])),
                pack2(x1.x + bflo(v[2]), x1.y + bfhi(v[2])), pack2(x1.z + bflo(v[3]), x1.w + bfhi(v[3]))};
    }
  }
}

DI void ph_norm2(const Params& p, int row0, int row1, int wstride) {
  const int tid = otid(), lane = tid & 63;
  for (int row = row0; row < row1; row += wstride) {
    const uint2* x = (const uint2*)(p.P + (size_t)row * 1024);
    float4 v[4];
    float ss = 0.f;
#pragma unroll
    for (int i = 0; i < 4; i++) {
      const uint2 xw = x[lane + i * 64];
      v[i] = make_float4(bflo(xw.x), bfhi(xw.x), bflo(xw.y), bfhi(xw.y));
      ss += v[i].x * v[i].x + v[i].y * v[i].y + v[i].z * v[i].z + v[i].w * v[i].w;
    }
    ss = wave_sum(ss);
    const float rs = rsqrtf(ss * (1.f / 1024.f) + 1e-6f);
    u16* hr = p.H + (size_t)row * 1024;
    float4 y[4];
    float am = 0.f;
#pragma unroll
    for (int i = 0; i < 4; i++) {
      const float4 g = ((const float4*)p.norm2_g)[lane + i * 64];
      y[i] = make_float4(v[i].x * rs * g.x, v[i].y * rs * g.y, v[i].z * rs * g.z, v[i].w * rs * g.w);
      ((uint2*)hr)[lane + i * 64] = make_uint2(pack2(y[i].x, y[i].y), pack2(y[i].z, y[i].w));
      am = fmaxf(am, fmaxf(fmaxf(fabsf(y[i].x), fabsf(y[i].y)), fmaxf(fabsf(y[i].z), fabsf(y[i].w))));
    }
    am = fmaxf(wave_max(am), 1e-30f);
    const float sc = 240.f / am;
    if (lane == 0) p.SH[row] = am * (1.f / 240.f);
    u32* h8 = (u32*)((unsigned char*)p.Y + (size_t)row * 1024);
#pragma unroll
    for (int i = 0; i < 4; i++) h8[lane + i * 64] = q4(y[i].x, y[i].y, y[i].z, y[i].w, sc);
  }
}

DI void ins16(float (&l)[16], float x) {
#pragma unroll
  for (int i = 0; i < 16; i++) {
    const float hi = fmaxf(l[i], x);
    x = fminf(l[i], x);
    l[i] = hi;
  }
}


DI void ce_desc(float& a, float& b) { const float hi = fmaxf(a, b), lo = fminf(a, b); a = hi; b = lo; }
DI void bitonic_sort16_desc(float (&a)[16]) {
#pragma unroll
  for (int k = 2; k <= 16; k <<= 1)
#pragma unroll
    for (int j = k >> 1; j > 0; j >>= 1)
#pragma unroll
      for (int i = 0; i < 16; i++) {
        const int l = i ^ j;
        if (l > i) {
          if ((i & k) == 0) ce_desc(a[i], a[l]);
          else ce_desc(a[l], a[i]);
        }
      }
}
DI void bitonic_merge16_desc(float (&a)[16]) {
#pragma unroll
  for (int j = 8; j > 0; j >>= 1)
#pragma unroll
    for (int i = 0; i < 16; i++) {
      const int l = i ^ j;
      if (l > i) ce_desc(a[i], a[l]);
    }
}
DI void top16_merge(float (&a)[16], const float (&b)[16]) {
#pragma unroll
  for (int i = 0; i < 16; i++) a[i] = fmaxf(a[i], b[15 - i]);
  bitonic_merge16_desc(a);
}

DI void ph_peerq(const Params& p, int bid, int nb, int sm = -1) {
  GT_VARS
  const int l31 = lane & 31, kh = lane >> 5;
  u16* Qs = (u16*)dsm;
  unsigned char* lt = (unsigned char*)(dsm + 135168 + wid * 1024);
  int* IDX = (int*)p.G;
  float* GATE = (float*)p.OATT;
  const int nM = 256, nN = 4;
  for (int round = 0;; ++round) {
    int pm, pn;
    if (sm >= 0) { if (round >= 4) break; pm = 256 + sm; pn = round; }
    else if (!tile_of(round, bid, nb, nM, nN, pm, pn)) break;
    {
      f32x4 acc[2][2][4][2];
      gemm256<1024>(p.H, p.WqT, pm * 256, pn * 256, acc);
      acc_to_lds(acc);
    }
#pragma unroll 1
    for (int hh = 0; hh < 2; hh++) {
      const int hp = pn * 2 + hh;
      float l1[16], l2[16];
#pragma unroll
      for (int i = 0; i < 16; i++) { l1[i] = 0.f; l2[i] = 0.f; }
#pragma unroll 1
      for (int pp = 0; pp < 2; pp++) {
        f32x16 sc[4];
#pragma unroll
        for (int m4 = 0; m4 < 4; m4++) {
#pragma unroll
          for (int i = 0; i < 16; i++) sc[m4][i] = 0.f;
#pragma unroll
          for (int kk = 0; kk < 4; kk++) {
            const bf16x8 a = *(const bf16x8*)(p.SK + (size_t)(pp * 128 + m4 * 32 + l31) * 64 + kk * 16 + kh * 8);
            const bf16x8 bq = *(const bf16x8*)(Qs + (wid * 32 + l31) * 264 + hh * 128 + pp * 64 + kk * 16 + kh * 8);
            sc[m4] = MFMA32(a, bq, sc[m4]);
          }
        }
        float l[16], q1[16], q2[16], q3[16];
#pragma unroll
        for (int i = 0; i < 16; i++) {
          const u32 nb_ = (i >> 2) * 8 + kh * 4 + (i & 3);
          l[i] = __uint_as_float((__float_as_uint(sc[0][i]) & ~0x7Fu) | nb_);
          q1[i] = __uint_as_float((__float_as_uint(sc[1][i]) & ~0x7Fu) | (32u + nb_));
          q2[i] = __uint_as_float((__float_as_uint(sc[2][i]) & ~0x7Fu) | (64u + nb_));
          q3[i] = __uint_as_float((__float_as_uint(sc[3][i]) & ~0x7Fu) | (96u + nb_));
        }
        bitonic_sort16_desc(l);
        bitonic_sort16_desc(q1);
        bitonic_sort16_desc(q2);
        bitonic_sort16_desc(q3);
        top16_merge(l, q1);
        top16_merge(q2, q3);
        top16_merge(l, q2);
        float o[16];
#pragma unroll
        for (int i = 0; i < 16; i++) o[i] = __shfl_xor(l[i], 32);
        top16_merge(l, o);
#pragma unroll
        for (int i = 0; i < 16; i++) {
          l1[i] = pp == 0 ? l[i] : l1[i];
          l2[i] = pp == 0 ? l2[i] : l[i];
        }
      }
      if (kh == 0) {
        u32 w[8];
#pragma unroll
        for (int q = 0; q < 4; q++) {
          w[q] = (__float_as_uint(l1[4 * q]) & 0x7F) | ((__float_as_uint(l1[4 * q + 1]) & 0x7F) << 8) |
                 ((__float_as_uint(l1[4 * q + 2]) & 0x7F) << 16) | ((__float_as_uint(l1[4 * q + 3]) & 0x7F) << 24);
          w[4 + q] = (__float_as_uint(l2[4 * q]) & 0x7F) | ((__float_as_uint(l2[4 * q + 1]) & 0x7F) << 8) |
                     ((__float_as_uint(l2[4 * q + 2]) & 0x7F) << 16) | ((__float_as_uint(l2[4 * q + 3]) & 0x7F) << 24);
        }
        *(uint4*)(lt + l31 * 32) = make_uint4(w[0], w[1], w[2], w[3]);
        *(uint4*)(lt + l31 * 32 + 16) = make_uint4(w[4], w[5], w[6], w[7]);
      }
      float v1[16], v2[16];
#pragma unroll
      for (int i = 0; i < 16; i++) {
        v1[i] = __uint_as_float(__float_as_uint(l1[i]) & ~0x7Fu);
        v2[i] = __uint_as_float(__float_as_uint(l2[i]) & ~0x7Fu);
      }
#define CAND(a, b) __uint_as_float((__float_as_uint(v1[a] + v2[b]) & ~0xFFu) | (u32)((a) * 16 + (b)))
      float l3[16], y1[16], y2[16];
#pragma unroll
      for (int b = 0; b < 16; b++) l3[b] = CAND(0, b);
#pragma unroll
      for (int b = 0; b < 8; b++) y1[b] = CAND(1, b);
#pragma unroll
      for (int b = 0; b < 5; b++) y1[8 + b] = CAND(2, b);
#pragma unroll
      for (int b = 0; b < 3; b++) y1[13 + b] = CAND(4, b);
#pragma unroll
      for (int b = 0; b < 4; b++) y2[b] = CAND(3, b);
      y2[4] = CAND(5, 0); y2[5] = CAND(5, 1); y2[6] = CAND(6, 0); y2[7] = CAND(6, 1); y2[8] = CAND(7, 0); y2[9] = CAND(7, 1);
      y2[10] = CAND(8, 0); y2[11] = CAND(9, 0); y2[12] = CAND(10, 0); y2[13] = CAND(11, 0); y2[14] = CAND(12, 0); y2[15] = CAND(13, 0);
      bitonic_sort16_desc(y1);
      bitonic_sort16_desc(y2);
      top16_merge(l3, y1);
      top16_merge(l3, y2);
      ins16(l3, CAND(14, 0));
      ins16(l3, CAND(15, 0));
#undef CAND
      __builtin_amdgcn_fence(__ATOMIC_RELEASE, "workgroup");
      __builtin_amdgcn_wave_barrier();
      if (kh == 0) {
        const int g = pm * 256 + wid * 32 + l31;
        float ev[16];
        int ei[16];
        float sum = 0.f;
        const float mxv = __uint_as_float(__float_as_uint(l3[0]) & ~0xFFu);
#pragma unroll
        for (int k = 0; k < 16; k++) {
          const u32 bits = __float_as_uint(l3[k]);
          const u32 pos = bits & 0xFF;
          ev[k] = __expf(__uint_as_float(bits & ~0xFFu) - mxv);
          sum += ev[k];
          ei[k] = (int)lt[l31 * 32 + (pos >> 4)] * 128 + (int)lt[l31 * 32 + 16 + (pos & 15)];
        }
        const float inv = 1.f / sum;
        int4* ip = (int4*)(IDX + (size_t)g * 128 + hp * 16);
        float4* gp = (float4*)(GATE + (size_t)g * 128 + hp * 16);
#pragma unroll
        for (int q = 0; q < 4; q++) {
          ip[q] = make_int4(ei[4 * q], ei[4 * q + 1], ei[4 * q + 2], ei[4 * q + 3]);
          gp[q] = make_float4(ev[4 * q] * inv, ev[4 * q + 1] * inv, ev[4 * q + 2] * inv, ev[4 * q + 3] * inv);
        }
      }
      __builtin_amdgcn_wave_barrier();
    }
  }
}

DI void ph_peer(const Params& p, int g0_, int g1_, int gstride, bool dry = false) {
  const int tid = otid(), lane = tid & 63, wv = tid >> 6;
  constexpr int ST = 1104;
  char* wb = dsm + wv * (16 * ST + 2048);
  unsigned char* stg = (unsigned char*)wb;
  unsigned char* hs = stg + 16 * ST;
  float* acts = (float*)(hs + 1024);
  int* idxs = (int*)(hs + 1536);
  const int gr = lane >> 3, gc = lane & 7;
  const int* IDX = (const int*)p.G;
  const float* GATE = (const float*)p.OATT;
  const unsigned char* H8 = (const unsigned char*)p.Y;
  const int n = lane & 15, quad = lane >> 4;
  for (int g = g0_; g < g1_; g += gstride) {
    *(u32x4*)(hs + lane * 16) = *(const u32x4*)(H8 + (size_t)g * 1024 + lane * 16);
    idxs[lane] = IDX[(size_t)g * 128 + lane];
    idxs[lane + 64] = IDX[(size_t)g * 128 + 64 + lane];
    const float shv = p.SH[g];
    __builtin_amdgcn_fence(__ATOMIC_RELEASE, "workgroup");
    __builtin_amdgcn_wave_barrier();
    {
      u32x4 ring[16];
      {
        const unsigned char* ua = p.U8 + (size_t)idxs[gr] * 1024 + gc * 16;
        const unsigned char* ub = p.U8 + (size_t)idxs[8 + gr] * 1024 + gc * 16;
#pragma unroll
        for (int i = 0; i < 8; i++) { ring[i] = *(const u32x4*)(ua + i * 128); ring[8 + i] = *(const u32x4*)(ub + i * 128); }
      }
#pragma unroll 1
      for (int grp = 0; grp < 8; grp++) {
        const int gn = grp < 7 ? grp + 1 : grp;
        const unsigned char* ua = p.U8 + (size_t)idxs[gn * 16 + gr] * 1024 + gc * 16;
        const unsigned char* ub = p.U8 + (size_t)idxs[gn * 16 + 8 + gr] * 1024 + gc * 16;
        const float4 gt = *(const float4*)(GATE + (size_t)g * 128 + grp * 16 + quad * 4);
        const int4 ee = *(const int4*)(idxs + grp * 16 + quad * 4);
        const float su0 = p.SU[ee.x], su1 = p.SU[ee.y], su2 = p.SU[ee.z], su3 = p.SU[ee.w];
        const float sv0 = p.SV[ee.x], sv1 = p.SV[ee.y], sv2 = p.SV[ee.z], sv3 = p.SV[ee.w];
#pragma unroll
        for (int i = 0; i < 8; i++) {
          *(u32x4*)(stg + gr * ST + i * 128 + gc * 16) = ring[i];
          *(u32x4*)(stg + (8 + gr) * ST + i * 128 + gc * 16) = ring[8 + i];
          if (grp < 7) { ring[i] = *(const u32x4*)(ua + i * 128); ring[8 + i] = *(const u32x4*)(ub + i * 128); }
        }
        __builtin_amdgcn_fence(__ATOMIC_RELEASE, "workgroup");
        __builtin_amdgcn_wave_barrier();
        f32x4 acc = {0.f, 0.f, 0.f, 0.f};
#pragma unroll
        for (int st = 0; st < 16; st++) {
          const u32x4 ua4 = *(const u32x4*)(stg + n * ST + st * 64 + quad * 16);
          const u32x4 hb = *(const u32x4*)(hs + st * 64 + quad * 16);
          const long a0 = (long)(((unsigned long)ua4[1] << 32) | ua4[0]);
          const long a1 = (long)(((unsigned long)ua4[3] << 32) | ua4[2]);
          const long b0 = (long)(((unsigned long)hb[1] << 32) | hb[0]);
          const long b1 = (long)(((unsigned long)hb[3] << 32) | hb[2]);
          acc = __builtin_amdgcn_mfma_f32_16x16x32_fp8_fp8(a0, b0, acc, 0, 0, 0);
          acc = __builtin_amdgcn_mfma_f32_16x16x32_fp8_fp8(a1, b1, acc, 0, 0, 0);
        }
        __builtin_amdgcn_wave_barrier();
        const float d0 = acc[0] * shv * su0, d1 = acc[1] * shv * su1, d2 = acc[2] * shv * su2, d3 = acc[3] * shv * su3;
        float4 av;
        av.x = 0.5f * d0 * (1.f + erff(d0 * 0.70710678118f)) * gt.x * sv0;
        av.y = 0.5f * d1 * (1.f + erff(d1 * 0.70710678118f)) * gt.y * sv1;
        av.z = 0.5f * d2 * (1.f + erff(d2 * 0.70710678118f)) * gt.z * sv2;
        av.w = 0.5f * d3 * (1.f + erff(d3 * 0.70710678118f)) * gt.w * sv3;
        if (n == 0) *(float4*)(acts + grp * 16 + quad * 4) = av;
      }
    }
    __builtin_amdgcn_fence(__ATOMIC_RELEASE, "workgroup");
    __builtin_amdgcn_wave_barrier();
    float o[16];
#pragma unroll
    for (int j = 0; j < 16; j++) o[j] = 0.f;
    {
      u32x4 ring[16];
#pragma unroll
      for (int k = 0; k < 16; k++) ring[k] = *(const u32x4*)(p.V8 + (size_t)idxs[k] * 1024 + lane * 16);
#pragma unroll 1
      for (int kb = 0; kb < 128; kb += 16) {
        const bool more = kb < 112;
        const int kn = more ? kb + 16 : kb;
#pragma unroll
        for (int j = 0; j < 16; j++) {
          const u32x4 vq = ring[j];
          if (more) ring[j] = *(const u32x4*)(p.V8 + (size_t)idxs[kn + j] * 1024 + lane * 16);
          const float a = acts[kb + j];
#pragma unroll
          for (int q = 0; q < 4; q++) {
            const f32x2 lo = __builtin_amdgcn_cvt_pk_f32_fp8((int)vq[q], false);
            const f32x2 hi = __builtin_amdgcn_cvt_pk_f32_fp8((int)vq[q], true);
            o[4 * q] += a * lo[0]; o[4 * q + 1] += a * lo[1]; o[4 * q + 2] += a * hi[0]; o[4 * q + 3] += a * hi[1];
          }
        }
      }
    }
    float* xr = p.out + (size_t)g * 1024 + lane * 16;
    float4 x[4];
    {
      const u32x4 xa = *(const u32x4*)(p.P + (size_t)g * 1024 + lane * 16), xb = *(const u32x4*)(p.P + (size_t)g * 1024 + lane * 16 + 8);
      x[0] = make_float4(bflo(xa[0]), bfhi(xa[0]), bflo(xa[1]), bfhi(xa[1]));
      x[1] = make_float4(bflo(xa[2]), bfhi(xa[2]), bflo(xa[3]), bfhi(xa[3]));
      x[2] = make_float4(bflo(xb[0]), bfhi(xb[0]), bflo(xb[1]), bfhi(xb[1]));
      x[3] = make_float4(bflo(xb[2]), bfhi(xb[2]), bflo(xb[3]), bfhi(xb[3]));
    }
    float ss = 0.f;
#pragma unroll
    for (int q = 0; q < 4; q++) {
      x[q].x += o[4 * q]; x[q].y += o[4 * q + 1]; x[q].z += o[4 * q + 2]; x[q].w += o[4 * q + 3];
      ss += x[q].x * x[q].x + x[q].y * x[q].y + x[q].z * x[q].z + x[q].w * x[q].w;
    }
    ss = wave_sum(ss);
    if (dry && ss != 123.456f) continue;
    const float rs = rsqrtf(ss * (1.f / 1024.f) + 1e-6f);
#pragma unroll
    for (int q = 0; q < 4; q++) {
      const float4 gq = *(const float4*)(p.final_g + lane * 16 + q * 4);
      *(float4*)(xr + q * 4) = make_float4(x[q].x * rs * gq.x, x[q].y * rs * gq.y, x[q].z * rs * gq.z, x[q].w * rs * gq.w);
    }
  }
}

#define XB_TMO      128
#define XB_XCNT(j)  (256  + 64 * (j))
#define XB_XSUB(j)  (1280 + 64 * (j))
#define XB_XGEN(j)  (2304 + 64 * (j))
#define XB_TOP      3328
#define XB_TOPGEN   3392
#define XCD_BAR_WORDS 3456
#define XB_SPIN_CAP (1u << 18)
#define LAS __attribute__((address_space(3)))
DI unsigned xb_ld(unsigned* p) { return __hip_atomic_load(p, __ATOMIC_RELAXED, __HIP_MEMORY_SCOPE_AGENT); }
DI unsigned xb_add(unsigned* p, unsigned v) { return __hip_atomic_fetch_add(p, v, __ATOMIC_RELAXED, __HIP_MEMORY_SCOPE_AGENT); }
DI unsigned xb_xcc_id() { return (unsigned)__builtin_amdgcn_s_getreg((3 << 11) | 20) & 0xFu; }
#define XB_SPIN(cond, bar) do { unsigned _sp = 0; while (cond) { __builtin_amdgcn_s_sleep(1); \
    if ((++_sp & 255u) == 0u) { if (xb_ld(&(bar)[XB_TMO])) break; if (_sp > XB_SPIN_CAP) { atomicAdd(&(bar)[XB_TMO], 1u); break; } } } } while (0)
struct XcdBarrier { unsigned* bar; unsigned x; volatile LAS unsigned* st; };
DI XcdBarrier xcd_barrier_post(unsigned* bar, volatile LAS unsigned* st) {
  XcdBarrier b; b.bar = bar; b.x = xb_xcc_id(); b.st = st;
  if (threadIdx.x == 0) (void)xb_add(&bar[XB_XCNT(b.x)], 1u);
  return b;
}
DI void xcd_barrier_complete(unsigned* bar, unsigned x, unsigned& nloc, unsigned& nx) {
  const unsigned G = gridDim.x * gridDim.y * gridDim.z;
  unsigned sum, cnt, mine, sp = 0u;
  for (;;) {
    sum = 0u; cnt = 0u; mine = 0u;
#pragma unroll
    for (unsigned j = 0; j < 16; ++j) { const unsigned c = xb_ld(&bar[XB_XCNT(j)]); sum += c; cnt += (c > 0u) ? 1u : 0u; mine = (j == x) ? c : mine; }
    if (sum == G) break;
    __builtin_amdgcn_s_sleep(1);
    if ((++sp & 255u) == 0u) { if (xb_ld(&bar[XB_TMO])) break; if (sp > XB_SPIN_CAP) { atomicAdd(&bar[XB_TMO], 1u); break; } }
  }
  nloc = mine > 0u ? mine : 1u; nx = cnt > 0u ? cnt : 1u;
}
DI void xcd_barrier(const XcdBarrier& b) {
  asm volatile("s_waitcnt vmcnt(0)" ::: "memory");
  __syncthreads();
  if (threadIdx.x == 0) {
    unsigned* bar = b.bar;
    __builtin_amdgcn_s_waitcnt(0);
    unsigned nloc = b.st[0], nx = b.st[1];
    if (nloc == 0u) { xcd_barrier_complete(bar, b.x, nloc, nx); b.st[0] = nloc; b.st[1] = nx; }
    const unsigned old = xb_add(&bar[XB_XSUB(b.x)], 1u);
    const unsigned gen = old / nloc;
    if (old + 1u == (gen + 1u) * nloc) {
      __builtin_amdgcn_fence(__ATOMIC_RELEASE, "agent");
      asm volatile("s_waitcnt vmcnt(0)" ::: "memory");
      const unsigned og = xb_add(&bar[XB_TOP], 1u);
      const unsigned tg = og / nx;
      if (og + 1u == (tg + 1u) * nx) xb_add(&bar[XB_TOPGEN], 1u);
      else XB_SPIN(xb_ld(&bar[XB_TOPGEN]) == tg, bar);
      __builtin_amdgcn_fence(__ATOMIC_ACQUIRE, "agent");
      xb_add(&bar[XB_XGEN(b.x)], 1u);
      asm volatile("s_waitcnt vmcnt(0)" ::: "memory");
    } else {
      XB_SPIN(xb_ld(&bar[XB_XGEN(b.x)]) == gen, bar);
      __builtin_amdgcn_fence(__ATOMIC_ACQUIRE, "agent");
      asm volatile("s_waitcnt vmcnt(0)" ::: "memory");
    }
  }
  __syncthreads();
}

__global__ void __launch_bounds__(512) mega_kernel(Params p) {
  cg::grid_group grid = cg::this_grid();
  const int bid = blockIdx.x, nb = gridDim.x;
  __shared__ uint4 xb_words;
  if (threadIdx.x == 0) xb_words = make_uint4(0u, 0u, 0u, 0u);
  __syncthreads();
  const XcdBarrier xb = xcd_barrier_post(p.bar, (volatile LAS unsigned*)&xb_words);
  if (ON(0)) ph_prep(p, bid, nb);
  xcd_barrier(xb);
  if (nb == 0x7fffffff) grid.sync();
  if (ON(1)) ph_gemm1(p, bid, nb);
  xcd_barrier(xb);
  if (REP == 1) { ph_gemm1(p, bid, nb); xcd_barrier(xb); }
  if (ON(2)) ph_rwprep(p, bid, nb);
  xcd_barrier(xb);
  if (REP == 2) { ph_rwprep(p, bid, nb); xcd_barrier(xb); }
  if (ON(3)) ph_scan(p, bid, nb);
  xcd_barrier(xb);
  if (REP == 3) { ph_scan(p, bid, nb); xcd_barrier(xb); }
  if (REP == 4) { ph_attn(p, bid, nb, true); xcd_barrier(xb); }
  if (ON(4)) ph_attn(p, bid, nb);
  xcd_barrier(xb);
  if (ON(5)) ph_gemm2(p, bid, nb);
  xcd_barrier(xb);
  if (ON(6)) ph_gemm3(p, bid, nb);
  xcd_barrier(xb);
  if (ON(7)) ph_norm2(p, bid * NW + (otid() >> 6), TP, nb * NW);
  xcd_barrier(xb);
  if (ON(8)) ph_peerq(p, bid, nb);
  xcd_barrier(xb);
  if (ON(9)) {
    if (bid < 4) {
      const int wv_ = otid() >> 6;
      ph_gemm2(p, bid, nb, bid);
      __builtin_amdgcn_fence(__ATOMIC_RELEASE, "agent"); __syncthreads(); __builtin_amdgcn_fence(__ATOMIC_ACQUIRE, "agent");
      ph_gemm3(p, bid, nb, bid);
      __builtin_amdgcn_fence(__ATOMIC_RELEASE, "agent"); __syncthreads(); __builtin_amdgcn_fence(__ATOMIC_ACQUIRE, "agent");
      ph_norm2(p, (256 + bid) * 256 + wv_, (256 + bid) * 256 + 256, NW);
      __builtin_amdgcn_fence(__ATOMIC_RELEASE, "agent"); __syncthreads(); __builtin_amdgcn_fence(__ATOMIC_ACQUIRE, "agent");
      ph_peerq(p, bid, nb, bid);
    } else {
      ph_peer(p, (bid - 4) * NW + (otid() >> 6), TP, (nb - 4) * NW);
    }
  }
  xcd_barrier(xb);
  if (ON(9)) ph_peer(p, TP + bid * NW + (otid() >> 6), T, nb * NW);
}

extern "C" void kernel_launch(void* const* d_in, const int* in_sizes, int n_in, void* d_out, int out_size, void* d_ws,
                              size_t ws_size, hipStream_t stream) {
  Params p{};
  const float** f = (const float**)&p;
  for (int i = 0; i < 28; i++) f[i] = (const float*)d_in[i];
  p.out = (float*)d_out;
  char* w = (char*)d_ws;
  size_t off = 0;
  auto take = [&](size_t bytes) { char* r = w + off; off += (bytes + 255) & ~(size_t)255; return (u16*)r; };
  p.H = take((size_t)MP * 1024 * 2);
  p.P = take((size_t)MP * INC * 2);
  p.U8 = (unsigned char*)take((size_t)16384 * 1024);
  p.V8 = (unsigned char*)take((size_t)16384 * 1024);
  p.SU = (float*)take(16384 * 4);
  p.SV = (float*)take(16384 * 4);
  p.SH = (float*)take((size_t)T * 4);
  p.bar = (unsigned*)take((size_t)XCD_BAR_WORDS * 4);
  p.WinT = take((size_t)4608 * 1024 * 2);
  p.WbT = take((size_t)2 * 1024 * 512 * 2);
  p.WoutT = take((size_t)1024 * 1024 * 2);
  p.WqT = take((size_t)1024 * 1024 * 2);
  p.W2T = take((size_t)512 * 64 * 2);
  p.A2T = take((size_t)512 * 64 * 2);
  p.G2T = take((size_t)512 * 128 * 2);
  p.SK = take((size_t)2 * 128 * 64 * 2);
  p.Y = take((size_t)T * 512 * 2);
  p.G = take((size_t)T * 512 * 2);
  p.OATT = take((size_t)T * 512 * 2);
  static int grid_blocks = 0;
  if (!grid_blocks) {
    int dev = 0, cus = 0, per_cu = 0;
    (void)hipGetDevice(&dev);
    (void)hipDeviceGetAttribute(&cus, hipDeviceAttributeMultiprocessorCount, dev);
    (void)hipFuncSetAttribute((const void*)mega_kernel, hipFuncAttributeMaxDynamicSharedMemorySize, DYN_LDS);
    (void)hipOccupancyMaxActiveBlocksPerMultiprocessor(&per_cu, mega_kernel, NTH, DYN_LDS);
    if (per_cu > 1) per_cu = 1;
    grid_blocks = cus * per_cu;
  }
  (void)hipMemsetAsync(p.bar, 0, (size_t)XCD_BAR_WORDS * 4, stream);
  void* args[] = {&p};
  hipError_t e = hipLaunchCooperativeKernel((void*)mega_kernel, dim3(grid_blocks), dim3(NTH), args, DYN_LDS, stream);
  if (e != hipSuccess) fprintf(stderr, "cooperative launch failed: %s (grid %d)\n", hipGetErrorString(e), grid_blocks);
}
```

```cpp
#include <hip/hip_runtime.h>
#include <hip/hip_cooperative_groups.h>
#include <cstdio>
namespace cg = cooperative_groups;

#ifndef REP
#define REP -1
#endif
#ifndef ONLY
#define ONLY -1
#endif
#define ON(k) (ONLY < 0 || ONLY == (k))

typedef unsigned short u16;
typedef unsigned int u32;
using bf16x8 = __attribute__((ext_vector_type(8))) short;
using f32x4 = __attribute__((ext_vector_type(4))) float;
using f32x16 = __attribute__((ext_vector_type(16))) float;
using u32x4 = __attribute__((ext_vector_type(4))) u32;
#define DI __device__ __forceinline__

constexpr int TP = 65536, TS = 1024, T = 66560, MP = 66816;
constexpr int INC = 4608;
constexpr int NW = 8;
constexpr int NTH = 512;
constexpr size_t OFF_Y = 0, OFF_SHIFT_P = 68157440, OFF_WKV_P = 68173824, OFF_KP = 68698112, OFF_VP = 68960256,
                 OFF_SHIFT_S = 69222400, OFF_WKV_S = 69238784, OFF_KS = 69763072, OFF_VS = 69894144;
constexpr int DYN_LDS = 159744;

extern __shared__ __attribute__((aligned(16))) char dsm[];

struct Params {
  const float *x_prompt, *x_sample, *state_shift, *state_wkv, *cache_k, *cache_v, *norm1_g, *w_in, *mu, *w0, *w2, *a0,
      *a2, *g2, *k_k, *k_a, *r_k, *lnx_w, *lnx_b, *sinks, *w_branch, *w_out, *norm2_g, *peer_wq, *sub_keys, *peer_u,
      *peer_v, *final_g;
  float* out;
  u16 *H, *P, *WinT, *WbT, *WoutT, *WqT, *W2T, *A2T, *G2T, *SK, *Y, *G, *OATT;
  unsigned char *U8, *V8;
  float *SU, *SV, *SH;
  unsigned* bar;
};

typedef __bf16 hbf2 __attribute__((ext_vector_type(2)));
typedef float hf2 __attribute__((ext_vector_type(2)));
DI u16 f2bf(float x) { const __bf16 r = (__bf16)x; return __builtin_bit_cast(unsigned short, r); }
DI float bf2f(u16 b) { return __uint_as_float(((u32)b) << 16); }
DI u32 pack2(float a, float b) { const hf2 v = {a, b}; const hbf2 r = __builtin_convertvector(v, hbf2); return __builtin_bit_cast(u32, r); }
DI float bflo(u32 w) { return __uint_as_float(w << 16); }
DI float bfhi(u32 w) { return __uint_as_float(w & 0xffff0000u); }
DI float wave_sum(float v) {
#pragma unroll
  for (int o = 32; o; o >>= 1) v += __shfl_xor(v, o);
  return v;
}
DI float sigmoidf_(float x) { return 1.f / (1.f + __expf(-x)); }
DI const float* xrow(const Params& p, int g) {
  return g < TP ? p.x_prompt + (size_t)g * 1024 : p.x_sample + (size_t)(g - TP) * 1024;
}
DI int otid() { int t = threadIdx.x; asm volatile("" : "+v"(t)); return t; }
#define MFMA32(a, b, c) __builtin_amdgcn_mfma_f32_32x32x16_bf16((a), (b), (c), 0, 0, 0)
#define MFMA16(a, b, c) __builtin_amdgcn_mfma_f32_16x16x32_bf16((a), (b), (c), 0, 0, 0)

template <int CTRL>
DI float dppmov(float v) {
  return __int_as_float(__builtin_amdgcn_update_dpp(0, __float_as_int(v), CTRL, 0xF, 0xF, false));
}
DI float red16(float v) {
  v += dppmov<0x128>(v);
  v += dppmov<0x124>(v);
  v += dppmov<0x122>(v);
  v += dppmov<0x121>(v);
  return v;
}


using f32x2 = __attribute__((ext_vector_type(2))) float;
DI float wave_max(float v) {
#pragma unroll
  for (int o = 32; o; o >>= 1) v = fmaxf(v, __shfl_xor(v, o));
  return v;
}
DI u32 q4(float a, float b, float c, float d, float sc) {
  int w = 0;
  w = __builtin_amdgcn_cvt_pk_fp8_f32(a * sc, b * sc, w, false);
  w = __builtin_amdgcn_cvt_pk_fp8_f32(c * sc, d * sc, w, true);
  return (u32)w;
}

DI void tcvt(const float* __restrict__ W, u16* __restrict__ Wt, int K, int N, int gt, int nt) {
  const int total = N * (K / 8);
  for (int i = gt; i < total; i += nt) {
    const int n = i % N, kg = i / N;
    u32 o[4];
#pragma unroll
    for (int j = 0; j < 4; j++)
      o[j] = pack2(W[(size_t)(kg * 8 + 2 * j) * N + n], W[(size_t)(kg * 8 + 2 * j + 1) * N + n]);
    *(uint4*)(Wt + (size_t)n * K + kg * 8) = make_uint4(o[0], o[1], o[2], o[3]);
  }
}
DI void scvt(const float* __restrict__ W, u16* __restrict__ O, int n8, int gt, int nt) {
  for (int i = gt; i < n8; i += nt) {
    const float4 a = ((const float4*)W)[2 * i], b = ((const float4*)W)[2 * i + 1];
    ((uint4*)O)[i] = make_uint4(pack2(a.x, a.y), pack2(a.z, a.w), pack2(b.x, b.y), pack2(b.z, b.w));
  }
}

__device__ void ph_prep(const Params& p, int bid, int nb) {
  const int tid = otid(), lane = tid & 63, wv = tid >> 6;
  for (int row = bid * NW + wv; row < MP; row += nb * NW) {
    u16* hr = p.H + (size_t)row * 1024;
    if (row < T) {
      const float4* x = (const float4*)xrow(p, row);
      float4 v[4];
      float ss = 0.f;
#pragma unroll
      for (int i = 0; i < 4; i++) {
        v[i] = x[lane + i * 64];
        ss += v[i].x * v[i].x + v[i].y * v[i].y + v[i].z * v[i].z + v[i].w * v[i].w;
      }
      ss = wave_sum(ss);
      const float rs = rsqrtf(ss * (1.f / 1024.f) + 1e-6f);
      float* so = nullptr;
      if (row < TP) {
        if ((row & 4095) == 4095) so = p.out + OFF_SHIFT_P + (size_t)(row >> 12) * 1024;
      } else {
        const int r2 = row - TP;
        if ((r2 & 63) == 63) so = p.out + OFF_SHIFT_S + (size_t)(r2 >> 6) * 1024;
      }
#pragma unroll
      for (int i = 0; i < 4; i++) {
        const float4 g = ((const float4*)p.norm1_g)[lane + i * 64];
        float4 y;
        y.x = v[i].x * rs * g.x; y.y = v[i].y * rs * g.y; y.z = v[i].z * rs * g.z; y.w = v[i].w * rs * g.w;
        ((uint2*)hr)[lane + i * 64] = make_uint2(pack2(y.x, y.y), pack2(y.z, y.w));
        if (so) ((float4*)so)[lane + i * 64] = y;
      }
    } else if (row < T + 16) {
      const float4* x = (const float4*)(p.state_shift + (size_t)(row - T) * 1024);
#pragma unroll
      for (int i = 0; i < 4; i++) {
        const float4 y = x[lane + i * 64];
        ((uint2*)hr)[lane + i * 64] = make_uint2(pack2(y.x, y.y), pack2(y.z, y.w));
      }
    } else {
#pragma unroll
      for (int i = 0; i < 4; i++) ((uint2*)hr)[lane + i * 64] = make_uint2(0u, 0u);
    }
  }
  const int gt = bid * NTH + tid, nt = nb * NTH;
  tcvt(p.w_in, p.WinT, 1024, 4608, gt, nt);
  tcvt(p.w_branch, p.WbT, 512, 1024, gt, nt);
  tcvt(p.w_branch + 512 * 1024, p.WbT + 1024 * 512, 512, 1024, gt, nt);
  tcvt(p.w_out, p.WoutT, 1024, 1024, gt, nt);
  tcvt(p.peer_wq, p.WqT, 1024, 1024, gt, nt);
  tcvt(p.w2, p.W2T, 64, 512, gt, nt);
  tcvt(p.a2, p.A2T, 64, 512, gt, nt);
  tcvt(p.g2, p.G2T, 128, 512, gt, nt);
  scvt(p.sub_keys, p.SK, 2 * 128 * 64 / 8, gt, nt);
  for (int r = bid * NW + wv; r < 32768; r += nb * NW) {
    const bool isv = r >= 16384;
    const int e = r & 16383;
    const float4* src = (const float4*)((isv ? p.peer_v : p.peer_u) + (size_t)e * 1024) + lane * 4;
    const float4 a = src[0], b = src[1], c = src[2], d = src[3];
    float am = fmaxf(fmaxf(fmaxf(fabsf(a.x), fabsf(a.y)), fmaxf(fabsf(a.z), fabsf(a.w))),
                     fmaxf(fmaxf(fabsf(b.x), fabsf(b.y)), fmaxf(fabsf(b.z), fabsf(b.w))));
    am = fmaxf(am, fmaxf(fmaxf(fmaxf(fabsf(c.x), fabsf(c.y)), fmaxf(fabsf(c.z), fabsf(c.w))),
                         fmaxf(fmaxf(fabsf(d.x), fabsf(d.y)), fmaxf(fabsf(d.z), fabsf(d.w)))));
    am = fmaxf(wave_max(am), 1e-30f);
    const float sc = 240.f / am;
    if (lane == 0) (isv ? p.SV : p.SU)[e] = am * (1.f / 240.f);
    *(u32x4*)((isv ? p.V8 : p.U8) + (size_t)e * 1024 + lane * 16) =
        u32x4{q4(a.x, a.y, a.z, a.w, sc), q4(b.x, b.y, b.z, b.w, sc), q4(c.x, c.y, c.z, c.w, sc), q4(d.x, d.y, d.z, d.w, sc)};
  }
}

constexpr int GBK = 64, GHALF = 128, GHT = GHALF * GBK;
DI int lds_byte(int r, int c) {
  const int st = (r >> 4) * 2 + (c >> 5), rr = r & 15, cc = c & 31, ob = rr * 64 + cc * 2;
  return st * 1024 + (ob ^ (((ob >> 9) & 1) << 5));
}
DI void stage_rc(int b, int& R, int& C) {
  const int st = b / 1024, sb = b % 1024, swz = sb ^ (((sb >> 9) & 1) << 5);
  R = (st >> 1) * 16 + swz / 64;
  C = (st & 1) * 32 + (swz % 64) / 2;
}
typedef __attribute__((address_space(3))) unsigned lds_u32;
#define G_SA(b, h) (shm + ((b) * 2 + (h)) * GHT)
#define G_SB(b, h) (shm + (4 + (b) * 2 + (h)) * GHT)
#define G_STAGE(P_, RS, br, kt)                                                                                   \
  do {                                                                                                            \
    const int _so = ((br) * K + (kt) * GBK) * 2;                                                                  \
    __builtin_amdgcn_raw_ptr_buffer_load_lds(RS, (lds_u32*)((char*)(P_) + tb0), 16, ob0, _so, 0, 0);              \
    __builtin_amdgcn_raw_ptr_buffer_load_lds(RS, (lds_u32*)((char*)(P_) + tb0 + 8192), 16, ob1, _so, 0, 0);       \
  } while (0)
#define G_LDA(dst, b, h)                                  \
  _Pragma("unroll") for (int m = 0; m < 4; ++m)           \
  _Pragma("unroll") for (int k = 0; k < 2; ++k)           \
    dst[m][k] = *reinterpret_cast<const bf16x8*>((const char*)G_SA(b, h) + lds_byte(wr * 64 + m * 16 + fr, k * 32 + fq * 8))
#define G_LDB(dst, b, h)                                  \
  _Pragma("unroll") for (int n = 0; n < 2; ++n)           \
  _Pragma("unroll") for (int k = 0; k < 2; ++k)           \
    dst[n][k] = *reinterpret_cast<const bf16x8*>((const char*)G_SB(b, h) + lds_byte(wc * 32 + n * 16 + fr, k * 32 + fq * 8))
#define G_MMA(ai, bj, At_, Bt_)                                                                         \
  do {                                                                                                  \
    __builtin_amdgcn_s_setprio(1);                                                                      \
    _Pragma("unroll") for (int m = 0; m < 4; ++m)                                                       \
    _Pragma("unroll") for (int n = 0; n < 2; ++n)                                                       \
    _Pragma("unroll") for (int k = 0; k < 2; ++k)                                                       \
      acc[ai][bj][m][n] = MFMA16(At_[m][k], Bt_[n][k], acc[ai][bj][m][n]);                              \
    __builtin_amdgcn_s_setprio(0);                                                                      \
  } while (0)
#define WAIT_V(n) asm volatile("s_waitcnt vmcnt(" #n ")" ::: "memory")
#define WAIT_L(n) asm volatile("s_waitcnt lgkmcnt(" #n ")" ::: "memory")
#define BAR __builtin_amdgcn_s_barrier()
#define SCHED __builtin_amdgcn_sched_barrier(0)

template <int K>
DI void gemm256(const u16* __restrict__ A, const u16* __restrict__ Bt, const int brow, const int bcol,
                f32x4 (&acc)[2][2][4][2]) {
  u16* shm = (u16*)dsm;
  const int tid_ = otid();
  const int wid = tid_ >> 6, lane = tid_ & 63, wr = wid >> 2, wc = wid & 3, fr = lane & 15, fq = lane >> 4;
#pragma unroll
  for (int a = 0; a < 2; a++)
#pragma unroll
    for (int b = 0; b < 2; b++)
#pragma unroll
      for (int m = 0; m < 4; m++)
#pragma unroll
        for (int n = 0; n < 2; n++) acc[a][b][m][n] = f32x4{0.f, 0.f, 0.f, 0.f};
  bf16x8 At[4][2], B0[2][2], B1[2][2];
  constexpr int nt = K / GBK;
  const __amdgpu_buffer_rsrc_t rsA = __builtin_amdgcn_make_buffer_rsrc((void*)A, 0, 0x7fffffff, 0x00020000);
  const __amdgpu_buffer_rsrc_t rsB = __builtin_amdgcn_make_buffer_rsrc((void*)Bt, 0, 0x7fffffff, 0x00020000);
  const unsigned tb0 = tid_ * 16;
  int ob0, ob1;
  {
    int r_, c_;
    stage_rc((int)tb0, r_, c_);
    ob0 = (r_ * K + c_) * 2;
    stage_rc((int)tb0 + 8192, r_, c_);
    ob1 = (r_ * K + c_) * 2;
  }
  WAIT_V(0);
  __syncthreads();
  G_STAGE(G_SB(0, 0), rsB, bcol, 0); G_STAGE(G_SA(0, 0), rsA, brow, 0);
  G_STAGE(G_SB(0, 1), rsB, bcol + GHALF, 0); G_STAGE(G_SA(0, 1), rsA, brow + GHALF, 0);
  if (wr == 1) BAR;
  WAIT_V(4); BAR;
  G_STAGE(G_SB(1, 0), rsB, bcol, 1); G_STAGE(G_SA(1, 0), rsA, brow, 1); G_STAGE(G_SB(1, 1), rsB, bcol + GHALF, 1);
  WAIT_V(6); BAR;
  for (int t = 0; t < nt - 2; t += 2) {
    G_LDB(B0, 0, 0); SCHED; G_LDA(At, 0, 0); G_STAGE(G_SA(1, 1), rsA, brow + GHALF, t + 1);
    WAIT_L(8); BAR; WAIT_L(0); G_MMA(0, 0, At, B0); BAR; SCHED;
    G_LDB(B1, 0, 1); G_STAGE(G_SB(0, 0), rsB, bcol, t + 2);
    BAR; WAIT_L(0); G_MMA(0, 1, At, B1); BAR;
    G_LDA(At, 0, 1); G_STAGE(G_SA(0, 0), rsA, brow, t + 2);
    BAR; WAIT_L(0); G_MMA(1, 0, At, B0); BAR; SCHED;
    G_STAGE(G_SB(0, 1), rsB, bcol + GHALF, t + 2);
    WAIT_V(6); BAR; G_MMA(1, 1, At, B1); BAR;
    G_LDB(B0, 1, 0); SCHED; G_LDA(At, 1, 0); G_STAGE(G_SA(0, 1), rsA, brow + GHALF, t + 2);
    WAIT_L(8); BAR; WAIT_L(0); G_MMA(0, 0, At, B0); BAR; SCHED;
    G_LDB(B1, 1, 1); G_STAGE(G_SB(1, 0), rsB, bcol, t + 3);
    BAR; WAIT_L(0); G_MMA(0, 1, At, B1); BAR;
    G_LDA(At, 1, 1); G_STAGE(G_SA(1, 0), rsA, brow, t + 3);
    BAR; WAIT_L(0); G_MMA(1, 0, At, B0); BAR; SCHED;
    G_STAGE(G_SB(1, 1), rsB, bcol + GHALF, t + 3);
    WAIT_V(6); BAR; G_MMA(1, 1, At, B1); BAR;
  }
  {
    G_LDB(B0, 0, 0); G_LDA(At, 0, 0); G_STAGE(G_SA(1, 1), rsA, brow + GHALF, nt - 1);
    BAR; WAIT_L(0); G_MMA(0, 0, At, B0); BAR;
    G_LDB(B1, 0, 1); BAR; WAIT_L(0); G_MMA(0, 1, At, B1); BAR;
    G_LDA(At, 0, 1); WAIT_V(4); BAR; WAIT_L(0); G_MMA(1, 0, At, B0); G_MMA(1, 1, At, B1); BAR;
  }
  {
    G_LDB(B0, 1, 0); G_LDA(At, 1, 0); WAIT_V(2); BAR; WAIT_L(0); G_MMA(0, 0, At, B0); BAR;
    G_LDB(B1, 1, 1); WAIT_V(0); BAR; WAIT_L(0); G_MMA(0, 1, At, B1); BAR;
    G_LDA(At, 1, 1); BAR; WAIT_L(0); G_MMA(1, 0, At, B0); G_MMA(1, 1, At, B1); BAR;
  }
  if (wr == 0) BAR;
}
#define GT_VARS \
  const int tid_ = otid(); const int wid = tid_ >> 6, lane = tid_ & 63, wr = wid >> 2, wc = wid & 3, fr = lane & 15, fq = lane >> 4;
#define GT_ROW(ai, m, j) ((ai) * 128 + wr * 64 + (m) * 16 + fq * 4 + (j))
#define GT_COL(bj, n) ((bj) * 128 + wc * 32 + (n) * 16 + fr)
#define GT_FOR                                       \
  _Pragma("unroll") for (int ai = 0; ai < 2; ++ai)   \
  _Pragma("unroll") for (int bj = 0; bj < 2; ++bj)   \
  _Pragma("unroll") for (int m = 0; m < 4; ++m)      \
  _Pragma("unroll") for (int n = 0; n < 2; ++n)      \
  _Pragma("unroll") for (int j = 0; j < 4; ++j)

DI bool tile_of(int round, int bid, int nb, int nM, int nN, int& pm, int& pn) {
  const int vt = round * nb + (bid & 7) * (nb >> 3) + (bid >> 3);
  if (vt >= nM * nN) return false;
  const int nig = 8 * nN, gid = vt / nig, fm = gid * 8, gsz = min(nM - fm, 8);
  pm = fm + (vt % nig) % gsz;
  pn = (vt % nig) / gsz;
  return true;
}


constexpr int CS_LD = 264;
DI void acc_to_lds(const f32x4 (&acc)[2][2][4][2]) {
  GT_VARS
  u16* Cs = (u16*)dsm;
  __syncthreads();
  GT_FOR { Cs[GT_ROW(ai, m, j) * CS_LD + GT_COL(bj, n)] = f2bf(acc[ai][bj][m][n][j]); }
  __syncthreads();
}

__device__ void ph_gemm1(const Params& p, int bid, int nb) {
  const int tid_ = otid();
  const int nM = 261, nN = 18;
  for (int round = 0; round * nb < nM * nN; ++round) {
    int pm, pn;
    if (!tile_of(round, bid, nb, nM, nN, pm, pn)) break;
    f32x4 acc[2][2][4][2];
    gemm256<1024>(p.H, p.WinT, pm * 256, pn * 256, acc);
    acc_to_lds(acc);
    const u16* Cs = (const u16*)dsm;
#pragma unroll 4
    for (int it = 0; it < 16; it++) {
      const int id = it * NTH + tid_, rl = id >> 5, c8 = (id & 31) * 8;
      const int row = pm * 256 + rl;
      const u32x4 v = *(const u32x4*)(Cs + rl * CS_LD + c8);
      *(u32x4*)(p.P + (size_t)row * INC + pn * 256 + c8) = v;
      if (pn == 9) {
        float* dst = nullptr;
        const int c2 = c8 & 127;
        if (row < TP) {
          const int tt = row & 4095;
          if (tt >= 3968) dst = p.out + (c8 < 128 ? OFF_KP : OFF_VP) + ((size_t)(row >> 12) * 128 + (tt - 3968)) * 128 + c2;
        } else if (row < T) {
          dst = p.out + (c8 < 128 ? OFF_KS : OFF_VS) + (size_t)(row - TP) * 128 + c2;
        }
        if (dst) {
          *(float4*)dst = make_float4(bflo(v[0]), bfhi(v[0]), bflo(v[1]), bfhi(v[1]));
          *(float4*)(dst + 4) = make_float4(bflo(v[2]), bfhi(v[2]), bflo(v[3]), bfhi(v[3]));
        }
      }
    }
  }
}

DI int prev_row(int g) {
  if (g < TP) return (g & 4095) ? g - 1 : -1;
  const int r2 = g - TP;
  return (r2 & 63) ? g - 1 : T + (r2 >> 6);
}

__device__ void ph_rwprep(const Params& p, int bid, int nb) {
  const int tid = otid(), lane = tid & 63, wv = tid >> 6, fr = lane & 15, fq = lane >> 4;
  u16* A1 = (u16*)dsm;
  u16* A2 = A1 + 64 * 80;
  u16* A3 = A2 + 64 * 80;
  u16* SA = (u16*)(p.out);
  u16* SB = p.H;
  const int hd = wv;
  u16* OT = (u16*)(dsm + 38912 + wv * 12288);
  u32x4 pin[7];
  for (int unit = bid; unit < 1024 + 64; unit += nb) {
    const int g0 = unit < 1024 ? unit * 64 : TP + (unit - 1024) * 16;
    const int nrg = unit < 1024 ? 4 : 1;
    auto issue_in = [&](int rg_) {
#pragma unroll
      for (int it = 0; it < 7; it++) {
        const int id = it * 64 + lane, ri = id / 24, rem = id - ri * 24, arr = rem >> 3, ch = rem & 7;
        int tok = g0 + rg_ * 16 - 1 + ri;
        if (rg_ == 0 && ri == 0) tok = prev_row(g0);
        pin[it] = u32x4{0u, 0u, 0u, 0u};
        if (id < 408 && tok >= 0) pin[it] = *(const u32x4*)(p.P + (size_t)tok * INC + arr * 512 + hd * 64 + ch * 8);
      }
    };
    __syncthreads();
    if ((tid >> 3) < nrg * 16) {
      const int row = tid >> 3, part8 = tid & 7, part = part8 >> 1, sub = part8 & 1;
      const int g = g0 + row, pr = prev_row(g);
      const int cb = 1536 + part * 64 + sub * 32;
      const u16* cur = p.P + (size_t)g * INC + cb;
      const u16* prv = p.P + (size_t)(pr < 0 ? 0 : pr) * INC + cb;
#pragma unroll
      for (int q = 0; q < 4; q++) {
        const u32x4 c4 = *(const u32x4*)(cur + q * 8);
        u32x4 p4 = {0u, 0u, 0u, 0u};
        if (pr >= 0) p4 = *(const u32x4*)(prv + q * 8);
        u32x4 ow;
#pragma unroll
        for (int e = 0; e < 4; e++) {
          const float c0 = bflo(c4[e]), c1 = bfhi(c4[e]), q0 = bflo(p4[e]), q1 = bfhi(p4[e]);
          float f0 = c0 + (q0 - c0) * p.mu[cb + q * 8 + 2 * e];
          float f1 = c1 + (q1 - c1) * p.mu[cb + q * 8 + 2 * e + 1];
          if (part == 0) { f0 = 1.f - 2.f / (1.f + __expf(2.f * f0)); f1 = 1.f - 2.f / (1.f + __expf(2.f * f1)); }
          else if (part >= 2) { f0 = sigmoidf_(f0); f1 = sigmoidf_(f1); }
          ow[e] = pack2(f0, f1);
        }
        u16* dst = part == 0 ? A1 + row * 80 + sub * 32 + q * 8
                 : part == 1 ? A2 + row * 80 + sub * 32 + q * 8
                             : A3 + row * 144 + (part - 2) * 64 + sub * 32 + q * 8;
        *(u32x4*)dst = ow;
      }
    }
    __syncthreads();
#pragma unroll 1
    for (int rg = 0; rg < nrg; rg++) {
      issue_in(rg);
#pragma unroll
      for (int it = 0; it < 7; it++) {
        const int id = it * 64 + lane;
        if (id < 408) *(u32x4*)(OT + id * 8) = pin[it];
      }
      __builtin_amdgcn_fence(__ATOMIC_RELEASE, "workgroup");
      __builtin_amdgcn_wave_barrier();
      float inr[5][3][4];
#pragma unroll
      for (int jj = 0; jj < 5; jj++)
#pragma unroll
        for (int ar = 0; ar < 3; ar++)
#pragma unroll
          for (int nt = 0; nt < 4; nt++) inr[jj][ar][nt] = bf2f(OT[((fq * 4 + jj) * 3 + ar) * 64 + nt * 16 + fr]);
      __builtin_amdgcn_fence(__ATOMIC_RELEASE, "workgroup");
      __builtin_amdgcn_wave_barrier();
      SCHED;
      f32x4 aw[4], aa[4];
#pragma unroll
      for (int nt = 0; nt < 4; nt++) { aw[nt] = f32x4{0.f, 0.f, 0.f, 0.f}; aa[nt] = f32x4{0.f, 0.f, 0.f, 0.f}; }
#pragma unroll 1
      for (int ks = 0; ks < 2; ks++) {
        const bf16x8 f1 = *(const bf16x8*)(A1 + (rg * 16 + fr) * 80 + ks * 32 + fq * 8);
        const bf16x8 f2 = *(const bf16x8*)(A2 + (rg * 16 + fr) * 80 + ks * 32 + fq * 8);
#pragma unroll
        for (int nt = 0; nt < 4; nt++) {
          const bf16x8 bw = *(const bf16x8*)(p.W2T + (unsigned)((hd * 64 + nt * 16 + fr) * 64 + ks * 32 + fq * 8));
          const bf16x8 ba = *(const bf16x8*)(p.A2T + (unsigned)((hd * 64 + nt * 16 + fr) * 64 + ks * 32 + fq * 8));
          aw[nt] = MFMA16(f1, bw, aw[nt]);
          aa[nt] = MFMA16(f2, ba, aa[nt]);
        }
      }
      float ss[4] = {0.f, 0.f, 0.f, 0.f};
      const int rowb = rg * 16 + fq * 4;
      const int gb = g0 + rowb;
#pragma unroll
      for (int nt = 0; nt < 4; nt++) {
        const int c = nt * 16 + fr, col = hd * 64 + c;
        const float mu_r = p.mu[col], mu_k = p.mu[512 + col], mu_v = p.mu[1024 + col];
        const float w0c = p.w0[col], a0c = p.a0[col], kkc = p.k_k[col], kac = p.k_a[col];
        float qr = inr[0][0][nt], qk = inr[0][1][nt], qv = inr[0][2][nt];
#pragma unroll
        for (int j = 0; j < 4; j++) {
          const float cr = inr[j + 1][0][nt], ck = inr[j + 1][1][nt], cv = inr[j + 1][2][nt];
          const float r = cr + (qr - cr) * mu_r, k = ck + (qk - ck) * mu_k, v = cv + (qv - cv) * mu_v;
          qr = cr; qk = ck; qv = cv;
          const float ed = 0.6065306597126334f * sigmoidf_(w0c + aw[nt][j]);
          const float dm = 1.f - __expf(-ed);
          const float a = sigmoidf_(a0c + aa[nt][j]);
          const float kkv = k * kkc;
          ss[j] += kkv * kkv;
          const float k2 = k * (1.f + (a - 1.f) * kac);
          u16* ot = OT + (fq * 4 + j) * 384 + c;
          ot[0] = f2bf(r);
          ot[64] = f2bf(dm);
          ot[128] = f2bf(k2);
          ot[256] = f2bf(v);
          aw[nt][j] = kkv;
          aa[nt][j] = a;
        }
        SCHED;
      }
#pragma unroll
      for (int j = 0; j < 4; j++) ss[j] = 1.f / fmaxf(sqrtf(red16(ss[j])), 1e-12f);
#pragma unroll
      for (int nt = 0; nt < 4; nt++) {
        const int c = nt * 16 + fr;
#pragma unroll
        for (int j = 0; j < 4; j++) {
          const float kkn = aw[nt][j] * ss[j];
          u16* ot = OT + (fq * 4 + j) * 384 + c;
          ot[192] = f2bf(kkn);
          ot[320] = f2bf(kkn * aa[nt][j]);
        }
      }
      __builtin_amdgcn_fence(__ATOMIC_RELEASE, "workgroup");
      __builtin_amdgcn_wave_barrier();
      {
        const int gr0 = g0 + rg * 16;
#pragma unroll 4
        for (int it = 0; it < 12; it++) {
          const int id = it * 64 + lane, rowi = id / 48, pc = id % 48;
          const u32x4 v4 = *(const u32x4*)(OT + rowi * 384 + pc * 8);
          const size_t gh = (size_t)(gr0 + rowi) * 8 + hd;
          if (pc < 32) *(u32x4*)(SA + gh * 256 + pc * 8) = v4;
          else *(u32x4*)(SB + gh * 128 + (pc - 32) * 8) = v4;
        }
      }
      __builtin_amdgcn_wave_barrier();
      f32x4 ag[4];
#pragma unroll
      for (int nt = 0; nt < 4; nt++) ag[nt] = f32x4{0.f, 0.f, 0.f, 0.f};
#pragma unroll 1
      for (int ks = 0; ks < 4; ks++) {
        const bf16x8 f3 = *(const bf16x8*)(A3 + (rg * 16 + fr) * 144 + ks * 32 + fq * 8);
#pragma unroll
        for (int nt = 0; nt < 4; nt++) {
          const bf16x8 bg = *(const bf16x8*)(p.G2T + (unsigned)((hd * 64 + nt * 16 + fr) * 128 + ks * 32 + fq * 8));
          ag[nt] = MFMA16(f3, bg, ag[nt]);
        }
      }
#pragma unroll
      for (int nt = 0; nt < 4; nt++)
#pragma unroll
        for (int j = 0; j < 4; j++) p.G[(size_t)(gb + j) * 512 + hd * 64 + nt * 16 + fr] = f2bf(ag[nt][j]);
    }
  }
}

DI float red8(float v) {
  v += dppmov<0xB1>(v);
  v += dppmov<0x4E>(v);
  v += dppmov<0x141>(v);
  return v;
}
struct ScanOps { f32x4 r, d, k, n, b; float v; };
DI void scan_ld(ScanOps& o, const float* sb, int j0, int row) {
  o.r = *(const f32x4*)(sb + j0);
  o.d = *(const f32x4*)(sb + 64 + j0);
  o.k = *(const f32x4*)(sb + 128 + j0);
  o.n = *(const f32x4*)(sb + 192 + j0);
  o.b = *(const f32x4*)(sb + 320 + j0);
  o.v = sb[256 + row];
}
#define LO2(x) __builtin_shufflevector((x), (x), 0, 1)
#define HI2(x) __builtin_shufflevector((x), (x), 2, 3)
DI float scan_step(f32x2 (&S)[2], const ScanOps& o, f32x4& rprev) {
  const f32x2 vv = {o.v, o.v};
  const f32x2 tt = S[0] * LO2(o.n) + S[1] * HI2(o.n);
  const f32x2 yy = S[0] * LO2(rprev) + S[1] * HI2(rprev);
  const f32x2 m0 = S[0] * LO2(o.d) + vv * LO2(o.k);
  const f32x2 m1 = S[1] * HI2(o.d) + vv * HI2(o.k);
  float a = tt[0] + tt[1], y = yy[0] + yy[1];
  a += dppmov<0x128>(a); y += dppmov<0x128>(y);
  a += dppmov<0x124>(a); y += dppmov<0x124>(y);
  a += dppmov<0x122>(a); y += dppmov<0x122>(y);
  a += dppmov<0x121>(a); y += dppmov<0x121>(y);
  const float sa = -a;
  const f32x2 sv = {sa, sa};
  S[0] = m0 + sv * LO2(o.b);
  S[1] = m1 + sv * HI2(o.b);
  rprev = o.r;
  return y;
}

__device__ void ph_scan(const Params& p, int bid, int nb) {
  const int tid = otid(), lane = tid & 63, wv = tid >> 6;
  float* buf = (float*)dsm;
  const u16* SA = (const u16*)(p.out);
  const u16* SB = p.H;
  constexpr int CH = 32;
  for (int item = bid; item < 512; item += nb) {
    const int type = item >> 8, r_ = item & 255, half = r_ & 1, hb = r_ >> 1, h = hb & 7, b = hb >> 3;
    const int nch = type ? 64 / CH : 4096 / CH;
    const int gbase = type ? TP + b * 64 : b * 4096;
    const bool active = true;
    const int row = half * 32 + wv * 4 + (lane >> 4), j0 = (lane & 15) * 4;
    f32x2 S[2];
#pragma unroll
    for (int j = 0; j < 2; j++) S[j] = f32x2{0.f, 0.f};
    if (type && active) {
      const float* s0 = p.state_wkv + ((size_t)(b * 8 + h) * 64 + row) * 64 + j0;
#pragma unroll
      for (int j = 0; j < 2; j++) S[j] = f32x2{s0[2 * j], s0[2 * j + 1]};
    }
    f32x4 rprev = {0.f, 0.f, 0.f, 0.f};
    float ykeep = 0.f;
    u32x4 la[2], lb;
    auto gload = [&](int c) {
#pragma unroll
      for (int q = 0; q < 2; q++) {
        const int idx = tid + q * NTH, step = idx >> 5, u = idx & 31;
        la[q] = *(const u32x4*)(SA + ((size_t)(gbase + c * CH + step) * 8 + h) * 256 + u * 8);
      }
      {
        const int step = tid >> 4, u = tid & 15;
        lb = *(const u32x4*)(SB + ((size_t)(gbase + c * CH + step) * 8 + h) * 128 + u * 8);
      }
    };
    gload(0);
    for (int c = 0; c < nch; c++) {
      __syncthreads();
#pragma unroll
      for (int q = 0; q < 2; q++) {
        const int idx = tid + q * NTH, step = idx >> 5, u = idx & 31, arr = u >> 3, c0 = (u & 7) * 8;
        float* d = buf + step * 384 + arr * 64 + c0;
        float f[8];
#pragma unroll
        for (int e = 0; e < 4; e++) { f[2 * e] = bflo(la[q][e]); f[2 * e + 1] = bfhi(la[q][e]); }
        if (arr == 1) {
#pragma unroll
          for (int e = 0; e < 8; e++) f[e] = 1.f - f[e];
        }
        *(float4*)d = make_float4(f[0], f[1], f[2], f[3]);
        *(float4*)(d + 4) = make_float4(f[4], f[5], f[6], f[7]);
      }
      {
        const int step = tid >> 4, u = tid & 15, arr = u >> 3, c0 = (u & 7) * 8;
        float* d = buf + step * 384 + (4 + arr) * 64 + c0;
        *(float4*)d = make_float4(bflo(lb[0]), bfhi(lb[0]), bflo(lb[1]), bfhi(lb[1]));
        *(float4*)(d + 4) = make_float4(bflo(lb[2]), bfhi(lb[2]), bflo(lb[3]), bfhi(lb[3]));
      }
      __syncthreads();
      if (c + 1 < nch) gload(c + 1);
      if (active) {
        ScanOps A0, A1, B0, B1;
        scan_ld(A0, buf, j0, row);
        scan_ld(A1, buf + 384, j0, row);
#pragma unroll 1
        for (int s = 0; s < CH; s += 4) {
          scan_ld(B0, buf + (s + 2) * 384, j0, row);
          scan_ld(B1, buf + (s + 3) * 384, j0, row);
          SCHED;
          {
            const int g0 = c * CH + s;
            const float y0 = scan_step(S, A0, rprev);
            ykeep = ((lane & 15) == ((g0 - 1) & 15)) ? y0 : ykeep;
            if ((g0 & 15) == 0 && g0 > 0)
              p.Y[(size_t)(gbase + g0 - 16 + (lane & 15)) * 512 + h * 64 + row] = f2bf(ykeep);
            const float y1 = scan_step(S, A1, rprev);
            ykeep = ((lane & 15) == (g0 & 15)) ? y1 : ykeep;
          }
          SCHED;
          const int sn = (s + 4 < CH) ? s + 4 : s;
          scan_ld(A0, buf + sn * 384, j0, row);
          scan_ld(A1, buf + (sn + 1) * 384, j0, row);
          SCHED;
          {
            const int g0 = c * CH + s;
            const float y2 = scan_step(S, B0, rprev);
            ykeep = ((lane & 15) == ((g0 + 1) & 15)) ? y2 : ykeep;
            const float y3 = scan_step(S, B1, rprev);
            ykeep = ((lane & 15) == ((g0 + 2) & 15)) ? y3 : ykeep;
          }
          SCHED;
        }
      }
    }
    if (active) {
      const f32x2 yy = S[0] * LO2(rprev) + S[1] * HI2(rprev);
      const float yl = red16(yy[0] + yy[1]);
      ykeep = ((lane & 15) == 15) ? yl : ykeep;
      p.Y[(size_t)(gbase + nch * CH - 16 + (lane & 15)) * 512 + h * 64 + row] = f2bf(ykeep);
    }
    if (active) {
      float* so = p.out + (type ? OFF_WKV_S : OFF_WKV_P) + ((size_t)(b * 8 + h) * 64 + row) * 64 + j0;
      *(float4*)so = make_float4(S[0][0], S[0][1], S[1][0], S[1][1]);
    }
  }
}

__device__ void ph_attn(const Params& p, int bid, int nb, bool dry = false) {
  const int tid = otid(), lane = tid & 63, wv = tid >> 6, fr = lane & 15, fq = lane >> 4;
  u16* Ks = (u16*)dsm;
  u16* Vt = Ks + 192 * 72;
  for (int item = bid; item < 2080; item += nb) {
    const int kvh = item & 1, r = item >> 1;
    const bool samp = r >= 1024;
    const int b = samp ? r - 1024 : r >> 6, c = samp ? 0 : (r & 63);
    const int gq0 = samp ? TP + b * 64 : b * 4096 + c * 64;
    __syncthreads();
#pragma unroll
    for (int q = 0; q < 3; q++) {
      const int idx = tid + q * NTH, j = idx >> 3, d0 = (idx & 7) * 8;
      u32x4 kq = {0u, 0u, 0u, 0u}, vq = {0u, 0u, 0u, 0u};
      if (!samp) {
        const int tok = (c - 2) * 64 + j;
        if (tok >= 0) {
          const u16* src = p.P + (size_t)(b * 4096 + tok) * INC + 2304 + kvh * 64 + d0;
          kq = *(const u32x4*)src;
          vq = *(const u32x4*)(src + 128);
        }
      } else if (j < 128) {
        const float4* ck = (const float4*)(p.cache_k + ((size_t)(b * 128 + j) * 2 + kvh) * 64 + d0);
        const float4* cv = (const float4*)(p.cache_v + ((size_t)(b * 128 + j) * 2 + kvh) * 64 + d0);
        const float4 k0 = ck[0], k1 = ck[1], v0 = cv[0], v1 = cv[1];
        kq = u32x4{pack2(k0.x, k0.y), pack2(k0.z, k0.w), pack2(k1.x, k1.y), pack2(k1.z, k1.w)};
        vq = u32x4{pack2(v0.x, v0.y), pack2(v0.z, v0.w), pack2(v1.x, v1.y), pack2(v1.z, v1.w)};
      } else {
        const u16* src = p.P + (size_t)(TP + b * 64 + (j - 128)) * INC + 2304 + kvh * 64 + d0;
        kq = *(const u32x4*)src;
        vq = *(const u32x4*)(src + 128);
      }
      *(u32x4*)(Ks + j * 72 + d0) = kq;
#pragma unroll
      for (int e = 0; e < 4; e++) {
        Vt[(d0 + 2 * e) * 196 + j] = (u16)(vq[e] & 0xffffu);
        Vt[(d0 + 2 * e + 1) * 196 + j] = (u16)(vq[e] >> 16);
      }
    }
    __syncthreads();
    const int qh = kvh * 4 + (wv & 3);
    const float slope = exp2f(-(float)(qh + 1)), sink = p.sinks[qh];
#pragma unroll 1
    for (int ps = 0; ps < 2; ps++) {
      const int q0 = (wv >> 2) * 32 + ps * 16;
      const int tq = q0 + fr;
      const u16* qp = p.P + (size_t)(gq0 + tq) * INC + 1792 + qh * 64 + fq * 8;
      const bf16x8 qf0 = *(const bf16x8*)(qp), qf1 = *(const bf16x8*)(qp + 32);
      f32x4 sc[12];
#pragma unroll
      for (int kt = 0; kt < 12; kt++) {
        sc[kt] = f32x4{0.f, 0.f, 0.f, 0.f};
        const bf16x8 a0 = *(const bf16x8*)(Ks + (kt * 16 + fr) * 72 + fq * 8);
        const bf16x8 a1 = *(const bf16x8*)(Ks + (kt * 16 + fr) * 72 + 32 + fq * 8);
        sc[kt] = MFMA16(a0, qf0, sc[kt]);
        sc[kt] = MFMA16(a1, qf1, sc[kt]);
        if ((kt & 3) == 3) SCHED;
      }
      float mx = -3e38f;
#pragma unroll
      for (int kt = 0; kt < 12; kt++)
#pragma unroll
        for (int j = 0; j < 4; j++) {
          const int key = kt * 16 + fq * 4 + j;
          float s = sc[kt][j] * 0.125f - slope * fabsf((float)(128 + tq - key));
          if (!samp && (c - 2) * 64 + key < 0) s = -1e30f;
          sc[kt][j] = s;
          mx = fmaxf(mx, s);
        }
      mx = fmaxf(mx, __shfl_xor(mx, 16));
      mx = fmaxf(mx, __shfl_xor(mx, 32));
      mx = fmaxf(mx, sink);
      float sum = 0.f;
#pragma unroll
      for (int kt = 0; kt < 12; kt++)
#pragma unroll
        for (int j = 0; j < 4; j++) {
          const float e = __expf(sc[kt][j] - mx);
          sc[kt][j] = e;
          sum += e;
        }
      sum += __shfl_xor(sum, 16);
      sum += __shfl_xor(sum, 32);
      sum += __expf(sink - mx);
      const float inv = 1.f / sum;
      f32x4 o[4];
#pragma unroll
      for (int dt = 0; dt < 4; dt++) o[dt] = f32x4{0.f, 0.f, 0.f, 0.f};
#pragma unroll
      for (int t2 = 0; t2 < 6; t2++) {
        const u32x4 pw = {pack2(sc[2 * t2][0] * inv, sc[2 * t2][1] * inv), pack2(sc[2 * t2][2] * inv, sc[2 * t2][3] * inv),
                          pack2(sc[2 * t2 + 1][0] * inv, sc[2 * t2 + 1][1] * inv),
                          pack2(sc[2 * t2 + 1][2] * inv, sc[2 * t2 + 1][3] * inv)};
        const bf16x8 pa = __builtin_bit_cast(bf16x8, pw);
#pragma unroll
        for (int dt = 0; dt < 4; dt++) {
          const u16* vp = Vt + (dt * 16 + fr) * 196 + t2 * 32 + fq * 4;
          const uint2 v0 = *(const uint2*)vp, v1 = *(const uint2*)(vp + 16);
          const bf16x8 vb = __builtin_bit_cast(bf16x8, u32x4{v0.x, v0.y, v1.x, v1.y});
          o[dt] = MFMA16(pa, vb, o[dt]);
        }
        SCHED;
      }
#pragma unroll
      for (int dt = 0; dt < 4; dt++)
#pragma unroll
        for (int j = 0; j < 4; j++)
          p.OATT[(size_t)(gq0 + q0 + fq * 4 + j) * 512 + qh * 64 + dt * 16 + fr] = f2bf(o[dt][j]);
    }
  }
  const u16* SA = (const u16*)(p.out);
  const u16* SB = p.H;
  for (int it4 = bid * NW + wv; it4 < T * 2; it4 += nb * NW) {
    const int it = it4 * 4 + (lane >> 4), c0 = (lane & 15) * 4;
    const int g = it >> 3, h = it & 7, col = h * 64 + c0;
    const uint2 yw = *(const uint2*)(p.Y + (size_t)g * 512 + col);
    const uint2 rw = *(const uint2*)(SA + (size_t)it * 256 + c0), kw = *(const uint2*)(SA + (size_t)it * 256 + 128 + c0);
    const uint2 vw = *(const uint2*)(SB + (size_t)it * 128 + c0), gw = *(const uint2*)(p.G + (size_t)g * 512 + col);
    const float4 lw = *(const float4*)(p.lnx_w + col), lb = *(const float4*)(p.lnx_b + col), rk = *(const float4*)(p.r_k + col);
    const float y0 = bflo(yw.x), y1 = bfhi(yw.x), y2 = bflo(yw.y), y3 = bfhi(yw.y);
    const float mean = red16((y0 + y1) + (y2 + y3)) * (1.f / 64.f);
    const float e0 = y0 - mean, e1 = y1 - mean, e2 = y2 - mean, e3 = y3 - mean;
    const float var = red16((e0 * e0 + e1 * e1) + (e2 * e2 + e3 * e3)) * (1.f / 64.f);
    const float bonus = red16((bflo(rw.x) * bflo(kw.x) * rk.x + bfhi(rw.x) * bfhi(kw.x) * rk.y) +
                              (bflo(rw.y) * bflo(kw.y) * rk.z + bfhi(rw.y) * bfhi(kw.y) * rk.w));
    const float rsd = rsqrtf(var + 64e-5f);
    const float o0 = (e0 * rsd * lw.x + lb.x + bonus * bflo(vw.x)) * bflo(gw.x);
    const float o1 = (e1 * rsd * lw.y + lb.y + bonus * bfhi(vw.x)) * bfhi(gw.x);
    const float o2 = (e2 * rsd * lw.z + lb.z + bonus * bflo(vw.y)) * bflo(gw.y);
    const float o3 = (e3 * rsd * lw.w + lb.w + bonus * bfhi(vw.y)) * bfhi(gw.y);
    if (!dry || o0 == 123.456f) *(uint2*)(p.Y + (size_t)g * 512 + col) = make_uint2(pack2(o0, o1), pack2(o2, o3));
  }
}

DI void ph_gemm2(const Params& p, int bid, int nb, int sm = -1) {
  const int tid_ = otid();
  u16* MG = p.H;
  const u16* Cs = (const u16*)dsm;
  const int nM = 256, nN = 4;
  for (int round = 0;; ++round) {
    int pm, pn;
    if (sm >= 0) { if (round >= 4) break; pm = 256 + sm; pn = round; }
    else if (!tile_of(round, bid, nb, nM, nN, pm, pn)) break;
    f32x4 acc[2][2][4][2];
#pragma unroll 1
    for (int br = 0; br < 2; br++) {
      gemm256<512>(br ? p.OATT : p.Y, p.WbT + (size_t)br * 1024 * 512, pm * 256, pn * 256, acc);
      acc_to_lds(acc);
#pragma unroll 2
      for (int it = 0; it < 16; it++) {
        const int id = it * NTH + tid_, rl = id >> 5, c8 = (id & 31) * 8;
        const int row = pm * 256 + rl, col = pn * 256 + c8;
        const u32x4 v = *(const u32x4*)(Cs + rl * CS_LD + c8);
        const u32x4 gw = *(const u32x4*)(p.P + (size_t)row * INC + 2560 + br * 1024 + col);
        u32x4 prev = {0u, 0u, 0u, 0u};
        if (br) prev = *(const u32x4*)(MG + (size_t)row * 1024 + col);
        u32x4 o;
#pragma unroll
        for (int e = 0; e < 4; e++) {
          const float r0 = bflo(prev[e]) + sigmoidf_(bflo(gw[e])) * bflo(v[e]);
          const float r1 = bfhi(prev[e]) + sigmoidf_(bfhi(gw[e])) * bfhi(v[e]);
          o[e] = pack2(r0, r1);
        }
        *(u32x4*)(MG + (size_t)row * 1024 + col) = o;
      }
    }
  }
}

DI void ph_gemm3(const Params& p, int bid, int nb, int sm = -1) {
  const int tid_ = otid();
  const u16* MG = p.H;
  const u16* Cs = (const u16*)dsm;
  const int nM = 256, nN = 4;
  for (int round = 0;; ++round) {
    int pm, pn;
    if (sm >= 0) { if (round >= 4) break; pm = 256 + sm; pn = round; }
    else if (!tile_of(round, bid, nb, nM, nN, pm, pn)) break;
    f32x4 acc[2][2][4][2];
    gemm256<1024>(MG, p.WoutT, pm * 256, pn * 256, acc);
    acc_to_lds(acc);
#pragma unroll 2
    for (int it = 0; it < 16; it++) {
      const int id = it * NTH + tid_, rl = id >> 5, c8 = (id & 31) * 8;
      const int row = pm * 256 + rl, col = pn * 256 + c8;
      const u32x4 v = *(const u32x4*)(Cs + rl * CS_LD + c8);
      const float* xr = xrow(p, row) + col;
      const float4 x0 = *(const float4*)xr, x1 = *(const float4*)(xr + 4);
      *(u32x4*)(p.P + (size_t)row * 1024 + col) =
          u32x4{pack2(x0.x + bflo(v[0]), x0.y + bfhi(v[0])), pack2(x0.z + bflo(v[1]), x0.w + bfhi(v[1])),
                pack2(x1.x + bflo(v[2]), x1.y + bfhi(v[2])), pack2(x1.z + bflo(v[3]), x1.w + bfhi(v[3]))};
    }
  }
}

DI void ph_norm2(const Params& p, int row0, int row1, int wstride) {
  const int tid = otid(), lane = tid & 63;
  for (int row = row0; row < row1; row += wstride) {
    const uint2* x = (const uint2*)(p.P + (size_t)row * 1024);
    float4 v[4];
    float ss = 0.f;
#pragma unroll
    for (int i = 0; i < 4; i++) {
      const uint2 xw = x[lane + i * 64];
      v[i] = make_float4(bflo(xw.x), bfhi(xw.x), bflo(xw.y), bfhi(xw.y));
      ss += v[i].x * v[i].x + v[i].y * v[i].y + v[i].z * v[i].z + v[i].w * v[i].w;
    }
    ss = wave_sum(ss);
    const float rs = rsqrtf(ss * (1.f / 1024.f) + 1e-6f);
    u16* hr = p.H + (size_t)row * 1024;
    float4 y[4];
    float am = 0.f;
#pragma unroll
    for (int i = 0; i < 4; i++) {
      const float4 g = ((const float4*)p.norm2_g)[lane + i * 64];
      y[i] = make_float4(v[i].x * rs * g.x, v[i].y * rs * g.y, v[i].z * rs * g.z, v[i].w * rs * g.w);
      ((uint2*)hr)[lane + i * 64] = make_uint2(pack2(y[i].x, y[i].y), pack2(y[i].z, y[i].w));
      am = fmaxf(am, fmaxf(fmaxf(fabsf(y[i].x), fabsf(y[i].y)), fmaxf(fabsf(y[i].z), fabsf(y[i].w))));
    }
    am = fmaxf(wave_max(am), 1e-30f);
    const float sc = 240.f / am;
    if (lane == 0) p.SH[row] = am * (1.f / 240.f);
    u32* h8 = (u32*)((unsigned char*)p.Y + (size_t)row * 1024);
#pragma unroll
    for (int i = 0; i < 4; i++) h8[lane + i * 64] = q4(y[i].x, y[i].y, y[i].z, y[i].w, sc);
  }
}

DI void ins16(float (&l)[16], float x) {
#pragma unroll
  for (int i = 0; i < 16; i++) {
    const float hi = fmaxf(l[i], x);
    x = fminf(l[i], x);
    l[i] = hi;
  }
}


DI void ce_desc(float& a, float& b) { const float hi = fmaxf(a, b), lo = fminf(a, b); a = hi; b = lo; }
DI void bitonic_sort16_desc(float (&a)[16]) {
#pragma unroll
  for (int k = 2; k <= 16; k <<= 1)
#pragma unroll
    for (int j = k >> 1; j > 0; j >>= 1)
#pragma unroll
      for (int i = 0; i < 16; i++) {
        const int l = i ^ j;
        if (l > i) {
          if ((i & k) == 0) ce_desc(a[i], a[l]);
          else ce_desc(a[l], a[i]);
        }
      }
}
DI void bitonic_merge16_desc(float (&a)[16]) {
#pragma unroll
  for (int j = 8; j > 0; j >>= 1)
#pragma unroll
    for (int i = 0; i < 16; i++) {
      const int l = i ^ j;
      if (l > i) ce_desc(a[i], a[l]);
    }
}
DI void top16_merge(float (&a)[16], const float (&b)[16]) {
#pragma unroll
  for (int i = 0; i < 16; i++) a[i] = fmaxf(a[i], b[15 - i]);
  bitonic_merge16_desc(a);
}

DI void ph_peerq(const Params& p, int bid, int nb, int sm = -1) {
  GT_VARS
  const int l31 = lane & 31, kh = lane >> 5;
  u16* Qs = (u16*)dsm;
  unsigned char* lt = (unsigned char*)(dsm + 135168 + wid * 1024);
  int* IDX = (int*)p.G;
  float* GATE = (float*)p.OATT;
  const int nM = 256, nN = 4;
  for (int round = 0;; ++round) {
    int pm, pn;
    if (sm >= 0) { if (round >= 4) break; pm = 256 + sm; pn = round; }
    else if (!tile_of(round, bid, nb, nM, nN, pm, pn)) break;
    {
      f32x4 acc[2][2][4][2];
      gemm256<1024>(p.H, p.WqT, pm * 256, pn * 256, acc);
      acc_to_lds(acc);
    }
#pragma unroll 1
    for (int hh = 0; hh < 2; hh++) {
      const int hp = pn * 2 + hh;
      float l1[16], l2[16];
#pragma unroll
      for (int i = 0; i < 16; i++) { l1[i] = 0.f; l2[i] = 0.f; }
#pragma unroll 1
      for (int pp = 0; pp < 2; pp++) {
        f32x16 sc[4];
#pragma unroll
        for (int m4 = 0; m4 < 4; m4++) {
#pragma unroll
          for (int i = 0; i < 16; i++) sc[m4][i] = 0.f;
#pragma unroll
          for (int kk = 0; kk < 4; kk++) {
            const bf16x8 a = *(const bf16x8*)(p.SK + (size_t)(pp * 128 + m4 * 32 + l31) * 64 + kk * 16 + kh * 8);
            const bf16x8 bq = *(const bf16x8*)(Qs + (wid * 32 + l31) * 264 + hh * 128 + pp * 64 + kk * 16 + kh * 8);
            sc[m4] = MFMA32(a, bq, sc[m4]);
          }
        }
        float l[16], q1[16], q2[16], q3[16];
#pragma unroll
        for (int i = 0; i < 16; i++) {
          const u32 nb_ = (i >> 2) * 8 + kh * 4 + (i & 3);
          l[i] = __uint_as_float((__float_as_uint(sc[0][i]) & ~0x7Fu) | nb_);
          q1[i] = __uint_as_float((__float_as_uint(sc[1][i]) & ~0x7Fu) | (32u + nb_));
          q2[i] = __uint_as_float((__float_as_uint(sc[2][i]) & ~0x7Fu) | (64u + nb_));
          q3[i] = __uint_as_float((__float_as_uint(sc[3][i]) & ~0x7Fu) | (96u + nb_));
        }
        bitonic_sort16_desc(l);
        bitonic_sort16_desc(q1);
        bitonic_sort16_desc(q2);
        bitonic_sort16_desc(q3);
        top16_merge(l, q1);
        top16_merge(q2, q3);
        top16_merge(l, q2);
        float o[16];
#pragma unroll
        for (int i = 0; i < 16; i++) o[i] = __shfl_xor(l[i], 32);
        top16_merge(l, o);
#pragma unroll
        for (int i = 0; i < 16; i++) {
          l1[i] = pp == 0 ? l[i] : l1[i];
          l2[i] = pp == 0 ? l2[i] : l[i];
        }
      }
      if (kh == 0) {
        u32 w[8];
#pragma unroll
        for (int q = 0; q < 4; q++) {
          w[q] = (__float_as_uint(l1[4 * q]) & 0x7F) | ((__float_as_uint(l1[4 * q + 1]) & 0x7F) << 8) |
                 ((__float_as_uint(l1[4 * q + 2]) & 0x7F) << 16) | ((__float_as_uint(l1[4 * q + 3]) & 0x7F) << 24);
          w[4 + q] = (__float_as_uint(l2[4 * q]) & 0x7F) | ((__float_as_uint(l2[4 * q + 1]) & 0x7F) << 8) |
                     ((__float_as_uint(l2[4 * q + 2]) & 0x7F) << 16) | ((__float_as_uint(l2[4 * q + 3]) & 0x7F) << 24);
        }
        *(uint4*)(lt + l31 * 32) = make_uint4(w[0], w[1], w[2], w[3]);
        *(uint4*)(lt + l31 * 32 + 16) = make_uint4(w[4], w[5], w[6], w[7]);
      }
      float v1[16], v2[16];
#pragma unroll
      for (int i = 0; i < 16; i++) {
        v1[i] = __uint_as_float(__float_as_uint(l1[i]) & ~0x7Fu);
        v2[i] = __uint_as_float(__float_as_uint(l2[i]) & ~0x7Fu);
      }
#define CAND(a, b) __uint_as_float((__float_as_uint(v1[a] + v2[b]) & ~0xFFu) | (u32)((a) * 16 + (b)))
      float l3[16], y1[16], y2[16];
#pragma unroll
      for (int b = 0; b < 16; b++) l3[b] = CAND(0, b);
#pragma unroll
      for (int b = 0; b < 8; b++) y1[b] = CAND(1, b);
#pragma unroll
      for (int b = 0; b < 5; b++) y1[8 + b] = CAND(2, b);
#pragma unroll
      for (int b = 0; b < 3; b++) y1[13 + b] = CAND(4, b);
#pragma unroll
      for (int b = 0; b < 4; b++) y2[b] = CAND(3, b);
      y2[4] = CAND(5, 0); y2[5] = CAND(5, 1); y2[6] = CAND(6, 0); y2[7] = CAND(6, 1); y2[8] = CAND(7, 0); y2[9] = CAND(7, 1);
      y2[10] = CAND(8, 0); y2[11] = CAND(9, 0); y2[12] = CAND(10, 0); y2[13] = CAND(11, 0); y2[14] = CAND(12, 0); y2[15] = CAND(13, 0);
      bitonic_sort16_desc(y1);
      bitonic_sort16_desc(y2);
      top16_merge(l3, y1);
      top16_merge(l3, y2);
      ins16(l3, CAND(14, 0));
      ins16(l3, CAND(15, 0));
#undef CAND
      __builtin_amdgcn_fence(__ATOMIC_RELEASE, "workgroup");
      __builtin_amdgcn_wave_barrier();
      if (kh == 0) {
        const int g = pm * 256 + wid * 32 + l31;
        float ev[16];
        int ei[16];
        float sum = 0.f;
        const float mxv = __uint_as_float(__float_as_uint(l3[0]) & ~0xFFu);
#pragma unroll
        for (int k = 0; k < 16; k++) {
          const u32 bits = __float_as_uint(l3[k]);
          const u32 pos = bits & 0xFF;
          ev[k] = __expf(__uint_as_float(bits & ~0xFFu) - mxv);
          sum += ev[k];
          ei[k] = (int)lt[l31 * 32 + (pos >> 4)] * 128 + (int)lt[l31 * 32 + 16 + (pos & 15)];
        }
        const float inv = 1.f / sum;
        int4* ip = (int4*)(IDX + (size_t)g * 128 + hp * 16);
        float4* gp = (float4*)(GATE + (size_t)g * 128 + hp * 16);
#pragma unroll
        for (int q = 0; q < 4; q++) {
          ip[q] = make_int4(ei[4 * q], ei[4 * q + 1], ei[4 * q + 2], ei[4 * q + 3]);
          gp[q] = make_float4(ev[4 * q] * inv, ev[4 * q + 1] * inv, ev[4 * q + 2] * inv, ev[4 * q + 3] * inv);
        }
      }
      __builtin_amdgcn_wave_barrier();
    }
  }
}

DI void ph_peer(const Params& p, int g0_, int g1_, int gstride, bool dry = false) {
  const int tid = otid(), lane = tid & 63, wv = tid >> 6;
  constexpr int ST = 1104;
  char* wb = dsm + wv * (16 * ST + 2048);
  unsigned char* stg = (unsigned char*)wb;
  unsigned char* hs = stg + 16 * ST;
  float* acts = (float*)(hs + 1024);
  int* idxs = (int*)(hs + 1536);
  const int gr = lane >> 3, gc = lane & 7;
  const int* IDX = (const int*)p.G;
  const float* GATE = (const float*)p.OATT;
  const unsigned char* H8 = (const unsigned char*)p.Y;
  const int n = lane & 15, quad = lane >> 4;
  for (int g = g0_; g < g1_; g += gstride) {
    *(u32x4*)(hs + lane * 16) = *(const u32x4*)(H8 + (size_t)g * 1024 + lane * 16);
    idxs[lane] = IDX[(size_t)g * 128 + lane];
    idxs[lane + 64] = IDX[(size_t)g * 128 + 64 + lane];
    const float shv = p.SH[g];
    __builtin_amdgcn_fence(__ATOMIC_RELEASE, "workgroup");
    __builtin_amdgcn_wave_barrier();
    {
      u32x4 ring[16];
      {
        const unsigned char* ua = p.U8 + (size_t)idxs[gr] * 1024 + gc * 16;
        const unsigned char* ub = p.U8 + (size_t)idxs[8 + gr] * 1024 + gc * 16;
#pragma unroll
        for (int i = 0; i < 8; i++) { ring[i] = *(const u32x4*)(ua + i * 128); ring[8 + i] = *(const u32x4*)(ub + i * 128); }
      }
#pragma unroll 1
      for (int grp = 0; grp < 8; grp++) {
        const int gn = grp < 7 ? grp + 1 : grp;
        const unsigned char* ua = p.U8 + (size_t)idxs[gn * 16 + gr] * 1024 + gc * 16;
        const unsigned char* ub = p.U8 + (size_t)idxs[gn * 16 + 8 + gr] * 1024 + gc * 16;
        const float4 gt = *(const float4*)(GATE + (size_t)g * 128 + grp * 16 + quad * 4);
        const int4 ee = *(const int4*)(idxs + grp * 16 + quad * 4);
        const float su0 = p.SU[ee.x], su1 = p.SU[ee.y], su2 = p.SU[ee.z], su3 = p.SU[ee.w];
        const float sv0 = p.SV[ee.x], sv1 = p.SV[ee.y], sv2 = p.SV[ee.z], sv3 = p.SV[ee.w];
#pragma unroll
        for (int i = 0; i < 8; i++) {
          *(u32x4*)(stg + gr * ST + i * 128 + gc * 16) = ring[i];
          *(u32x4*)(stg + (8 + gr) * ST + i * 128 + gc * 16) = ring[8 + i];
          if (grp < 7) { ring[i] = *(const u32x4*)(ua + i * 128); ring[8 + i] = *(const u32x4*)(ub + i * 128); }
        }
        __builtin_amdgcn_fence(__ATOMIC_RELEASE, "workgroup");
        __builtin_amdgcn_wave_barrier();
        f32x4 acc = {0.f, 0.f, 0.f, 0.f};
#pragma unroll
        for (int st = 0; st < 16; st++) {
          const u32x4 ua4 = *(const u32x4*)(stg + n * ST + st * 64 + quad * 16);
          const u32x4 hb = *(const u32x4*)(hs + st * 64 + quad * 16);
          const long a0 = (long)(((unsigned long)ua4[1] << 32) | ua4[0]);
          const long a1 = (long)(((unsigned long)ua4[3] << 32) | ua4[2]);
          const long b0 = (long)(((unsigned long)hb[1] << 32) | hb[0]);
          const long b1 = (long)(((unsigned long)hb[3] << 32) | hb[2]);
          acc = __builtin_amdgcn_mfma_f32_16x16x32_fp8_fp8(a0, b0, acc, 0, 0, 0);
          acc = __builtin_amdgcn_mfma_f32_16x16x32_fp8_fp8(a1, b1, acc, 0, 0, 0);
        }
        __builtin_amdgcn_wave_barrier();
        const float d0 = acc[0] * shv * su0, d1 = acc[1] * shv * su1, d2 = acc[2] * shv * su2, d3 = acc[3] * shv * su3;
        float4 av;
        av.x = 0.5f * d0 * (1.f + erff(d0 * 0.70710678118f)) * gt.x * sv0;
        av.y = 0.5f * d1 * (1.f + erff(d1 * 0.70710678118f)) * gt.y * sv1;
        av.z = 0.5f * d2 * (1.f + erff(d2 * 0.70710678118f)) * gt.z * sv2;
        av.w = 0.5f * d3 * (1.f + erff(d3 * 0.70710678118f)) * gt.w * sv3;
        if (n == 0) *(float4*)(acts + grp * 16 + quad * 4) = av;
      }
    }
    __builtin_amdgcn_fence(__ATOMIC_RELEASE, "workgroup");
    __builtin_amdgcn_wave_barrier();
    float o[16];
#pragma unroll
    for (int j = 0; j < 16; j++) o[j] = 0.f;
    {
      u32x4 ring[16];
#pragma unroll
      for (int k = 0; k < 16; k++) ring[k] = *(const u32x4*)(p.V8 + (size_t)idxs[k] * 1024 + lane * 16);
#pragma unroll 1
      for (int kb = 0; kb < 128; kb += 16) {
        const bool more = kb < 112;
        const int kn = more ? kb + 16 : kb;
#pragma unroll
        for (int j = 0; j < 16; j++) {
          const u32x4 vq = ring[j];
          if (more) ring[j] = *(const u32x4*)(p.V8 + (size_t)idxs[kn + j] * 1024 + lane * 16);
          const float a = acts[kb + j];
#pragma unroll
          for (int q = 0; q < 4; q++) {
            const f32x2 lo = __builtin_amdgcn_cvt_pk_f32_fp8((int)vq[q], false);
            const f32x2 hi = __builtin_amdgcn_cvt_pk_f32_fp8((int)vq[q], true);
            o[4 * q] += a * lo[0]; o[4 * q + 1] += a * lo[1]; o[4 * q + 2] += a * hi[0]; o[4 * q + 3] += a * hi[1];
          }
        }
      }
    }
    float* xr = p.out + (size_t)g * 1024 + lane * 16;
    float4 x[4];
    {
      const u32x4 xa = *(const u32x4*)(p.P + (size_t)g * 1024 + lane * 16), xb = *(const u32x4*)(p.P + (size_t)g * 1024 + lane * 16 + 8);
      x[0] = make_float4(bflo(xa[0]), bfhi(xa[0]), bflo(xa[1]), bfhi(xa[1]));
      x[1] = make_float4(bflo(xa[2]), bfhi(xa[2]), bflo(xa[3]), bfhi(xa[3]));
      x[2] = make_float4(bflo(xb[0]), bfhi(xb[0]), bflo(xb[1]), bfhi(xb[1]));
      x[3] = make_float4(bflo(xb[2]), bfhi(xb[2]), bflo(xb[3]), bfhi(xb[3]));
    }
    float ss = 0.f;
#pragma unroll
    for (int q = 0; q < 4; q++) {
      x[q].x += o[4 * q]; x[q].y += o[4 * q + 1]; x[q].z += o[4 * q + 2]; x[q].w += o[4 * q + 3];
      ss += x[q].x * x[q].x + x[q].y * x[q].y + x[q].z * x[q].z + x[q].w * x[q].w;
    }
    ss = wave_sum(ss);
    if (dry && ss != 123.456f) continue;
    const float rs = rsqrtf(ss * (1.f / 1024.f) + 1e-6f);
#pragma unroll
    for (int q = 0; q < 4; q++) {
      const float4 gq = *(const float4*)(p.final_g + lane * 16 + q * 4);
      *(float4*)(xr + q * 4) = make_float4(x[q].x * rs * gq.x, x[q].y * rs * gq.y, x[q].z * rs * gq.z, x[q].w * rs * gq.w);
    }
  }
}

#define XB_TMO      128
#define XB_XCNT(j)  (256  + 64 * (j))
#define XB_XSUB(j)  (1280 + 64 * (j))
#define XB_XGEN(j)  (2304 + 64 * (j))
#define XB_TOP      3328
#define XB_TOPGEN   3392
#define XCD_BAR_WORDS 3456
#define XB_SPIN_CAP (1u << 18)
#define LAS __attribute__((address_space(3)))
DI unsigned xb_ld(unsigned* p) { return __hip_atomic_load(p, __ATOMIC_RELAXED, __HIP_MEMORY_SCOPE_AGENT); }
DI unsigned xb_add(unsigned* p, unsigned v) { return __hip_atomic_fetch_add(p, v, __ATOMIC_RELAXED, __HIP_MEMORY_SCOPE_AGENT); }
DI unsigned xb_xcc_id() { return (unsigned)__builtin_amdgcn_s_getreg((3 << 11) | 20) & 0xFu; }
#define XB_SPIN(cond, bar) do { unsigned _sp = 0; while (cond) { __builtin_amdgcn_s_sleep(1); \
    if ((++_sp & 255u) == 0u) { if (xb_ld(&(bar)[XB_TMO])) break; if (_sp > XB_SPIN_CAP) { atomicAdd(&(bar)[XB_TMO], 1u); break; } } } } while (0)
struct XcdBarrier { unsigned* bar; unsigned x; volatile LAS unsigned* st; };
DI XcdBarrier xcd_barrier_post(unsigned* bar, volatile LAS unsigned* st) {
  XcdBarrier b; b.bar = bar; b.x = xb_xcc_id(); b.st = st;
  if (threadIdx.x == 0) (void)xb_add(&bar[XB_XCNT(b.x)], 1u);
  return b;
}
DI void xcd_barrier_complete(unsigned* bar, unsigned x, unsigned& nloc, unsigned& nx) {
  const unsigned G = gridDim.x * gridDim.y * gridDim.z;
  unsigned sum, cnt, mine, sp = 0u;
  for (;;) {
    sum = 0u; cnt = 0u; mine = 0u;
#pragma unroll
    for (unsigned j = 0; j < 16; ++j) { const unsigned c = xb_ld(&bar[XB_XCNT(j)]); sum += c; cnt += (c > 0u) ? 1u : 0u; mine = (j == x) ? c : mine; }
    if (sum == G) break;
    __builtin_amdgcn_s_sleep(1);
    if ((++sp & 255u) == 0u) { if (xb_ld(&bar[XB_TMO])) break; if (sp > XB_SPIN_CAP) { atomicAdd(&bar[XB_TMO], 1u); break; } }
  }
  nloc = mine > 0u ? mine : 1u; nx = cnt > 0u ? cnt : 1u;
}
DI void xcd_barrier(const XcdBarrier& b) {
  asm volatile("s_waitcnt vmcnt(0)" ::: "memory");
  __syncthreads();
  if (threadIdx.x == 0) {
    unsigned* bar = b.bar;
    __builtin_amdgcn_s_waitcnt(0);
    unsigned nloc = b.st[0], nx = b.st[1];
    if (nloc == 0u) { xcd_barrier_complete(bar, b.x, nloc, nx); b.st[0] = nloc; b.st[1] = nx; }
    const unsigned old = xb_add(&bar[XB_XSUB(b.x)], 1u);
    const unsigned gen = old / nloc;
    if (old + 1u == (gen + 1u) * nloc) {
      __builtin_amdgcn_fence(__ATOMIC_RELEASE, "agent");
      asm volatile("s_waitcnt vmcnt(0)" ::: "memory");
      const unsigned og = xb_add(&bar[XB_TOP], 1u);
      const unsigned tg = og / nx;
      if (og + 1u == (tg + 1u) * nx) xb_add(&bar[XB_TOPGEN], 1u);
      else XB_SPIN(xb_ld(&bar[XB_TOPGEN]) == tg, bar);
      __builtin_amdgcn_fence(__ATOMIC_ACQUIRE, "agent");
      xb_add(&bar[XB_XGEN(b.x)], 1u);
      asm volatile("s_waitcnt vmcnt(0)" ::: "memory");
    } else {
      XB_SPIN(xb_ld(&bar[XB_XGEN(b.x)]) == gen, bar);
      __builtin_amdgcn_fence(__ATOMIC_ACQUIRE, "agent");
      asm volatile("s_waitcnt vmcnt(0)" ::: "memory");
    }
  }
  __syncthreads();
}

__global__ void __launch_bounds__(512) mega_kernel(Params p) {
  cg::grid_group grid = cg::this_grid();
  const int bid = blockIdx.x, nb = gridDim.x;
  __shared__ uint4 xb_words;
  if (threadIdx.x == 0) xb_words = make_uint4(0u, 0u, 0u, 0u);
  __syncthreads();
  const XcdBarrier xb = xcd_barrier_post(p.bar, (volatile LAS unsigned*)&xb_words);
  if (ON(0)) ph_prep(p, bid, nb);
  xcd_barrier(xb);
  if (nb == 0x7fffffff) grid.sync();
  if (ON(1)) ph_gemm1(p, bid, nb);
  xcd_barrier(xb);
  if (REP == 1) { ph_gemm1(p, bid, nb); xcd_barrier(xb); }
  if (ON(2)) ph_rwprep(p, bid, nb);
  xcd_barrier(xb);
  if (REP == 2) { ph_rwprep(p, bid, nb); xcd_barrier(xb); }
  if (ON(3)) ph_scan(p, bid, nb);
  xcd_barrier(xb);
  if (REP == 3) { ph_scan(p, bid, nb); xcd_barrier(xb); }
  if (REP == 4) { ph_attn(p, bid, nb, true); xcd_barrier(xb); }
  if (ON(4)) ph_attn(p, bid, nb);
  xcd_barrier(xb);
  if (ON(5)) ph_gemm2(p, bid, nb);
  xcd_barrier(xb);
  if (ON(6)) ph_gemm3(p, bid, nb);
  xcd_barrier(xb);
  if (ON(7)) ph_norm2(p, bid * NW + (otid() >> 6), TP, nb * NW);
  xcd_barrier(xb);
  if (ON(8)) ph_peerq(p, bid, nb);
  xcd_barrier(xb);
  if (ON(9)) {
    if (bid < 4) {
      const int wv_ = otid() >> 6;
      ph_gemm2(p, bid, nb, bid);
      __builtin_amdgcn_fence(__ATOMIC_RELEASE, "agent"); __syncthreads(); __builtin_amdgcn_fence(__ATOMIC_ACQUIRE, "agent");
      ph_gemm3(p, bid, nb, bid);
      __builtin_amdgcn_fence(__ATOMIC_RELEASE, "agent"); __syncthreads(); __builtin_amdgcn_fence(__ATOMIC_ACQUIRE, "agent");
      ph_norm2(p, (256 + bid) * 256 + wv_, (256 + bid) * 256 + 256, NW);
      __builtin_amdgcn_fence(__ATOMIC_RELEASE, "agent"); __syncthreads(); __builtin_amdgcn_fence(__ATOMIC_ACQUIRE, "agent");
      ph_peerq(p, bid, nb, bid);
      asm volatile("s_waitcnt vmcnt(0)" ::: "memory");
      __syncthreads();
      if (threadIdx.x == 0) {
        __builtin_amdgcn_fence(__ATOMIC_RELEASE, "agent");
        asm volatile("s_waitcnt vmcnt(0)" ::: "memory");
        (void)xb_add(&p.bar[0], 1u);
        XB_SPIN(xb_ld(&p.bar[0]) < 4u, p.bar);
        __builtin_amdgcn_fence(__ATOMIC_ACQUIRE, "agent");
        asm volatile("s_waitcnt vmcnt(0)" ::: "memory");
      }
      __syncthreads();
      { const int s_ = 992 + bid * NW + (otid() >> 6); ph_peer(p, TP + s_, TP + s_ + 1, 1); }
    } else {
      const int wi = (bid - 4) * NW + (otid() >> 6);
      ph_peer(p, wi, TP, (nb - 4) * NW);
      if (bid - 4 >= 128) {
        if (threadIdx.x == 0) {
          XB_SPIN(xb_ld(&p.bar[0]) < 4u, p.bar);
          __builtin_amdgcn_fence(__ATOMIC_ACQUIRE, "agent");
          asm volatile("s_waitcnt vmcnt(0)" ::: "memory");
        }
        __syncthreads();
        const int s_ = wi - 1024;
        ph_peer(p, TP + s_, TP + s_ + 1, 1);
      }
    }
  }
}

extern "C" void kernel_launch(void* const* d_in, const int* in_sizes, int n_in, void* d_out, int out_size, void* d_ws,
                              size_t ws_size, hipStream_t stream) {
  Params p{};
  const float** f = (const float**)&p;
  for (int i = 0; i < 28; i++) f[i] = (const float*)d_in[i];
  p.out = (float*)d_out;
  char* w = (char*)d_ws;
  size_t off = 0;
  auto take = [&](size_t bytes) { char* r = w + off; off += (bytes + 255) & ~(size_t)255; return (u16*)r; };
  p.H = take((size_t)MP * 1024 * 2);
  p.P = take((size_t)MP * INC * 2);
  p.U8 = (unsigned char*)take((size_t)16384 * 1024);
  p.V8 = (unsigned char*)take((size_t)16384 * 1024);
  p.SU = (float*)take(16384 * 4);
  p.SV = (float*)take(16384 * 4);
  p.SH = (float*)take((size_t)T * 4);
  p.bar = (unsigned*)take((size_t)XCD_BAR_WORDS * 4);
  p.WinT = take((size_t)4608 * 1024 * 2);
  p.WbT = take((size_t)2 * 1024 * 512 * 2);
  p.WoutT = take((size_t)1024 * 1024 * 2);
  p.WqT = take((size_t)1024 * 1024 * 2);
  p.W2T = take((size_t)512 * 64 * 2);
  p.A2T = take((size_t)512 * 64 * 2);
  p.G2T = take((size_t)512 * 128 * 2);
  p.SK = take((size_t)2 * 128 * 64 * 2);
  p.Y = take((size_t)T * 512 * 2);
  p.G = take((size_t)T * 512 * 2);
  p.OATT = take((size_t)T * 512 * 2);
  static int grid_blocks = 0;
  if (!grid_blocks) {
    int dev = 0, cus = 0, per_cu = 0;
    (void)hipGetDevice(&dev);
    (void)hipDeviceGetAttribute(&cus, hipDeviceAttributeMultiprocessorCount, dev);
    (void)hipFuncSetAttribute((const void*)mega_kernel, hipFuncAttributeMaxDynamicSharedMemorySize, DYN_LDS);
    (void)hipOccupancyMaxActiveBlocksPerMultiprocessor(&per_cu, mega_kernel, NTH, DYN_LDS);
    if (per_cu > 1) per_cu = 1;
    grid_blocks = cus * per_cu;
  }
  (void)hipMemsetAsync(p.bar, 0, (size_t)XCD_BAR_WORDS * 4, stream);
  void* args[] = {&p};
  hipError_t e = hipLaunchCooperativeKernel((void*)mega_kernel, dim3(grid_blocks), dim3(NTH), args, DYN_LDS, stream);
  if (e != hipSuccess) fprintf(stderr, "cooperative launch failed: %s (grid %d)\n", hipGetErrorString(e), grid_blocks);
}
```

```cpp
#include <hip/hip_runtime.h>
#include <hip/hip_cooperative_groups.h>
#include <cstdio>
namespace cg = cooperative_groups;

#ifndef REP
#define REP -1
#endif
#ifndef ONLY
#define ONLY -1
#endif
#define ON(k) (ONLY < 0 || ONLY == (k))

typedef unsigned short u16;
typedef unsigned int u32;
using bf16x8 = __attribute__((ext_vector_type(8))) short;
using f32x4 = __attribute__((ext_vector_type(4))) float;
using f32x16 = __attribute__((ext_vector_type(16))) float;
using u32x4 = __attribute__((ext_vector_type(4))) u32;
#define DI __device__ __forceinline__

constexpr int TP = 65536, TS = 1024, T = 66560, MP = 66816;
constexpr int INC = 4608;
constexpr int NW = 8;
constexpr int NTH = 512;
constexpr size_t OFF_Y = 0, OFF_SHIFT_P = 68157440, OFF_WKV_P = 68173824, OFF_KP = 68698112, OFF_VP = 68960256,
                 OFF_SHIFT_S = 69222400, OFF_WKV_S = 69238784, OFF_KS = 69763072, OFF_VS = 69894144;
constexpr int DYN_LDS = 159744;

extern __shared__ __attribute__((aligned(16))) char dsm[];

struct Params {
  const float *x_prompt, *x_sample, *state_shift, *state_wkv, *cache_k, *cache_v, *norm1_g, *w_in, *mu, *w0, *w2, *a0,
      *a2, *g2, *k_k, *k_a, *r_k, *lnx_w, *lnx_b, *sinks, *w_branch, *w_out, *norm2_g, *peer_wq, *sub_keys, *peer_u,
      *peer_v, *final_g;
  float* out;
  u16 *H, *P, *WinT, *WbT, *WoutT, *WqT, *W2T, *A2T, *G2T, *SK, *Y, *G, *OATT;
  unsigned char *U8, *V8;
  float *SU, *SV, *SH;
  unsigned* bar;
};

typedef __bf16 hbf2 __attribute__((ext_vector_type(2)));
typedef float hf2 __attribute__((ext_vector_type(2)));
DI u16 f2bf(float x) { const __bf16 r = (__bf16)x; return __builtin_bit_cast(unsigned short, r); }
DI float bf2f(u16 b) { return __uint_as_float(((u32)b) << 16); }
DI u32 pack2(float a, float b) { const hf2 v = {a, b}; const hbf2 r = __builtin_convertvector(v, hbf2); return __builtin_bit_cast(u32, r); }
DI float bflo(u32 w) { return __uint_as_float(w << 16); }
DI float bfhi(u32 w) { return __uint_as_float(w & 0xffff0000u); }
DI float wave_sum(float v) {
#pragma unroll
  for (int o = 32; o; o >>= 1) v += __shfl_xor(v, o);
  return v;
}
DI float sigmoidf_(float x) { return 1.f / (1.f + __expf(-x)); }
DI const float* xrow(const Params& p, int g) {
  return g < TP ? p.x_prompt + (size_t)g * 1024 : p.x_sample + (size_t)(g - TP) * 1024;
}
DI int otid() { int t = threadIdx.x; asm volatile("" : "+v"(t)); return t; }
#define MFMA32(a, b, c) __builtin_amdgcn_mfma_f32_32x32x16_bf16((a), (b), (c), 0, 0, 0)
#define MFMA16(a, b, c) __builtin_amdgcn_mfma_f32_16x16x32_bf16((a), (b), (c), 0, 0, 0)

template <int CTRL>
DI float dppmov(float v) {
  return __int_as_float(__builtin_amdgcn_update_dpp(0, __float_as_int(v), CTRL, 0xF, 0xF, false));
}
DI float red16(float v) {
  v += dppmov<0x128>(v);
  v += dppmov<0x124>(v);
  v += dppmov<0x122>(v);
  v += dppmov<0x121>(v);
  return v;
}


using f32x2 = __attribute__((ext_vector_type(2))) float;
DI float wave_max(float v) {
#pragma unroll
  for (int o = 32; o; o >>= 1) v = fmaxf(v, __shfl_xor(v, o));
  return v;
}
DI u32 q4(float a, float b, float c, float d, float sc) {
  int w = 0;
  w = __builtin_amdgcn_cvt_pk_fp8_f32(a * sc, b * sc, w, false);
  w = __builtin_amdgcn_cvt_pk_fp8_f32(c * sc, d * sc, w, true);
  return (u32)w;
}

DI void tcvt(const float* __restrict__ W, u16* __restrict__ Wt, int K, int N, int gt, int nt) {
  const int total = N * (K / 8);
  for (int i = gt; i < total; i += nt) {
    const int n = i % N, kg = i / N;
    u32 o[4];
#pragma unroll
    for (int j = 0; j < 4; j++)
      o[j] = pack2(W[(size_t)(kg * 8 + 2 * j) * N + n], W[(size_t)(kg * 8 + 2 * j + 1) * N + n]);
    *(uint4*)(Wt + (size_t)n * K + kg * 8) = make_uint4(o[0], o[1], o[2], o[3]);
  }
}
DI void scvt(const float* __restrict__ W, u16* __restrict__ O, int n8, int gt, int nt) {
  for (int i = gt; i < n8; i += nt) {
    const float4 a = ((const float4*)W)[2 * i], b = ((const float4*)W)[2 * i + 1];
    ((uint4*)O)[i] = make_uint4(pack2(a.x, a.y), pack2(a.z, a.w), pack2(b.x, b.y), pack2(b.z, b.w));
  }
}

__device__ void ph_prep(const Params& p, int bid, int nb) {
  const int tid = otid(), lane = tid & 63, wv = tid >> 6;
  for (int row = bid * NW + wv; row < MP; row += nb * NW) {
    u16* hr = p.H + (size_t)row * 1024;
    if (row < T) {
      const float4* x = (const float4*)xrow(p, row);
      float4 v[4];
      float ss = 0.f;
#pragma unroll
      for (int i = 0; i < 4; i++) {
        v[i] = x[lane + i * 64];
        ss += v[i].x * v[i].x + v[i].y * v[i].y + v[i].z * v[i].z + v[i].w * v[i].w;
      }
      ss = wave_sum(ss);
      const float rs = rsqrtf(ss * (1.f / 1024.f) + 1e-6f);
      float* so = nullptr;
      if (row < TP) {
        if ((row & 4095) == 4095) so = p.out + OFF_SHIFT_P + (size_t)(row >> 12) * 1024;
      } else {
        const int r2 = row - TP;
        if ((r2 & 63) == 63) so = p.out + OFF_SHIFT_S + (size_t)(r2 >> 6) * 1024;
      }
#pragma unroll
      for (int i = 0; i < 4; i++) {
        const float4 g = ((const float4*)p.norm1_g)[lane + i * 64];
        float4 y;
        y.x = v[i].x * rs * g.x; y.y = v[i].y * rs * g.y; y.z = v[i].z * rs * g.z; y.w = v[i].w * rs * g.w;
        ((uint2*)hr)[lane + i * 64] = make_uint2(pack2(y.x, y.y), pack2(y.z, y.w));
        if (so) ((float4*)so)[lane + i * 64] = y;
      }
    } else if (row < T + 16) {
      const float4* x = (const float4*)(p.state_shift + (size_t)(row - T) * 1024);
#pragma unroll
      for (int i = 0; i < 4; i++) {
        const float4 y = x[lane + i * 64];
        ((uint2*)hr)[lane + i * 64] = make_uint2(pack2(y.x, y.y), pack2(y.z, y.w));
      }
    } else {
#pragma unroll
      for (int i = 0; i < 4; i++) ((uint2*)hr)[lane + i * 64] = make_uint2(0u, 0u);
    }
  }
  const int gt = bid * NTH + tid, nt = nb * NTH;
  tcvt(p.w_in, p.WinT, 1024, 4608, gt, nt);
  tcvt(p.w_branch, p.WbT, 512, 1024, gt, nt);
  tcvt(p.w_branch + 512 * 1024, p.WbT + 1024 * 512, 512, 1024, gt, nt);
  tcvt(p.w_out, p.WoutT, 1024, 1024, gt, nt);
  tcvt(p.peer_wq, p.WqT, 1024, 1024, gt, nt);
  tcvt(p.w2, p.W2T, 64, 512, gt, nt);
  tcvt(p.a2, p.A2T, 64, 512, gt, nt);
  tcvt(p.g2, p.G2T, 128, 512, gt, nt);
  scvt(p.sub_keys, p.SK, 2 * 128 * 64 / 8, gt, nt);
}

DI void quant_tables(const Params& p, int w0_, int wstride, int lane) {
  for (int r = w0_; r < 32768; r += wstride) {
    const bool isv = r >= 16384;
    const int e = r & 16383;
    const float4* src = (const float4*)((isv ? p.peer_v : p.peer_u) + (size_t)e * 1024) + lane * 4;
    const float4 a = src[0], b = src[1], c = src[2], d = src[3];
    float am = fmaxf(fmaxf(fmaxf(fabsf(a.x), fabsf(a.y)), fmaxf(fabsf(a.z), fabsf(a.w))),
                     fmaxf(fmaxf(fabsf(b.x), fabsf(b.y)), fmaxf(fabsf(b.z), fabsf(b.w))));
    am = fmaxf(am, fmaxf(fmaxf(fmaxf(fabsf(c.x), fabsf(c.y)), fmaxf(fabsf(c.z), fabsf(c.w))),
                         fmaxf(fmaxf(fabsf(d.x), fabsf(d.y)), fmaxf(fabsf(d.z), fabsf(d.w)))));
    am = fmaxf(wave_max(am), 1e-30f);
    const float sc = 240.f / am;
    if (lane == 0) (isv ? p.SV : p.SU)[e] = am * (1.f / 240.f);
    *(u32x4*)((isv ? p.V8 : p.U8) + (size_t)e * 1024 + lane * 16) =
        u32x4{q4(a.x, a.y, a.z, a.w, sc), q4(b.x, b.y, b.z, b.w, sc), q4(c.x, c.y, c.z, c.w, sc), q4(d.x, d.y, d.z, d.w, sc)};
  }
}

constexpr int GBK = 64, GHALF = 128, GHT = GHALF * GBK;
DI int lds_byte(int r, int c) {
  const int st = (r >> 4) * 2 + (c >> 5), rr = r & 15, cc = c & 31, ob = rr * 64 + cc * 2;
  return st * 1024 + (ob ^ (((ob >> 9) & 1) << 5));
}
DI void stage_rc(int b, int& R, int& C) {
  const int st = b / 1024, sb = b % 1024, swz = sb ^ (((sb >> 9) & 1) << 5);
  R = (st >> 1) * 16 + swz / 64;
  C = (st & 1) * 32 + (swz % 64) / 2;
}
typedef __attribute__((address_space(3))) unsigned lds_u32;
#define G_SA(b, h) (shm + ((b) * 2 + (h)) * GHT)
#define G_SB(b, h) (shm + (4 + (b) * 2 + (h)) * GHT)
#define G_STAGE(P_, RS, br, kt)                                                                                   \
  do {                                                                                                            \
    const int _so = ((br) * K + (kt) * GBK) * 2;                                                                  \
    __builtin_amdgcn_raw_ptr_buffer_load_lds(RS, (lds_u32*)((char*)(P_) + tb0), 16, ob0, _so, 0, 0);              \
    __builtin_amdgcn_raw_ptr_buffer_load_lds(RS, (lds_u32*)((char*)(P_) + tb0 + 8192), 16, ob1, _so, 0, 0);       \
  } while (0)
#define G_LDA(dst, b, h)                                  \
  _Pragma("unroll") for (int m = 0; m < 4; ++m)           \
  _Pragma("unroll") for (int k = 0; k < 2; ++k)           \
    dst[m][k] = *reinterpret_cast<const bf16x8*>((const char*)G_SA(b, h) + lds_byte(wr * 64 + m * 16 + fr, k * 32 + fq * 8))
#define G_LDB(dst, b, h)                                  \
  _Pragma("unroll") for (int n = 0; n < 2; ++n)           \
  _Pragma("unroll") for (int k = 0; k < 2; ++k)           \
    dst[n][k] = *reinterpret_cast<const bf16x8*>((const char*)G_SB(b, h) + lds_byte(wc * 32 + n * 16 + fr, k * 32 + fq * 8))
#define G_MMA(ai, bj, At_, Bt_)                                                                         \
  do {                                                                                                  \
    __builtin_amdgcn_s_setprio(1);                                                                      \
    _Pragma("unroll") for (int m = 0; m < 4; ++m)                                                       \
    _Pragma("unroll") for (int n = 0; n < 2; ++n)                                                       \
    _Pragma("unroll") for (int k = 0; k < 2; ++k)                                                       \
      acc[ai][bj][m][n] = MFMA16(At_[m][k], Bt_[n][k], acc[ai][bj][m][n]);                              \
    __builtin_amdgcn_s_setprio(0);                                                                      \
  } while (0)
#define WAIT_V(n) asm volatile("s_waitcnt vmcnt(" #n ")" ::: "memory")
#define WAIT_L(n) asm volatile("s_waitcnt lgkmcnt(" #n ")" ::: "memory")
#define BAR __builtin_amdgcn_s_barrier()
#define SCHED __builtin_amdgcn_sched_barrier(0)

template <int K>
DI void gemm256(const u16* __restrict__ A, const u16* __restrict__ Bt, const int brow, const int bcol,
                f32x4 (&acc)[2][2][4][2]) {
  u16* shm = (u16*)dsm;
  const int tid_ = otid();
  const int wid = tid_ >> 6, lane = tid_ & 63, wr = wid >> 2, wc = wid & 3, fr = lane & 15, fq = lane >> 4;
#pragma unroll
  for (int a = 0; a < 2; a++)
#pragma unroll
    for (int b = 0; b < 2; b++)
#pragma unroll
      for (int m = 0; m < 4; m++)
#pragma unroll
        for (int n = 0; n < 2; n++) acc[a][b][m][n] = f32x4{0.f, 0.f, 0.f, 0.f};
  bf16x8 At[4][2], B0[2][2], B1[2][2];
  constexpr int nt = K / GBK;
  const __amdgpu_buffer_rsrc_t rsA = __builtin_amdgcn_make_buffer_rsrc((void*)A, 0, 0x7fffffff, 0x00020000);
  const __amdgpu_buffer_rsrc_t rsB = __builtin_amdgcn_make_buffer_rsrc((void*)Bt, 0, 0x7fffffff, 0x00020000);
  const unsigned tb0 = tid_ * 16;
  int ob0, ob1;
  {
    int r_, c_;
    stage_rc((int)tb0, r_, c_);
    ob0 = (r_ * K + c_) * 2;
    stage_rc((int)tb0 + 8192, r_, c_);
    ob1 = (r_ * K + c_) * 2;
  }
  WAIT_V(0);
  __syncthreads();
  G_STAGE(G_SB(0, 0), rsB, bcol, 0); G_STAGE(G_SA(0, 0), rsA, brow, 0);
  G_STAGE(G_SB(0, 1), rsB, bcol + GHALF, 0); G_STAGE(G_SA(0, 1), rsA, brow + GHALF, 0);
  if (wr == 1) BAR;
  WAIT_V(4); BAR;
  G_STAGE(G_SB(1, 0), rsB, bcol, 1); G_STAGE(G_SA(1, 0), rsA, brow, 1); G_STAGE(G_SB(1, 1), rsB, bcol + GHALF, 1);
  WAIT_V(6); BAR;
  for (int t = 0; t < nt - 2; t += 2) {
    G_LDB(B0, 0, 0); SCHED; G_LDA(At, 0, 0); G_STAGE(G_SA(1, 1), rsA, brow + GHALF, t + 1);
    WAIT_L(8); BAR; WAIT_L(0); G_MMA(0, 0, At, B0); BAR; SCHED;
    G_LDB(B1, 0, 1); G_STAGE(G_SB(0, 0), rsB, bcol, t + 2);
    BAR; WAIT_L(0); G_MMA(0, 1, At, B1); BAR;
    G_LDA(At, 0, 1); G_STAGE(G_SA(0, 0), rsA, brow, t + 2);
    BAR; WAIT_L(0); G_MMA(1, 0, At, B0); BAR; SCHED;
    G_STAGE(G_SB(0, 1), rsB, bcol + GHALF, t + 2);
    WAIT_V(6); BAR; G_MMA(1, 1, At, B1); BAR;
    G_LDB(B0, 1, 0); SCHED; G_LDA(At, 1, 0); G_STAGE(G_SA(0, 1), rsA, brow + GHALF, t + 2);
    WAIT_L(8); BAR; WAIT_L(0); G_MMA(0, 0, At, B0); BAR; SCHED;
    G_LDB(B1, 1, 1); G_STAGE(G_SB(1, 0), rsB, bcol, t + 3);
    BAR; WAIT_L(0); G_MMA(0, 1, At, B1); BAR;
    G_LDA(At, 1, 1); G_STAGE(G_SA(1, 0), rsA, brow, t + 3);
    BAR; WAIT_L(0); G_MMA(1, 0, At, B0); BAR; SCHED;
    G_STAGE(G_SB(1, 1), rsB, bcol + GHALF, t + 3);
    WAIT_V(6); BAR; G_MMA(1, 1, At, B1); BAR;
  }
  {
    G_LDB(B0, 0, 0); G_LDA(At, 0, 0); G_STAGE(G_SA(1, 1), rsA, brow + GHALF, nt - 1);
    BAR; WAIT_L(0); G_MMA(0, 0, At, B0); BAR;
    G_LDB(B1, 0, 1); BAR; WAIT_L(0); G_MMA(0, 1, At, B1); BAR;
    G_LDA(At, 0, 1); WAIT_V(4); BAR; WAIT_L(0); G_MMA(1, 0, At, B0); G_MMA(1, 1, At, B1); BAR;
  }
  {
    G_LDB(B0, 1, 0); G_LDA(At, 1, 0); WAIT_V(2); BAR; WAIT_L(0); G_MMA(0, 0, At, B0); BAR;
    G_LDB(B1, 1, 1); WAIT_V(0); BAR; WAIT_L(0); G_MMA(0, 1, At, B1); BAR;
    G_LDA(At, 1, 1); BAR; WAIT_L(0); G_MMA(1, 0, At, B0); G_MMA(1, 1, At, B1); BAR;
  }
  if (wr == 0) BAR;
}
#define GT_VARS \
  const int tid_ = otid(); const int wid = tid_ >> 6, lane = tid_ & 63, wr = wid >> 2, wc = wid & 3, fr = lane & 15, fq = lane >> 4;
#define GT_ROW(ai, m, j) ((ai) * 128 + wr * 64 + (m) * 16 + fq * 4 + (j))
#define GT_COL(bj, n) ((bj) * 128 + wc * 32 + (n) * 16 + fr)
#define GT_FOR                                       \
  _Pragma("unroll") for (int ai = 0; ai < 2; ++ai)   \
  _Pragma("unroll") for (int bj = 0; bj < 2; ++bj)   \
  _Pragma("unroll") for (int m = 0; m < 4; ++m)      \
  _Pragma("unroll") for (int n = 0; n < 2; ++n)      \
  _Pragma("unroll") for (int j = 0; j < 4; ++j)

DI bool tile_of(int round, int bid, int nb, int nM, int nN, int& pm, int& pn) {
  const int vt = round * nb + (bid & 7) * (nb >> 3) + (bid >> 3);
  if (vt >= nM * nN) return false;
  const int nig = 8 * nN, gid = vt / nig, fm = gid * 8, gsz = min(nM - fm, 8);
  pm = fm + (vt % nig) % gsz;
  pn = (vt % nig) / gsz;
  return true;
}


constexpr int CS_LD = 264;
DI void acc_to_lds(const f32x4 (&acc)[2][2][4][2]) {
  GT_VARS
  u16* Cs = (u16*)dsm;
  __syncthreads();
  GT_FOR { Cs[GT_ROW(ai, m, j) * CS_LD + GT_COL(bj, n)] = f2bf(acc[ai][bj][m][n][j]); }
  __syncthreads();
}

__device__ void ph_gemm1(const Params& p, int bid, int nb) {
  const int tid_ = otid();
  const int nM = 261, nN = 18;
  for (int round = 0; round * nb < nM * nN; ++round) {
    int pm, pn;
    if (!tile_of(round, bid, nb, nM, nN, pm, pn)) break;
    f32x4 acc[2][2][4][2];
    gemm256<1024>(p.H, p.WinT, pm * 256, pn * 256, acc);
    acc_to_lds(acc);
    const u16* Cs = (const u16*)dsm;
#pragma unroll 4
    for (int it = 0; it < 16; it++) {
      const int id = it * NTH + tid_, rl = id >> 5, c8 = (id & 31) * 8;
      const int row = pm * 256 + rl;
      const u32x4 v = *(const u32x4*)(Cs + rl * CS_LD + c8);
      *(u32x4*)(p.P + (size_t)row * INC + pn * 256 + c8) = v;
      if (pn == 9) {
        float* dst = nullptr;
        const int c2 = c8 & 127;
        if (row < TP) {
          const int tt = row & 4095;
          if (tt >= 3968) dst = p.out + (c8 < 128 ? OFF_KP : OFF_VP) + ((size_t)(row >> 12) * 128 + (tt - 3968)) * 128 + c2;
        } else if (row < T) {
          dst = p.out + (c8 < 128 ? OFF_KS : OFF_VS) + (size_t)(row - TP) * 128 + c2;
        }
        if (dst) {
          *(float4*)dst = make_float4(bflo(v[0]), bfhi(v[0]), bflo(v[1]), bfhi(v[1]));
          *(float4*)(dst + 4) = make_float4(bflo(v[2]), bfhi(v[2]), bflo(v[3]), bfhi(v[3]));
        }
      }
    }
  }
  {
    const int lv = (bid & 7) * (nb >> 3) + (bid >> 3);
    const int rem = (nM * nN) % nb;
    const int nidle = rem ? nb - rem : nb, rank = rem ? lv - rem : lv;
    if (rank >= 0) quant_tables(p, rank * NW + (tid_ >> 6), nidle * NW, tid_ & 63);
  }
}

DI int prev_row(int g) {
  if (g < TP) return (g & 4095) ? g - 1 : -1;
  const int r2 = g - TP;
  return (r2 & 63) ? g - 1 : T + (r2 >> 6);
}

__device__ void ph_rwprep(const Params& p, int bid, int nb) {
  const int tid = otid(), lane = tid & 63, wv = tid >> 6, fr = lane & 15, fq = lane >> 4;
  u16* A1 = (u16*)dsm;
  u16* A2 = A1 + 64 * 80;
  u16* A3 = A2 + 64 * 80;
  u16* SA = (u16*)(p.out);
  u16* SB = p.H;
  const int hd = wv;
  u16* OT = (u16*)(dsm + 38912 + wv * 12288);
  u32x4 pin[7];
  for (int unit = bid; unit < 1024 + 64; unit += nb) {
    const int g0 = unit < 1024 ? unit * 64 : TP + (unit - 1024) * 16;
    const int nrg = unit < 1024 ? 4 : 1;
    auto issue_in = [&](int rg_) {
#pragma unroll
      for (int it = 0; it < 7; it++) {
        const int id = it * 64 + lane, ri = id / 24, rem = id - ri * 24, arr = rem >> 3, ch = rem & 7;
        int tok = g0 + rg_ * 16 - 1 + ri;
        if (rg_ == 0 && ri == 0) tok = prev_row(g0);
        pin[it] = u32x4{0u, 0u, 0u, 0u};
        if (id < 408 && tok >= 0) pin[it] = *(const u32x4*)(p.P + (size_t)tok * INC + arr * 512 + hd * 64 + ch * 8);
      }
    };
    __syncthreads();
    if ((tid >> 3) < nrg * 16) {
      const int row = tid >> 3, part8 = tid & 7, part = part8 >> 1, sub = part8 & 1;
      const int g = g0 + row, pr = prev_row(g);
      const int cb = 1536 + part * 64 + sub * 32;
      const u16* cur = p.P + (size_t)g * INC + cb;
      const u16* prv = p.P + (size_t)(pr < 0 ? 0 : pr) * INC + cb;
#pragma unroll
      for (int q = 0; q < 4; q++) {
        const u32x4 c4 = *(const u32x4*)(cur + q * 8);
        u32x4 p4 = {0u, 0u, 0u, 0u};
        if (pr >= 0) p4 = *(const u32x4*)(prv + q * 8);
        u32x4 ow;
#pragma unroll
        for (int e = 0; e < 4; e++) {
          const float c0 = bflo(c4[e]), c1 = bfhi(c4[e]), q0 = bflo(p4[e]), q1 = bfhi(p4[e]);
          float f0 = c0 + (q0 - c0) * p.mu[cb + q * 8 + 2 * e];
          float f1 = c1 + (q1 - c1) * p.mu[cb + q * 8 + 2 * e + 1];
          if (part == 0) { f0 = 1.f - 2.f / (1.f + __expf(2.f * f0)); f1 = 1.f - 2.f / (1.f + __expf(2.f * f1)); }
          else if (part >= 2) { f0 = sigmoidf_(f0); f1 = sigmoidf_(f1); }
          ow[e] = pack2(f0, f1);
        }
        u16* dst = part == 0 ? A1 + row * 80 + sub * 32 + q * 8
                 : part == 1 ? A2 + row * 80 + sub * 32 + q * 8
                             : A3 + row * 144 + (part - 2) * 64 + sub * 32 + q * 8;
        *(u32x4*)dst = ow;
      }
    }
    __syncthreads();
#pragma unroll 1
    for (int rg = 0; rg < nrg; rg++) {
      issue_in(rg);
#pragma unroll
      for (int it = 0; it < 7; it++) {
        const int id = it * 64 + lane;
        if (id < 408) *(u32x4*)(OT + id * 8) = pin[it];
      }
      __builtin_amdgcn_fence(__ATOMIC_RELEASE, "workgroup");
      __builtin_amdgcn_wave_barrier();
      float inr[5][3][4];
#pragma unroll
      for (int jj = 0; jj < 5; jj++)
#pragma unroll
        for (int ar = 0; ar < 3; ar++)
#pragma unroll
          for (int nt = 0; nt < 4; nt++) inr[jj][ar][nt] = bf2f(OT[((fq * 4 + jj) * 3 + ar) * 64 + nt * 16 + fr]);
      __builtin_amdgcn_fence(__ATOMIC_RELEASE, "workgroup");
      __builtin_amdgcn_wave_barrier();
      SCHED;
      f32x4 aw[4], aa[4];
#pragma unroll
      for (int nt = 0; nt < 4; nt++) { aw[nt] = f32x4{0.f, 0.f, 0.f, 0.f}; aa[nt] = f32x4{0.f, 0.f, 0.f, 0.f}; }
#pragma unroll 1
      for (int ks = 0; ks < 2; ks++) {
        const bf16x8 f1 = *(const bf16x8*)(A1 + (rg * 16 + fr) * 80 + ks * 32 + fq * 8);
        const bf16x8 f2 = *(const bf16x8*)(A2 + (rg * 16 + fr) * 80 + ks * 32 + fq * 8);
#pragma unroll
        for (int nt = 0; nt < 4; nt++) {
          const bf16x8 bw = *(const bf16x8*)(p.W2T + (unsigned)((hd * 64 + nt * 16 + fr) * 64 + ks * 32 + fq * 8));
          const bf16x8 ba = *(const bf16x8*)(p.A2T + (unsigned)((hd * 64 + nt * 16 + fr) * 64 + ks * 32 + fq * 8));
          aw[nt] = MFMA16(f1, bw, aw[nt]);
          aa[nt] = MFMA16(f2, ba, aa[nt]);
        }
      }
      float ss[4] = {0.f, 0.f, 0.f, 0.f};
      const int rowb = rg * 16 + fq * 4;
      const int gb = g0 + rowb;
#pragma unroll
      for (int nt = 0; nt < 4; nt++) {
        const int c = nt * 16 + fr, col = hd * 64 + c;
        const float mu_r = p.mu[col], mu_k = p.mu[512 + col], mu_v = p.mu[1024 + col];
        const float w0c = p.w0[col], a0c = p.a0[col], kkc = p.k_k[col], kac = p.k_a[col];
        float qr = inr[0][0][nt], qk = inr[0][1][nt], qv = inr[0][2][nt];
#pragma unroll
        for (int j = 0; j < 4; j++) {
          const float cr = inr[j + 1][0][nt], ck = inr[j + 1][1][nt], cv = inr[j + 1][2][nt];
          const float r = cr + (qr - cr) * mu_r, k = ck + (qk - ck) * mu_k, v = cv + (qv - cv) * mu_v;
          qr = cr; qk = ck; qv = cv;
          const float ed = 0.6065306597126334f * sigmoidf_(w0c + aw[nt][j]);
          const float dm = 1.f - __expf(-ed);
          const float a = sigmoidf_(a0c + aa[nt][j]);
          const float kkv = k * kkc;
          ss[j] += kkv * kkv;
          const float k2 = k * (1.f + (a - 1.f) * kac);
          u16* ot = OT + (fq * 4 + j) * 384 + c;
          ot[0] = f2bf(r);
          ot[64] = f2bf(dm);
          ot[128] = f2bf(k2);
          ot[256] = f2bf(v);
          aw[nt][j] = kkv;
          aa[nt][j] = a;
        }
        SCHED;
      }
#pragma unroll
      for (int j = 0; j < 4; j++) ss[j] = 1.f / fmaxf(sqrtf(red16(ss[j])), 1e-12f);
#pragma unroll
      for (int nt = 0; nt < 4; nt++) {
        const int c = nt * 16 + fr;
#pragma unroll
        for (int j = 0; j < 4; j++) {
          const float kkn = aw[nt][j] * ss[j];
          u16* ot = OT + (fq * 4 + j) * 384 + c;
          ot[192] = f2bf(kkn);
          ot[320] = f2bf(kkn * aa[nt][j]);
        }
      }
      __builtin_amdgcn_fence(__ATOMIC_RELEASE, "workgroup");
      __builtin_amdgcn_wave_barrier();
      {
        const int gr0 = g0 + rg * 16;
#pragma unroll 4
        for (int it = 0; it < 12; it++) {
          const int id = it * 64 + lane, rowi = id / 48, pc = id % 48;
          const u32x4 v4 = *(const u32x4*)(OT + rowi * 384 + pc * 8);
          const size_t gh = (size_t)(gr0 + rowi) * 8 + hd;
          if (pc < 32) *(u32x4*)(SA + gh * 256 + pc * 8) = v4;
          else *(u32x4*)(SB + gh * 128 + (pc - 32) * 8) = v4;
        }
      }
      __builtin_amdgcn_wave_barrier();
      f32x4 ag[4];
#pragma unroll
      for (int nt = 0; nt < 4; nt++) ag[nt] = f32x4{0.f, 0.f, 0.f, 0.f};
#pragma unroll 1
      for (int ks = 0; ks < 4; ks++) {
        const bf16x8 f3 = *(const bf16x8*)(A3 + (rg * 16 + fr) * 144 + ks * 32 + fq * 8);
#pragma unroll
        for (int nt = 0; nt < 4; nt++) {
          const bf16x8 bg = *(const bf16x8*)(p.G2T + (unsigned)((hd * 64 + nt * 16 + fr) * 128 + ks * 32 + fq * 8));
          ag[nt] = MFMA16(f3, bg, ag[nt]);
        }
      }
#pragma unroll
      for (int nt = 0; nt < 4; nt++)
#pragma unroll
        for (int j = 0; j < 4; j++) p.G[(size_t)(gb + j) * 512 + hd * 64 + nt * 16 + fr] = f2bf(ag[nt][j]);
    }
  }
}

DI float red8(float v) {
  v += dppmov<0xB1>(v);
  v += dppmov<0x4E>(v);
  v += dppmov<0x141>(v);
  return v;
}
struct ScanOps { f32x4 r, d, k, n, b; float v; };
DI void scan_ld(ScanOps& o, const float* sb, int j0, int row) {
  o.r = *(const f32x4*)(sb + j0);
  o.d = *(const f32x4*)(sb + 64 + j0);
  o.k = *(const f32x4*)(sb + 128 + j0);
  o.n = *(const f32x4*)(sb + 192 + j0);
  o.b = *(const f32x4*)(sb + 320 + j0);
  o.v = sb[256 + row];
}
#define LO2(x) __builtin_shufflevector((x), (x), 0, 1)
#define HI2(x) __builtin_shufflevector((x), (x), 2, 3)
DI float scan_step(f32x2 (&S)[2], const ScanOps& o, f32x4& rprev) {
  const f32x2 vv = {o.v, o.v};
  const f32x2 tt = S[0] * LO2(o.n) + S[1] * HI2(o.n);
  const f32x2 yy = S[0] * LO2(rprev) + S[1] * HI2(rprev);
  const f32x2 m0 = S[0] * LO2(o.d) + vv * LO2(o.k);
  const f32x2 m1 = S[1] * HI2(o.d) + vv * HI2(o.k);
  float a = tt[0] + tt[1], y = yy[0] + yy[1];
  a += dppmov<0x128>(a); y += dppmov<0x128>(y);
  a += dppmov<0x124>(a); y += dppmov<0x124>(y);
  a += dppmov<0x122>(a); y += dppmov<0x122>(y);
  a += dppmov<0x121>(a); y += dppmov<0x121>(y);
  const float sa = -a;
  const f32x2 sv = {sa, sa};
  S[0] = m0 + sv * LO2(o.b);
  S[1] = m1 + sv * HI2(o.b);
  rprev = o.r;
  return y;
}

__device__ void ph_scan(const Params& p, int bid, int nb) {
  const int tid = otid(), lane = tid & 63, wv = tid >> 6;
  float* buf = (float*)dsm;
  const u16* SA = (const u16*)(p.out);
  const u16* SB = p.H;
  constexpr int CH = 32;
  for (int item = bid; item < 512; item += nb) {
    const int type = item >> 8, r_ = item & 255, half = r_ & 1, hb = r_ >> 1, h = hb & 7, b = hb >> 3;
    const int nch = type ? 64 / CH : 4096 / CH;
    const int gbase = type ? TP + b * 64 : b * 4096;
    const bool active = true;
    const int row = half * 32 + wv * 4 + (lane >> 4), j0 = (lane & 15) * 4;
    f32x2 S[2];
#pragma unroll
    for (int j = 0; j < 2; j++) S[j] = f32x2{0.f, 0.f};
    if (type && active) {
      const float* s0 = p.state_wkv + ((size_t)(b * 8 + h) * 64 + row) * 64 + j0;
#pragma unroll
      for (int j = 0; j < 2; j++) S[j] = f32x2{s0[2 * j], s0[2 * j + 1]};
    }
    f32x4 rprev = {0.f, 0.f, 0.f, 0.f};
    float ykeep = 0.f;
    u32x4 la[2], lb;
    auto gload = [&](int c) {
#pragma unroll
      for (int q = 0; q < 2; q++) {
        const int idx = tid + q * NTH, step = idx >> 5, u = idx & 31;
        la[q] = *(const u32x4*)(SA + ((size_t)(gbase + c * CH + step) * 8 + h) * 256 + u * 8);
      }
      {
        const int step = tid >> 4, u = tid & 15;
        lb = *(const u32x4*)(SB + ((size_t)(gbase + c * CH + step) * 8 + h) * 128 + u * 8);
      }
    };
    gload(0);
    for (int c = 0; c < nch; c++) {
      __syncthreads();
#pragma unroll
      for (int q = 0; q < 2; q++) {
        const int idx = tid + q * NTH, step = idx >> 5, u = idx & 31, arr = u >> 3, c0 = (u & 7) * 8;
        float* d = buf + step * 384 + arr * 64 + c0;
        float f[8];
#pragma unroll
        for (int e = 0; e < 4; e++) { f[2 * e] = bflo(la[q][e]); f[2 * e + 1] = bfhi(la[q][e]); }
        if (arr == 1) {
#pragma unroll
          for (int e = 0; e < 8; e++) f[e] = 1.f - f[e];
        }
        *(float4*)d = make_float4(f[0], f[1], f[2], f[3]);
        *(float4*)(d + 4) = make_float4(f[4], f[5], f[6], f[7]);
      }
      {
        const int step = tid >> 4, u = tid & 15, arr = u >> 3, c0 = (u & 7) * 8;
        float* d = buf + step * 384 + (4 + arr) * 64 + c0;
        *(float4*)d = make_float4(bflo(lb[0]), bfhi(lb[0]), bflo(lb[1]), bfhi(lb[1]));
        *(float4*)(d + 4) = make_float4(bflo(lb[2]), bfhi(lb[2]), bflo(lb[3]), bfhi(lb[3]));
      }
      __syncthreads();
      if (c + 1 < nch) gload(c + 1);
      if (active) {
        ScanOps A0, A1, B0, B1;
        scan_ld(A0, buf, j0, row);
        scan_ld(A1, buf + 384, j0, row);
#pragma unroll 1
        for (int s = 0; s < CH; s += 4) {
          scan_ld(B0, buf + (s + 2) * 384, j0, row);
          scan_ld(B1, buf + (s + 3) * 384, j0, row);
          SCHED;
          {
            const int g0 = c * CH + s;
            const float y0 = scan_step(S, A0, rprev);
            ykeep = ((lane & 15) == ((g0 - 1) & 15)) ? y0 : ykeep;
            if ((g0 & 15) == 0 && g0 > 0)
              p.Y[(size_t)(gbase + g0 - 16 + (lane & 15)) * 512 + h * 64 + row] = f2bf(ykeep);
            const float y1 = scan_step(S, A1, rprev);
            ykeep = ((lane & 15) == (g0 & 15)) ? y1 : ykeep;
          }
          SCHED;
          const int sn = (s + 4 < CH) ? s + 4 : s;
          scan_ld(A0, buf + sn * 384, j0, row);
          scan_ld(A1, buf + (sn + 1) * 384, j0, row);
          SCHED;
          {
            const int g0 = c * CH + s;
            const float y2 = scan_step(S, B0, rprev);
            ykeep = ((lane & 15) == ((g0 + 1) & 15)) ? y2 : ykeep;
            const float y3 = scan_step(S, B1, rprev);
            ykeep = ((lane & 15) == ((g0 + 2) & 15)) ? y3 : ykeep;
          }
          SCHED;
        }
      }
    }
    if (active) {
      const f32x2 yy = S[0] * LO2(rprev) + S[1] * HI2(rprev);
      const float yl = red16(yy[0] + yy[1]);
      ykeep = ((lane & 15) == 15) ? yl : ykeep;
      p.Y[(size_t)(gbase + nch * CH - 16 + (lane & 15)) * 512 + h * 64 + row] = f2bf(ykeep);
    }
    if (active) {
      float* so = p.out + (type ? OFF_WKV_S : OFF_WKV_P) + ((size_t)(b * 8 + h) * 64 + row) * 64 + j0;
      *(float4*)so = make_float4(S[0][0], S[0][1], S[1][0], S[1][1]);
    }
  }
}

__device__ void ph_attn(const Params& p, int bid, int nb, bool dry = false) {
  const int tid = otid(), lane = tid & 63, wv = tid >> 6, fr = lane & 15, fq = lane >> 4;
  u16* Ks = (u16*)dsm;
  u16* Vt = Ks + 192 * 72;
  for (int item = bid; item < 2080; item += nb) {
    const int kvh = item & 1, r = item >> 1;
    const bool samp = r >= 1024;
    const int b = samp ? r - 1024 : r >> 6, c = samp ? 0 : (r & 63);
    const int gq0 = samp ? TP + b * 64 : b * 4096 + c * 64;
    __syncthreads();
#pragma unroll
    for (int q = 0; q < 3; q++) {
      const int idx = tid + q * NTH, j = idx >> 3, d0 = (idx & 7) * 8;
      u32x4 kq = {0u, 0u, 0u, 0u}, vq = {0u, 0u, 0u, 0u};
      if (!samp) {
        const int tok = (c - 2) * 64 + j;
        if (tok >= 0) {
          const u16* src = p.P + (size_t)(b * 4096 + tok) * INC + 2304 + kvh * 64 + d0;
          kq = *(const u32x4*)src;
          vq = *(const u32x4*)(src + 128);
        }
      } else if (j < 128) {
        const float4* ck = (const float4*)(p.cache_k + ((size_t)(b * 128 + j) * 2 + kvh) * 64 + d0);
        const float4* cv = (const float4*)(p.cache_v + ((size_t)(b * 128 + j) * 2 + kvh) * 64 + d0);
        const float4 k0 = ck[0], k1 = ck[1], v0 = cv[0], v1 = cv[1];
        kq = u32x4{pack2(k0.x, k0.y), pack2(k0.z, k0.w), pack2(k1.x, k1.y), pack2(k1.z, k1.w)};
        vq = u32x4{pack2(v0.x, v0.y), pack2(v0.z, v0.w), pack2(v1.x, v1.y), pack2(v1.z, v1.w)};
      } else {
        const u16* src = p.P + (size_t)(TP + b * 64 + (j - 128)) * INC + 2304 + kvh * 64 + d0;
        kq = *(const u32x4*)src;
        vq = *(const u32x4*)(src + 128);
      }
      *(u32x4*)(Ks + j * 72 + d0) = kq;
#pragma unroll
      for (int e = 0; e < 4; e++) {
        Vt[(d0 + 2 * e) * 196 + j] = (u16)(vq[e] & 0xffffu);
        Vt[(d0 + 2 * e + 1) * 196 + j] = (u16)(vq[e] >> 16);
      }
    }
    __syncthreads();
    const int qh = kvh * 4 + (wv & 3);
    const float slope = exp2f(-(float)(qh + 1)), sink = p.sinks[qh];
#pragma unroll 1
    for (int ps = 0; ps < 2; ps++) {
      const int q0 = (wv >> 2) * 32 + ps * 16;
      const int tq = q0 + fr;
      const u16* qp = p.P + (size_t)(gq0 + tq) * INC + 1792 + qh * 64 + fq * 8;
      const bf16x8 qf0 = *(const bf16x8*)(qp), qf1 = *(const bf16x8*)(qp + 32);
      f32x4 sc[12];
#pragma unroll
      for (int kt = 0; kt < 12; kt++) {
        sc[kt] = f32x4{0.f, 0.f, 0.f, 0.f};
        const bf16x8 a0 = *(const bf16x8*)(Ks + (kt * 16 + fr) * 72 + fq * 8);
        const bf16x8 a1 = *(const bf16x8*)(Ks + (kt * 16 + fr) * 72 + 32 + fq * 8);
        sc[kt] = MFMA16(a0, qf0, sc[kt]);
        sc[kt] = MFMA16(a1, qf1, sc[kt]);
        if ((kt & 3) == 3) SCHED;
      }
      float mx = -3e38f;
#pragma unroll
      for (int kt = 0; kt < 12; kt++)
#pragma unroll
        for (int j = 0; j < 4; j++) {
          const int key = kt * 16 + fq * 4 + j;
          float s = sc[kt][j] * 0.125f - slope * fabsf((float)(128 + tq - key));
          if (!samp && (c - 2) * 64 + key < 0) s = -1e30f;
          sc[kt][j] = s;
          mx = fmaxf(mx, s);
        }
      mx = fmaxf(mx, __shfl_xor(mx, 16));
      mx = fmaxf(mx, __shfl_xor(mx, 32));
      mx = fmaxf(mx, sink);
      float sum = 0.f;
#pragma unroll
      for (int kt = 0; kt < 12; kt++)
#pragma unroll
        for (int j = 0; j < 4; j++) {
          const float e = __expf(sc[kt][j] - mx);
          sc[kt][j] = e;
          sum += e;
        }
      sum += __shfl_xor(sum, 16);
      sum += __shfl_xor(sum, 32);
      sum += __expf(sink - mx);
      const float inv = 1.f / sum;
      f32x4 o[4];
#pragma unroll
      for (int dt = 0; dt < 4; dt++) o[dt] = f32x4{0.f, 0.f, 0.f, 0.f};
#pragma unroll
      for (int t2 = 0; t2 < 6; t2++) {
        const u32x4 pw = {pack2(sc[2 * t2][0] * inv, sc[2 * t2][1] * inv), pack2(sc[2 * t2][2] * inv, sc[2 * t2][3] * inv),
                          pack2(sc[2 * t2 + 1][0] * inv, sc[2 * t2 + 1][1] * inv),
                          pack2(sc[2 * t2 + 1][2] * inv, sc[2 * t2 + 1][3] * inv)};
        const bf16x8 pa = __builtin_bit_cast(bf16x8, pw);
#pragma unroll
        for (int dt = 0; dt < 4; dt++) {
          const u16* vp = Vt + (dt * 16 + fr) * 196 + t2 * 32 + fq * 4;
          const uint2 v0 = *(const uint2*)vp, v1 = *(const uint2*)(vp + 16);
          const bf16x8 vb = __builtin_bit_cast(bf16x8, u32x4{v0.x, v0.y, v1.x, v1.y});
          o[dt] = MFMA16(pa, vb, o[dt]);
        }
        SCHED;
      }
#pragma unroll
      for (int dt = 0; dt < 4; dt++)
#pragma unroll
        for (int j = 0; j < 4; j++)
          p.OATT[(size_t)(gq0 + q0 + fq * 4 + j) * 512 + qh * 64 + dt * 16 + fr] = f2bf(o[dt][j]);
    }
  }
  const u16* SA = (const u16*)(p.out);
  const u16* SB = p.H;
  for (int it4 = bid * NW + wv; it4 < T * 2; it4 += nb * NW) {
    const int it = it4 * 4 + (lane >> 4), c0 = (lane & 15) * 4;
    const int g = it >> 3, h = it & 7, col = h * 64 + c0;
    const uint2 yw = *(const uint2*)(p.Y + (size_t)g * 512 + col);
    const uint2 rw = *(const uint2*)(SA + (size_t)it * 256 + c0), kw = *(const uint2*)(SA + (size_t)it * 256 + 128 + c0);
    const uint2 vw = *(const uint2*)(SB + (size_t)it * 128 + c0), gw = *(const uint2*)(p.G + (size_t)g * 512 + col);
    const float4 lw = *(const float4*)(p.lnx_w + col), lb = *(const float4*)(p.lnx_b + col), rk = *(const float4*)(p.r_k + col);
    const float y0 = bflo(yw.x), y1 = bfhi(yw.x), y2 = bflo(yw.y), y3 = bfhi(yw.y);
    const float mean = red16((y0 + y1) + (y2 + y3)) * (1.f / 64.f);
    const float e0 = y0 - mean, e1 = y1 - mean, e2 = y2 - mean, e3 = y3 - mean;
    const float var = red16((e0 * e0 + e1 * e1) + (e2 * e2 + e3 * e3)) * (1.f / 64.f);
    const float bonus = red16((bflo(rw.x) * bflo(kw.x) * rk.x + bfhi(rw.x) * bfhi(kw.x) * rk.y) +
                              (bflo(rw.y) * bflo(kw.y) * rk.z + bfhi(rw.y) * bfhi(kw.y) * rk.w));
    const float rsd = rsqrtf(var + 64e-5f);
    const float o0 = (e0 * rsd * lw.x + lb.x + bonus * bflo(vw.x)) * bflo(gw.x);
    const float o1 = (e1 * rsd * lw.y + lb.y + bonus * bfhi(vw.x)) * bfhi(gw.x);
    const float o2 = (e2 * rsd * lw.z + lb.z + bonus * bflo(vw.y)) * bflo(gw.y);
    const float o3 = (e3 * rsd * lw.w + lb.w + bonus * bfhi(vw.y)) * bfhi(gw.y);
    if (!dry || o0 == 123.456f) *(uint2*)(p.Y + (size_t)g * 512 + col) = make_uint2(pack2(o0, o1), pack2(o2, o3));
  }
}

DI void ph_gemm2(const Params& p, int bid, int nb, int sm = -1) {
  const int tid_ = otid();
  u16* MG = p.H;
  const u16* Cs = (const u16*)dsm;
  const int nM = 256, nN = 4;
  for (int round = 0;; ++round) {
    int pm, pn;
    if (sm >= 0) { if (round >= 4) break; pm = 256 + sm; pn = round; }
    else if (!tile_of(round, bid, nb, nM, nN, pm, pn)) break;
    f32x4 acc[2][2][4][2];
#pragma unroll 1
    for (int br = 0; br < 2; br++) {
      gemm256<512>(br ? p.OATT : p.Y, p.WbT + (size_t)br * 1024 * 512, pm * 256, pn * 256, acc);
      acc_to_lds(acc);
#pragma unroll 2
      for (int it = 0; it < 16; it++) {
        const int id = it * NTH + tid_, rl = id >> 5, c8 = (id & 31) * 8;
        const int row = pm * 256 + rl, col = pn * 256 + c8;
        const u32x4 v = *(const u32x4*)(Cs + rl * CS_LD + c8);
        const u32x4 gw = *(const u32x4*)(p.P + (size_t)row * INC + 2560 + br * 1024 + col);
        u32x4 prev = {0u, 0u, 0u, 0u};
        if (br) prev = *(const u32x4*)(MG + (size_t)row * 1024 + col);
        u32x4 o;
#pragma unroll
        for (int e = 0; e < 4; e++) {
          const float r0 = bflo(prev[e]) + sigmoidf_(bflo(gw[e])) * bflo(v[e]);
          const float r1 = bfhi(prev[e]) + sigmoidf_(bfhi(gw[e])) * bfhi(v[e]);
          o[e] = pack2(r0, r1);
        }
        *(u32x4*)(MG + (size_t)row * 1024 + col) = o;
      }
    }
  }
}

DI void ph_gemm3(const Params& p, int bid, int nb, int sm = -1) {
  const int tid_ = otid();
  const u16* MG = p.H;
  const u16* Cs = (const u16*)dsm;
  const int nM = 256, nN = 4;
  for (int round = 0;; ++round) {
    int pm, pn;
    if (sm >= 0) { if (round >= 4) break; pm = 256 + sm; pn = round; }
    else if (!tile_of(round, bid, nb, nM, nN, pm, pn)) break;
    f32x4 acc[2][2][4][2];
    gemm256<1024>(MG, p.WoutT, pm * 256, pn * 256, acc);
    acc_to_lds(acc);
#pragma unroll 2
    for (int it = 0; it < 16; it++) {
      const int id = it * NTH + tid_, rl = id >> 5, c8 = (id & 31) * 8;
      const int row = pm * 256 + rl, col = pn * 256 + c8;
      const u32x4 v = *(const u32x4*)(Cs + rl * CS_LD + c8);
      const float* xr = xrow(p, row) + col;
      const float4 x0 = *(const float4*)xr, x1 = *(const float4*)(xr + 4);
      *(u32x4*)(p.P + (size_t)row * 1024 + col) =
          u32x4{pack2(x0.x + bflo(v[0]), x0.y + bfhi(v[0])), pack2(x0.z + bflo(v[1]), x0.w + bfhi(v[1])),
                pack2(x1.x + bflo(v[2]), x1.y + bfhi(v[2])), pack2(x1.z + bflo(v[3]), x1.w + bfhi(v[3]))};
    }
  }
}

DI void ph_norm2(const Params& p, int row0, int row1, int wstride) {
  const int tid = otid(), lane = tid & 63;
  for (int row = row0; row < row1; row += wstride) {
    const uint2* x = (const uint2*)(p.P + (size_t)row * 1024);
    float4 v[4];
    float ss = 0.f;
#pragma unroll
    for (int i = 0; i < 4; i++) {
      const uint2 xw = x[lane + i * 64];
      v[i] = make_float4(bflo(xw.x), bfhi(xw.x), bflo(xw.y), bfhi(xw.y));
      ss += v[i].x * v[i].x + v[i].y * v[i].y + v[i].z * v[i].z + v[i].w * v[i].w;
    }
    ss = wave_sum(ss);
    const float rs = rsqrtf(ss * (1.f / 1024.f) + 1e-6f);
    u16* hr = p.H + (size_t)row * 1024;
    float4 y[4];
    float am = 0.f;
#pragma unroll
    for (int i = 0; i < 4; i++) {
      const float4 g = ((const float4*)p.norm2_g)[lane + i * 64];
      y[i] = make_float4(v[i].x * rs * g.x, v[i].y * rs * g.y, v[i].z * rs * g.z, v[i].w * rs * g.w);
      ((uint2*)hr)[lane + i * 64] = make_uint2(pack2(y[i].x, y[i].y), pack2(y[i].z, y[i].w));
      am = fmaxf(am, fmaxf(fmaxf(fabsf(y[i].x), fabsf(y[i].y)), fmaxf(fabsf(y[i].z), fabsf(y[i].w))));
    }
    am = fmaxf(wave_max(am), 1e-30f);
    const float sc = 240.f / am;
    if (lane == 0) p.SH[row] = am * (1.f / 240.f);
    u32* h8 = (u32*)((unsigned char*)p.Y + (size_t)row * 1024);
#pragma unroll
    for (int i = 0; i < 4; i++) h8[lane + i * 64] = q4(y[i].x, y[i].y, y[i].z, y[i].w, sc);
  }
}

DI void ins16(float (&l)[16], float x) {
#pragma unroll
  for (int i = 0; i < 16; i++) {
    const float hi = fmaxf(l[i], x);
    x = fminf(l[i], x);
    l[i] = hi;
  }
}


DI void ce_desc(float& a, float& b) { const float hi = fmaxf(a, b), lo = fminf(a, b); a = hi; b = lo; }
DI void bitonic_sort16_desc(float (&a)[16]) {
#pragma unroll
  for (int k = 2; k <= 16; k <<= 1)
#pragma unroll
    for (int j = k >> 1; j > 0; j >>= 1)
#pragma unroll
      for (int i = 0; i < 16; i++) {
        const int l = i ^ j;
        if (l > i) {
          if ((i & k) == 0) ce_desc(a[i], a[l]);
          else ce_desc(a[l], a[i]);
        }
      }
}
DI void bitonic_merge16_desc(float (&a)[16]) {
#pragma unroll
  for (int j = 8; j > 0; j >>= 1)
#pragma unroll
    for (int i = 0; i < 16; i++) {
      const int l = i ^ j;
      if (l > i) ce_desc(a[i], a[l]);
    }
}
DI void top16_merge(float (&a)[16], const float (&b)[16]) {
#pragma unroll
  for (int i = 0; i < 16; i++) a[i] = fmaxf(a[i], b[15 - i]);
  bitonic_merge16_desc(a);
}

DI void ph_peerq(const Params& p, int bid, int nb, int sm = -1) {
  GT_VARS
  const int l31 = lane & 31, kh = lane >> 5;
  u16* Qs = (u16*)dsm;
  unsigned char* lt = (unsigned char*)(dsm + 135168 + wid * 1024);
  int* IDX = (int*)p.G;
  float* GATE = (float*)p.OATT;
  const int nM = 256, nN = 4;
  for (int round = 0;; ++round) {
    int pm, pn;
    if (sm >= 0) { if (round >= 4) break; pm = 256 + sm; pn = round; }
    else if (!tile_of(round, bid, nb, nM, nN, pm, pn)) break;
    {
      f32x4 acc[2][2][4][2];
      gemm256<1024>(p.H, p.WqT, pm * 256, pn * 256, acc);
      acc_to_lds(acc);
    }
#pragma unroll 1
    for (int hh = 0; hh < 2; hh++) {
      const int hp = pn * 2 + hh;
      float l1[16], l2[16];
#pragma unroll
      for (int i = 0; i < 16; i++) { l1[i] = 0.f; l2[i] = 0.f; }
#pragma unroll 1
      for (int pp = 0; pp < 2; pp++) {
        f32x16 sc[4];
#pragma unroll
        for (int m4 = 0; m4 < 4; m4++) {
#pragma unroll
          for (int i = 0; i < 16; i++) sc[m4][i] = 0.f;
#pragma unroll
          for (int kk = 0; kk < 4; kk++) {
            const bf16x8 a = *(const bf16x8*)(p.SK + (size_t)(pp * 128 + m4 * 32 + l31) * 64 + kk * 16 + kh * 8);
            const bf16x8 bq = *(const bf16x8*)(Qs + (wid * 32 + l31) * 264 + hh * 128 + pp * 64 + kk * 16 + kh * 8);
            sc[m4] = MFMA32(a, bq, sc[m4]);
          }
        }
        float l[16], q1[16], q2[16], q3[16];
#pragma unroll
        for (int i = 0; i < 16; i++) {
          const u32 nb_ = (i >> 2) * 8 + kh * 4 + (i & 3);
          l[i] = __uint_as_float((__float_as_uint(sc[0][i]) & ~0x7Fu) | nb_);
          q1[i] = __uint_as_float((__float_as_uint(sc[1][i]) & ~0x7Fu) | (32u + nb_));
          q2[i] = __uint_as_float((__float_as_uint(sc[2][i]) & ~0x7Fu) | (64u + nb_));
          q3[i] = __uint_as_float((__float_as_uint(sc[3][i]) & ~0x7Fu) | (96u + nb_));
        }
        bitonic_sort16_desc(l);
        bitonic_sort16_desc(q1);
        bitonic_sort16_desc(q2);
        bitonic_sort16_desc(q3);
        top16_merge(l, q1);
        top16_merge(q2, q3);
        top16_merge(l, q2);
        float o[16];
#pragma unroll
        for (int i = 0; i < 16; i++) o[i] = __shfl_xor(l[i], 32);
        top16_merge(l, o);
#pragma unroll
        for (int i = 0; i < 16; i++) {
          l1[i] = pp == 0 ? l[i] : l1[i];
          l2[i] = pp == 0 ? l2[i] : l[i];
        }
      }
      if (kh == 0) {
        u32 w[8];
#pragma unroll
        for (int q = 0; q < 4; q++) {
          w[q] = (__float_as_uint(l1[4 * q]) & 0x7F) | ((__float_as_uint(l1[4 * q + 1]) & 0x7F) << 8) |
                 ((__float_as_uint(l1[4 * q + 2]) & 0x7F) << 16) | ((__float_as_uint(l1[4 * q + 3]) & 0x7F) << 24);
          w[4 + q] = (__float_as_uint(l2[4 * q]) & 0x7F) | ((__float_as_uint(l2[4 * q + 1]) & 0x7F) << 8) |
                     ((__float_as_uint(l2[4 * q + 2]) & 0x7F) << 16) | ((__float_as_uint(l2[4 * q + 3]) & 0x7F) << 24);
        }
        *(uint4*)(lt + l31 * 32) = make_uint4(w[0], w[1], w[2], w[3]);
        *(uint4*)(lt + l31 * 32 + 16) = make_uint4(w[4], w[5], w[6], w[7]);
      }
      float v1[16], v2[16];
#pragma unroll
      for (int i = 0; i < 16; i++) {
        v1[i] = __uint_as_float(__float_as_uint(l1[i]) & ~0x7Fu);
        v2[i] = __uint_as_float(__float_as_uint(l2[i]) & ~0x7Fu);
      }
#define CAND(a, b) __uint_as_float((__float_as_uint(v1[a] + v2[b]) & ~0xFFu) | (u32)((a) * 16 + (b)))
      float l3[16], y1[16], y2[16];
#pragma unroll
      for (int b = 0; b < 16; b++) l3[b] = CAND(0, b);
#pragma unroll
      for (int b = 0; b < 8; b++) y1[b] = CAND(1, b);
#pragma unroll
      for (int b = 0; b < 5; b++) y1[8 + b] = CAND(2, b);
#pragma unroll
      for (int b = 0; b < 3; b++) y1[13 + b] = CAND(4, b);
#pragma unroll
      for (int b = 0; b < 4; b++) y2[b] = CAND(3, b);
      y2[4] = CAND(5, 0); y2[5] = CAND(5, 1); y2[6] = CAND(6, 0); y2[7] = CAND(6, 1); y2[8] = CAND(7, 0); y2[9] = CAND(7, 1);
      y2[10] = CAND(8, 0); y2[11] = CAND(9, 0); y2[12] = CAND(10, 0); y2[13] = CAND(11, 0); y2[14] = CAND(12, 0); y2[15] = CAND(13, 0);
      bitonic_sort16_desc(y1);
      bitonic_sort16_desc(y2);
      top16_merge(l3, y1);
      top16_merge(l3, y2);
      ins16(l3, CAND(14, 0));
      ins16(l3, CAND(15, 0));
#undef CAND
      __builtin_amdgcn_fence(__ATOMIC_RELEASE, "workgroup");
      __builtin_amdgcn_wave_barrier();
      if (kh == 0) {
        const int g = pm * 256 + wid * 32 + l31;
        float ev[16];
        int ei[16];
        float sum = 0.f;
        const float mxv = __uint_as_float(__float_as_uint(l3[0]) & ~0xFFu);
#pragma unroll
        for (int k = 0; k < 16; k++) {
          const u32 bits = __float_as_uint(l3[k]);
          const u32 pos = bits & 0xFF;
          ev[k] = __expf(__uint_as_float(bits & ~0xFFu) - mxv);
          sum += ev[k];
          ei[k] = (int)lt[l31 * 32 + (pos >> 4)] * 128 + (int)lt[l31 * 32 + 16 + (pos & 15)];
        }
        const float inv = 1.f / sum;
        int4* ip = (int4*)(IDX + (size_t)g * 128 + hp * 16);
        float4* gp = (float4*)(GATE + (size_t)g * 128 + hp * 16);
#pragma unroll
        for (int q = 0; q < 4; q++) {
          ip[q] = make_int4(ei[4 * q], ei[4 * q + 1], ei[4 * q + 2], ei[4 * q + 3]);
          gp[q] = make_float4(ev[4 * q] * inv, ev[4 * q + 1] * inv, ev[4 * q + 2] * inv, ev[4 * q + 3] * inv);
        }
      }
      __builtin_amdgcn_wave_barrier();
    }
  }
}

DI void ph_peer(const Params& p, int g0_, int g1_, int gstride, bool dry = false) {
  const int tid = otid(), lane = tid & 63, wv = tid >> 6;
  constexpr int ST = 1104;
  char* wb = dsm + wv * (16 * ST + 2048);
  unsigned char* stg = (unsigned char*)wb;
  unsigned char* hs = stg + 16 * ST;
  float* acts = (float*)(hs + 1024);
  int* idxs = (int*)(hs + 1536);
  const int gr = lane >> 3, gc = lane & 7;
  const int* IDX = (const int*)p.G;
  const float* GATE = (const float*)p.OATT;
  const unsigned char* H8 = (const unsigned char*)p.Y;
  const int n = lane & 15, quad = lane >> 4;
  for (int g = g0_; g < g1_; g += gstride) {
    *(u32x4*)(hs + lane * 16) = *(const u32x4*)(H8 + (size_t)g * 1024 + lane * 16);
    idxs[lane] = IDX[(size_t)g * 128 + lane];
    idxs[lane + 64] = IDX[(size_t)g * 128 + 64 + lane];
    const float shv = p.SH[g];
    __builtin_amdgcn_fence(__ATOMIC_RELEASE, "workgroup");
    __builtin_amdgcn_wave_barrier();
    {
      u32x4 ring[16];
      {
        const unsigned char* ua = p.U8 + (size_t)idxs[gr] * 1024 + gc * 16;
        const unsigned char* ub = p.U8 + (size_t)idxs[8 + gr] * 1024 + gc * 16;
#pragma unroll
        for (int i = 0; i < 8; i++) { ring[i] = *(const u32x4*)(ua + i * 128); ring[8 + i] = *(const u32x4*)(ub + i * 128); }
      }
#pragma unroll 1
      for (int grp = 0; grp < 8; grp++) {
        const int gn = grp < 7 ? grp + 1 : grp;
        const unsigned char* ua = p.U8 + (size_t)idxs[gn * 16 + gr] * 1024 + gc * 16;
        const unsigned char* ub = p.U8 + (size_t)idxs[gn * 16 + 8 + gr] * 1024 + gc * 16;
        const float4 gt = *(const float4*)(GATE + (size_t)g * 128 + grp * 16 + quad * 4);
        const int4 ee = *(const int4*)(idxs + grp * 16 + quad * 4);
        const float su0 = p.SU[ee.x], su1 = p.SU[ee.y], su2 = p.SU[ee.z], su3 = p.SU[ee.w];
        const float sv0 = p.SV[ee.x], sv1 = p.SV[ee.y], sv2 = p.SV[ee.z], sv3 = p.SV[ee.w];
#pragma unroll
        for (int i = 0; i < 8; i++) {
          *(u32x4*)(stg + gr * ST + i * 128 + gc * 16) = ring[i];
          *(u32x4*)(stg + (8 + gr) * ST + i * 128 + gc * 16) = ring[8 + i];
          if (grp < 7) { ring[i] = *(const u32x4*)(ua + i * 128); ring[8 + i] = *(const u32x4*)(ub + i * 128); }
        }
        __builtin_amdgcn_fence(__ATOMIC_RELEASE, "workgroup");
        __builtin_amdgcn_wave_barrier();
        f32x4 acc = {0.f, 0.f, 0.f, 0.f};
#pragma unroll
        for (int st = 0; st < 16; st++) {
          const u32x4 ua4 = *(const u32x4*)(stg + n * ST + st * 64 + quad * 16);
          const u32x4 hb = *(const u32x4*)(hs + st * 64 + quad * 16);
          const long a0 = (long)(((unsigned long)ua4[1] << 32) | ua4[0]);
          const long a1 = (long)(((unsigned long)ua4[3] << 32) | ua4[2]);
          const long b0 = (long)(((unsigned long)hb[1] << 32) | hb[0]);
          const long b1 = (long)(((unsigned long)hb[3] << 32) | hb[2]);
          acc = __builtin_amdgcn_mfma_f32_16x16x32_fp8_fp8(a0, b0, acc, 0, 0, 0);
          acc = __builtin_amdgcn_mfma_f32_16x16x32_fp8_fp8(a1, b1, acc, 0, 0, 0);
        }
        __builtin_amdgcn_wave_barrier();
        const float d0 = acc[0] * shv * su0, d1 = acc[1] * shv * su1, d2 = acc[2] * shv * su2, d3 = acc[3] * shv * su3;
        float4 av;
        av.x = 0.5f * d0 * (1.f + erff(d0 * 0.70710678118f)) * gt.x * sv0;
        av.y = 0.5f * d1 * (1.f + erff(d1 * 0.70710678118f)) * gt.y * sv1;
        av.z = 0.5f * d2 * (1.f + erff(d2 * 0.70710678118f)) * gt.z * sv2;
        av.w = 0.5f * d3 * (1.f + erff(d3 * 0.70710678118f)) * gt.w * sv3;
        if (n == 0) *(float4*)(acts + grp * 16 + quad * 4) = av;
      }
    }
    __builtin_amdgcn_fence(__ATOMIC_RELEASE, "workgroup");
    __builtin_amdgcn_wave_barrier();
    float o[16];
#pragma unroll
    for (int j = 0; j < 16; j++) o[j] = 0.f;
    {
      u32x4 ring[16];
#pragma unroll
      for (int k = 0; k < 16; k++) ring[k] = *(const u32x4*)(p.V8 + (size_t)idxs[k] * 1024 + lane * 16);
#pragma unroll 1
      for (int kb = 0; kb < 128; kb += 16) {
        const bool more = kb < 112;
        const int kn = more ? kb + 16 : kb;
#pragma unroll
        for (int j = 0; j < 16; j++) {
          const u32x4 vq = ring[j];
          if (more) ring[j] = *(const u32x4*)(p.V8 + (size_t)idxs[kn + j] * 1024 + lane * 16);
          const float a = acts[kb + j];
#pragma unroll
          for (int q = 0; q < 4; q++) {
            const f32x2 lo = __builtin_amdgcn_cvt_pk_f32_fp8((int)vq[q], false);
            const f32x2 hi = __builtin_amdgcn_cvt_pk_f32_fp8((int)vq[q], true);
            o[4 * q] += a * lo[0]; o[4 * q + 1] += a * lo[1]; o[4 * q + 2] += a * hi[0]; o[4 * q + 3] += a * hi[1];
          }
        }
      }
    }
    float* xr = p.out + (size_t)g * 1024 + lane * 16;
    float4 x[4];
    {
      const u32x4 xa = *(const u32x4*)(p.P + (size_t)g * 1024 + lane * 16), xb = *(const u32x4*)(p.P + (size_t)g * 1024 + lane * 16 + 8);
      x[0] = make_float4(bflo(xa[0]), bfhi(xa[0]), bflo(xa[1]), bfhi(xa[1]));
      x[1] = make_float4(bflo(xa[2]), bfhi(xa[2]), bflo(xa[3]), bfhi(xa[3]));
      x[2] = make_float4(bflo(xb[0]), bfhi(xb[0]), bflo(xb[1]), bfhi(xb[1]));
      x[3] = make_float4(bflo(xb[2]), bfhi(xb[2]), bflo(xb[3]), bfhi(xb[3]));
    }
    float ss = 0.f;
#pragma unroll
    for (int q = 0; q < 4; q++) {
      x[q].x += o[4 * q]; x[q].y += o[4 * q + 1]; x[q].z += o[4 * q + 2]; x[q].w += o[4 * q + 3];
      ss += x[q].x * x[q].x + x[q].y * x[q].y + x[q].z * x[q].z + x[q].w * x[q].w;
    }
    ss = wave_sum(ss);
    if (dry && ss != 123.456f) continue;
    const float rs = rsqrtf(ss * (1.f / 1024.f) + 1e-6f);
#pragma unroll
    for (int q = 0; q < 4; q++) {
      const float4 gq = *(const float4*)(p.final_g + lane * 16 + q * 4);
      *(float4*)(xr + q * 4) = make_float4(x[q].x * rs * gq.x, x[q].y * rs * gq.y, x[q].z * rs * gq.z, x[q].w * rs * gq.w);
    }
  }
}

#define XB_TMO      128
#define XB_XCNT(j)  (256  + 64 * (j))
#define XB_XSUB(j)  (1280 + 64 * (j))
#define XB_XGEN(j)  (2304 + 64 * (j))
#define XB_TOP      3328
#define XB_TOPGEN   3392
#define XCD_BAR_WORDS 3456
#define XB_SPIN_CAP (1u << 18)
#define LAS __attribute__((address_space(3)))
DI unsigned xb_ld(unsigned* p) { return __hip_atomic_load(p, __ATOMIC_RELAXED, __HIP_MEMORY_SCOPE_AGENT); }
DI unsigned xb_add(unsigned* p, unsigned v) { return __hip_atomic_fetch_add(p, v, __ATOMIC_RELAXED, __HIP_MEMORY_SCOPE_AGENT); }
DI unsigned xb_xcc_id() { return (unsigned)__builtin_amdgcn_s_getreg((3 << 11) | 20) & 0xFu; }
#define XB_SPIN(cond, bar) do { unsigned _sp = 0; while (cond) { __builtin_amdgcn_s_sleep(1); \
    if ((++_sp & 255u) == 0u) { if (xb_ld(&(bar)[XB_TMO])) break; if (_sp > XB_SPIN_CAP) { atomicAdd(&(bar)[XB_TMO], 1u); break; } } } } while (0)
struct XcdBarrier { unsigned* bar; unsigned x; volatile LAS unsigned* st; };
DI XcdBarrier xcd_barrier_post(unsigned* bar, volatile LAS unsigned* st) {
  XcdBarrier b; b.bar = bar; b.x = xb_xcc_id(); b.st = st;
  if (threadIdx.x == 0) (void)xb_add(&bar[XB_XCNT(b.x)], 1u);
  return b;
}
DI void xcd_barrier_complete(unsigned* bar, unsigned x, unsigned& nloc, unsigned& nx) {
  const unsigned G = gridDim.x * gridDim.y * gridDim.z;
  unsigned sum, cnt, mine, sp = 0u;
  for (;;) {
    sum = 0u; cnt = 0u; mine = 0u;
#pragma unroll
    for (unsigned j = 0; j < 16; ++j) { const unsigned c = xb_ld(&bar[XB_XCNT(j)]); sum += c; cnt += (c > 0u) ? 1u : 0u; mine = (j == x) ? c : mine; }
    if (sum == G) break;
    __builtin_amdgcn_s_sleep(1);
    if ((++sp & 255u) == 0u) { if (xb_ld(&bar[XB_TMO])) break; if (sp > XB_SPIN_CAP) { atomicAdd(&bar[XB_TMO], 1u); break; } }
  }
  nloc = mine > 0u ? mine : 1u; nx = cnt > 0u ? cnt : 1u;
}
DI void xcd_barrier(const XcdBarrier& b) {
  asm volatile("s_waitcnt vmcnt(0)" ::: "memory");
  __syncthreads();
  if (threadIdx.x == 0) {
    unsigned* bar = b.bar;
    __builtin_amdgcn_s_waitcnt(0);
    unsigned nloc = b.st[0], nx = b.st[1];
    if (nloc == 0u) { xcd_barrier_complete(bar, b.x, nloc, nx); b.st[0] = nloc; b.st[1] = nx; }
    const unsigned old = xb_add(&bar[XB_XSUB(b.x)], 1u);
    const unsigned gen = old / nloc;
    if (old + 1u == (gen + 1u) * nloc) {
      __builtin_amdgcn_fence(__ATOMIC_RELEASE, "agent");
      asm volatile("s_waitcnt vmcnt(0)" ::: "memory");
      const unsigned og = xb_add(&bar[XB_TOP], 1u);
      const unsigned tg = og / nx;
      if (og + 1u == (tg + 1u) * nx) xb_add(&bar[XB_TOPGEN], 1u);
      else XB_SPIN(xb_ld(&bar[XB_TOPGEN]) == tg, bar);
      __builtin_amdgcn_fence(__ATOMIC_ACQUIRE, "agent");
      xb_add(&bar[XB_XGEN(b.x)], 1u);
      asm volatile("s_waitcnt vmcnt(0)" ::: "memory");
    } else {
      XB_SPIN(xb_ld(&bar[XB_XGEN(b.x)]) == gen, bar);
      __builtin_amdgcn_fence(__ATOMIC_ACQUIRE, "agent");
      asm volatile("s_waitcnt vmcnt(0)" ::: "memory");
    }
  }
  __syncthreads();
}

__global__ void __launch_bounds__(512) mega_kernel(Params p) {
  cg::grid_group grid = cg::this_grid();
  const int bid = blockIdx.x, nb = gridDim.x;
  __shared__ uint4 xb_words;
  if (threadIdx.x == 0) xb_words = make_uint4(0u, 0u, 0u, 0u);
  __syncthreads();
  const XcdBarrier xb = xcd_barrier_post(p.bar, (volatile LAS unsigned*)&xb_words);
  if (ON(0)) ph_prep(p, bid, nb);
  xcd_barrier(xb);
  if (nb == 0x7fffffff) grid.sync();
  if (ON(1)) ph_gemm1(p, bid, nb);
  xcd_barrier(xb);
  if (REP == 1) { ph_gemm1(p, bid, nb); xcd_barrier(xb); }
  if (ON(2)) ph_rwprep(p, bid, nb);
  xcd_barrier(xb);
  if (REP == 2) { ph_rwprep(p, bid, nb); xcd_barrier(xb); }
  if (ON(3)) ph_scan(p, bid, nb);
  xcd_barrier(xb);
  if (REP == 3) { ph_scan(p, bid, nb); xcd_barrier(xb); }
  if (REP == 4) { ph_attn(p, bid, nb, true); xcd_barrier(xb); }
  if (ON(4)) ph_attn(p, bid, nb);
  xcd_barrier(xb);
  if (ON(5)) ph_gemm2(p, bid, nb);
  xcd_barrier(xb);
  if (ON(6)) ph_gemm3(p, bid, nb);
  xcd_barrier(xb);
  if (ON(7)) ph_norm2(p, bid * NW + (otid() >> 6), TP, nb * NW);
  xcd_barrier(xb);
  if (ON(8)) ph_peerq(p, bid, nb);
  xcd_barrier(xb);
  if (ON(9)) {
    if (bid < 4) {
      const int wv_ = otid() >> 6;
      ph_gemm2(p, bid, nb, bid);
      __builtin_amdgcn_fence(__ATOMIC_RELEASE, "agent"); __syncthreads(); __builtin_amdgcn_fence(__ATOMIC_ACQUIRE, "agent");
      ph_gemm3(p, bid, nb, bid);
      __builtin_amdgcn_fence(__ATOMIC_RELEASE, "agent"); __syncthreads(); __builtin_amdgcn_fence(__ATOMIC_ACQUIRE, "agent");
      ph_norm2(p, (256 + bid) * 256 + wv_, (256 + bid) * 256 + 256, NW);
      __builtin_amdgcn_fence(__ATOMIC_RELEASE, "agent"); __syncthreads(); __builtin_amdgcn_fence(__ATOMIC_ACQUIRE, "agent");
      ph_peerq(p, bid, nb, bid);
      asm volatile("s_waitcnt vmcnt(0)" ::: "memory");
      __syncthreads();
      if (threadIdx.x == 0) {
        __builtin_amdgcn_fence(__ATOMIC_RELEASE, "agent");
        asm volatile("s_waitcnt vmcnt(0)" ::: "memory");
        (void)xb_add(&p.bar[0], 1u);
        XB_SPIN(xb_ld(&p.bar[0]) < 4u, p.bar);
        __builtin_amdgcn_fence(__ATOMIC_ACQUIRE, "agent");
        asm volatile("s_waitcnt vmcnt(0)" ::: "memory");
      }
      __syncthreads();
      { const int s_ = 992 + bid * NW + (otid() >> 6); ph_peer(p, TP + s_, TP + s_ + 1, 1); }
    } else {
      const int wi = (bid - 4) * NW + (otid() >> 6);
      ph_peer(p, wi, TP, (nb - 4) * NW);
      if (bid - 4 >= 128) {
        if (threadIdx.x == 0) {
          XB_SPIN(xb_ld(&p.bar[0]) < 4u, p.bar);
          __builtin_amdgcn_fence(__ATOMIC_ACQUIRE, "agent");
          asm volatile("s_waitcnt vmcnt(0)" ::: "memory");
        }
        __syncthreads();
        const int s_ = wi - 1024;
        ph_peer(p, TP + s_, TP + s_ + 1, 1);
      }
    }
  }
}

extern "C" void kernel_launch(void* const* d_in, const int* in_sizes, int n_in, void* d_out, int out_size, void* d_ws,
                              size_t ws_size, hipStream_t stream) {
  Params p{};
  const float** f = (const float**)&p;
  for (int i = 0; i < 28; i++) f[i] = (const float*)d_in[i];
  p.out = (float*)d_out;
  char* w = (char*)d_ws;
  size_t off = 0;
  auto take = [&](size_t bytes) { char* r = w + off; off += (bytes + 255) & ~(size_t)255; return (u16*)r; };
  p.H = take((size_t)MP * 1024 * 2);
  p.P = take((size_t)MP * INC * 2);
  p.U8 = (unsigned char*)take((size_t)16384 * 1024);
  p.V8 = (unsigned char*)take((size_t)16384 * 1024);
  p.SU = (float*)take(16384 * 4);
  p.SV = (float*)take(16384 * 4);
  p.SH = (float*)take((size_t)T * 4);
  p.bar = (unsigned*)take((size_t)XCD_BAR_WORDS * 4);
  p.WinT = take((size_t)4608 * 1024 * 2);
  p.WbT = take((size_t)2 * 1024 * 512 * 2);
  p.WoutT = take((size_t)1024 * 1024 * 2);
  p.WqT = take((size_t)1024 * 1024 * 2);
  p.W2T = take((size_t)512 * 64 * 2);
  p.A2T = take((size_t)512 * 64 * 2);
  p.G2T = take((size_t)512 * 128 * 2);
  p.SK = take((size_t)2 * 128 * 64 * 2);
  p.Y = take((size_t)T * 512 * 2);
  p.G = take((size_t)T * 512 * 2);
  p.OATT = take((size_t)T * 512 * 2);
  static int grid_blocks = 0;
  if (!grid_blocks) {
    int dev = 0, cus = 0, per_cu = 0;
    (void)hipGetDevice(&dev);
    (void)hipDeviceGetAttribute(&cus, hipDeviceAttributeMultiprocessorCount, dev);
    (void)hipFuncSetAttribute((const void*)mega_kernel, hipFuncAttributeMaxDynamicSharedMemorySize, DYN_LDS);
    (void)hipOccupancyMaxActiveBlocksPerMultiprocessor(&per_cu, mega_kernel, NTH, DYN_LDS);
    if (per_cu > 1) per_cu = 1;
    grid_blocks = cus * per_cu;
  }
  (void)hipMemsetAsync(p.bar, 0, (size_t)XCD_BAR_WORDS * 4, stream);
  void* args[] = {&p};
  hipError_t e = hipLaunchCooperativeKernel((void*)mega_kernel, dim3(grid_blocks), dim3(NTH), args, DYN_LDS, stream);
  if (e != hipSuccess) fprintf(stderr, "cooperative launch failed: %s (grid %d)\n", hipGetErrorString(e), grid_blocks);
}
```
